# Optimizing an MI355X kernel written in HIP

```python
import jax, jax.numpy as jnp
from jax import lax
import numpy as np

D_MODEL = 1024
BATCH = 8
SEQ = 2048
DEPTH = 2

GRID_W = 64
CTX_LEN = 256
N_EVEN = (DEPTH + 1) // 2
N_ODD = DEPTH // 2

MLA_HEADS = 8
MLA_Q_RANK = 384
MLA_KV_RANK = 256
MLA_NOPE = 64
MLA_ROPE = 32
MLA_V = 64
MLA_QK = MLA_NOPE + MLA_ROPE
GQA_HEADS = 8
GQA_KV_HEADS = 2
GQA_DIM = 64
EVEN_SPLITS = (MLA_Q_RANK, MLA_KV_RANK, MLA_ROPE, GQA_HEADS * GQA_DIM,
               GQA_KV_HEADS * GQA_DIM, GQA_KV_HEADS * GQA_DIM)
EVEN_IN = sum(EVEN_SPLITS)
EVEN_MIX = MLA_HEADS * MLA_V + GQA_HEADS * GQA_DIM
MLSTM_HEADS = 8
MLSTM_QK = 64
MLSTM_V = 128
MLSTM_CONV = 3
MLSTM_CHUNK = 64
ODD_SPLITS = (2 * MLSTM_HEADS * MLSTM_QK, MLSTM_HEADS * MLSTM_V, MLSTM_HEADS * MLSTM_V, 4 * MLSTM_HEADS)
ODD_IN = sum(ODD_SPLITS)
D_FF = 2816
FFN_CONV = 3

Q_BLOCK = 128
ROPE_THETA = 10000.0
EPS = 1e-6

kernel_name = "hybrid_mla_gqa_mlstm_convffn_dit"


def rmsnorm(x, g):
    xf = x.astype(jnp.float32)
    y = xf * lax.rsqrt(jnp.mean(xf * xf, axis=-1, keepdims=True) + EPS)
    return (y * g.astype(jnp.float32)).astype(x.dtype)


def modulate(h, shift, scale):
    return h * (1 + scale) + shift


def split_cols(p, sizes):
    return jnp.split(p, np.cumsum(sizes)[:-1].tolist(), axis=-1)


def dwconv(x, w, b):
    width, T = w.shape[0], x.shape[1]
    left = (width - 1) // 2
    xp = jnp.pad(x, ((0, 0), (left, width - 1 - left), (0, 0)))
    return sum(xp[:, j:j + T] * w[j] for j in range(width)) + b


def axial_rope_tables(n_tokens, rot_dim):
    rows = n_tokens // GRID_W
    row = jnp.repeat(jnp.arange(rows), GRID_W).astype(jnp.float32)
    col = jnp.tile(jnp.arange(GRID_W), rows).astype(jnp.float32)
    n_freq = rot_dim // 4
    inv = ROPE_THETA ** (-jnp.arange(n_freq, dtype=jnp.float32) / n_freq)
    a_r, a_c = row[:, None] * inv, col[:, None] * inv
    ang = jnp.concatenate([a_r, a_r, a_c, a_c], axis=-1)
    return jnp.cos(ang), jnp.sin(ang)


def apply_rope(x, cos, sin):
    a1, a2, b1, b2 = jnp.split(x, 4, axis=-1)
    rot = jnp.concatenate([-a2, a1, -b2, b1], axis=-1)
    shape = (1, x.shape[1]) + (1,) * (x.ndim - 3) + (x.shape[-1],)
    return x * cos.reshape(shape).astype(x.dtype) + rot * sin.reshape(shape).astype(x.dtype)


def attend(q, k, v):
    B, T, G, R, dk = q.shape
    nb = T // Q_BLOCK
    scale = dk ** -0.5
    qb = jnp.moveaxis(q.reshape(B, nb, Q_BLOCK, G, R, dk), 1, 0)

    def block(qi):
        s = jnp.einsum('bqgrd,bsgd->bgrqs', qi, k).astype(jnp.float32) * scale
        p = jax.nn.softmax(s, axis=-1).astype(v.dtype)
        return jnp.einsum('bgrqs,bsgd->bqgrd', p, v)

    out = lax.map(block, qb)
    return jnp.moveaxis(out, 0, 1).reshape(B, T, G, R, v.shape[-1])


def mla_q(cq, g_qa, w_qb, g_q, rope):
    B, T, _ = cq.shape
    q = jnp.dot(rmsnorm(cq, g_qa), w_qb).reshape(B, T, MLA_HEADS, MLA_QK)
    q = rmsnorm(q, g_q)
    if rope is not None:
        q = jnp.concatenate([q[..., :MLA_NOPE], apply_rope(q[..., MLA_NOPE:], *rope)], axis=-1)
    return q[:, :, :, None, :]


def mla_kv(ckv, k_rope, g_kva, w_kvb, g_k, rope):
    B, T, _ = ckv.shape
    kv = jnp.dot(rmsnorm(ckv, g_kva), w_kvb).reshape(B, T, MLA_HEADS, MLA_NOPE + MLA_V)
    k_nope, v = kv[..., :MLA_NOPE], kv[..., MLA_NOPE:]
    k_pe = jnp.broadcast_to(k_rope[:, :, None, :], (B, T, MLA_HEADS, MLA_ROPE))
    k = rmsnorm(jnp.concatenate([k_nope, k_pe], axis=-1), g_k)
    if rope is not None:
        k = jnp.concatenate([k[..., :MLA_NOPE], apply_rope(k[..., MLA_NOPE:], *rope)], axis=-1)
    return k, v


def gqa_q(q, g_q, rope):
    B, T, _ = q.shape
    q = rmsnorm(q.reshape(B, T, GQA_HEADS, GQA_DIM), g_q)
    if rope is not None:
        q = apply_rope(q, *rope)
    return q.reshape(B, T, GQA_KV_HEADS, GQA_HEADS // GQA_KV_HEADS, GQA_DIM)


def gqa_kv(k, v, g_k, rope):
    B, T, _ = k.shape
    k = rmsnorm(k.reshape(B, T, GQA_KV_HEADS, GQA_DIM), g_k)
    if rope is not None:
        k = apply_rope(k, *rope)
    return k, v.reshape(B, T, GQA_KV_HEADS, GQA_DIM)


def even_mixer(h_lat, h_ctx, w_in, g_qa, w_qb, g_kva, w_kvb, g_mq, g_mk, g_gq, g_gk, w_out,
               rope_mla, rope_gqa, need_ctx_out):
    cq_l, ckv_l, kr_l, gq_l, gk_l, gv_l = split_cols(jnp.dot(h_lat, w_in), EVEN_SPLITS)
    cq_c, ckv_c, kr_c, gq_c, gk_c, gv_c = split_cols(jnp.dot(h_ctx, w_in), EVEN_SPLITS)
    ka_c, va_c = mla_kv(ckv_c, kr_c, g_kva, w_kvb, g_mk, None)
    ka_l, va_l = mla_kv(ckv_l, kr_l, g_kva, w_kvb, g_mk, rope_mla)
    kb_c, vb_c = gqa_kv(gk_c, gv_c, g_gk, None)
    kb_l, vb_l = gqa_kv(gk_l, gv_l, g_gk, rope_gqa)
    ka, va = jnp.concatenate([ka_c, ka_l], axis=1), jnp.concatenate([va_c, va_l], axis=1)
    kb, vb = jnp.concatenate([kb_c, kb_l], axis=1), jnp.concatenate([vb_c, vb_l], axis=1)

    def merge(o_a, o_b):
        B, T = o_a.shape[:2]
        return jnp.dot(jnp.concatenate([o_a.reshape(B, T, -1), o_b.reshape(B, T, -1)], axis=-1), w_out)

    out_lat = merge(attend(mla_q(cq_l, g_qa, w_qb, g_mq, rope_mla), ka, va),
                    attend(gqa_q(gq_l, g_gq, rope_gqa), kb, vb))
    out_ctx = None
    if need_ctx_out:
        out_ctx = merge(attend(mla_q(cq_c, g_qa, w_qb, g_mq, None), ka_c, va_c),
                        attend(gqa_q(gq_c, g_gq, None), kb_c, vb_c))
    return out_lat, out_ctx


def mlstm_inputs(h, w_in, conv_w, conv_b, gate_b):
    B, T, _ = h.shape
    qk, v, o, g = split_cols(jnp.dot(h, w_in), ODD_SPLITS)
    q, k = jnp.split(jax.nn.silu(dwconv(qk, conv_w, conv_b)), 2, axis=-1)

    def heads(t, d):
        return jnp.swapaxes(t.reshape(B, T, MLSTM_HEADS, d), 1, 2).astype(jnp.float32)

    g = (g + gate_b).astype(jnp.float32).reshape(B, T, 4, MLSTM_HEADS)
    g = jnp.transpose(g, (2, 0, 3, 1))
    gates = (g[0], jax.nn.log_sigmoid(g[1]), g[2], jax.nn.log_sigmoid(g[3]))
    return heads(q, MLSTM_QK), heads(k, MLSTM_QK) * MLSTM_QK ** -0.5, heads(v, MLSTM_V), o, gates


def mlstm_state_update(state, k, v, log_i, b):
    C, n, m = state
    b_last = b[..., -1]
    a = b_last[..., None] - b + log_i
    m_new = jnp.maximum(b_last + m, jnp.max(a, axis=-1))
    decay = jnp.exp(b_last + m - m_new)
    w = jnp.exp(a - m_new[..., None])
    C_new = decay[..., None, None] * C + jnp.einsum('bhs,bhsv,bhsd->bhvd', w, v, k)
    n_new = decay[..., None] * n + jnp.einsum('bhs,bhsd->bhd', w, k)
    return (C_new, n_new, m_new)


def mlstm_chunkwise(q, k, v, log_i, log_f, state0):
    B, H, T, dk = q.shape
    dv = v.shape[-1]
    L = MLSTM_CHUNK
    nc = T // L
    lower = jnp.tril(jnp.ones((L, L), dtype=bool))

    def chunks(t):
        return jnp.moveaxis(t.reshape((B, H, nc, L) + t.shape[3:]), 2, 0)

    def step(state, inp):
        C, n, m = state
        qc, kc, vc, ic, fc = inp
        b = jnp.cumsum(fc, axis=-1)
        logw = jnp.where(lower, b[..., :, None] - b[..., None, :] + ic[..., None, :], -jnp.inf)
        log_inter = b + m[..., None]
        m_t = jnp.maximum(log_inter, jnp.max(logw, axis=-1))
        w_inter = jnp.exp(log_inter - m_t)
        s = jnp.einsum('bhtd,bhsd->bhts', qc, kc) * jnp.exp(logw - m_t[..., None])
        num = w_inter[..., None] * jnp.einsum('bhvd,bhtd->bhtv', C, qc) + jnp.einsum('bhts,bhsv->bhtv', s, vc)
        den = w_inter * jnp.einsum('bhd,bhtd->bht', n, qc) + jnp.sum(s, axis=-1)
        h = num / jnp.maximum(jnp.abs(den), jnp.exp(-m_t))[..., None]
        return mlstm_state_update(state, kc, vc, ic, b), h

    state, h = lax.scan(step, state0, (chunks(q), chunks(k), chunks(v), chunks(log_i), chunks(log_f)))
    return jnp.moveaxis(h, 0, 2).reshape(B, H, T, dv), state


def mlstm_direction(q_l, k_l, v_l, li_l, lf_l, q_c, k_c, v_c, li_c, lf_c, need_ctx_out):
    B, H = q_l.shape[:2]
    state0 = (jnp.zeros((B, H, MLSTM_V, MLSTM_QK), jnp.float32),
              jnp.zeros((B, H, MLSTM_QK), jnp.float32),
              jnp.zeros((B, H), jnp.float32))
    if need_ctx_out:
        h_c, state_c = mlstm_chunkwise(q_c, k_c, v_c, li_c, lf_c, state0)
    else:
        h_c = None
        state_c = mlstm_state_update(state0, k_c, v_c, li_c, jnp.cumsum(lf_c, axis=-1))
    h_l, _ = mlstm_chunkwise(q_l, k_l, v_l, li_l, lf_l, state_c)
    return h_l, h_c


def odd_mixer(h_lat, h_ctx, w_in, conv_w, conv_b, gate_b, out_g, w_out, need_ctx_out):
    q_l, k_l, v_l, o_l, g_l = mlstm_inputs(h_lat, w_in, conv_w, conv_b, gate_b)
    q_c, k_c, v_c, o_c, g_c = mlstm_inputs(h_ctx, w_in, conv_w, conv_b, gate_b)

    def rev(t):
        return jnp.flip(t, axis=2)

    hf_l, hf_c = mlstm_direction(q_l, k_l, v_l, g_l[0], g_l[1], q_c, k_c, v_c, g_c[0], g_c[1], need_ctx_out)
    hb_l, hb_c = mlstm_direction(rev(q_l), rev(k_l), rev(v_l), rev(g_l[2]), rev(g_l[3]),
                                 rev(q_c), rev(k_c), rev(v_c), rev(g_c[2]), rev(g_c[3]), need_ctx_out)

    def readout(hf, hb, o):
        h = jnp.swapaxes(hf + rev(hb), 1, 2)
        B, T = h.shape[:2]
        h = rmsnorm(h, out_g).reshape(B, T, -1).astype(o.dtype)
        return jnp.dot(h * jax.nn.sigmoid(o), w_out)

    out_lat = readout(hf_l, hb_l, o_l)
    out_ctx = readout(hf_c, hb_c, o_c) if need_ctx_out else None
    return out_lat, out_ctx


def conv_ffn(h, w_up, conv_w, conv_b, w_down):
    gate, val = jnp.split(jnp.dot(h, w_up), 2, axis=-1)
    return jnp.dot(jax.nn.silu(dwconv(gate, conv_w, conv_b)) * val, w_down)


def setup_inputs(seed: int = 0) -> dict:
    key = jax.random.key(seed)
    keys = jax.random.split(key, 40)
    counter = iter(range(40))
    D = D_MODEL

    def nrm(shape, scale):
        return jax.random.normal(keys[next(counter)], shape, jnp.float32) * scale

    def gain(shape):
        return 1.0 + nrm(shape, 0.05)

    H = MLSTM_HEADS
    i_bias = nrm((N_ODD, 2, 1, H), 0.1)
    f_bias = jnp.linspace(3.0, 6.0, H, dtype=jnp.float32) + nrm((N_ODD, 2, 1, H), 0.1)
    ml_gate_b = jnp.concatenate([i_bias, f_bias], axis=2).reshape(N_ODD, 4 * H)
    return {
        'x': nrm((BATCH, SEQ, D), 1.0),
        'c': nrm((BATCH, D), 1.0),
        'ctx': nrm((BATCH, CTX_LEN, D), 1.0),
        'c_ctx': nrm((D,), 1.0),
        'ada_w': nrm((DEPTH, D, 6 * D), 0.5 * D ** -0.5),
        'ada_b': nrm((DEPTH, 6 * D), 0.02),
        'norm1_g': gain((DEPTH, D)),
        'norm2_g': gain((DEPTH, D)),
        'ffn_w_up': nrm((DEPTH, D, 2 * D_FF), D ** -0.5),
        'ffn_conv_w': nrm((DEPTH, FFN_CONV, D_FF), 0.5),
        'ffn_conv_b': nrm((DEPTH, D_FF), 0.02),
        'ffn_w_down': nrm((DEPTH, D_FF, D), D_FF ** -0.5),
        'att_w_in': nrm((N_EVEN, D, EVEN_IN), D ** -0.5),
        'mla_qa_g': gain((N_EVEN, MLA_Q_RANK)),
        'mla_w_qb': nrm((N_EVEN, MLA_Q_RANK, MLA_HEADS * MLA_QK), MLA_Q_RANK ** -0.5),
        'mla_kva_g': gain((N_EVEN, MLA_KV_RANK)),
        'mla_w_kvb': nrm((N_EVEN, MLA_KV_RANK, MLA_HEADS * (MLA_NOPE + MLA_V)), MLA_KV_RANK ** -0.5),
        'mla_q_g': gain((N_EVEN, MLA_QK)),
        'mla_k_g': gain((N_EVEN, MLA_QK)),
        'gqa_q_g': gain((N_EVEN, GQA_DIM)),
        'gqa_k_g': gain((N_EVEN, GQA_DIM)),
        'att_w_out': nrm((N_EVEN, EVEN_MIX, D), EVEN_MIX ** -0.5),
        'ml_w_in': nrm((N_ODD, D, ODD_IN), D ** -0.5),
        'ml_conv_w': nrm((N_ODD, MLSTM_CONV, 2 * H * MLSTM_QK), 0.5),
        'ml_conv_b': nrm((N_ODD, 2 * H * MLSTM_QK), 0.02),
        'ml_gate_b': ml_gate_b,
        'ml_out_g': gain((N_ODD, H, MLSTM_V)),
        'ml_w_out': nrm((N_ODD, H * MLSTM_V, D), (H * MLSTM_V) ** -0.5),
    }


def reference(x, c, ctx, c_ctx, ada_w, ada_b, norm1_g, norm2_g, ffn_w_up, ffn_conv_w, ffn_conv_b,
              ffn_w_down, att_w_in, mla_qa_g, mla_w_qb, mla_kva_g, mla_w_kvb, mla_q_g, mla_k_g,
              gqa_q_g, gqa_k_g, att_w_out, ml_w_in, ml_conv_w, ml_conv_b, ml_gate_b, ml_out_g, ml_w_out):
    n_lat = x.shape[1]
    rope_mla = axial_rope_tables(n_lat, MLA_ROPE)
    rope_gqa = axial_rope_tables(n_lat, GQA_DIM)
    for layer in range(DEPTH):
        need_ctx_out = layer < DEPTH - 1
        j = layer // 2
        mod_lat = (jnp.dot(jax.nn.silu(c), ada_w[layer]) + ada_b[layer])[:, None, :]
        mod_ctx = jnp.dot(jax.nn.silu(c_ctx), ada_w[layer]) + ada_b[layer]
        sh1, sc1, gt1, sh2, sc2, gt2 = jnp.split(mod_lat, 6, axis=-1)
        csh1, csc1, cgt1, csh2, csc2, cgt2 = jnp.split(mod_ctx, 6, axis=-1)
        h_lat = modulate(rmsnorm(x, norm1_g[layer]), sh1, sc1)
        h_ctx = modulate(rmsnorm(ctx, norm1_g[layer]), csh1, csc1)
        if layer % 2 == 0:
            out_lat, out_ctx = even_mixer(h_lat, h_ctx, att_w_in[j], mla_qa_g[j], mla_w_qb[j], mla_kva_g[j],
                                          mla_w_kvb[j], mla_q_g[j], mla_k_g[j], gqa_q_g[j], gqa_k_g[j],
                                          att_w_out[j], rope_mla, rope_gqa, need_ctx_out)
        else:
            out_lat, out_ctx = odd_mixer(h_lat, h_ctx, ml_w_in[j], ml_conv_w[j], ml_conv_b[j], ml_gate_b[j],
                                         ml_out_g[j], ml_w_out[j], need_ctx_out)
        x = x + gt1 * out_lat
        x = x + gt2 * conv_ffn(modulate(rmsnorm(x, norm2_g[layer]), sh2, sc2),
                               ffn_w_up[layer], ffn_conv_w[layer], ffn_conv_b[layer], ffn_w_down[layer])
        if need_ctx_out:
            ctx = ctx + cgt1 * out_ctx
            ctx = ctx + cgt2 * conv_ffn(modulate(rmsnorm(ctx, norm2_g[layer]), csh2, csc2),
                                       ffn_w_up[layer], ffn_conv_w[layer], ffn_conv_b[layer], ffn_w_down[layer])
    return x
```

```cpp
#include <hip/hip_runtime.h>
#include <hip/hip_cooperative_groups.h>
#include <cstdio>
namespace cg = cooperative_groups;

typedef unsigned short bf16_t;
using bf16x8 = __attribute__((ext_vector_type(8))) short;
using f32x16 = __attribute__((ext_vector_type(16))) float;
using f32x4 = __attribute__((ext_vector_type(4))) float;
#define DI __device__ __forceinline__
#define MFMA(a, b, c) __builtin_amdgcn_mfma_f32_32x32x16_bf16((a), (b), (c), 0, 0, 0)
#define MFMA16(a, b, c) __builtin_amdgcn_mfma_f32_16x16x32_bf16((a), (b), (c), 0, 0, 0)
#define LDS_BARRIER() do { asm volatile("s_waitcnt lgkmcnt(0)" ::: "memory"); __builtin_amdgcn_s_barrier(); asm volatile("" ::: "memory"); } while (0)
#define TID ((int)(threadIdx.x & 255))
#define HBI ((int)(threadIdx.x >> 8))

constexpr float EPSF = 1e-6f;
constexpr float LOG2E = 1.4426950408889634f;
constexpr int NTHREADS = 512;
constexpr int HB_SMEM = 73728;
constexpr int SMEM_ALL = 2 * HB_SMEM;
constexpr int GP = 72;
constexpr int CP = 132;
constexpr int ROWSS_OFF = 67584;

constexpr size_t OFF_WT_UP1 = 0;
constexpr size_t OFF_WT_DOWN1 = OFF_WT_UP1 + 5632ull * 1024 * 2;
constexpr size_t OFF_WT_IN1 = OFF_WT_DOWN1 + 1024ull * 2816 * 2;
constexpr size_t OFF_WT_OUT1 = OFF_WT_IN1 + 3328ull * 1024 * 2;
constexpr size_t OFF_MOD = OFF_WT_OUT1 + 1024ull * 1024 * 2;
constexpr size_t OFF_TABG = OFF_MOD + 2ull * 9 * 6144 * 4;
constexpr size_t OFF_TABM = OFF_TABG + 64 * 16 * 2 * 4;
constexpr size_t OFF_ZROW = OFF_TABM + 64 * 8 * 2 * 4;
constexpr size_t OFF_W0 = OFF_ZROW + 8192;
constexpr size_t OFF_WT_IN0 = OFF_W0;
constexpr size_t OFF_WT_QB = OFF_WT_IN0 + 1536ull * 1024 * 2;
constexpr size_t OFF_WT_KVB = OFF_WT_QB + 1024ull * 384 * 2;
constexpr size_t OFF_WT_OUT0 = OFF_WT_KVB + 1024ull * 256 * 2;
constexpr size_t OFF_WT_UP0 = OFF_WT_OUT0 + 1024ull * 1024 * 2;
constexpr size_t OFF_WT_DOWN0 = OFF_WT_UP0 + 5632ull * 1024 * 2;
constexpr size_t OFF_XRC = OFF_WT_DOWN0 + 1024ull * 2816 * 2;
constexpr size_t OFF_R = OFF_XRC + 2048ull * 1024 * 4;
constexpr size_t OFF_QG = OFF_R;
constexpr size_t OFF_KG = OFF_QG + 18432ull * 512 * 2;
constexpr size_t OFF_VGT = OFF_KG + 18432ull * 128 * 2;
constexpr size_t OFF_CQ = OFF_VGT + 18432ull * 128 * 2;
constexpr size_t OFF_CKV = OFF_CQ + 18432ull * 384 * 2;
constexpr size_t OFF_KR = OFF_CKV + 18432ull * 256 * 2;
constexpr size_t OFF_QM = OFF_KR + 18432ull * 32 * 4;
constexpr size_t OFF_KM = OFF_QM + 18432ull * 768 * 2;
constexpr size_t OFF_VMT = OFF_KM + 18432ull * 768 * 2;
constexpr size_t END_L0 = OFF_VMT + 18432ull * 512 * 2;
constexpr size_t OFF_ACT = OFF_R;
constexpr size_t END_ACT = OFF_ACT + 18432ull * 2816 * 2;
constexpr size_t OFF_QKRAW = OFF_W0;
constexpr size_t OFF_V1 = OFF_QKRAW + 18432ull * 1024 * 2;
constexpr size_t OFF_OG = OFF_V1 + 18432ull * 1024 * 2;
constexpr size_t OFF_GATES = OFF_OG + 16384ull * 1024 * 2;
constexpr size_t OFF_HF = OFF_GATES + 18432ull * 32 * 4;
constexpr size_t OFF_HB = OFF_HF + 16384ull * 1024 * 2;
constexpr size_t END_L1 = OFF_HB + 16384ull * 1024 * 2;
constexpr size_t cmax(size_t a, size_t b) { return a > b ? a : b; }
constexpr size_t OFF_H = cmax(cmax(END_L0, END_ACT), END_L1);
constexpr size_t OFF_BAR = OFF_H + 18432ull * 1024 * 2;
constexpr size_t OFF_SCAN = OFF_BAR + 16384;
constexpr size_t WS_END = OFF_SCAN + 2304ull * 384 * 4;
static_assert(WS_END <= 268435456ull, "workspace too large");
static_assert(OFF_H % 256 == 0 && OFF_R % 256 == 0 && OFF_HF % 256 == 0, "align");

struct Params {
    const float *x, *c, *ctx, *c_ctx, *ada_w, *ada_b, *norm1_g, *norm2_g, *ffn_w_up, *ffn_conv_w, *ffn_conv_b, *ffn_w_down,
        *att_w_in, *mla_qa_g, *mla_w_qb, *mla_kva_g, *mla_w_kvb, *mla_q_g, *mla_k_g, *gqa_q_g, *gqa_k_g, *att_w_out,
        *ml_w_in, *ml_conv_w, *ml_conv_b, *ml_gate_b, *ml_out_g, *ml_w_out;
    float* out;
    char* ws;
};

DI unsigned short f2bf_sw(float x) { unsigned u = __float_as_uint(x); u += 0x7fffu + ((u >> 16) & 1u); return (unsigned short)(u >> 16); }
DI unsigned short f2bf(float x) { unsigned r; asm("v_cvt_pk_bf16_f32 %0, %1, %1" : "=v"(r) : "v"(x)); return (unsigned short)(r & 0xffffu); }
DI unsigned pack2(float a, float b) { unsigned r; asm("v_cvt_pk_bf16_f32 %0, %1, %2" : "=v"(r) : "v"(a), "v"(b)); return r; }
DI bf16x8 pack_frag(float a0, float a1, float a2, float a3, float a4, float a5, float a6, float a7) {
    using u32x4_ = __attribute__((ext_vector_type(4))) unsigned; u32x4_ p;
    asm volatile("v_cvt_pk_bf16_f32 %0, %4, %5\n\tv_cvt_pk_bf16_f32 %1, %6, %7\n\tv_cvt_pk_bf16_f32 %2, %8, %9\n\tv_cvt_pk_bf16_f32 %3, %10, %11\n\ts_nop 1"
                 : "=&v"(p[0]), "=&v"(p[1]), "=&v"(p[2]), "=&v"(p[3]) : "v"(a0), "v"(a1), "v"(a2), "v"(a3), "v"(a4), "v"(a5), "v"(a6), "v"(a7));
    return __builtin_bit_cast(bf16x8, p);
}
DI float bflo(unsigned v) { return __uint_as_float(v << 16); }
DI float bfhi(unsigned v) { return __uint_as_float(v & 0xffff0000u); }
DI float bf2f(unsigned short v) { return __uint_as_float(((unsigned)v) << 16); }
DI uint4 pack8(const float* v) { uint4 o; o.x = pack2(v[0], v[1]); o.y = pack2(v[2], v[3]); o.z = pack2(v[4], v[5]); o.w = pack2(v[6], v[7]); return o; }
DI void unpack8(uint4 u, float* v) { v[0] = bflo(u.x); v[1] = bfhi(u.x); v[2] = bflo(u.y); v[3] = bfhi(u.y); v[4] = bflo(u.z); v[5] = bfhi(u.z); v[6] = bflo(u.w); v[7] = bfhi(u.w); }
DI int crow(int reg, int h) { return (reg & 3) + 8 * (reg >> 2) + 4 * h; }
DI float sigmoidf_(float x) { return __builtin_amdgcn_rcpf(1.f + __expf(-x)); }
DI float siluf_(float x) { return x * __builtin_amdgcn_rcpf(1.f + __expf(-x)); }
DI float logsigmoidf_(float x) { return fminf(x, 0.f) - log1pf(__expf(-fabsf(x))); }
DI f32x16 zero16() { f32x16 z;
#pragma unroll
    for (int i = 0; i < 16; ++i) z[i] = 0.f; return z; }

DI void row_info(int m0, int& b, int& t0, bool& lat) {
    if (m0 < 16384) { b = m0 >> 11; t0 = m0 & 2047; lat = true; }
    else { int q = m0 - 16384; b = q >> 8; t0 = q & 255; lat = false; }
}

template <bool SS, bool HALO, class Epi>
DI void gemm_tile(const bf16_t* ap0, const bf16_t* ap1, const bf16_t* ap2, const bf16_t* ap3, unsigned mk0, unsigned mk1, unsigned mk2, unsigned mk3, const bf16_t* __restrict__ Bt, int ldb, int K, char* smem, Epi epi) {
    const int tid = TID, lane = tid & 63, w = tid >> 6, h = lane >> 5, r = lane & 31;
    const int wm = w >> 1, wn = w & 1;
    const int lr = tid >> 3, kc = tid & 7;
    ap0 += kc * 8; ap1 += kc * 8; ap2 += kc * 8; ap3 += kc * 8;
    const bf16_t* bp0 = Bt + (size_t)lr * ldb + kc * 8;
    const bf16_t* bp1 = bp0 + (size_t)32 * ldb; const bf16_t* bp2 = bp0 + (size_t)64 * ldb; const bf16_t* bp3 = bp0 + (size_t)96 * ldb;
    f32x16 acc00 = zero16(), acc01 = zero16(), acc10 = zero16(), acc11 = zero16();
    float ss0 = 0.f, ss1 = 0.f, ss2 = 0.f, ss3 = 0.f;
    uint4 ra0, ra1, ra2, ra3, rb0, rb1, rb2, rb3;
    const int nk = K >> 6;
#define GLOAD(k0) { ra0 = *(const uint4*)(ap0 + (k0)); ra1 = *(const uint4*)(ap1 + (k0)); ra2 = *(const uint4*)(ap2 + (k0)); ra3 = *(const uint4*)(ap3 + (k0)); \
                    rb0 = *(const uint4*)(bp0 + (k0)); rb1 = *(const uint4*)(bp1 + (k0)); rb2 = *(const uint4*)(bp2 + (k0)); rb3 = *(const uint4*)(bp3 + (k0)); }
#define SSQ(ssv, rv) { if (SS) { float f_[8]; unpack8(rv, f_); ssv += f_[0]*f_[0] + f_[1]*f_[1] + f_[2]*f_[2] + f_[3]*f_[3] + f_[4]*f_[4] + f_[5]*f_[5] + f_[6]*f_[6] + f_[7]*f_[7]; } }
#define MSK(rv, mk) { rv.x &= mk; rv.y &= mk; rv.z &= mk; rv.w &= mk; }
#define SWRITE(s_) { if (HALO) { MSK(ra0, mk0) MSK(ra1, mk1) MSK(ra2, mk2) MSK(ra3, mk3) } bf16_t* As_ = (bf16_t*)(smem + (s_) * 36864) + lr * GP + kc * 8; bf16_t* Bs_ = As_ + 128 * GP; \
                     *(uint4*)(As_) = ra0; *(uint4*)(As_ + 32 * GP) = ra1; *(uint4*)(As_ + 64 * GP) = ra2; *(uint4*)(As_ + 96 * GP) = ra3; \
                     *(uint4*)(Bs_) = rb0; *(uint4*)(Bs_ + 32 * GP) = rb1; *(uint4*)(Bs_ + 64 * GP) = rb2; *(uint4*)(Bs_ + 96 * GP) = rb3; \
                     SSQ(ss0, ra0) SSQ(ss1, ra1) SSQ(ss2, ra2) SSQ(ss3, ra3) }
    GLOAD(0) SWRITE(0) __syncthreads();
#pragma unroll 1
    for (int kt = 0; kt < nk; ++kt) {
        if (kt + 1 < nk) GLOAD((kt + 1) * 64)
        {
            const bf16_t* As = (const bf16_t*)(smem + (kt & 1) * 36864) + (wm * 64 + r) * GP + h * 8;
            const bf16_t* Bs = (const bf16_t*)(smem + (kt & 1) * 36864) + 128 * GP + (wn * 64 + r) * GP + h * 8;
#pragma unroll
            for (int ks = 0; ks < 4; ++ks) {
                const bf16x8 a0 = *(const bf16x8*)(As + ks * 16), a1 = *(const bf16x8*)(As + 32 * GP + ks * 16);
                const bf16x8 b0 = *(const bf16x8*)(Bs + ks * 16), b1 = *(const bf16x8*)(Bs + 32 * GP + ks * 16);
                acc00 = MFMA(a0, b0, acc00); acc01 = MFMA(a0, b1, acc01); acc10 = MFMA(a1, b0, acc10); acc11 = MFMA(a1, b1, acc11);
            }
        }
        if (kt + 1 < nk) SWRITE((kt + 1) & 1)
        __syncthreads();
    }
#undef GLOAD
#undef SWRITE
#undef SSQ
#undef MSK
    float* Cs = (float*)smem;
    {
        float* cb = Cs + (wm * 64 + 4 * h) * CP + wn * 64 + r;
#pragma unroll
        for (int g = 0; g < 16; ++g) {
            const int ro = (g & 3) + 8 * (g >> 2);
            cb[ro * CP] = acc00[g]; cb[ro * CP + 32] = acc01[g]; cb[(ro + 32) * CP] = acc10[g]; cb[(ro + 32) * CP + 32] = acc11[g];
        }
    }
    if (SS) {
        float* rowss = (float*)(smem + ROWSS_OFF);
        ss0 += __shfl_xor(ss0, 1); ss0 += __shfl_xor(ss0, 2); ss0 += __shfl_xor(ss0, 4);
        ss1 += __shfl_xor(ss1, 1); ss1 += __shfl_xor(ss1, 2); ss1 += __shfl_xor(ss1, 4);
        ss2 += __shfl_xor(ss2, 1); ss2 += __shfl_xor(ss2, 2); ss2 += __shfl_xor(ss2, 4);
        ss3 += __shfl_xor(ss3, 1); ss3 += __shfl_xor(ss3, 2); ss3 += __shfl_xor(ss3, 4);
        if (kc == 0) { rowss[lr] = ss0; rowss[lr + 32] = ss1; rowss[lr + 64] = ss2; rowss[lr + 96] = ss3; }
    }
    __syncthreads();
    epi((const float*)smem, (const float*)(smem + ROWSS_OFF));
    __syncthreads();
}


DI int g_row(int i) { return ((i * 8 + (int)(threadIdx.x >> 6)) * 8) + (int)((threadIdx.x & 63) >> 3); }
DI int b_perm(int row) { return ((row >> 5) & 1) * 128 + (row >> 6) * 32 + (row & 31); }
DI int g_chunk(int row) { return (int)(threadIdx.x & 7) ^ ((row >> 1) & 7); }
#define GLDS(g_, l_) __builtin_amdgcn_global_load_lds((const unsigned*)(g_), (unsigned*)(l_), 16, 0, 0)
template <class Epi>
DI void gemm256(const char* wsb, const bf16_t* a0p, const bf16_t* a1p, const bf16_t* a2p, const bf16_t* a3p,
                const bf16_t* b0p, const bf16_t* b1p, const bf16_t* b2p, const bf16_t* b3p, int K, char* smem_all, Epi epi) {
    const unsigned a0 = (unsigned)((const char*)a0p - wsb), a1 = (unsigned)((const char*)a1p - wsb), a2 = (unsigned)((const char*)a2p - wsb), a3 = (unsigned)((const char*)a3p - wsb);
    const unsigned b0 = (unsigned)((const char*)b0p - wsb), b1 = (unsigned)((const char*)b1p - wsb), b2 = (unsigned)((const char*)b2p - wsb), b3 = (unsigned)((const char*)b3p - wsb);
    const int lane = threadIdx.x & 63, wid = __builtin_amdgcn_readfirstlane(threadIdx.x >> 6), wr = wid >> 2, wc = wid & 3, fr = lane & 15, fq = lane >> 4;
    f32x4 acc[8][4];
#pragma unroll
    for (int m = 0; m < 8; ++m)
#pragma unroll
        for (int n = 0; n < 4; ++n) acc[m][n] = (f32x4){0.f, 0.f, 0.f, 0.f};
#define STAGE256(buf, k0) { char* sa_ = smem_all + (buf) * 65536 + wid * 1024; char* sb_ = sa_ + 32768; const char* wk_ = wsb + (size_t)(k0) * 2; \
        GLDS(wk_ + a0, sa_); GLDS(wk_ + a1, sa_ + 8192); GLDS(wk_ + a2, sa_ + 16384); GLDS(wk_ + a3, sa_ + 24576); \
        GLDS(wk_ + b0, sb_); GLDS(wk_ + b1, sb_ + 8192); GLDS(wk_ + b2, sb_ + 16384); GLDS(wk_ + b3, sb_ + 24576); }
    const int sw = (fr >> 1) & 7;
    const unsigned offA = (wr * 128 + fr) * 128, offB = 32768 + (wc * 64 + fr) * 128;
    const unsigned co0 = ((0 + fq) ^ sw) << 4, co1 = ((4 + fq) ^ sw) << 4;
    const unsigned lds0 = (unsigned)(size_t)smem_all;
    const int nt = K >> 6;
    STAGE256(0, 0)
    asm volatile("s_waitcnt vmcnt(0)" ::: "memory");
    __syncthreads();
#pragma unroll 1
    for (int t = 0; t < nt; ++t) {
        const int cur = t & 1;
        if (t + 1 < nt) STAGE256(cur ^ 1, (t + 1) * 64)
        const unsigned lb = lds0 + cur * 65536;
        const unsigned aA0 = lb + offA + co0, aA1 = lb + offA + co1, aB0 = lb + offB + co0, aB1 = lb + offB + co1;
        bf16x8 Bq0[4], Bq1[4], Aq0[2], Aq1[2];
#define DSR(dst, addr, off) asm volatile("ds_read_b128 %0, %1 offset:%2" : "=v"(dst) : "v"(addr), "n"(off) : "memory")
#define LDA2(dst, addr, mo) { DSR(dst[0], addr, (mo) * 2048); DSR(dst[1], addr, ((mo) + 1) * 2048); }
#define LDB4(dst, addr) { DSR(dst[0], addr, 0); DSR(dst[1], addr, 2048); DSR(dst[2], addr, 4096); DSR(dst[3], addr, 6144); }
#define WAIT_A(n, X) asm volatile("s_waitcnt lgkmcnt(" #n ")" : "+v"(X[0]), "+v"(X[1]) :: "memory")
#define WAIT_AB(n, X, Y) asm volatile("s_waitcnt lgkmcnt(" #n ")" : "+v"(X[0]), "+v"(X[1]), "+v"(Y[0]), "+v"(Y[1]), "+v"(Y[2]), "+v"(Y[3]) :: "memory")
#define MM8(Aq, Bq, mo) { _Pragma("unroll") for (int m = 0; m < 2; ++m) _Pragma("unroll") for (int n = 0; n < 4; ++n) acc[(mo) + m][n] = MFMA16(Aq[m], Bq[n], acc[(mo) + m][n]); }
        LDB4(Bq0, aB0) LDA2(Aq0, aA0, 0) LDA2(Aq1, aA0, 2)
        WAIT_AB(2, Aq0, Bq0);
        MM8(Aq0, Bq0, 0)
        LDA2(Aq0, aA0, 4)
        WAIT_A(2, Aq1);
        MM8(Aq1, Bq0, 2)
        LDA2(Aq1, aA0, 6) LDB4(Bq1, aB1)
        WAIT_A(6, Aq0);
        MM8(Aq0, Bq0, 4)
        LDA2(Aq0, aA1, 0)
        WAIT_A(6, Aq1);
        MM8(Aq1, Bq0, 6)
        LDA2(Aq1, aA1, 2)
        WAIT_AB(2, Aq0, Bq1);
        MM8(Aq0, Bq1, 0)
        LDA2(Aq0, aA1, 4)
        WAIT_A(2, Aq1);
        MM8(Aq1, Bq1, 2)
        LDA2(Aq1, aA1, 6)
        WAIT_A(2, Aq0);
        MM8(Aq0, Bq1, 4)
        WAIT_A(0, Aq1);
        MM8(Aq1, Bq1, 6)
#undef DSR
#undef LDA2
#undef LDB4
#undef WAIT_A
#undef WAIT_AB
#undef MM8
        asm volatile("s_waitcnt vmcnt(0)" ::: "memory");
        __syncthreads();
    }
#undef STAGE256
    int t_ = threadIdx.x;
    asm volatile("" : "+v"(t_));
    const int lane_ = t_ & 63, wid_ = t_ >> 6, wr_ = wid_ >> 2, wc_ = wid_ & 3, fr_ = lane_ & 15, fq_ = lane_ >> 4, hb_ = t_ >> 8;
#pragma unroll
    for (int p = 0; p < 2; ++p) {
        {
            float* Cs = (float*)(smem_all + wr_ * HB_SMEM) + (4 * fq_) * CP + wc_ * 32 + fr_;
#pragma unroll
            for (int m = 0; m < 8; ++m)
#pragma unroll
                for (int n = 0; n < 2; ++n)
#pragma unroll
                    for (int j = 0; j < 4; ++j) Cs[(m * 16 + j) * CP + n * 16] = acc[m][2 * p + n][j];
        }
        __syncthreads();
        epi((const float*)(smem_all + hb_ * HB_SMEM), hb_, p, t_ & 255);
        __syncthreads();
    }
}

DI void epi_store_bf16(const float* Cs, bf16_t* dst, int ld, int tid) {
#pragma unroll 2
    for (int j = 0; j < 8; ++j) {
        int c = tid + 256 * j, row = c >> 4, cc = c & 15;
        const float4* cp = (const float4*)(Cs + row * CP + cc * 8);
        float4 f0 = cp[0], f1 = cp[1];
        float v[8] = {f0.x, f0.y, f0.z, f0.w, f1.x, f1.y, f1.z, f1.w};
        *(uint4*)(dst + (size_t)row * ld + cc * 8) = pack8(v);
    }
}
DI void epi_resid(const float* Cs, const float* src, float* dst, const float* gate, int tid) {
#pragma unroll 4
    for (int j = 0; j < 16; ++j) {
        int c = tid + 256 * j, row = c >> 5, c4 = c & 31;
        float4 cv = *(const float4*)(Cs + row * CP + c4 * 4);
        float4 sv = *(const float4*)(src + (size_t)row * 1024 + c4 * 4);
        float4 gv = *(const float4*)(gate + c4 * 4);
        float4 o; o.x = sv.x + gv.x * cv.x; o.y = sv.y + gv.y * cv.y; o.z = sv.z + gv.z * cv.z; o.w = sv.w + gv.w * cv.w;
        *(float4*)(dst + (size_t)row * 1024 + c4 * 4) = o;
    }
}

DI int wsrc_col(int mode, int tn, int c) {
    if (mode == 0) return tn * 128 + c;
    if (mode == 1) {
        const int np = tn * 128;
        if (np < 512) return 672 + np + c;
        if (np < 640) return 1184 + np - 512 + c;
        if (np < 768) return 1312 + np - 640 + c;
        if (np < 1152) return np - 768 + c;
        if (np < 1408) return 384 + np - 1152 + c;
        return c < 32 ? 640 + c : -1;
    }
    if (mode == 2) return c < 96 ? tn * 96 + c : -1;
    return c < 64 ? 64 * tn + c : 2816 + 64 * tn + c - 64;
}
DI void wtile(const float* __restrict__ src, int Nsrc, const float* __restrict__ g, bf16_t* __restrict__ dst, int K, int k0, int tn, int mode, char* smem) {
    bf16_t* T = (bf16_t*)smem;
    const int tid = TID, lane = tid & 63, w = tid >> 6, rsub = lane >> 5, c4 = (lane & 31) * 4;
    int sc = wsrc_col(mode, tn, c4);
    if (sc >= Nsrc) sc = -1;
#pragma unroll 8
    for (int i = 0; i < 16; ++i) {
        const int rr = w * 32 + 2 * i + rsub;
        float4 v = make_float4(0.f, 0.f, 0.f, 0.f);
        if (sc >= 0) { v = *(const float4*)(src + (size_t)(k0 + rr) * Nsrc + sc); if (g) { const float gg = g[k0 + rr]; v.x *= gg; v.y *= gg; v.z *= gg; v.w *= gg; } }
        T[(c4 + 0) * 130 + rr] = f2bf(v.x);
        T[(c4 + 1) * 130 + rr] = f2bf(v.y);
        T[(c4 + 2) * 130 + rr] = f2bf(v.z);
        T[(c4 + 3) * 130 + rr] = f2bf(v.w);
    }
    __syncthreads();
#pragma unroll
    for (int j = 0; j < 8; ++j) {
        const int c = tid + 256 * j, n = c >> 4, kc = c & 15;
        const unsigned* s32 = (const unsigned*)(T + n * 130 + kc * 8);
        uint4 o; o.x = s32[0]; o.y = s32[1]; o.z = s32[2]; o.w = s32[3];
        *(uint4*)(dst + (size_t)(tn * 128 + n) * K + k0 + kc * 8) = o;
    }
    __syncthreads();
}

DI void mod_item(const Params& p, int item, char* smem) {
    const int tid = TID, lane = tid & 63, w = tid >> 6, hl = lane >> 5, cl = lane & 31;
    const int l = item / 192, n0 = (item % 192) * 32;
    float* sl = (float*)smem;
    for (int i = tid; i < 9216; i += 256) {
        int rr = i >> 10, k = i & 1023;
        float cv = rr < 8 ? p.c[rr * 1024 + k] : p.c_ctx[k];
        sl[i] = cv / (1.f + expf(-cv));
    }
    __syncthreads();
    float acc[9];
#pragma unroll
    for (int q = 0; q < 9; ++q) acc[q] = 0.f;
    const float* wp = p.ada_w + (size_t)l * 1024 * 6144 + n0 + cl;
#pragma unroll 16
    for (int kk = 0; kk < 128; ++kk) {
        const int k = w * 256 + 2 * kk + hl;
        float wv = wp[(size_t)k * 6144];
#pragma unroll
        for (int q = 0; q < 9; ++q) acc[q] += sl[q * 1024 + k] * wv;
    }
    float* red = (float*)(smem + 36864);
#pragma unroll
    for (int q = 0; q < 9; ++q) red[((w * 2 + hl) * 9 + q) * 32 + cl] = acc[q];
    __syncthreads();
    float* MOD = (float*)(p.ws + OFF_MOD);
    for (int i = tid; i < 288; i += 256) {
        int q = i >> 5, ln = i & 31;
        float sacc = 0.f;
#pragma unroll
        for (int u = 0; u < 8; ++u) sacc += red[(u * 9 + q) * 32 + ln];
        sacc += p.ada_b[l * 6144 + n0 + ln];
        MOD[(size_t)(l * 9 + q) * 6144 + n0 + ln] = sacc;
    }
    __syncthreads();
}

DI void sincos_d(double x, float& s, float& c) {
    const double TWO_PI = 6.283185307179586476925;
    double t = x / TWO_PI;
    t -= rint(t);
    double y = t * TWO_PI, y2 = y * y;
    double sv = y, cv = 1.0, ts = y, tc = 1.0;
#pragma unroll 1
    for (int k = 1; k <= 14; ++k) {
        tc *= -y2 / (double)((2 * k - 1) * (2 * k));
        ts *= -y2 / (double)((2 * k) * (2 * k + 1));
        cv += tc; sv += ts;
    }
    s = (float)sv; c = (float)cv;
}

DI void rope_tables(const Params& p) {
    float* TG = (float*)(p.ws + OFF_TABG);
    float* TM = (float*)(p.ws + OFF_TABM);
    for (int i = TID; i < 1024; i += 256) {
        int v = i >> 4, f = i & 15;
        float inv = exp2f(-(float)f / 16.f * 13.287712379549449f);
        float ang = (float)v * inv, s, c;
        sincos_d((double)ang, s, c);
        TG[i] = c; TG[1024 + i] = s;
    }
    for (int i = TID; i < 512; i += 256) {
        int v = i >> 3, f = i & 7;
        float inv = exp2f(-(float)f / 8.f * 13.287712379549449f);
        float ang = (float)v * inv, s, c;
        sincos_d((double)ang, s, c);
        TM[i] = c; TM[512 + i] = s;
    }
}

constexpr int NW = 10;
constexpr int N_WT = 8 * 12 + 3 * 8 + 2 * 8 + 8 * 8 + 8 * 44 + 22 * 8 + 8 * 44 + 22 * 8 + 8 * 26 + 8 * 8;
constexpr int N_MOD = 384;
constexpr int N_P0 = N_MOD + N_WT;
static_assert(N_P0 % 2 == 0 && N_MOD % 2 == 0, "phase 0 items are dealt to half-block pairs");

DI void phase0(const Params& p, char* smem_all) {
    char* smem = smem_all + HBI * HB_SMEM;
    if (blockIdx.x == gridDim.x - 1) {
        if (HBI == 0) rope_tables(p);
        else { for (int i = TID; i < 512; i += 256) ((uint4*)(p.ws + OFF_ZROW))[i] = make_uint4(0, 0, 0, 0); }
    }
    for (int it0 = blockIdx.x * 2; it0 < N_P0; it0 += gridDim.x * 2) {
        const int item = it0 + HBI;
        if (item < N_MOD) { mod_item(p, item, smem); continue; }
        int t = item - N_MOD;
        int wi = 0;
        int cnt[NW] = {8 * 12, 3 * 8, 2 * 8, 8 * 8, 8 * 44, 22 * 8, 8 * 44, 22 * 8, 8 * 26, 8 * 8};
#pragma unroll
        for (int i = 0; i < NW - 1; ++i) { if (wi == i && t >= cnt[i]) { t -= cnt[i]; wi = i + 1; } }
        const float* src; const float* g = nullptr; bf16_t* dst; int K, Nsrc, ntn, mode;
        switch (wi) {
            case 0: src = p.att_w_in; dst = (bf16_t*)(p.ws + OFF_WT_IN0); K = 1024; Nsrc = 1440; ntn = 12; mode = 1; break;
            case 1: src = p.mla_w_qb; g = p.mla_qa_g; dst = (bf16_t*)(p.ws + OFF_WT_QB); K = 384; Nsrc = 768; ntn = 8; mode = 2; break;
            case 2: src = p.mla_w_kvb; g = p.mla_kva_g; dst = (bf16_t*)(p.ws + OFF_WT_KVB); K = 256; Nsrc = 1024; ntn = 8; mode = 0; break;
            case 3: src = p.att_w_out; dst = (bf16_t*)(p.ws + OFF_WT_OUT0); K = 1024; Nsrc = 1024; ntn = 8; mode = 0; break;
            case 4: src = p.ffn_w_up; dst = (bf16_t*)(p.ws + OFF_WT_UP0); K = 1024; Nsrc = 5632; ntn = 44; mode = 3; break;
            case 5: src = p.ffn_w_down; dst = (bf16_t*)(p.ws + OFF_WT_DOWN0); K = 2816; Nsrc = 1024; ntn = 8; mode = 0; break;
            case 6: src = p.ffn_w_up + 1024ull * 5632; dst = (bf16_t*)(p.ws + OFF_WT_UP1); K = 1024; Nsrc = 5632; ntn = 44; mode = 3; break;
            case 7: src = p.ffn_w_down + 2816ull * 1024; dst = (bf16_t*)(p.ws + OFF_WT_DOWN1); K = 2816; Nsrc = 1024; ntn = 8; mode = 0; break;
            case 8: src = p.ml_w_in; dst = (bf16_t*)(p.ws + OFF_WT_IN1); K = 1024; Nsrc = 3104; ntn = 26; mode = 0; break;
            default: src = p.ml_w_out; dst = (bf16_t*)(p.ws + OFF_WT_OUT1); K = 1024; Nsrc = 1024; ntn = 8; mode = 0; break;
        }
        const int tn = t % ntn, tk = t / ntn;
        wtile(src, Nsrc, g, dst, K, tk * 128, tn, mode, smem);
    }
}

DI void norm_row_ptrs(int row, const float* srcLat, const float* srcCtx, const float* mod, int shift_idx, const float*& src, const float*& sh) {
    int mb;
    if (row < 16384) { src = srcLat + (size_t)row * 1024; mb = row >> 11; }
    else { src = srcCtx + (size_t)(row - 16384) * 1024; mb = 8; }
    sh = mod + (size_t)mb * 6144 + shift_idx * 1024;
}
DI void norm_row_finish(const float4 (&v)[4], float ss, const float* g, const float* sh, bf16_t* dst, int lane) {
#pragma unroll
    for (int o = 32; o >= 1; o >>= 1) ss += __shfl_xor(ss, o);
    const float rstd = rsqrtf(ss * (1.f / 1024.f) + EPSF);
    const float* sc = sh + 1024;
#pragma unroll
    for (int j = 0; j < 4; ++j) {
        const int c = j * 256 + lane * 4;
        const float4 gv = *(const float4*)(g + c), shv = *(const float4*)(sh + c), scv = *(const float4*)(sc + c);
        const float o0 = v[j].x * rstd * gv.x * (1.f + scv.x) + shv.x;
        const float o1 = v[j].y * rstd * gv.y * (1.f + scv.y) + shv.y;
        const float o2 = v[j].z * rstd * gv.z * (1.f + scv.z) + shv.z;
        const float o3 = v[j].w * rstd * gv.w * (1.f + scv.w) + shv.w;
        uint2 o; o.x = pack2(o0, o1); o.y = pack2(o2, o3);
        *(uint2*)(dst + c) = o;
    }
}
DI void phase_norm(const Params& p, const float* srcLat, const float* srcCtx, const float* g, const float* mod, int shift_idx, int nrows) {
    const int lane = threadIdx.x & 63, w = threadIdx.x >> 6;
    bf16_t* H = (bf16_t*)(p.ws + OFF_H);
    for (int row = (blockIdx.x * 8 + w) * 2; row < nrows; row += gridDim.x * 16) {
        const float *srcA, *shA, *srcB, *shB;
        norm_row_ptrs(row, srcLat, srcCtx, mod, shift_idx, srcA, shA);
        norm_row_ptrs(row + 1, srcLat, srcCtx, mod, shift_idx, srcB, shB);
        float4 va[4], vb[4];
        float sa = 0.f, sb = 0.f;
#pragma unroll
        for (int j = 0; j < 4; ++j) { va[j] = *(const float4*)(srcA + j * 256 + lane * 4); vb[j] = *(const float4*)(srcB + j * 256 + lane * 4); }
#pragma unroll
        for (int j = 0; j < 4; ++j) { sa += va[j].x * va[j].x + va[j].y * va[j].y + va[j].z * va[j].z + va[j].w * va[j].w; sb += vb[j].x * vb[j].x + vb[j].y * vb[j].y + vb[j].z * vb[j].z + vb[j].w * vb[j].w; }
        norm_row_finish(va, sa, g, shA, H + (size_t)row * 1024, lane);
        norm_row_finish(vb, sb, g, shB, H + (size_t)(row + 1) * 1024, lane);
    }
}

template <int Q>
DI void rope_apply(float* v, const float* tab, int rw, int cl) {
#pragma unroll
    for (int f = 0; f < Q; ++f) {
        float cr = tab[rw * Q + f], sr = tab[64 * Q + rw * Q + f], cc = tab[cl * Q + f], sc = tab[64 * Q + cl * Q + f];
        float a1 = v[f], a2 = v[Q + f], b1 = v[2 * Q + f], b2 = v[3 * Q + f];
        v[f] = a1 * cr - a2 * sr; v[Q + f] = a2 * cr + a1 * sr;
        v[2 * Q + f] = b1 * cc - b2 * sc; v[3 * Q + f] = b2 * cc + b1 * sc;
    }
}

DI void phase_inproj0(const Params& p, char* smem_all) {
    const bf16_t* H = (const bf16_t*)(p.ws + OFF_H);
    const bf16_t* W = (const bf16_t*)(p.ws + OFF_WT_IN0);
    const float* TG = (const float*)(p.ws + OFF_TABG);
    for (int id = blockIdx.x; id < 72 * 6; id += gridDim.x) {
        const int nt2 = id / 72, mt2 = id % 72;
        auto epi = [&](const float* Cs, int si, int sj, int tid) {
            const int nt = 2 * nt2 + sj, m0 = (2 * mt2 + si) * 128;
            int b, t0; bool lat; row_info(m0, b, t0, lat);
            const int s0 = lat ? 256 + t0 : t0;
            if (nt < 5) {
                const int row = tid & 127, half = tid >> 7;
                const float4* cp = (const float4*)(Cs + row * CP + half * 64);
                float ss = 0.f;
#pragma unroll
                for (int i = 0; i < 16; ++i) { float4 f = cp[i]; ss += f.x * f.x + f.y * f.y + f.z * f.z + f.w * f.w; }
                const float rstd = rsqrtf(ss * (1.f / 64.f) + EPSF);
                const float* g = nt < 4 ? p.gqa_q_g : p.gqa_k_g;
                const float osc = nt < 4 ? 0.125f * LOG2E : 1.f;
                bf16_t* dst;
                if (nt < 4) dst = (bf16_t*)(p.ws + OFF_QG) + ((size_t)(b * 2304 + s0 + row) * 8 + nt * 2 + half) * 64;
                else dst = (bf16_t*)(p.ws + OFF_KG) + ((size_t)(b * 2304 + s0 + row) * 2 + half) * 64;
                const int t = t0 + row;
#pragma unroll 1
                for (int hh = 0; hh < 2; ++hh) {
                    float v[32];
#pragma unroll
                    for (int i = 0; i < 8; ++i) { float4 f = cp[hh * 8 + i]; const float4 gv = *(const float4*)(g + hh * 32 + 4 * i);
                        v[4 * i] = f.x * rstd * gv.x; v[4 * i + 1] = f.y * rstd * gv.y; v[4 * i + 2] = f.z * rstd * gv.z; v[4 * i + 3] = f.w * rstd * gv.w; }
                    if (lat) {
                        const int pos = hh ? (t & 63) : (t >> 6);
#pragma unroll
                        for (int f = 0; f < 16; ++f) {
                            const float c_ = TG[pos * 16 + f], s_ = TG[1024 + pos * 16 + f];
                            const float x1 = v[f], x2 = v[16 + f];
                            v[f] = x1 * c_ - x2 * s_; v[16 + f] = x2 * c_ + x1 * s_;
                        }
                    }
#pragma unroll
                    for (int i = 0; i < 32; ++i) v[i] *= osc;
#pragma unroll
                    for (int i = 0; i < 4; ++i) *(uint4*)(dst + hh * 32 + i * 8) = pack8(v + i * 8);
                }
            } else if (nt == 5) {
                const int dall = tid & 127, ch0 = (tid >> 7) * 8;
                bf16_t* dst = (bf16_t*)(p.ws + OFF_VGT) + ((size_t)(b * 2 + (dall >> 6)) * 64 + (dall & 63)) * 2304 + s0;
#pragma unroll 2
                for (int ch = 0; ch < 8; ++ch) {
                    float v[8];
#pragma unroll
                    for (int i = 0; i < 8; ++i) v[i] = Cs[((ch0 + ch) * 8 + i) * CP + dall];
                    *(uint4*)(dst + (ch0 + ch) * 8) = pack8(v);
                }
            } else if (nt < 9) {
                epi_store_bf16(Cs, (bf16_t*)(p.ws + OFF_CQ) + (size_t)m0 * 384 + (nt - 6) * 128, 384, tid);
            } else if (nt < 11) {
                epi_store_bf16(Cs, (bf16_t*)(p.ws + OFF_CKV) + (size_t)m0 * 256 + (nt - 9) * 128, 256, tid);
            } else {
                const int row = tid >> 1, half = tid & 1;
                float* dst = (float*)(p.ws + OFF_KR) + (size_t)(m0 + row) * 32 + half * 16;
                const float4* cp = (const float4*)(Cs + row * CP + half * 16);
#pragma unroll
                for (int i = 0; i < 4; ++i) ((float4*)dst)[i] = cp[i];
            }
        };
        const int r0 = g_row(0), r1 = g_row(1), r2 = g_row(2), r3 = g_row(3);
        const bf16_t* Ab = H + (size_t)mt2 * 256 * 1024;
        const bf16_t* Bb = W + (size_t)nt2 * 256 * 1024;
        gemm256(p.ws, Ab + (size_t)r0 * 1024 + g_chunk(r0) * 8, Ab + (size_t)r1 * 1024 + g_chunk(r1) * 8, Ab + (size_t)r2 * 1024 + g_chunk(r2) * 8, Ab + (size_t)r3 * 1024 + g_chunk(r3) * 8,
                Bb + (size_t)b_perm(r0) * 1024 + g_chunk(r0) * 8, Bb + (size_t)b_perm(r1) * 1024 + g_chunk(r1) * 8, Bb + (size_t)b_perm(r2) * 1024 + g_chunk(r2) * 8, Bb + (size_t)b_perm(r3) * 1024 + g_chunk(r3) * 8,
                1024, smem_all, epi);
    }
}

DI void phase_mla_up(const Params& p, char* smem_all) {
    char* smem = smem_all + HBI * HB_SMEM;
    const float* TM = (const float*)(p.ws + OFF_TABM);
    for (int id0 = blockIdx.x * 2; id0 < 144 * 16; id0 += gridDim.x * 2) {
        const int id = id0 + HBI;
        const int nt = (id / 144) & 7, isKV = (id / 144) >> 3, mt = id % 144, m0 = mt * 128;
        int b, t0; bool lat; row_info(m0, b, t0, lat);
        const int s0 = lat ? 256 + t0 : t0;
        if (!isKV) {
            const bf16_t* A = (const bf16_t*)(p.ws + OFF_CQ);
#undef AROW
#define AROW(o_) (A + (size_t)(m0 + (TID >> 3) + (o_)) * 384)
            auto epi = [&](const float* Cs, const float* rowss) {
                const int tid = TID, row = tid >> 1, part = tid & 1;
                const float r1 = rsqrtf(rowss[row] * (1.f / 384.f) + EPSF);
                float v[48];
                const float4* cp = (const float4*)(Cs + row * CP + part * 48);
                float ss = 0.f;
#pragma unroll
                for (int i = 0; i < 12; ++i) { float4 f = cp[i]; v[4 * i] = f.x * r1; v[4 * i + 1] = f.y * r1; v[4 * i + 2] = f.z * r1; v[4 * i + 3] = f.w * r1; }
#pragma unroll
                for (int i = 0; i < 48; ++i) ss += v[i] * v[i];
                ss += __shfl_xor(ss, 1);
                const float r2 = rsqrtf(ss * (1.f / 96.f) + EPSF);
                const float* g = p.mla_q_g + part * 48;
#pragma unroll
                for (int i = 0; i < 48; ++i) v[i] = v[i] * r2 * g[i];
                if (lat && part == 1) { int t = t0 + row; rope_apply<8>(v + 16, TM, t >> 6, t & 63); }
                const float sc = 0.10206207261596575f * LOG2E;
#pragma unroll
                for (int i = 0; i < 48; ++i) v[i] *= sc;
                bf16_t* dst = (bf16_t*)(p.ws + OFF_QM) + ((size_t)(b * 2304 + s0 + row) * 8 + nt) * 96 + part * 48;
#pragma unroll
                for (int i = 0; i < 6; ++i) *(uint4*)(dst + i * 8) = pack8(v + i * 8);
            };
            gemm_tile<true, false>(AROW(0), AROW(32), AROW(64), AROW(96), 0u, 0u, 0u, 0u, (const bf16_t*)(p.ws + OFF_WT_QB) + (size_t)nt * 128 * 384, 384, 384, smem, epi);
        } else {
            const bf16_t* A = (const bf16_t*)(p.ws + OFF_CKV);
#undef AROW
#define AROW(o_) (A + (size_t)(m0 + (TID >> 3) + (o_)) * 256)
            auto epi = [&](const float* Cs, const float* rowss) {
                const int tid = TID;
                {
                    const int row = tid >> 1, part = tid & 1;
                    const float r1 = rsqrtf(rowss[row] * (1.f / 256.f) + EPSF);
                    float v[48];
                    if (part == 0) {
                        const float4* cp = (const float4*)(Cs + row * CP);
#pragma unroll
                        for (int i = 0; i < 12; ++i) { float4 f = cp[i]; v[4 * i] = f.x * r1; v[4 * i + 1] = f.y * r1; v[4 * i + 2] = f.z * r1; v[4 * i + 3] = f.w * r1; }
                    } else {
                        const float4* cp = (const float4*)(Cs + row * CP + 48);
#pragma unroll
                        for (int i = 0; i < 4; ++i) { float4 f = cp[i]; v[4 * i] = f.x * r1; v[4 * i + 1] = f.y * r1; v[4 * i + 2] = f.z * r1; v[4 * i + 3] = f.w * r1; }
                        const float4* kp = (const float4*)((const float*)(p.ws + OFF_KR) + (size_t)(m0 + row) * 32);
#pragma unroll
                        for (int i = 0; i < 8; ++i) { float4 f = kp[i]; v[16 + 4 * i] = f.x; v[16 + 4 * i + 1] = f.y; v[16 + 4 * i + 2] = f.z; v[16 + 4 * i + 3] = f.w; }
                    }
                    float ss = 0.f;
#pragma unroll
                    for (int i = 0; i < 48; ++i) ss += v[i] * v[i];
                    ss += __shfl_xor(ss, 1);
                    const float r2 = rsqrtf(ss * (1.f / 96.f) + EPSF);
                    const float* g = p.mla_k_g + part * 48;
#pragma unroll
                    for (int i = 0; i < 48; ++i) v[i] = v[i] * r2 * g[i];
                    if (lat && part == 1) { int t = t0 + row; rope_apply<8>(v + 16, TM, t >> 6, t & 63); }
                    bf16_t* dst = (bf16_t*)(p.ws + OFF_KM) + ((size_t)(b * 2304 + s0 + row) * 8 + nt) * 96 + part * 48;
#pragma unroll
                    for (int i = 0; i < 6; ++i) *(uint4*)(dst + i * 8) = pack8(v + i * 8);
                }
                {
                    const int d = tid & 63, cg4 = (tid >> 6) * 4;
                    bf16_t* dst = (bf16_t*)(p.ws + OFF_VMT) + ((size_t)(b * 8 + nt) * 64 + d) * 2304 + s0;
#pragma unroll 1
                    for (int ch = 0; ch < 4; ++ch) {
                        float v[8];
#pragma unroll
                        for (int i = 0; i < 8; ++i) { int rr = (cg4 + ch) * 8 + i; v[i] = Cs[rr * CP + 64 + d] * rsqrtf(rowss[rr] * (1.f / 256.f) + EPSF); }
                        *(uint4*)(dst + (cg4 + ch) * 8) = pack8(v);
                    }
                }
            };
            gemm_tile<true, false>(AROW(0), AROW(32), AROW(64), AROW(96), 0u, 0u, 0u, 0u, (const bf16_t*)(p.ws + OFF_WT_KVB) + (size_t)nt * 128 * 256, 256, 256, smem, epi);
        }
    }
}

template <int DK>
DI void attn_body(const bf16_t* __restrict__ Q, int qstride, const bf16_t* __restrict__ Kp, int kstride, const bf16_t* __restrict__ VT,
                  int nkeys, bf16_t* __restrict__ Odst, char* smem) {
    constexpr int KP = DK + 8, VP = 72, NST = DK / 16, KCH = DK / 8;
    constexpr int NKL = (64 * KCH) / 256;
    constexpr int STAGE = 64 * KP * 2 + 64 * VP * 2;
    const int tid = TID, lane = tid & 63, w = tid >> 6, h = lane >> 5, r = lane & 31;
    bf16x8 qf[NST];
    {
        const bf16_t* qrow = Q + (size_t)(w * 32 + r) * qstride;
#pragma unroll
        for (int st = 0; st < NST; ++st) qf[st] = *(const bf16x8*)(qrow + st * 16 + h * 8);
    }
    f32x16 o[2]; o[0] = zero16(); o[1] = zero16();
    float m = 0.f, l = 0.f;
    uint4 ak0, ak1, ak2 = make_uint4(0, 0, 0, 0), av0, av1, bk0, bk1, bk2 = make_uint4(0, 0, 0, 0), bv0, bv1;
    const int kr0 = tid / KCH, kc0 = tid % KCH, kr1 = (tid + 256) / KCH, kc1 = (tid + 256) % KCH, kr2 = (tid + 512) / KCH, kc2 = (tid + 512) % KCH;
    const int vd0 = tid >> 3, vc0 = tid & 7;
#define AGLOAD(P_, key0) { P_##k0 = *(const uint4*)(Kp + (size_t)((key0) + kr0) * kstride + kc0 * 8); P_##k1 = *(const uint4*)(Kp + (size_t)((key0) + kr1) * kstride + kc1 * 8); \
                       if (NKL == 3) P_##k2 = *(const uint4*)(Kp + (size_t)((key0) + kr2) * kstride + kc2 * 8); \
                       P_##v0 = *(const uint4*)(VT + (size_t)vd0 * 2304 + (key0) + vc0 * 8); P_##v1 = *(const uint4*)(VT + (size_t)(vd0 + 32) * 2304 + (key0) + vc0 * 8); }
#define ASWRITE(P_, s_) { bf16_t* Ks_ = (bf16_t*)(smem + (s_) * STAGE); bf16_t* Vs_ = Ks_ + 64 * KP; \
                      *(uint4*)(Ks_ + kr0 * KP + kc0 * 8) = P_##k0; *(uint4*)(Ks_ + kr1 * KP + kc1 * 8) = P_##k1; if (NKL == 3) *(uint4*)(Ks_ + kr2 * KP + kc2 * 8) = P_##k2; \
                      *(uint4*)(Vs_ + vd0 * VP + vc0 * 8) = P_##v0; *(uint4*)(Vs_ + (vd0 + 32) * VP + vc0 * 8) = P_##v1; }
    const int nkt = nkeys >> 6;
    AGLOAD(a, 0) ASWRITE(a, 0) AGLOAD(a, 64) AGLOAD(b, 128) __syncthreads();
#pragma unroll 1
    for (int kt = 0; kt < nkt; kt += 2) {
        {
            const bf16_t* Ks = (const bf16_t*)(smem);
            const bf16_t* Vs = Ks + 64 * KP;
            f32x16 s[2];
#pragma unroll
            for (int i = 0; i < 16; ++i) { s[0][i] = -m; s[1][i] = -m; }
#pragma unroll
            for (int st = 0; st < NST; ++st)
#pragma unroll
                for (int kk = 0; kk < 2; ++kk) {
                    bf16x8 a = *(const bf16x8*)(Ks + (kk * 32 + r) * KP + st * 16 + h * 8);
                    s[kk] = MFMA(a, qf[st], s[kk]);
                }
            float mx = s[0][0];
#pragma unroll
            for (int i = 0; i < 16; ++i) { mx = fmaxf(mx, s[0][i]); mx = fmaxf(mx, s[1][i]); }
            mx = fmaxf(mx, __shfl_xor(mx, 32));
            if (__any(mx > 8.f)) {
                const float d = fmaxf(mx, 0.f);
                const float alpha = __builtin_amdgcn_exp2f(-d);
                l *= alpha;
#pragma unroll
                for (int i = 0; i < 16; ++i) { o[0][i] *= alpha; o[1][i] *= alpha; s[0][i] -= d; s[1][i] -= d; }
                m += d;
            }
            float ps = 0.f;
#pragma unroll
            for (int kk = 0; kk < 2; ++kk)
#pragma unroll
                for (int i = 0; i < 16; ++i) { float pv = __builtin_amdgcn_exp2f(s[kk][i]); s[kk][i] = pv; ps += pv; }
            l += ps;
#pragma unroll
            for (int kk = 0; kk < 2; ++kk)
#pragma unroll
                for (int s2 = 0; s2 < 2; ++s2) {
                    const bf16x8 pb = pack_frag(s[kk][8 * s2 + 0], s[kk][8 * s2 + 1], s[kk][8 * s2 + 2], s[kk][8 * s2 + 3], s[kk][8 * s2 + 4], s[kk][8 * s2 + 5], s[kk][8 * s2 + 6], s[kk][8 * s2 + 7]);
#pragma unroll
                    for (int dt = 0; dt < 2; ++dt) {
                        const bf16_t* vp = Vs + (dt * 32 + r) * VP + kk * 32 + 16 * s2 + 4 * h;
                        uint2 lo = *(const uint2*)vp, hi = *(const uint2*)(vp + 8);
                        uint4 vu; vu.x = lo.x; vu.y = lo.y; vu.z = hi.x; vu.w = hi.y;
                        o[dt] = MFMA(__builtin_bit_cast(bf16x8, vu), pb, o[dt]);
                    }
                }
        }
        ASWRITE(a, 1)
        if (kt + 3 < nkt) AGLOAD(a, (kt + 3) * 64)
        LDS_BARRIER();
        {
            const bf16_t* Ks = (const bf16_t*)(smem + STAGE);
            const bf16_t* Vs = Ks + 64 * KP;
            f32x16 s[2];
#pragma unroll
            for (int i = 0; i < 16; ++i) { s[0][i] = -m; s[1][i] = -m; }
#pragma unroll
            for (int st = 0; st < NST; ++st)
#pragma unroll
                for (int kk = 0; kk < 2; ++kk) {
                    bf16x8 a = *(const bf16x8*)(Ks + (kk * 32 + r) * KP + st * 16 + h * 8);
                    s[kk] = MFMA(a, qf[st], s[kk]);
                }
            float mx = s[0][0];
#pragma unroll
            for (int i = 0; i < 16; ++i) { mx = fmaxf(mx, s[0][i]); mx = fmaxf(mx, s[1][i]); }
            mx = fmaxf(mx, __shfl_xor(mx, 32));
            if (__any(mx > 8.f)) {
                const float d = fmaxf(mx, 0.f);
                const float alpha = __builtin_amdgcn_exp2f(-d);
                l *= alpha;
#pragma unroll
                for (int i = 0; i < 16; ++i) { o[0][i] *= alpha; o[1][i] *= alpha; s[0][i] -= d; s[1][i] -= d; }
                m += d;
            }
            float ps = 0.f;
#pragma unroll
            for (int kk = 0; kk < 2; ++kk)
#pragma unroll
                for (int i = 0; i < 16; ++i) { float pv = __builtin_amdgcn_exp2f(s[kk][i]); s[kk][i] = pv; ps += pv; }
            l += ps;
#pragma unroll
            for (int kk = 0; kk < 2; ++kk)
#pragma unroll
                for (int s2 = 0; s2 < 2; ++s2) {
                    const bf16x8 pb = pack_frag(s[kk][8 * s2 + 0], s[kk][8 * s2 + 1], s[kk][8 * s2 + 2], s[kk][8 * s2 + 3], s[kk][8 * s2 + 4], s[kk][8 * s2 + 5], s[kk][8 * s2 + 6], s[kk][8 * s2 + 7]);
#pragma unroll
                    for (int dt = 0; dt < 2; ++dt) {
                        const bf16_t* vp = Vs + (dt * 32 + r) * VP + kk * 32 + 16 * s2 + 4 * h;
                        uint2 lo = *(const uint2*)vp, hi = *(const uint2*)(vp + 8);
                        uint4 vu; vu.x = lo.x; vu.y = lo.y; vu.z = hi.x; vu.w = hi.y;
                        o[dt] = MFMA(__builtin_bit_cast(bf16x8, vu), pb, o[dt]);
                    }
                }
        }
        if (kt + 2 < nkt) ASWRITE(b, 0)
        if (kt + 4 < nkt) AGLOAD(b, (kt + 4) * 64)
        LDS_BARRIER();
    }
#undef AGLOAD
#undef ASWRITE
    l += __shfl_xor(l, 32);
    const float inv = 1.f / l;
    bf16_t* Os = (bf16_t*)smem + (size_t)w * 32 * 72;
#pragma unroll
    for (int dt = 0; dt < 2; ++dt)
#pragma unroll
        for (int g = 0; g < 4; ++g) {
            uint2 u; u.x = pack2(o[dt][4 * g] * inv, o[dt][4 * g + 1] * inv); u.y = pack2(o[dt][4 * g + 2] * inv, o[dt][4 * g + 3] * inv);
            *(uint2*)(Os + r * 72 + dt * 32 + 8 * g + 4 * h) = u;
        }
    __syncthreads();
#pragma unroll
    for (int j = 0; j < 4; ++j) {
        int c = lane + 64 * j, row = c >> 3, cc = c & 7;
        uint4 u = *(const uint4*)(Os + row * 72 + cc * 8);
        *(uint4*)(Odst + (size_t)(w * 32 + row) * 1024 + cc * 8) = u;
    }
    __syncthreads();
}

DI void phase_attn(const Params& p, char* smem_all) {
    char* smem = smem_all + HBI * HB_SMEM;
    bf16_t* O = (bf16_t*)(p.ws + OFF_H);
    for (int it0 = blockIdx.x * 2; it0 < 2304; it0 += gridDim.x * 2) {
        const int item = it0 + HBI;
        int b, kind, hq, qb, nkeys, sq0, orow;
        if (item < 2048) { qb = item & 15; hq = (item >> 4) & 7; kind = (item >> 7) & 1; b = item >> 8; sq0 = 256 + qb * 128; nkeys = 2304; orow = b * 2048 + qb * 128; }
        else { int it = item - 2048; qb = it & 1; hq = (it >> 1) & 7; kind = (it >> 4) & 1; b = it >> 5; sq0 = qb * 128; nkeys = 256; orow = 16384 + b * 256 + qb * 128; }
        bf16_t* od = O + (size_t)orow * 1024 + kind * 512 + hq * 64;
        if (kind == 0) {
            const bf16_t* Q = (const bf16_t*)(p.ws + OFF_QM) + ((size_t)(b * 2304 + sq0) * 8 + hq) * 96;
            const bf16_t* K = (const bf16_t*)(p.ws + OFF_KM) + ((size_t)(b * 2304) * 8 + hq) * 96;
            const bf16_t* VT = (const bf16_t*)(p.ws + OFF_VMT) + (size_t)(b * 8 + hq) * 64 * 2304;
            attn_body<96>(Q, 768, K, 768, VT, nkeys, od, smem);
        } else {
            const int kvh = hq >> 2;
            const bf16_t* Q = (const bf16_t*)(p.ws + OFF_QG) + ((size_t)(b * 2304 + sq0) * 8 + hq) * 64;
            const bf16_t* K = (const bf16_t*)(p.ws + OFF_KG) + ((size_t)(b * 2304) * 2 + kvh) * 64;
            const bf16_t* VT = (const bf16_t*)(p.ws + OFF_VGT) + (size_t)(b * 2 + kvh) * 64 * 2304;
            attn_body<64>(Q, 512, K, 128, VT, nkeys, od, smem);
        }
    }
}

DI void phase_proj_resid(const Params& p, const bf16_t* A, int K, const bf16_t* W, const float* mod, int gate_idx,
                         const float* srcLat, const float* srcCtx, float* dstLat, float* dstCtx, int mtiles2, bool ctx_small, char* smem_all) {
    for (int id = blockIdx.x; id < mtiles2 * 4; id += gridDim.x) {
        const int nt2 = id / mtiles2, mt2 = id % mtiles2;
        auto epi = [&](const float* Cs, int si, int sj, int tid) {
            const int nt = 2 * nt2 + sj, m0 = (2 * mt2 + si) * 128;
            const float* src; float* dst; int mb;
            if (m0 < 16384) { src = srcLat + (size_t)m0 * 1024; dst = dstLat + (size_t)m0 * 1024; mb = m0 >> 11; }
            else { src = srcCtx + (size_t)(m0 - 16384) * 1024; dst = dstCtx + (size_t)(m0 - 16384) * 1024; mb = 8; }
            epi_resid(Cs, src + nt * 128, dst + nt * 128, mod + (size_t)mb * 6144 + gate_idx * 1024 + nt * 128, tid);
        };
        const int r0 = g_row(0), r1 = g_row(1), r2 = g_row(2), r3 = g_row(3);
        const bf16_t* Ab = A + (size_t)mt2 * 256 * K;
        const bf16_t* Bb = W + (size_t)nt2 * 256 * K;
        gemm256(p.ws, Ab + (size_t)r0 * K + g_chunk(r0) * 8, Ab + (size_t)r1 * K + g_chunk(r1) * 8, Ab + (size_t)r2 * K + g_chunk(r2) * 8, Ab + (size_t)r3 * K + g_chunk(r3) * 8,
                Bb + (size_t)b_perm(r0) * K + g_chunk(r0) * 8, Bb + (size_t)b_perm(r1) * K + g_chunk(r1) * 8, Bb + (size_t)b_perm(r2) * K + g_chunk(r2) * 8, Bb + (size_t)b_perm(r3) * K + g_chunk(r3) * 8,
                K, smem_all, epi);
    }
    if (ctx_small) {
        char* smem = smem_all + HBI * HB_SMEM;
        for (int id0 = blockIdx.x * 2; id0 < 128; id0 += gridDim.x * 2) {
            const int id = id0 + HBI, nt = id >> 4, m0 = 16384 + (id & 15) * 128;
            auto epi = [&](const float* Cs, const float*) {
                epi_resid(Cs, srcCtx + (size_t)(m0 - 16384) * 1024 + nt * 128, dstCtx + (size_t)(m0 - 16384) * 1024 + nt * 128, mod + (size_t)8 * 6144 + gate_idx * 1024 + nt * 128, TID);
            };
            const bf16_t* Ar = A + (size_t)(m0 + (TID >> 3)) * K;
            gemm_tile<false, false>(Ar, Ar + (size_t)32 * K, Ar + (size_t)64 * K, Ar + (size_t)96 * K, 0u, 0u, 0u, 0u, W + (size_t)nt * 128 * K, K, K, smem, epi);
        }
    }
}

DI float4 conv4(float4 w0, float4 w1, float4 w2, float4 bb, float4 gm, float4 g0, float4 gp, float4 v) {
    float4 o;
    o.x = siluf_(w0.x * gm.x + w1.x * g0.x + w2.x * gp.x + bb.x) * v.x;
    o.y = siluf_(w0.y * gm.y + w1.y * g0.y + w2.y * gp.y + bb.y) * v.y;
    o.z = siluf_(w0.z * gm.z + w1.z * g0.z + w2.z * gp.z + bb.z) * v.z;
    o.w = siluf_(w0.w * gm.w + w1.w * g0.w + w2.w * gp.w + bb.w) * v.w;
    return o;
}
DI void halo_info(int mt, int& base, int& T, int& tstart) {
    int ti;
    if (mt < 136) { base = (mt / 17) * 2048; T = 2048; ti = mt % 17; }
    else { int q = mt - 136; base = 16384 + (q / 3) * 256; T = 256; ti = q % 3; }
    tstart = 126 * ti - 1;
}
DI const bf16_t* halo_ptr(const bf16_t* H, const bf16_t* Z, int mt2, int row) {
    int base, T, tstart; halo_info(2 * mt2 + (row >> 7), base, T, tstart);
    const int t = tstart + (row & 127);
    return (t >= 0 && t < T) ? H + (size_t)(base + t) * 1024 + g_chunk(row) * 8 : Z;
}
DI void phase_ffn_up(const Params& p, const bf16_t* W, const float* convw, const float* convb, int mtiles2, char* smem_all) {
    const bf16_t* H = (const bf16_t*)(p.ws + OFF_H);
    const bf16_t* Z = (const bf16_t*)(p.ws + OFF_ZROW);
    bf16_t* ACT = (bf16_t*)(p.ws + OFF_ACT);
    for (int id = blockIdx.x; id < mtiles2 * 22; id += gridDim.x) {
        const int nt2 = id / mtiles2, mt2 = id % mtiles2;
        auto epi = [&](const float* Cs, int si, int sj, int tid) {
            const int nt = 2 * nt2 + sj;
            int base, T, tstart; halo_info(2 * mt2 + si, base, T, tstart);
            const int cc = tid & 7;
            const int cg0 = nt * 64 + cc * 8;
            const float4 w0a = *(const float4*)(convw + cg0), w0b = *(const float4*)(convw + cg0 + 4);
            const float4 w1a = *(const float4*)(convw + 2816 + cg0), w1b = *(const float4*)(convw + 2816 + cg0 + 4);
            const float4 w2a = *(const float4*)(convw + 5632 + cg0), w2b = *(const float4*)(convw + 5632 + cg0 + 4);
            const float4 bba = *(const float4*)(convb + cg0), bbb = *(const float4*)(convb + cg0 + 4);
#pragma unroll
            for (int j = 0; j < 4; ++j) {
                const int rr = (tid >> 3) + 32 * j, t = tstart + rr;
                if (rr >= 1 && rr <= 126 && t < T) {
                    const float4* a = (const float4*)(Cs + (rr - 1) * CP + cc * 8);
                    const float4* bq = (const float4*)(Cs + rr * CP + cc * 8);
                    const float4* c = (const float4*)(Cs + (rr + 1) * CP + cc * 8);
                    const float4* d = (const float4*)(Cs + rr * CP + 64 + cc * 8);
                    const float4 oa = conv4(w0a, w1a, w2a, bba, a[0], bq[0], c[0], d[0]);
                    const float4 ob = conv4(w0b, w1b, w2b, bbb, a[1], bq[1], c[1], d[1]);
                    uint4 u; u.x = pack2(oa.x, oa.y); u.y = pack2(oa.z, oa.w); u.z = pack2(ob.x, ob.y); u.w = pack2(ob.z, ob.w);
                    *(uint4*)(ACT + (size_t)(base + t) * 2816 + cg0) = u;
                }
            }
        };
        const int r0 = g_row(0), r1 = g_row(1), r2 = g_row(2), r3 = g_row(3);
        const bf16_t* Bb = W + (size_t)nt2 * 256 * 1024;
        gemm256(p.ws, halo_ptr(H, Z, mt2, r0), halo_ptr(H, Z, mt2, r1), halo_ptr(H, Z, mt2, r2), halo_ptr(H, Z, mt2, r3),
                Bb + (size_t)b_perm(r0) * 1024 + g_chunk(r0) * 8, Bb + (size_t)b_perm(r1) * 1024 + g_chunk(r1) * 8, Bb + (size_t)b_perm(r2) * 1024 + g_chunk(r2) * 8, Bb + (size_t)b_perm(r3) * 1024 + g_chunk(r3) * 8,
                1024, smem_all, epi);
    }
}

DI void phase_inproj1(const Params& p, char* smem_all) {
    const bf16_t* H = (const bf16_t*)(p.ws + OFF_H);
    const bf16_t* W = (const bf16_t*)(p.ws + OFF_WT_IN1);
    for (int id = blockIdx.x; id < 72 * 13; id += gridDim.x) {
        const int nt2 = id / 72, mt2 = id % 72;
        if (mt2 >= 64 && nt2 >= 8 && nt2 < 12) continue;
        auto epi = [&](const float* Cs, int si, int sj, int tid) {
            const int nt = 2 * nt2 + sj, m0 = (2 * mt2 + si) * 128;
            if (nt < 8) epi_store_bf16(Cs, (bf16_t*)(p.ws + OFF_QKRAW) + (size_t)m0 * 1024 + nt * 128, 1024, tid);
            else if (nt < 16) epi_store_bf16(Cs, (bf16_t*)(p.ws + OFF_V1) + (size_t)m0 * 1024 + (nt - 8) * 128, 1024, tid);
            else if (nt < 24) epi_store_bf16(Cs, (bf16_t*)(p.ws + OFF_OG) + (size_t)m0 * 1024 + (nt - 16) * 128, 1024, tid);
            else if (nt == 24) {
                const int row = tid >> 1, half = tid & 1;
                float* dst = (float*)(p.ws + OFF_GATES) + (size_t)(m0 + row) * 32 + half * 16;
#pragma unroll
                for (int i = 0; i < 16; ++i) {
                    int c = half * 16 + i;
                    float v = Cs[row * CP + c] + p.ml_gate_b[c];
                    if (c & 8) v = logsigmoidf_(v);
                    dst[i] = v;
                }
            }
        };
        const int r0 = g_row(0), r1 = g_row(1), r2 = g_row(2), r3 = g_row(3);
        const bf16_t* Ab = H + (size_t)mt2 * 256 * 1024;
        const bf16_t* Bb = W + (size_t)nt2 * 256 * 1024;
        gemm256(p.ws, Ab + (size_t)r0 * 1024 + g_chunk(r0) * 8, Ab + (size_t)r1 * 1024 + g_chunk(r1) * 8, Ab + (size_t)r2 * 1024 + g_chunk(r2) * 8, Ab + (size_t)r3 * 1024 + g_chunk(r3) * 8,
                Bb + (size_t)b_perm(r0) * 1024 + g_chunk(r0) * 8, Bb + (size_t)b_perm(r1) * 1024 + g_chunk(r1) * 8, Bb + (size_t)b_perm(r2) * 1024 + g_chunk(r2) * 8, Bb + (size_t)b_perm(r3) * 1024 + g_chunk(r3) * 8,
                1024, smem_all, epi);
    }
}

DI void phase_qkconv(const Params& p) {
    const bf16_t* QK = (const bf16_t*)(p.ws + OFF_QKRAW);
    bf16_t* QC = (bf16_t*)(p.ws + OFF_H);
    {
        const int lane = threadIdx.x & 63, gw = blockIdx.x * 8 + (threadIdx.x >> 6);
        const float* GT = (const float*)(p.ws + OFF_GATES);
        float* SC = (float*)(p.ws + OFF_SCAN);
        for (int seg = gw; seg < 2304; seg += gridDim.x * 8) {
            const int step = seg % 18, dir = (seg / 18) & 1, hd = (seg / 36) & 7, b = seg / 288;
            int base, P0;
            if (step < 2) { base = 16384 + b * 256; P0 = (dir ? 1 - step : step) * 128; } else { base = b * 2048; P0 = (dir ? 17 - step : step - 2) * 128; }
            const int pa = dir ? P0 + 127 - lane : P0 + lane, pb = dir ? pa - 64 : pa + 64;
            const float* ga = GT + (size_t)(base + pa) * 32 + dir * 16 + hd; const float* gb = GT + (size_t)(base + pb) * 32 + dir * 16 + hd;
            const float i0 = ga[0], f0 = ga[8], i1 = gb[0], f1 = gb[8];
            float b0 = f0, b1 = f1;
#pragma unroll
            for (int off = 1; off < 64; off <<= 1) { float t0 = __shfl_up(b0, off), t1 = __shfl_up(b1, off); if (lane >= off) { b0 += t0; b1 += t1; } }
            b1 += __shfl(b0, 63);
            float p0 = i0 - b0, p1 = i1 - b1;
            const float c0 = p0, c1 = p1;
#pragma unroll
            for (int off = 1; off < 64; off <<= 1) { float t0 = __shfl_up(p0, off), t1 = __shfl_up(p1, off); if (lane >= off) { p0 = fmaxf(p0, t0); p1 = fmaxf(p1, t1); } }
            p1 = fmaxf(p1, __shfl(p0, 63));
            float* o = SC + (size_t)seg * 384;
            o[lane] = b0; o[64 + lane] = b1; o[128 + lane] = p0; o[192 + lane] = p1; o[256 + lane] = c0; o[320 + lane] = c1;
        }
    }
    for (int c = blockIdx.x * NTHREADS + threadIdx.x; c < 18432 * 128; c += gridDim.x * NTHREADS) {
        const int row = c >> 7, col = (c & 127) * 8;
        int T, t;
        if (row < 16384) { T = 2048; t = row & 2047; } else { T = 256; t = (row - 16384) & 255; }
        float acc[8];
        { const float4 b0 = *(const float4*)(p.ml_conv_b + col), b1 = *(const float4*)(p.ml_conv_b + col + 4);
          acc[0] = b0.x; acc[1] = b0.y; acc[2] = b0.z; acc[3] = b0.w; acc[4] = b1.x; acc[5] = b1.y; acc[6] = b1.z; acc[7] = b1.w; }
#pragma unroll
        for (int dj = 0; dj < 3; ++dj) {
            const int tt = t + dj - 1;
            const float on = (tt >= 0 && tt < T) ? 1.f : 0.f;
            const int rr = row + min(max(tt, 0), T - 1) - t;
            float f[8]; unpack8(*(const uint4*)(QK + (size_t)rr * 1024 + col), f);
            const float4 w0 = *(const float4*)(p.ml_conv_w + dj * 1024 + col), w1 = *(const float4*)(p.ml_conv_w + dj * 1024 + col + 4);
            acc[0] += w0.x * on * f[0]; acc[1] += w0.y * on * f[1]; acc[2] += w0.z * on * f[2]; acc[3] += w0.w * on * f[3];
            acc[4] += w1.x * on * f[4]; acc[5] += w1.y * on * f[5]; acc[6] += w1.z * on * f[6]; acc[7] += w1.w * on * f[7];
        }
        const float sc = col >= 512 ? 0.125f : 1.f;
#pragma unroll
        for (int i = 0; i < 8; ++i) acc[i] = siluf_(acc[i]) * sc;
        *(uint4*)(QC + (size_t)row * 1024 + col) = pack8(acc);
    }
}

DI void phase_mlstm(const Params& p, char* smem) {
    constexpr int LP = 72, TP = 136, L = 128;
    bf16_t* Qc = (bf16_t*)smem;
    bf16_t* Kc = Qc + L * LP;
    bf16_t* KcT = Kc + L * LP;
    bf16_t* VcT = KcT + 64 * TP;
    bf16_t* VwT = VcT + 64 * TP;
    bf16_t* Pm = VwT + 64 * TP;
    bf16_t* Cb = Pm + L * TP;
    float* fa = (float*)(Cb + 64 * LP);
    float* bcum = fa; float* ig = fa + 128; float* mtv = fa + 256; float* wint = fa + 384; float* denI = fa + 512; float* denX = fa + 640;
    float* wgt = fa + 768; float* nvec = fa + 896; float* scal = fa + 960; float* csv = fa + 1024; float* denP = fa + 1152;
    static_assert((2 * L * LP + 3 * 64 * TP + L * TP + 64 * LP) * 2 + 1408 * 4 <= SMEM_ALL, "mLSTM LDS");
    const int lane0 = threadIdx.x & 63, w = __builtin_amdgcn_readfirstlane(threadIdx.x >> 6);
    const bf16_t* QK = (const bf16_t*)(p.ws + OFF_H);
    const bf16_t* V1 = (const bf16_t*)(p.ws + OFF_V1);
    const float* GT = (const float*)(p.ws + OFF_GATES);
    for (int item = blockIdx.x; item < 256; item += gridDim.x) {
        const int vh = item & 1, dir = (item >> 1) & 1, hd = (item >> 2) & 7, b = item >> 5;
        bf16_t* Hout = (bf16_t*)(p.ws + (dir ? OFF_HB : OFF_HF));
        f32x16 accC = zero16();
        float m_prev = 0.f;
        for (int i = w * 64 + lane0; i < 64 * LP; i += 512) Cb[i] = 0;
        if (w == 0) nvec[lane0] = 0.f;
        int lane = lane0, tid = w * 64 + lane0, h = lane0 >> 5, r = lane0 & 31;
        int u = tid >> 2, part = tid & 3;
        uint4 rq0, rq1, rk0, rk1, rv0, rv1;
        float sc_b = 0.f, sc_p = 0.f, sc_c = 0.f, sc_bl = 0.f, sc_pl = 0.f;
#define ML_STEP_GEOM(st, base_, P0_) { if ((st) < 2) { base_ = 16384 + b * 256; P0_ = (dir ? 1 - (st) : (st)) * L; } else { base_ = b * 2048; P0_ = (dir ? 17 - (st) : (st) - 2) * L; } }
#define ML_PREFETCH(st) { int base_, P0_; ML_STEP_GEOM(st, base_, P0_) \
            const int pos_ = dir ? P0_ + L - 1 - u : P0_ + u; \
            { const bf16_t* rowp = QK + (size_t)(base_ + pos_) * 1024; \
              const int qcol = hd * 64 + part * 16, kcol = 512 + qcol; rq0 = *(const uint4*)(rowp + qcol); rq1 = *(const uint4*)(rowp + qcol + 8); rk0 = *(const uint4*)(rowp + kcol); rk1 = *(const uint4*)(rowp + kcol + 8); } \
            { const bf16_t* vp_ = V1 + (size_t)(base_ + pos_) * 1024 + hd * 128 + vh * 64 + part * 16; rv0 = *(const uint4*)vp_; rv1 = *(const uint4*)(vp_ + 8); } \
            if (w < 2) { const float* sp_ = (const float*)(p.ws + OFF_SCAN) + (size_t)((((b * 8 + hd) * 2 + dir) * 18) + (st)) * 384; \
                sc_b = sp_[tid]; sc_p = sp_[128 + tid]; sc_c = sp_[256 + tid]; sc_bl = sp_[127]; sc_pl = sp_[255]; } }
        ML_PREFETCH(0)
        __syncthreads();
#pragma unroll 1
        for (int step = 0; step < 18; ++step) {
            lane = lane0; asm volatile("" : "+v"(lane));
            tid = w * 64 + lane; h = lane >> 5; r = lane & 31; u = tid >> 2; part = tid & 3;
            int base, P0; ML_STEP_GEOM(step, base, P0)
            const bool full = step >= 2;
            if (w < 2) {
                const float mt = fmaxf(sc_b + m_prev, sc_b + sc_p);
                const float mnew = fmaxf(sc_bl + m_prev, sc_bl + sc_pl);
                bcum[tid] = sc_b; csv[tid] = sc_c; mtv[tid] = mt;
                wint[tid] = __expf(sc_b + m_prev - mt);
                wgt[tid] = __expf(sc_bl + sc_c - mnew);
                if (tid == 0) { scal[0] = mnew; scal[1] = __expf(sc_bl + m_prev - mnew); }
            }
            {
                *(uint4*)(Qc + u * LP + part * 16) = rq0; *(uint4*)(Qc + u * LP + part * 16 + 8) = rq1;
                *(uint4*)(Kc + u * LP + part * 16) = rk0; *(uint4*)(Kc + u * LP + part * 16 + 8) = rk1;
#define ML_T2(dstT, wv, ci) { dstT[(part * 16 + (ci)) * TP + u] = (bf16_t)((wv) & 0xffffu); dstT[(part * 16 + (ci) + 1) * TP + u] = (bf16_t)((wv) >> 16); }
                ML_T2(KcT, rk0.x, 0) ML_T2(KcT, rk0.y, 2) ML_T2(KcT, rk0.z, 4) ML_T2(KcT, rk0.w, 6) ML_T2(KcT, rk1.x, 8) ML_T2(KcT, rk1.y, 10) ML_T2(KcT, rk1.z, 12) ML_T2(KcT, rk1.w, 14)
                ML_T2(VcT, rv0.x, 0) ML_T2(VcT, rv0.y, 2) ML_T2(VcT, rv0.z, 4) ML_T2(VcT, rv0.w, 6) ML_T2(VcT, rv1.x, 8) ML_T2(VcT, rv1.y, 10) ML_T2(VcT, rv1.z, 12) ML_T2(VcT, rv1.w, 14)
#undef ML_T2
            }
            if (step + 1 < 18) ML_PREFETCH(step + 1)
            LDS_BARRIER();
            const float m_new = scal[0], decay = scal[1];
            {
                const int vv = tid >> 3, s0_ = (tid & 7) * 16;
#pragma unroll
                for (int q = 0; q < 2; ++q) {
                    float f[8]; unpack8(*(const uint4*)(VcT + vv * TP + s0_ + q * 8), f);
                    const float4 w0 = *(const float4*)(wgt + s0_ + q * 8), w1 = *(const float4*)(wgt + s0_ + q * 8 + 4);
                    f[0] *= w0.x; f[1] *= w0.y; f[2] *= w0.z; f[3] *= w0.w; f[4] *= w1.x; f[5] *= w1.y; f[6] *= w1.z; f[7] *= w1.w;
                    *(uint4*)(VwT + vv * TP + s0_ + q * 8) = pack8(f);
                }
            }
            if (full) {
                {
                    float sacc_ = 0.f;
#pragma unroll
                    for (int q = 0; q < 2; ++q) {
                        float f[8]; unpack8(*(const uint4*)(Qc + u * LP + part * 16 + q * 8), f);
                        const float4 n0 = *(const float4*)(nvec + part * 16 + q * 8), n1 = *(const float4*)(nvec + part * 16 + q * 8 + 4);
                        sacc_ += f[0] * n0.x + f[1] * n0.y + f[2] * n0.z + f[3] * n0.w + f[4] * n1.x + f[5] * n1.y + f[6] * n1.z + f[7] * n1.w;
                    }
                    sacc_ += __shfl_xor(sacc_, 1); sacc_ += __shfl_xor(sacc_, 2);
                    if (part == 0) denX[u] = sacc_;
                }
                const int ti = w >> 1, t = ti * 32 + r;
                const float bt = bcum[t] - mtv[t];
                float rs = 0.f;
#pragma unroll
                for (int q = 0; q < 2; ++q) {
                    const int si = 2 * (w & 1) + q;
                    if (si <= ti) {
                        f32x16 sacc = zero16();
#pragma unroll
                        for (int ks = 0; ks < 4; ++ks) {
                            bf16x8 a = *(const bf16x8*)(Kc + (si * 32 + r) * LP + ks * 16 + h * 8);
                            bf16x8 bb = *(const bf16x8*)(Qc + (ti * 32 + r) * LP + ks * 16 + h * 8);
                            sacc = MFMA(a, bb, sacc);
                        }
#pragma unroll
                        for (int g4 = 0; g4 < 4; ++g4) {
                            const int s0_ = si * 32 + 8 * g4 + 4 * h;
                            const float4 c4 = *(const float4*)(csv + s0_);
                            float p0 = s0_ + 0 <= t ? sacc[4 * g4 + 0] * __expf(bt + c4.x) : 0.f;
                            float p1 = s0_ + 1 <= t ? sacc[4 * g4 + 1] * __expf(bt + c4.y) : 0.f;
                            float p2 = s0_ + 2 <= t ? sacc[4 * g4 + 2] * __expf(bt + c4.z) : 0.f;
                            float p3 = s0_ + 3 <= t ? sacc[4 * g4 + 3] * __expf(bt + c4.w) : 0.f;
                            rs += (p0 + p1) + (p2 + p3);
                            uint2 pk; pk.x = pack2(p0, p1); pk.y = pack2(p2, p3);
                            *(uint2*)(Pm + t * TP + s0_) = pk;
                        }
                    } else {
#pragma unroll
                        for (int g4 = 0; g4 < 4; ++g4) *(uint2*)(Pm + t * TP + si * 32 + 8 * g4 + 4 * h) = make_uint2(0u, 0u);
                    }
                }
                rs += __shfl_xor(rs, 32);
                if (h == 0) denP[(w & 1) * 128 + t] = rs;
            }
            LDS_BARRIER();
            f32x16 hacc = zero16();
            const int ti = w >> 1, vi = w & 1;
            if (full) {
#pragma unroll
                for (int ks = 0; ks < 4; ++ks) {
                    bf16x8 a = *(const bf16x8*)(Cb + (vi * 32 + r) * LP + ks * 16 + h * 8);
                    bf16x8 bb = *(const bf16x8*)(Qc + (ti * 32 + r) * LP + ks * 16 + h * 8);
                    hacc = MFMA(a, bb, hacc);
                }
                const float wi = wint[ti * 32 + r];
#pragma unroll
                for (int g = 0; g < 16; ++g) hacc[g] *= wi;
#pragma unroll
                for (int ks = 0; ks < 8; ++ks) {
                    if (ks <= 2 * ti + 1) {
                        bf16x8 a = *(const bf16x8*)(VcT + (vi * 32 + r) * TP + ks * 16 + h * 8);
                        bf16x8 bb = *(const bf16x8*)(Pm + (ti * 32 + r) * TP + ks * 16 + h * 8);
                        hacc = MFMA(a, bb, hacc);
                    }
                }
            }
            LDS_BARRIER();
            if (full) {
                const int t = ti * 32 + r;
                const float den = wint[t] * denX[t] + denP[t] + denP[128 + t];
                const float inv = __builtin_amdgcn_rcpf(fmaxf(fabsf(den), __expf(-mtv[t])));
                bf16_t* hp = Pm + t * LP + vi * 32 + 4 * h;
#pragma unroll
                for (int g4 = 0; g4 < 4; ++g4) {
                    uint2 pk; pk.x = pack2(hacc[4 * g4] * inv, hacc[4 * g4 + 1] * inv); pk.y = pack2(hacc[4 * g4 + 2] * inv, hacc[4 * g4 + 3] * inv);
                    *(uint2*)(hp + 8 * g4) = pk;
                }
            }
            if (w < 4) {
                const int vi2 = w >> 1, di = w & 1;
#pragma unroll
                for (int g = 0; g < 16; ++g) accC[g] *= decay;
#pragma unroll
                for (int ks = 0; ks < 8; ++ks) {
                    bf16x8 a = *(const bf16x8*)(VwT + (vi2 * 32 + r) * TP + ks * 16 + h * 8);
                    bf16x8 bb = *(const bf16x8*)(KcT + (di * 32 + r) * TP + ks * 16 + h * 8);
                    accC = MFMA(a, bb, accC);
                }
#pragma unroll
                for (int g = 0; g < 16; ++g) Cb[(vi2 * 32 + crow(g, h)) * LP + di * 32 + r] = f2bf_sw(accC[g]);
            } else {
                const int t2 = tid - 256, d = t2 >> 2, pq = t2 & 3;
                float sacc_ = 0.f;
#pragma unroll
                for (int q = 0; q < 4; ++q) {
                    float f[8]; unpack8(*(const uint4*)(KcT + d * TP + pq * 32 + q * 8), f);
                    const float4 w0 = *(const float4*)(wgt + pq * 32 + q * 8), w1 = *(const float4*)(wgt + pq * 32 + q * 8 + 4);
                    sacc_ += f[0] * w0.x + f[1] * w0.y + f[2] * w0.z + f[3] * w0.w + f[4] * w1.x + f[5] * w1.y + f[6] * w1.z + f[7] * w1.w;
                }
                sacc_ += __shfl_xor(sacc_, 1); sacc_ += __shfl_xor(sacc_, 2);
                if (pq == 0) nvec[d] = decay * nvec[d] + sacc_;
            }
            m_prev = m_new;
            LDS_BARRIER();
            if (full) {
#pragma unroll
                for (int q = 0; q < 2; ++q) {
                    const int c = tid + 512 * q, t = c >> 3, ch = c & 7;
                    const int pos = dir ? P0 + L - 1 - t : P0 + t;
                    *(uint4*)(Hout + (size_t)(base + pos) * 1024 + hd * 128 + vh * 64 + ch * 8) = *(const uint4*)(Pm + t * LP + ch * 8);
                }
            }
        }
#undef ML_STEP_GEOM
#undef ML_PREFETCH
    }
}

DI void phase_mix(const Params& p) {
    const int lane = threadIdx.x & 63, w = threadIdx.x >> 6;
    const bf16_t* HF = (const bf16_t*)(p.ws + OFF_HF);
    const bf16_t* HB = (const bf16_t*)(p.ws + OFF_HB);
    const bf16_t* OG = (const bf16_t*)(p.ws + OFF_OG);
    bf16_t* H = (bf16_t*)(p.ws + OFF_H);
    for (int row = blockIdx.x * 8 + w; row < 16384; row += gridDim.x * 8) {
        const size_t o = (size_t)row * 1024 + lane * 16;
        float a[16], bq[16], og[16];
        unpack8(*(const uint4*)(HF + o), a); unpack8(*(const uint4*)(HF + o + 8), a + 8);
        unpack8(*(const uint4*)(HB + o), bq); unpack8(*(const uint4*)(HB + o + 8), bq + 8);
        unpack8(*(const uint4*)(OG + o), og); unpack8(*(const uint4*)(OG + o + 8), og + 8);
        float ss = 0.f;
#pragma unroll
        for (int i = 0; i < 16; ++i) { a[i] += bq[i]; ss += a[i] * a[i]; }
        ss += __shfl_xor(ss, 1); ss += __shfl_xor(ss, 2); ss += __shfl_xor(ss, 4);
        const float rstd = rsqrtf(ss * (1.f / 128.f) + EPSF);
        const float* g = p.ml_out_g + lane * 16;
#pragma unroll
        for (int i = 0; i < 16; ++i) a[i] = a[i] * rstd * g[i] * sigmoidf_(og[i]);
        *(uint4*)(H + o) = pack8(a); *(uint4*)(H + o + 8) = pack8(a + 8);
    }
}

#define XB_TMO      128
#define XB_XCNT(j)  (256  + 64 * (j))
#define XB_XSUB(j)  (1280 + 64 * (j))
#define XB_XGEN(j)  (2304 + 64 * (j))
#define XB_TOP      3328
#define XB_TOPGEN   3392
#define XCD_BAR_WORDS 3456
#define XB_SPIN_CAP (1u << 18)
#define LAS __attribute__((address_space(3)))

__device__ __forceinline__ unsigned xb_ld(unsigned* p)              { return __hip_atomic_load(p, __ATOMIC_RELAXED, __HIP_MEMORY_SCOPE_AGENT); }
__device__ __forceinline__ unsigned xb_add(unsigned* p, unsigned v) { return __hip_atomic_fetch_add(p, v, __ATOMIC_RELAXED, __HIP_MEMORY_SCOPE_AGENT); }
__device__ __forceinline__ unsigned xb_xcc_id() { return (unsigned)__builtin_amdgcn_s_getreg((3 << 11) | 20) & 0xFu; }
#define XB_SPIN(cond, bar) do { unsigned _sp = 0; while (cond) { __builtin_amdgcn_s_sleep(1); \
    if ((++_sp & 255u) == 0u) { if (xb_ld(&(bar)[XB_TMO])) break; if (_sp > XB_SPIN_CAP) { atomicAdd(&(bar)[XB_TMO], 1u); break; } } } } while (0)

struct XcdBarrier {
    unsigned* bar; unsigned x;
    volatile LAS unsigned* st;
};

__device__ __forceinline__ XcdBarrier xcd_barrier_post(unsigned* bar, volatile LAS unsigned* st) {
    XcdBarrier b; b.bar = bar; b.x = xb_xcc_id(); b.st = st;
    if (threadIdx.x == 0) (void)xb_add(&bar[XB_XCNT(b.x)], 1u);
    return b;
}
__device__ __forceinline__ void xcd_barrier_complete(unsigned* bar, unsigned x, unsigned& nloc, unsigned& nx) {
    const unsigned G = gridDim.x * gridDim.y * gridDim.z;
    unsigned sum, cnt, mine, sp = 0u;
    for (;;) {
        sum = 0u; cnt = 0u; mine = 0u;
#pragma unroll
        for (unsigned j = 0; j < 16; ++j) { const unsigned c = xb_ld(&bar[XB_XCNT(j)]); sum += c; cnt += (c > 0u) ? 1u : 0u; mine = (j == x) ? c : mine; }
        if (sum == G) break;
        __builtin_amdgcn_s_sleep(1);
        if ((++sp & 255u) == 0u) { if (xb_ld(&bar[XB_TMO])) break; if (sp > XB_SPIN_CAP) { atomicAdd(&bar[XB_TMO], 1u); break; } }
    }
    nloc = mine > 0u ? mine : 1u; nx = cnt > 0u ? cnt : 1u;
}

__device__ __forceinline__ void xcd_barrier(const XcdBarrier& b) {
    asm volatile("s_waitcnt vmcnt(0)" ::: "memory");
    __syncthreads();
    if (threadIdx.x == 0) {
        unsigned* bar = b.bar;
        __builtin_amdgcn_s_waitcnt(0);
        unsigned nloc = b.st[0], nx = b.st[1];
        if (nloc == 0u) { xcd_barrier_complete(bar, b.x, nloc, nx); b.st[0] = nloc; b.st[1] = nx; }
        const unsigned old = xb_add(&bar[XB_XSUB(b.x)], 1u);
        const unsigned gen = old / nloc;
        if (old + 1u == (gen + 1u) * nloc) {
            __builtin_amdgcn_fence(__ATOMIC_RELEASE, "agent");
            asm volatile("s_waitcnt vmcnt(0)" ::: "memory");
            const unsigned og = xb_add(&bar[XB_TOP], 1u);
            const unsigned tg = og / nx;
            if (og + 1u == (tg + 1u) * nx) xb_add(&bar[XB_TOPGEN], 1u);
            else XB_SPIN(xb_ld(&bar[XB_TOPGEN]) == tg, bar);
            __builtin_amdgcn_fence(__ATOMIC_ACQUIRE, "agent");
            xb_add(&bar[XB_XGEN(b.x)], 1u);
            asm volatile("s_waitcnt vmcnt(0)" ::: "memory");
        } else {
            XB_SPIN(xb_ld(&bar[XB_XGEN(b.x)]) == gen, bar);
            __builtin_amdgcn_fence(__ATOMIC_ACQUIRE, "agent");
            asm volatile("s_waitcnt vmcnt(0)" ::: "memory");
        }
    }
    __syncthreads();
}


__global__ void __launch_bounds__(NTHREADS, 2) __attribute__((amdgpu_waves_per_eu(2, 2))) fwd_megakernel(Params p) {
    __shared__ __attribute__((aligned(1024))) char smem[SMEM_ALL];
    cg::grid_group grid = cg::this_grid();
    __shared__ uint4 xb_words;
    if (threadIdx.x == 0) xb_words = make_uint4(0u, 0u, 0u, 0u);
    __syncthreads();
    XcdBarrier xb = xcd_barrier_post((unsigned*)(p.ws + OFF_BAR), (volatile LAS unsigned*)&xb_words);
    const float* MOD0 = (const float*)(p.ws + OFF_MOD);
    const float* MOD1 = MOD0 + 9 * 6144;
    float* XRC = (float*)(p.ws + OFF_XRC);
    const bf16_t* Hb = (const bf16_t*)(p.ws + OFF_H);

    phase0(p, smem);
    if (p.ws == nullptr) grid.sync();
    xcd_barrier(xb);
    phase_norm(p, p.x, p.ctx, p.norm1_g, MOD0, 0, 18432);
    xcd_barrier(xb);
    phase_inproj0(p, smem);
    xcd_barrier(xb);
    phase_mla_up(p, smem);
    xcd_barrier(xb);
    phase_attn(p, smem);
    xcd_barrier(xb);
    phase_proj_resid(p, Hb, 1024, (const bf16_t*)(p.ws + OFF_WT_OUT0), MOD0, 2, p.x, p.ctx, p.out, XRC, 64, true, smem);
    xcd_barrier(xb);
    phase_norm(p, p.out, XRC, p.norm2_g, MOD0, 3, 18432);
    xcd_barrier(xb);
    phase_ffn_up(p, (const bf16_t*)(p.ws + OFF_WT_UP0), p.ffn_conv_w, p.ffn_conv_b, 80, smem);
    xcd_barrier(xb);
    phase_proj_resid(p, (const bf16_t*)(p.ws + OFF_ACT), 2816, (const bf16_t*)(p.ws + OFF_WT_DOWN0), MOD0, 5, p.out, XRC, p.out, XRC, 64, true, smem);
    xcd_barrier(xb);
    phase_norm(p, p.out, XRC, p.norm1_g + 1024, MOD1, 0, 18432);
    xcd_barrier(xb);
    phase_inproj1(p, smem);
    xcd_barrier(xb);
    phase_qkconv(p);
    xcd_barrier(xb);
    phase_mlstm(p, smem);
    xcd_barrier(xb);
    phase_mix(p);
    xcd_barrier(xb);
    phase_proj_resid(p, Hb, 1024, (const bf16_t*)(p.ws + OFF_WT_OUT1), MOD1, 2, p.out, XRC, p.out, XRC, 64, false, smem);
    xcd_barrier(xb);
    phase_norm(p, p.out, XRC, p.norm2_g + 1024, MOD1, 3, 16384);
    xcd_barrier(xb);
    phase_ffn_up(p, (const bf16_t*)(p.ws + OFF_WT_UP1), p.ffn_conv_w + 3 * 2816, p.ffn_conv_b + 2816, 68, smem);
    xcd_barrier(xb);
    phase_proj_resid(p, (const bf16_t*)(p.ws + OFF_ACT), 2816, (const bf16_t*)(p.ws + OFF_WT_DOWN1), MOD1, 5, p.out, XRC, p.out, XRC, 64, false, smem);
}

extern "C" void kernel_launch(void* const* d_in, const int* in_sizes, int n_in, void* d_out, int out_size, void* d_ws, size_t ws_size,
                              hipStream_t stream) {
    static int grid_blocks = 0;
    if (!grid_blocks) {
        int dev = 0, cus = 0, per_cu = 0;
        hipGetDevice(&dev);
        hipDeviceGetAttribute(&cus, hipDeviceAttributeMultiprocessorCount, dev);
        hipOccupancyMaxActiveBlocksPerMultiprocessor(&per_cu, fwd_megakernel, NTHREADS, 0);
        if (per_cu < 1) per_cu = 1;
        if (per_cu > 1) per_cu = 1;
        grid_blocks = cus * per_cu;
        if (ws_size < WS_END) fprintf(stderr, "kernel_launch: workspace too small: %zu < %zu\n", ws_size, (size_t)WS_END);
    }
    Params p{};
    const float** pf = (const float**)&p;
    for (int i = 0; i < 28; ++i) pf[i] = (const float*)d_in[i];
    p.out = (float*)d_out;
    p.ws = (char*)d_ws;
    hipMemsetAsync((char*)d_ws + OFF_BAR, 0, 16384, stream);
    void* args[] = {&p};
    hipError_t e = hipLaunchCooperativeKernel((void*)fwd_megakernel, dim3(grid_blocks), dim3(NTHREADS), args, 0, stream);
    if (e != hipSuccess) fprintf(stderr, "cooperative launch failed: %s (grid %d)\n", hipGetErrorString(e), grid_blocks);
}
```

```cpp
#include <hip/hip_runtime.h>
#include <hip/hip_cooperative_groups.h>
#include <cstdio>
namespace cg = cooperative_groups;

typedef unsigned short bf16_t;
using bf16x8 = __attribute__((ext_vector_type(8))) short;
using f32x16 = __attribute__((ext_vector_type(16))) float;
using f32x4 = __attribute__((ext_vector_type(4))) float;
#define DI __device__ __forceinline__
#define MFMA(a, b, c) __builtin_amdgcn_mfma_f32_32x32x16_bf16((a), (b), (c), 0, 0, 0)
#define MFMA16(a, b, c) __builtin_amdgcn_mfma_f32_16x16x32_bf16((a), (b), (c), 0, 0, 0)
#define LDS_BARRIER() do { asm volatile("s_waitcnt lgkmcnt(0)" ::: "memory"); __builtin_amdgcn_s_barrier(); asm volatile("" ::: "memory"); } while (0)
#define TID ((int)(threadIdx.x & 255))
#define HBI ((int)(threadIdx.x >> 8))

constexpr float EPSF = 1e-6f;
constexpr float LOG2E = 1.4426950408889634f;
constexpr int NTHREADS = 512;
constexpr int HB_SMEM = 73728;
constexpr int SMEM_ALL = 2 * HB_SMEM;
constexpr int GP = 72;
constexpr int CP = 132;
constexpr int ROWSS_OFF = 67584;

constexpr size_t OFF_WT_UP1 = 0;
constexpr size_t OFF_WT_DOWN1 = OFF_WT_UP1 + 5632ull * 1024 * 2;
constexpr size_t OFF_WT_IN1 = OFF_WT_DOWN1 + 1024ull * 2816 * 2;
constexpr size_t OFF_WT_OUT1 = OFF_WT_IN1 + 3328ull * 1024 * 2;
constexpr size_t OFF_MOD = OFF_WT_OUT1 + 1024ull * 1024 * 2;
constexpr size_t OFF_TABG = OFF_MOD + 2ull * 9 * 6144 * 4;
constexpr size_t OFF_TABM = OFF_TABG + 64 * 16 * 2 * 4;
constexpr size_t OFF_ZROW = OFF_TABM + 64 * 8 * 2 * 4;
constexpr size_t OFF_W0 = OFF_ZROW + 8192;
constexpr size_t OFF_WT_IN0 = OFF_W0;
constexpr size_t OFF_WT_QB = OFF_WT_IN0 + 1536ull * 1024 * 2;
constexpr size_t OFF_WT_KVB = OFF_WT_QB + 1024ull * 384 * 2;
constexpr size_t OFF_WT_OUT0 = OFF_WT_KVB + 1024ull * 256 * 2;
constexpr size_t OFF_WT_UP0 = OFF_WT_OUT0 + 1024ull * 1024 * 2;
constexpr size_t OFF_WT_DOWN0 = OFF_WT_UP0 + 5632ull * 1024 * 2;
constexpr size_t OFF_XRC = OFF_WT_DOWN0 + 1024ull * 2816 * 2;
constexpr size_t OFF_R = OFF_XRC + 2048ull * 1024 * 4;
constexpr size_t OFF_QG = OFF_R;
constexpr size_t OFF_KG = OFF_QG + 18432ull * 512 * 2;
constexpr size_t OFF_VGT = OFF_KG + 18432ull * 128 * 2;
constexpr size_t OFF_CQ = OFF_VGT + 18432ull * 128 * 2;
constexpr size_t OFF_CKV = OFF_CQ + 18432ull * 384 * 2;
constexpr size_t OFF_KR = OFF_CKV + 18432ull * 256 * 2;
constexpr size_t OFF_QM = OFF_KR + 18432ull * 32 * 4;
constexpr size_t OFF_KM = OFF_QM + 18432ull * 768 * 2;
constexpr size_t OFF_VMT = OFF_KM + 18432ull * 768 * 2;
constexpr size_t END_L0 = OFF_VMT + 18432ull * 512 * 2;
constexpr size_t OFF_ACT = OFF_R;
constexpr size_t END_ACT = OFF_ACT + 18432ull * 2816 * 2;
constexpr size_t OFF_QKRAW = OFF_W0;
constexpr size_t OFF_V1 = OFF_QKRAW + 18432ull * 1024 * 2;
constexpr size_t OFF_OG = OFF_V1 + 18432ull * 1024 * 2;
constexpr size_t OFF_GATES = OFF_OG + 16384ull * 1024 * 2;
constexpr size_t OFF_HF = OFF_GATES + 18432ull * 32 * 4;
constexpr size_t OFF_HB = OFF_HF + 16384ull * 1024 * 2;
constexpr size_t END_L1 = OFF_HB + 16384ull * 1024 * 2;
constexpr size_t cmax(size_t a, size_t b) { return a > b ? a : b; }
constexpr size_t OFF_H = cmax(cmax(END_L0, END_ACT), END_L1);
constexpr size_t OFF_BAR = OFF_H + 18432ull * 1024 * 2;
constexpr size_t OFF_SCAN = OFF_BAR + 16384;
constexpr size_t WS_END = OFF_SCAN + 2304ull * 384 * 4;
static_assert(WS_END <= 268435456ull, "workspace too large");
static_assert(OFF_H % 256 == 0 && OFF_R % 256 == 0 && OFF_HF % 256 == 0, "align");

struct Params {
    const float *x, *c, *ctx, *c_ctx, *ada_w, *ada_b, *norm1_g, *norm2_g, *ffn_w_up, *ffn_conv_w, *ffn_conv_b, *ffn_w_down,
        *att_w_in, *mla_qa_g, *mla_w_qb, *mla_kva_g, *mla_w_kvb, *mla_q_g, *mla_k_g, *gqa_q_g, *gqa_k_g, *att_w_out,
        *ml_w_in, *ml_conv_w, *ml_conv_b, *ml_gate_b, *ml_out_g, *ml_w_out;
    float* out;
    char* ws;
};

DI unsigned short f2bf_sw(float x) { unsigned u = __float_as_uint(x); u += 0x7fffu + ((u >> 16) & 1u); return (unsigned short)(u >> 16); }
DI unsigned short f2bf(float x) { unsigned r; asm("v_cvt_pk_bf16_f32 %0, %1, %1" : "=v"(r) : "v"(x)); return (unsigned short)(r & 0xffffu); }
DI unsigned pack2(float a, float b) { unsigned r; asm("v_cvt_pk_bf16_f32 %0, %1, %2" : "=v"(r) : "v"(a), "v"(b)); return r; }
DI bf16x8 pack_frag(float a0, float a1, float a2, float a3, float a4, float a5, float a6, float a7) {
    using u32x4_ = __attribute__((ext_vector_type(4))) unsigned; u32x4_ p;
    asm volatile("v_cvt_pk_bf16_f32 %0, %4, %5\n\tv_cvt_pk_bf16_f32 %1, %6, %7\n\tv_cvt_pk_bf16_f32 %2, %8, %9\n\tv_cvt_pk_bf16_f32 %3, %10, %11\n\ts_nop 1"
                 : "=&v"(p[0]), "=&v"(p[1]), "=&v"(p[2]), "=&v"(p[3]) : "v"(a0), "v"(a1), "v"(a2), "v"(a3), "v"(a4), "v"(a5), "v"(a6), "v"(a7));
    return __builtin_bit_cast(bf16x8, p);
}
DI float bflo(unsigned v) { return __uint_as_float(v << 16); }
DI float bfhi(unsigned v) { return __uint_as_float(v & 0xffff0000u); }
DI float bf2f(unsigned short v) { return __uint_as_float(((unsigned)v) << 16); }
DI uint4 pack8(const float* v) { uint4 o; o.x = pack2(v[0], v[1]); o.y = pack2(v[2], v[3]); o.z = pack2(v[4], v[5]); o.w = pack2(v[6], v[7]); return o; }
DI void unpack8(uint4 u, float* v) { v[0] = bflo(u.x); v[1] = bfhi(u.x); v[2] = bflo(u.y); v[3] = bfhi(u.y); v[4] = bflo(u.z); v[5] = bfhi(u.z); v[6] = bflo(u.w); v[7] = bfhi(u.w); }
DI int crow(int reg, int h) { return (reg & 3) + 8 * (reg >> 2) + 4 * h; }
DI float sigmoidf_(float x) { return __builtin_amdgcn_rcpf(1.f + __expf(-x)); }
DI float siluf_(float x) { return x * __builtin_amdgcn_rcpf(1.f + __expf(-x)); }
DI float logsigmoidf_(float x) { return fminf(x, 0.f) - log1pf(__expf(-fabsf(x))); }
DI f32x16 zero16() { f32x16 z;
#pragma unroll
    for (int i = 0; i < 16; ++i) z[i] = 0.f; return z; }

DI void row_info(int m0, int& b, int& t0, bool& lat) {
    if (m0 < 16384) { b = m0 >> 11; t0 = m0 & 2047; lat = true; }
    else { int q = m0 - 16384; b = q >> 8; t0 = q & 255; lat = false; }
}

template <bool SS, bool HALO, class Epi>
DI void gemm_tile(const bf16_t* ap0, const bf16_t* ap1, const bf16_t* ap2, const bf16_t* ap3, unsigned mk0, unsigned mk1, unsigned mk2, unsigned mk3, const bf16_t* __restrict__ Bt, int ldb, int K, char* smem, Epi epi) {
    const int tid = TID, lane = tid & 63, w = tid >> 6, h = lane >> 5, r = lane & 31;
    const int wm = w >> 1, wn = w & 1;
    const int lr = tid >> 3, kc = tid & 7;
    ap0 += kc * 8; ap1 += kc * 8; ap2 += kc * 8; ap3 += kc * 8;
    const bf16_t* bp0 = Bt + (size_t)lr * ldb + kc * 8;
    const bf16_t* bp1 = bp0 + (size_t)32 * ldb; const bf16_t* bp2 = bp0 + (size_t)64 * ldb; const bf16_t* bp3 = bp0 + (size_t)96 * ldb;
    f32x16 acc00 = zero16(), acc01 = zero16(), acc10 = zero16(), acc11 = zero16();
    float ss0 = 0.f, ss1 = 0.f, ss2 = 0.f, ss3 = 0.f;
    uint4 ra0, ra1, ra2, ra3, rb0, rb1, rb2, rb3;
    const int nk = K >> 6;
#define GLOAD(k0) { ra0 = *(const uint4*)(ap0 + (k0)); ra1 = *(const uint4*)(ap1 + (k0)); ra2 = *(const uint4*)(ap2 + (k0)); ra3 = *(const uint4*)(ap3 + (k0)); \
                    rb0 = *(const uint4*)(bp0 + (k0)); rb1 = *(const uint4*)(bp1 + (k0)); rb2 = *(const uint4*)(bp2 + (k0)); rb3 = *(const uint4*)(bp3 + (k0)); }
#define SSQ(ssv, rv) { if (SS) { float f_[8]; unpack8(rv, f_); ssv += f_[0]*f_[0] + f_[1]*f_[1] + f_[2]*f_[2] + f_[3]*f_[3] + f_[4]*f_[4] + f_[5]*f_[5] + f_[6]*f_[6] + f_[7]*f_[7]; } }
#define MSK(rv, mk) { rv.x &= mk; rv.y &= mk; rv.z &= mk; rv.w &= mk; }
#define SWRITE(s_) { if (HALO) { MSK(ra0, mk0) MSK(ra1, mk1) MSK(ra2, mk2) MSK(ra3, mk3) } bf16_t* As_ = (bf16_t*)(smem + (s_) * 36864) + lr * GP + kc * 8; bf16_t* Bs_ = As_ + 128 * GP; \
                     *(uint4*)(As_) = ra0; *(uint4*)(As_ + 32 * GP) = ra1; *(uint4*)(As_ + 64 * GP) = ra2; *(uint4*)(As_ + 96 * GP) = ra3; \
                     *(uint4*)(Bs_) = rb0; *(uint4*)(Bs_ + 32 * GP) = rb1; *(uint4*)(Bs_ + 64 * GP) = rb2; *(uint4*)(Bs_ + 96 * GP) = rb3; \
                     SSQ(ss0, ra0) SSQ(ss1, ra1) SSQ(ss2, ra2) SSQ(ss3, ra3) }
    GLOAD(0) SWRITE(0) __syncthreads();
#pragma unroll 1
    for (int kt = 0; kt < nk; ++kt) {
        if (kt + 1 < nk) GLOAD((kt + 1) * 64)
        {
            const bf16_t* As = (const bf16_t*)(smem + (kt & 1) * 36864) + (wm * 64 + r) * GP + h * 8;
            const bf16_t* Bs = (const bf16_t*)(smem + (kt & 1) * 36864) + 128 * GP + (wn * 64 + r) * GP + h * 8;
#pragma unroll
            for (int ks = 0; ks < 4; ++ks) {
                const bf16x8 a0 = *(const bf16x8*)(As + ks * 16), a1 = *(const bf16x8*)(As + 32 * GP + ks * 16);
                const bf16x8 b0 = *(const bf16x8*)(Bs + ks * 16), b1 = *(const bf16x8*)(Bs + 32 * GP + ks * 16);
                acc00 = MFMA(a0, b0, acc00); acc01 = MFMA(a0, b1, acc01); acc10 = MFMA(a1, b0, acc10); acc11 = MFMA(a1, b1, acc11);
            }
        }
        if (kt + 1 < nk) SWRITE((kt + 1) & 1)
        __syncthreads();
    }
#undef GLOAD
#undef SWRITE
#undef SSQ
#undef MSK
    float* Cs = (float*)smem;
    {
        float* cb = Cs + (wm * 64 + 4 * h) * CP + wn * 64 + r;
#pragma unroll
        for (int g = 0; g < 16; ++g) {
            const int ro = (g & 3) + 8 * (g >> 2);
            cb[ro * CP] = acc00[g]; cb[ro * CP + 32] = acc01[g]; cb[(ro + 32) * CP] = acc10[g]; cb[(ro + 32) * CP + 32] = acc11[g];
        }
    }
    if (SS) {
        float* rowss = (float*)(smem + ROWSS_OFF);
        ss0 += __shfl_xor(ss0, 1); ss0 += __shfl_xor(ss0, 2); ss0 += __shfl_xor(ss0, 4);
        ss1 += __shfl_xor(ss1, 1); ss1 += __shfl_xor(ss1, 2); ss1 += __shfl_xor(ss1, 4);
        ss2 += __shfl_xor(ss2, 1); ss2 += __shfl_xor(ss2, 2); ss2 += __shfl_xor(ss2, 4);
        ss3 += __shfl_xor(ss3, 1); ss3 += __shfl_xor(ss3, 2); ss3 += __shfl_xor(ss3, 4);
        if (kc == 0) { rowss[lr] = ss0; rowss[lr + 32] = ss1; rowss[lr + 64] = ss2; rowss[lr + 96] = ss3; }
    }
    __syncthreads();
    epi((const float*)smem, (const float*)(smem + ROWSS_OFF));
    __syncthreads();
}


DI int g_row(int i) { return ((i * 8 + (int)(threadIdx.x >> 6)) * 8) + (int)((threadIdx.x & 63) >> 3); }
DI int b_perm(int row) { return ((row >> 5) & 1) * 128 + (row >> 6) * 32 + (row & 31); }
DI int g_chunk(int row) { return (int)(threadIdx.x & 7) ^ ((row >> 1) & 7); }
#define GLDS(g_, l_) __builtin_amdgcn_global_load_lds((const unsigned*)(g_), (unsigned*)(l_), 16, 0, 0)
template <class Epi>
DI void gemm256(const char* wsb, const bf16_t* a0p, const bf16_t* a1p, const bf16_t* a2p, const bf16_t* a3p,
                const bf16_t* b0p, const bf16_t* b1p, const bf16_t* b2p, const bf16_t* b3p, int K, char* smem_all, Epi epi) {
    const unsigned a0 = (unsigned)((const char*)a0p - wsb), a1 = (unsigned)((const char*)a1p - wsb), a2 = (unsigned)((const char*)a2p - wsb), a3 = (unsigned)((const char*)a3p - wsb);
    const unsigned b0 = (unsigned)((const char*)b0p - wsb), b1 = (unsigned)((const char*)b1p - wsb), b2 = (unsigned)((const char*)b2p - wsb), b3 = (unsigned)((const char*)b3p - wsb);
    const int lane = threadIdx.x & 63, wid = __builtin_amdgcn_readfirstlane(threadIdx.x >> 6), wr = wid >> 2, wc = wid & 3, fr = lane & 15, fq = lane >> 4;
    f32x4 acc[8][4];
#pragma unroll
    for (int m = 0; m < 8; ++m)
#pragma unroll
        for (int n = 0; n < 4; ++n) acc[m][n] = (f32x4){0.f, 0.f, 0.f, 0.f};
#define STAGE256(buf, k0) { char* sa_ = smem_all + (buf) * 65536 + wid * 1024; char* sb_ = sa_ + 32768; const char* wk_ = wsb + (size_t)(k0) * 2; \
        GLDS(wk_ + a0, sa_); GLDS(wk_ + a1, sa_ + 8192); GLDS(wk_ + a2, sa_ + 16384); GLDS(wk_ + a3, sa_ + 24576); \
        GLDS(wk_ + b0, sb_); GLDS(wk_ + b1, sb_ + 8192); GLDS(wk_ + b2, sb_ + 16384); GLDS(wk_ + b3, sb_ + 24576); }
    const int sw = (fr >> 1) & 7;
    const unsigned offA = (wr * 128 + fr) * 128, offB = 32768 + (wc * 64 + fr) * 128;
    const unsigned co0 = ((0 + fq) ^ sw) << 4, co1 = ((4 + fq) ^ sw) << 4;
    const unsigned lds0 = (unsigned)(size_t)smem_all;
    const int nt = K >> 6;
    STAGE256(0, 0)
    asm volatile("s_waitcnt vmcnt(0)" ::: "memory");
    __syncthreads();
#pragma unroll 1
    for (int t = 0; t < nt; ++t) {
        const int cur = t & 1;
        if (t + 1 < nt) STAGE256(cur ^ 1, (t + 1) * 64)
        const unsigned lb = lds0 + cur * 65536;
        const unsigned aA0 = lb + offA + co0, aA1 = lb + offA + co1, aB0 = lb + offB + co0, aB1 = lb + offB + co1;
        bf16x8 Bq0[4], Bq1[4], Aq0[2], Aq1[2];
#define DSR(dst, addr, off) asm volatile("ds_read_b128 %0, %1 offset:%2" : "=v"(dst) : "v"(addr), "n"(off) : "memory")
#define LDA2(dst, addr, mo) { DSR(dst[0], addr, (mo) * 2048); DSR(dst[1], addr, ((mo) + 1) * 2048); }
#define LDB4(dst, addr) { DSR(dst[0], addr, 0); DSR(dst[1], addr, 2048); DSR(dst[2], addr, 4096); DSR(dst[3], addr, 6144); }
#define WAIT_A(n, X) asm volatile("s_waitcnt lgkmcnt(" #n ")" : "+v"(X[0]), "+v"(X[1]) :: "memory")
#define WAIT_AB(n, X, Y) asm volatile("s_waitcnt lgkmcnt(" #n ")" : "+v"(X[0]), "+v"(X[1]), "+v"(Y[0]), "+v"(Y[1]), "+v"(Y[2]), "+v"(Y[3]) :: "memory")
#define MM8(Aq, Bq, mo) { _Pragma("unroll") for (int m = 0; m < 2; ++m) _Pragma("unroll") for (int n = 0; n < 4; ++n) acc[(mo) + m][n] = MFMA16(Aq[m], Bq[n], acc[(mo) + m][n]); }
        LDB4(Bq0, aB0) LDA2(Aq0, aA0, 0) LDA2(Aq1, aA0, 2)
        WAIT_AB(2, Aq0, Bq0);
        MM8(Aq0, Bq0, 0)
        LDA2(Aq0, aA0, 4)
        WAIT_A(2, Aq1);
        MM8(Aq1, Bq0, 2)
        LDA2(Aq1, aA0, 6) LDB4(Bq1, aB1)
        WAIT_A(6, Aq0);
        MM8(Aq0, Bq0, 4)
        LDA2(Aq0, aA1, 0)
        WAIT_A(6, Aq1);
        MM8(Aq1, Bq0, 6)
        LDA2(Aq1, aA1, 2)
        WAIT_AB(2, Aq0, Bq1);
        MM8(Aq0, Bq1, 0)
        LDA2(Aq0, aA1, 4)
        WAIT_A(2, Aq1);
        MM8(Aq1, Bq1, 2)
        LDA2(Aq1, aA1, 6)
        WAIT_A(2, Aq0);
        MM8(Aq0, Bq1, 4)
        WAIT_A(0, Aq1);
        MM8(Aq1, Bq1, 6)
#undef DSR
#undef LDA2
#undef LDB4
#undef WAIT_A
#undef WAIT_AB
#undef MM8
        asm volatile("s_waitcnt vmcnt(0)" ::: "memory");
        __syncthreads();
    }
#undef STAGE256
    int t_ = threadIdx.x;
    asm volatile("" : "+v"(t_));
    const int lane_ = t_ & 63, wid_ = t_ >> 6, wr_ = wid_ >> 2, wc_ = wid_ & 3, fr_ = lane_ & 15, fq_ = lane_ >> 4, hb_ = t_ >> 8;
#pragma unroll
    for (int p = 0; p < 2; ++p) {
        {
            float* Cs = (float*)(smem_all + wr_ * HB_SMEM) + (4 * fq_) * CP + wc_ * 32 + fr_;
#pragma unroll
            for (int m = 0; m < 8; ++m)
#pragma unroll
                for (int n = 0; n < 2; ++n)
#pragma unroll
                    for (int j = 0; j < 4; ++j) Cs[(m * 16 + j) * CP + n * 16] = acc[m][2 * p + n][j];
        }
        __syncthreads();
        epi((const float*)(smem_all + hb_ * HB_SMEM), hb_, p, t_ & 255);
        __syncthreads();
    }
}

DI void epi_store_bf16(const float* Cs, bf16_t* dst, int ld, int tid) {
#pragma unroll 2
    for (int j = 0; j < 8; ++j) {
        int c = tid + 256 * j, row = c >> 4, cc = c & 15;
        const float4* cp = (const float4*)(Cs + row * CP + cc * 8);
        float4 f0 = cp[0], f1 = cp[1];
        float v[8] = {f0.x, f0.y, f0.z, f0.w, f1.x, f1.y, f1.z, f1.w};
        *(uint4*)(dst + (size_t)row * ld + cc * 8) = pack8(v);
    }
}
DI void epi_resid(const float* Cs, const float* src, float* dst, const float* gate, int tid) {
#pragma unroll 4
    for (int j = 0; j < 16; ++j) {
        int c = tid + 256 * j, row = c >> 5, c4 = c & 31;
        float4 cv = *(const float4*)(Cs + row * CP + c4 * 4);
        float4 sv = *(const float4*)(src + (size_t)row * 1024 + c4 * 4);
        float4 gv = *(const float4*)(gate + c4 * 4);
        float4 o; o.x = sv.x + gv.x * cv.x; o.y = sv.y + gv.y * cv.y; o.z = sv.z + gv.z * cv.z; o.w = sv.w + gv.w * cv.w;
        *(float4*)(dst + (size_t)row * 1024 + c4 * 4) = o;
    }
}

DI int wsrc_col(int mode, int tn, int c) {
    if (mode == 0) return tn * 128 + c;
    if (mode == 1) {
        const int np = tn * 128;
        if (np < 512) return 672 + np + c;
        if (np < 640) return 1184 + np - 512 + c;
        if (np < 768) return 1312 + np - 640 + c;
        if (np < 1152) return np - 768 + c;
        if (np < 1408) return 384 + np - 1152 + c;
        return c < 32 ? 640 + c : -1;
    }
    if (mode == 2) return c < 96 ? tn * 96 + c : -1;
    return c < 64 ? 64 * tn + c : 2816 + 64 * tn + c - 64;
}
DI void wtile(const float* __restrict__ src, int Nsrc, const float* __restrict__ g, bf16_t* __restrict__ dst, int K, int k0, int tn, int mode, char* smem) {
    bf16_t* T = (bf16_t*)smem;
    const int tid = TID, lane = tid & 63, w = tid >> 6, rsub = lane >> 5, c4 = (lane & 31) * 4;
    int sc = wsrc_col(mode, tn, c4);
    if (sc >= Nsrc) sc = -1;
#pragma unroll 8
    for (int i = 0; i < 16; ++i) {
        const int rr = w * 32 + 2 * i + rsub;
        float4 v = make_float4(0.f, 0.f, 0.f, 0.f);
        if (sc >= 0) { v = *(const float4*)(src + (size_t)(k0 + rr) * Nsrc + sc); if (g) { const float gg = g[k0 + rr]; v.x *= gg; v.y *= gg; v.z *= gg; v.w *= gg; } }
        T[(c4 + 0) * 130 + rr] = f2bf(v.x);
        T[(c4 + 1) * 130 + rr] = f2bf(v.y);
        T[(c4 + 2) * 130 + rr] = f2bf(v.z);
        T[(c4 + 3) * 130 + rr] = f2bf(v.w);
    }
    __syncthreads();
#pragma unroll
    for (int j = 0; j < 8; ++j) {
        const int c = tid + 256 * j, n = c >> 4, kc = c & 15;
        const unsigned* s32 = (const unsigned*)(T + n * 130 + kc * 8);
        uint4 o; o.x = s32[0]; o.y = s32[1]; o.z = s32[2]; o.w = s32[3];
        *(uint4*)(dst + (size_t)(tn * 128 + n) * K + k0 + kc * 8) = o;
    }
    __syncthreads();
}

DI void mod_item(const Params& p, int item, char* smem) {
    const int tid = TID, lane = tid & 63, w = tid >> 6, hl = lane >> 5, cl = lane & 31;
    const int l = item / 192, n0 = (item % 192) * 32;
    float* sl = (float*)smem;
    for (int i = tid; i < 9216; i += 256) {
        int rr = i >> 10, k = i & 1023;
        float cv = rr < 8 ? p.c[rr * 1024 + k] : p.c_ctx[k];
        sl[i] = cv / (1.f + expf(-cv));
    }
    __syncthreads();
    float acc[9];
#pragma unroll
    for (int q = 0; q < 9; ++q) acc[q] = 0.f;
    const float* wp = p.ada_w + (size_t)l * 1024 * 6144 + n0 + cl;
#pragma unroll 16
    for (int kk = 0; kk < 128; ++kk) {
        const int k = w * 256 + 2 * kk + hl;
        float wv = wp[(size_t)k * 6144];
#pragma unroll
        for (int q = 0; q < 9; ++q) acc[q] += sl[q * 1024 + k] * wv;
    }
    float* red = (float*)(smem + 36864);
#pragma unroll
    for (int q = 0; q < 9; ++q) red[((w * 2 + hl) * 9 + q) * 32 + cl] = acc[q];
    __syncthreads();
    float* MOD = (float*)(p.ws + OFF_MOD);
    for (int i = tid; i < 288; i += 256) {
        int q = i >> 5, ln = i & 31;
        float sacc = 0.f;
#pragma unroll
        for (int u = 0; u < 8; ++u) sacc += red[(u * 9 + q) * 32 + ln];
        sacc += p.ada_b[l * 6144 + n0 + ln];
        MOD[(size_t)(l * 9 + q) * 6144 + n0 + ln] = sacc;
    }
    __syncthreads();
}

DI void sincos_d(double x, float& s, float& c) {
    const double TWO_PI = 6.283185307179586476925;
    double t = x / TWO_PI;
    t -= rint(t);
    double y = t * TWO_PI, y2 = y * y;
    double sv = y, cv = 1.0, ts = y, tc = 1.0;
#pragma unroll 1
    for (int k = 1; k <= 14; ++k) {
        tc *= -y2 / (double)((2 * k - 1) * (2 * k));
        ts *= -y2 / (double)((2 * k) * (2 * k + 1));
        cv += tc; sv += ts;
    }
    s = (float)sv; c = (float)cv;
}

DI void rope_tables(const Params& p) {
    float* TG = (float*)(p.ws + OFF_TABG);
    float* TM = (float*)(p.ws + OFF_TABM);
    for (int i = TID; i < 1024; i += 256) {
        int v = i >> 4, f = i & 15;
        float inv = exp2f(-(float)f / 16.f * 13.287712379549449f);
        float ang = (float)v * inv, s, c;
        sincos_d((double)ang, s, c);
        TG[i] = c; TG[1024 + i] = s;
    }
    for (int i = TID; i < 512; i += 256) {
        int v = i >> 3, f = i & 7;
        float inv = exp2f(-(float)f / 8.f * 13.287712379549449f);
        float ang = (float)v * inv, s, c;
        sincos_d((double)ang, s, c);
        TM[i] = c; TM[512 + i] = s;
    }
}

constexpr int NW = 10;
constexpr int N_WT = 8 * 12 + 3 * 8 + 2 * 8 + 8 * 8 + 8 * 44 + 22 * 8 + 8 * 44 + 22 * 8 + 8 * 26 + 8 * 8;
constexpr int N_MOD = 384;
constexpr int N_P0 = N_MOD + N_WT;
static_assert(N_P0 % 2 == 0 && N_MOD % 2 == 0, "phase 0 items are dealt to half-block pairs");

DI void phase0(const Params& p, char* smem_all) {
    char* smem = smem_all + HBI * HB_SMEM;
    if (blockIdx.x == gridDim.x - 1) {
        if (HBI == 0) rope_tables(p);
        else { for (int i = TID; i < 512; i += 256) ((uint4*)(p.ws + OFF_ZROW))[i] = make_uint4(0, 0, 0, 0); }
    }
    for (int it0 = blockIdx.x * 2; it0 < N_P0; it0 += gridDim.x * 2) {
        const int item = it0 + HBI;
        if (item < N_MOD) { mod_item(p, item, smem); continue; }
        int t = item - N_MOD;
        int wi = 0;
        int cnt[NW] = {8 * 12, 3 * 8, 2 * 8, 8 * 8, 8 * 44, 22 * 8, 8 * 44, 22 * 8, 8 * 26, 8 * 8};
#pragma unroll
        for (int i = 0; i < NW - 1; ++i) { if (wi == i && t >= cnt[i]) { t -= cnt[i]; wi = i + 1; } }
        const float* src; const float* g = nullptr; bf16_t* dst; int K, Nsrc, ntn, mode;
        switch (wi) {
            case 0: src = p.att_w_in; dst = (bf16_t*)(p.ws + OFF_WT_IN0); K = 1024; Nsrc = 1440; ntn = 12; mode = 1; break;
            case 1: src = p.mla_w_qb; g = p.mla_qa_g; dst = (bf16_t*)(p.ws + OFF_WT_QB); K = 384; Nsrc = 768; ntn = 8; mode = 2; break;
            case 2: src = p.mla_w_kvb; g = p.mla_kva_g; dst = (bf16_t*)(p.ws + OFF_WT_KVB); K = 256; Nsrc = 1024; ntn = 8; mode = 0; break;
            case 3: src = p.att_w_out; dst = (bf16_t*)(p.ws + OFF_WT_OUT0); K = 1024; Nsrc = 1024; ntn = 8; mode = 0; break;
            case 4: src = p.ffn_w_up; dst = (bf16_t*)(p.ws + OFF_WT_UP0); K = 1024; Nsrc = 5632; ntn = 44; mode = 3; break;
            case 5: src = p.ffn_w_down; dst = (bf16_t*)(p.ws + OFF_WT_DOWN0); K = 2816; Nsrc = 1024; ntn = 8; mode = 0; break;
            case 6: src = p.ffn_w_up + 1024ull * 5632; dst = (bf16_t*)(p.ws + OFF_WT_UP1); K = 1024; Nsrc = 5632; ntn = 44; mode = 3; break;
            case 7: src = p.ffn_w_down + 2816ull * 1024; dst = (bf16_t*)(p.ws + OFF_WT_DOWN1); K = 2816; Nsrc = 1024; ntn = 8; mode = 0; break;
            case 8: src = p.ml_w_in; dst = (bf16_t*)(p.ws + OFF_WT_IN1); K = 1024; Nsrc = 3104; ntn = 26; mode = 0; break;
            default: src = p.ml_w_out; dst = (bf16_t*)(p.ws + OFF_WT_OUT1); K = 1024; Nsrc = 1024; ntn = 8; mode = 0; break;
        }
        const int tn = t % ntn, tk = t / ntn;
        wtile(src, Nsrc, g, dst, K, tk * 128, tn, mode, smem);
    }
}

DI void norm_row_ptrs(int row, const float* srcLat, const float* srcCtx, const float* mod, int shift_idx, const float*& src, const float*& sh) {
    int mb;
    if (row < 16384) { src = srcLat + (size_t)row * 1024; mb = row >> 11; }
    else { src = srcCtx + (size_t)(row - 16384) * 1024; mb = 8; }
    sh = mod + (size_t)mb * 6144 + shift_idx * 1024;
}
DI void norm_row_finish(const float4 (&v)[4], float ss, const float* g, const float* sh, bf16_t* dst, int lane) {
#pragma unroll
    for (int o = 32; o >= 1; o >>= 1) ss += __shfl_xor(ss, o);
    const float rstd = rsqrtf(ss * (1.f / 1024.f) + EPSF);
    const float* sc = sh + 1024;
#pragma unroll
    for (int j = 0; j < 4; ++j) {
        const int c = j * 256 + lane * 4;
        const float4 gv = *(const float4*)(g + c), shv = *(const float4*)(sh + c), scv = *(const float4*)(sc + c);
        const float o0 = v[j].x * rstd * gv.x * (1.f + scv.x) + shv.x;
        const float o1 = v[j].y * rstd * gv.y * (1.f + scv.y) + shv.y;
        const float o2 = v[j].z * rstd * gv.z * (1.f + scv.z) + shv.z;
        const float o3 = v[j].w * rstd * gv.w * (1.f + scv.w) + shv.w;
        uint2 o; o.x = pack2(o0, o1); o.y = pack2(o2, o3);
        *(uint2*)(dst + c) = o;
    }
}
DI void phase_norm(const Params& p, const float* srcLat, const float* srcCtx, const float* g, const float* mod, int shift_idx, int nrows) {
    const int lane = threadIdx.x & 63, w = threadIdx.x >> 6;
    bf16_t* H = (bf16_t*)(p.ws + OFF_H);
    for (int row = (blockIdx.x * 8 + w) * 2; row < nrows; row += gridDim.x * 16) {
        const float *srcA, *shA, *srcB, *shB;
        norm_row_ptrs(row, srcLat, srcCtx, mod, shift_idx, srcA, shA);
        norm_row_ptrs(row + 1, srcLat, srcCtx, mod, shift_idx, srcB, shB);
        float4 va[4], vb[4];
        float sa = 0.f, sb = 0.f;
#pragma unroll
        for (int j = 0; j < 4; ++j) { va[j] = *(const float4*)(srcA + j * 256 + lane * 4); vb[j] = *(const float4*)(srcB + j * 256 + lane * 4); }
#pragma unroll
        for (int j = 0; j < 4; ++j) { sa += va[j].x * va[j].x + va[j].y * va[j].y + va[j].z * va[j].z + va[j].w * va[j].w; sb += vb[j].x * vb[j].x + vb[j].y * vb[j].y + vb[j].z * vb[j].z + vb[j].w * vb[j].w; }
        norm_row_finish(va, sa, g, shA, H + (size_t)row * 1024, lane);
        norm_row_finish(vb, sb, g, shB, H + (size_t)(row + 1) * 1024, lane);
    }
}

template <int Q>
DI void rope_apply(float* v, const float* tab, int rw, int cl) {
#pragma unroll
    for (int f = 0; f < Q; ++f) {
        float cr = tab[rw * Q + f], sr = tab[64 * Q + rw * Q + f], cc = tab[cl * Q + f], sc = tab[64 * Q + cl * Q + f];
        float a1 = v[f], a2 = v[Q + f], b1 = v[2 * Q + f], b2 = v[3 * Q + f];
        v[f] = a1 * cr - a2 * sr; v[Q + f] = a2 * cr + a1 * sr;
        v[2 * Q + f] = b1 * cc - b2 * sc; v[3 * Q + f] = b2 * cc + b1 * sc;
    }
}

DI void phase_inproj0(const Params& p, char* smem_all) {
    const bf16_t* H = (const bf16_t*)(p.ws + OFF_H);
    const bf16_t* W = (const bf16_t*)(p.ws + OFF_WT_IN0);
    const float* TG = (const float*)(p.ws + OFF_TABG);
    for (int id = blockIdx.x; id < 72 * 6; id += gridDim.x) {
        const int nt2 = id / 72, mt2 = id % 72;
        auto epi = [&](const float* Cs, int si, int sj, int tid) {
            const int nt = 2 * nt2 + sj, m0 = (2 * mt2 + si) * 128;
            int b, t0; bool lat; row_info(m0, b, t0, lat);
            const int s0 = lat ? 256 + t0 : t0;
            if (nt < 5) {
                const int row = tid & 127, half = tid >> 7;
                const float4* cp = (const float4*)(Cs + row * CP + half * 64);
                float ss = 0.f;
#pragma unroll
                for (int i = 0; i < 16; ++i) { float4 f = cp[i]; ss += f.x * f.x + f.y * f.y + f.z * f.z + f.w * f.w; }
                const float rstd = rsqrtf(ss * (1.f / 64.f) + EPSF);
                const float* g = nt < 4 ? p.gqa_q_g : p.gqa_k_g;
                const float osc = nt < 4 ? 0.125f * LOG2E : 1.f;
                bf16_t* dst;
                if (nt < 4) dst = (bf16_t*)(p.ws + OFF_QG) + ((size_t)(b * 2304 + s0 + row) * 8 + nt * 2 + half) * 64;
                else dst = (bf16_t*)(p.ws + OFF_KG) + ((size_t)(b * 2304 + s0 + row) * 2 + half) * 64;
                const int t = t0 + row;
#pragma unroll 1
                for (int hh = 0; hh < 2; ++hh) {
                    float v[32];
#pragma unroll
                    for (int i = 0; i < 8; ++i) { float4 f = cp[hh * 8 + i]; const float4 gv = *(const float4*)(g + hh * 32 + 4 * i);
                        v[4 * i] = f.x * rstd * gv.x; v[4 * i + 1] = f.y * rstd * gv.y; v[4 * i + 2] = f.z * rstd * gv.z; v[4 * i + 3] = f.w * rstd * gv.w; }
                    if (lat) {
                        const int pos = hh ? (t & 63) : (t >> 6);
#pragma unroll
                        for (int f = 0; f < 16; ++f) {
                            const float c_ = TG[pos * 16 + f], s_ = TG[1024 + pos * 16 + f];
                            const float x1 = v[f], x2 = v[16 + f];
                            v[f] = x1 * c_ - x2 * s_; v[16 + f] = x2 * c_ + x1 * s_;
                        }
                    }
#pragma unroll
                    for (int i = 0; i < 32; ++i) v[i] *= osc;
#pragma unroll
                    for (int i = 0; i < 4; ++i) *(uint4*)(dst + hh * 32 + i * 8) = pack8(v + i * 8);
                }
            } else if (nt == 5) {
                const int dall = tid & 127, ch0 = (tid >> 7) * 8;
                bf16_t* dst = (bf16_t*)(p.ws + OFF_VGT) + ((size_t)(b * 2 + (dall >> 6)) * 64 + (dall & 63)) * 2304 + s0;
#pragma unroll 2
                for (int ch = 0; ch < 8; ++ch) {
                    float v[8];
#pragma unroll
                    for (int i = 0; i < 8; ++i) v[i] = Cs[((ch0 + ch) * 8 + i) * CP + dall];
                    *(uint4*)(dst + (ch0 + ch) * 8) = pack8(v);
                }
            } else if (nt < 9) {
                epi_store_bf16(Cs, (bf16_t*)(p.ws + OFF_CQ) + (size_t)m0 * 384 + (nt - 6) * 128, 384, tid);
            } else if (nt < 11) {
                epi_store_bf16(Cs, (bf16_t*)(p.ws + OFF_CKV) + (size_t)m0 * 256 + (nt - 9) * 128, 256, tid);
            } else {
                const int row = tid >> 1, half = tid & 1;
                float* dst = (float*)(p.ws + OFF_KR) + (size_t)(m0 + row) * 32 + half * 16;
                const float4* cp = (const float4*)(Cs + row * CP + half * 16);
#pragma unroll
                for (int i = 0; i < 4; ++i) ((float4*)dst)[i] = cp[i];
            }
        };
        const int r0 = g_row(0), r1 = g_row(1), r2 = g_row(2), r3 = g_row(3);
        const bf16_t* Ab = H + (size_t)mt2 * 256 * 1024;
        const bf16_t* Bb = W + (size_t)nt2 * 256 * 1024;
        gemm256(p.ws, Ab + (size_t)r0 * 1024 + g_chunk(r0) * 8, Ab + (size_t)r1 * 1024 + g_chunk(r1) * 8, Ab + (size_t)r2 * 1024 + g_chunk(r2) * 8, Ab + (size_t)r3 * 1024 + g_chunk(r3) * 8,
                Bb + (size_t)b_perm(r0) * 1024 + g_chunk(r0) * 8, Bb + (size_t)b_perm(r1) * 1024 + g_chunk(r1) * 8, Bb + (size_t)b_perm(r2) * 1024 + g_chunk(r2) * 8, Bb + (size_t)b_perm(r3) * 1024 + g_chunk(r3) * 8,
                1024, smem_all, epi);
    }
}

DI void phase_mla_up(const Params& p, char* smem_all) {
    char* smem = smem_all + HBI * HB_SMEM;
    const float* TM = (const float*)(p.ws + OFF_TABM);
    for (int id0 = blockIdx.x * 2; id0 < 144 * 16; id0 += gridDim.x * 2) {
        const int id = id0 + HBI;
        const int nt = (id / 144) & 7, isKV = (id / 144) >> 3, mt = id % 144, m0 = mt * 128;
        int b, t0; bool lat; row_info(m0, b, t0, lat);
        const int s0 = lat ? 256 + t0 : t0;
        if (!isKV) {
            const bf16_t* A = (const bf16_t*)(p.ws + OFF_CQ);
#undef AROW
#define AROW(o_) (A + (size_t)(m0 + (TID >> 3) + (o_)) * 384)
            auto epi = [&](const float* Cs, const float* rowss) {
                const int tid = TID, row = tid >> 1, part = tid & 1;
                const float r1 = rsqrtf(rowss[row] * (1.f / 384.f) + EPSF);
                float v[48];
                const float4* cp = (const float4*)(Cs + row * CP + part * 48);
                float ss = 0.f;
#pragma unroll
                for (int i = 0; i < 12; ++i) { float4 f = cp[i]; v[4 * i] = f.x * r1; v[4 * i + 1] = f.y * r1; v[4 * i + 2] = f.z * r1; v[4 * i + 3] = f.w * r1; }
#pragma unroll
                for (int i = 0; i < 48; ++i) ss += v[i] * v[i];
                ss += __shfl_xor(ss, 1);
                const float r2 = rsqrtf(ss * (1.f / 96.f) + EPSF);
                const float* g = p.mla_q_g + part * 48;
#pragma unroll
                for (int i = 0; i < 48; ++i) v[i] = v[i] * r2 * g[i];
                if (lat && part == 1) { int t = t0 + row; rope_apply<8>(v + 16, TM, t >> 6, t & 63); }
                const float sc = 0.10206207261596575f * LOG2E;
#pragma unroll
                for (int i = 0; i < 48; ++i) v[i] *= sc;
                bf16_t* dst = (bf16_t*)(p.ws + OFF_QM) + ((size_t)(b * 2304 + s0 + row) * 8 + nt) * 96 + part * 48;
#pragma unroll
                for (int i = 0; i < 6; ++i) *(uint4*)(dst + i * 8) = pack8(v + i * 8);
            };
            gemm_tile<true, false>(AROW(0), AROW(32), AROW(64), AROW(96), 0u, 0u, 0u, 0u, (const bf16_t*)(p.ws + OFF_WT_QB) + (size_t)nt * 128 * 384, 384, 384, smem, epi);
        } else {
            const bf16_t* A = (const bf16_t*)(p.ws + OFF_CKV);
#undef AROW
#define AROW(o_) (A + (size_t)(m0 + (TID >> 3) + (o_)) * 256)
            auto epi = [&](const float* Cs, const float* rowss) {
                const int tid = TID;
                {
                    const int row = tid >> 1, part = tid & 1;
                    const float r1 = rsqrtf(rowss[row] * (1.f / 256.f) + EPSF);
                    float v[48];
                    if (part == 0) {
                        const float4* cp = (const float4*)(Cs + row * CP);
#pragma unroll
                        for (int i = 0; i < 12; ++i) { float4 f = cp[i]; v[4 * i] = f.x * r1; v[4 * i + 1] = f.y * r1; v[4 * i + 2] = f.z * r1; v[4 * i + 3] = f.w * r1; }
                    } else {
                        const float4* cp = (const float4*)(Cs + row * CP + 48);
#pragma unroll
                        for (int i = 0; i < 4; ++i) { float4 f = cp[i]; v[4 * i] = f.x * r1; v[4 * i + 1] = f.y * r1; v[4 * i + 2] = f.z * r1; v[4 * i + 3] = f.w * r1; }
                        const float4* kp = (const float4*)((const float*)(p.ws + OFF_KR) + (size_t)(m0 + row) * 32);
#pragma unroll
                        for (int i = 0; i < 8; ++i) { float4 f = kp[i]; v[16 + 4 * i] = f.x; v[16 + 4 * i + 1] = f.y; v[16 + 4 * i + 2] = f.z; v[16 + 4 * i + 3] = f.w; }
                    }
                    float ss = 0.f;
#pragma unroll
                    for (int i = 0; i < 48; ++i) ss += v[i] * v[i];
                    ss += __shfl_xor(ss, 1);
                    const float r2 = rsqrtf(ss * (1.f / 96.f) + EPSF);
                    const float* g = p.mla_k_g + part * 48;
#pragma unroll
                    for (int i = 0; i < 48; ++i) v[i] = v[i] * r2 * g[i];
                    if (lat && part == 1) { int t = t0 + row; rope_apply<8>(v + 16, TM, t >> 6, t & 63); }
                    bf16_t* dst = (bf16_t*)(p.ws + OFF_KM) + ((size_t)(b * 2304 + s0 + row) * 8 + nt) * 96 + part * 48;
#pragma unroll
                    for (int i = 0; i < 6; ++i) *(uint4*)(dst + i * 8) = pack8(v + i * 8);
                }
                {
                    const int d = tid & 63, cg4 = (tid >> 6) * 4;
                    bf16_t* dst = (bf16_t*)(p.ws + OFF_VMT) + ((size_t)(b * 8 + nt) * 64 + d) * 2304 + s0;
#pragma unroll 1
                    for (int ch = 0; ch < 4; ++ch) {
                        float v[8];
#pragma unroll
                        for (int i = 0; i < 8; ++i) { int rr = (cg4 + ch) * 8 + i; v[i] = Cs[rr * CP + 64 + d] * rsqrtf(rowss[rr] * (1.f / 256.f) + EPSF); }
                        *(uint4*)(dst + (cg4 + ch) * 8) = pack8(v);
                    }
                }
            };
            gemm_tile<true, false>(AROW(0), AROW(32), AROW(64), AROW(96), 0u, 0u, 0u, 0u, (const bf16_t*)(p.ws + OFF_WT_KVB) + (size_t)nt * 128 * 256, 256, 256, smem, epi);
        }
    }
}

template <int DK>
DI void attn_body(const bf16_t* __restrict__ Q, int qstride, const bf16_t* __restrict__ Kp, int kstride, const bf16_t* __restrict__ VT,
                  int nkeys, bf16_t* __restrict__ Odst, char* smem, char* smem_os) {
    constexpr int KP = DK + 8, VP = 72, NST = DK / 16, KCH = DK / 8;
    constexpr int NKL = (64 * KCH) / 256;
    constexpr int STAGE = 64 * KP * 2 + 64 * VP * 2;
    const int tid = TID, lane = tid & 63, w = tid >> 6, h = lane >> 5, r = lane & 31;
    bf16x8 qf[NST];
    {
        const bf16_t* qrow = Q + (size_t)(w * 32 + r) * qstride;
#pragma unroll
        for (int st = 0; st < NST; ++st) qf[st] = *(const bf16x8*)(qrow + st * 16 + h * 8);
    }
    f32x16 o[2]; o[0] = zero16(); o[1] = zero16();
    float m = 0.f, l = 0.f;
    uint4 ak0, ak1 = make_uint4(0, 0, 0, 0), av0, bk0, bk1 = make_uint4(0, 0, 0, 0), bv0;
    const int t5 = threadIdx.x;
    const int kr0 = t5 / KCH, kc0 = t5 % KCH, kr1 = (t5 + 512) / KCH, kc1 = (t5 + 512) % KCH;
    const bool k2 = t5 + 512 < 64 * KCH;
    const int vd0 = t5 >> 3, vc0 = t5 & 7;
#define AGLOAD(P_, key0) { P_##k0 = *(const uint4*)(Kp + (size_t)((key0) + kr0) * kstride + kc0 * 8); if (k2) P_##k1 = *(const uint4*)(Kp + (size_t)((key0) + kr1) * kstride + kc1 * 8); \
                       P_##v0 = *(const uint4*)(VT + (size_t)vd0 * 2304 + (key0) + vc0 * 8); }
#define ASWRITE(P_, s_) { bf16_t* Ks_ = (bf16_t*)(smem + (s_) * STAGE); bf16_t* Vs_ = Ks_ + 64 * KP; \
                      *(uint4*)(Ks_ + kr0 * KP + kc0 * 8) = P_##k0; if (k2) *(uint4*)(Ks_ + kr1 * KP + kc1 * 8) = P_##k1; \
                      *(uint4*)(Vs_ + vd0 * VP + vc0 * 8) = P_##v0; }
    const int nkt = nkeys >> 6;
    AGLOAD(a, 0) ASWRITE(a, 0) AGLOAD(a, 64) AGLOAD(b, 128) __syncthreads();
#pragma unroll 1
    for (int kt = 0; kt < nkt; kt += 2) {
        {
            const bf16_t* Ks = (const bf16_t*)(smem);
            const bf16_t* Vs = Ks + 64 * KP;
            f32x16 s[2];
#pragma unroll
            for (int i = 0; i < 16; ++i) { s[0][i] = -m; s[1][i] = -m; }
#pragma unroll
            for (int st = 0; st < NST; ++st)
#pragma unroll
                for (int kk = 0; kk < 2; ++kk) {
                    bf16x8 a = *(const bf16x8*)(Ks + (kk * 32 + r) * KP + st * 16 + h * 8);
                    s[kk] = MFMA(a, qf[st], s[kk]);
                }
            float mx = s[0][0];
#pragma unroll
            for (int i = 0; i < 16; ++i) { mx = fmaxf(mx, s[0][i]); mx = fmaxf(mx, s[1][i]); }
            mx = fmaxf(mx, __shfl_xor(mx, 32));
            if (__any(mx > 8.f)) {
                const float d = fmaxf(mx, 0.f);
                const float alpha = __builtin_amdgcn_exp2f(-d);
                l *= alpha;
#pragma unroll
                for (int i = 0; i < 16; ++i) { o[0][i] *= alpha; o[1][i] *= alpha; s[0][i] -= d; s[1][i] -= d; }
                m += d;
            }
            float ps = 0.f;
#pragma unroll
            for (int kk = 0; kk < 2; ++kk)
#pragma unroll
                for (int i = 0; i < 16; ++i) { float pv = __builtin_amdgcn_exp2f(s[kk][i]); s[kk][i] = pv; ps += pv; }
            l += ps;
#pragma unroll
            for (int kk = 0; kk < 2; ++kk)
#pragma unroll
                for (int s2 = 0; s2 < 2; ++s2) {
                    const bf16x8 pb = pack_frag(s[kk][8 * s2 + 0], s[kk][8 * s2 + 1], s[kk][8 * s2 + 2], s[kk][8 * s2 + 3], s[kk][8 * s2 + 4], s[kk][8 * s2 + 5], s[kk][8 * s2 + 6], s[kk][8 * s2 + 7]);
#pragma unroll
                    for (int dt = 0; dt < 2; ++dt) {
                        const bf16_t* vp = Vs + (dt * 32 + r) * VP + kk * 32 + 16 * s2 + 4 * h;
                        uint2 lo = *(const uint2*)vp, hi = *(const uint2*)(vp + 8);
                        uint4 vu; vu.x = lo.x; vu.y = lo.y; vu.z = hi.x; vu.w = hi.y;
                        o[dt] = MFMA(__builtin_bit_cast(bf16x8, vu), pb, o[dt]);
                    }
                }
        }
        ASWRITE(a, 1)
        if (kt + 3 < nkt) AGLOAD(a, (kt + 3) * 64)
        LDS_BARRIER();
        {
            const bf16_t* Ks = (const bf16_t*)(smem + STAGE);
            const bf16_t* Vs = Ks + 64 * KP;
            f32x16 s[2];
#pragma unroll
            for (int i = 0; i < 16; ++i) { s[0][i] = -m; s[1][i] = -m; }
#pragma unroll
            for (int st = 0; st < NST; ++st)
#pragma unroll
                for (int kk = 0; kk < 2; ++kk) {
                    bf16x8 a = *(const bf16x8*)(Ks + (kk * 32 + r) * KP + st * 16 + h * 8);
                    s[kk] = MFMA(a, qf[st], s[kk]);
                }
            float mx = s[0][0];
#pragma unroll
            for (int i = 0; i < 16; ++i) { mx = fmaxf(mx, s[0][i]); mx = fmaxf(mx, s[1][i]); }
            mx = fmaxf(mx, __shfl_xor(mx, 32));
            if (__any(mx > 8.f)) {
                const float d = fmaxf(mx, 0.f);
                const float alpha = __builtin_amdgcn_exp2f(-d);
                l *= alpha;
#pragma unroll
                for (int i = 0; i < 16; ++i) { o[0][i] *= alpha; o[1][i] *= alpha; s[0][i] -= d; s[1][i] -= d; }
                m += d;
            }
            float ps = 0.f;
#pragma unroll
            for (int kk = 0; kk < 2; ++kk)
#pragma unroll
                for (int i = 0; i < 16; ++i) { float pv = __builtin_amdgcn_exp2f(s[kk][i]); s[kk][i] = pv; ps += pv; }
            l += ps;
#pragma unroll
            for (int kk = 0; kk < 2; ++kk)
#pragma unroll
                for (int s2 = 0; s2 < 2; ++s2) {
                    const bf16x8 pb = pack_frag(s[kk][8 * s2 + 0], s[kk][8 * s2 + 1], s[kk][8 * s2 + 2], s[kk][8 * s2 + 3], s[kk][8 * s2 + 4], s[kk][8 * s2 + 5], s[kk][8 * s2 + 6], s[kk][8 * s2 + 7]);
#pragma unroll
                    for (int dt = 0; dt < 2; ++dt) {
                        const bf16_t* vp = Vs + (dt * 32 + r) * VP + kk * 32 + 16 * s2 + 4 * h;
                        uint2 lo = *(const uint2*)vp, hi = *(const uint2*)(vp + 8);
                        uint4 vu; vu.x = lo.x; vu.y = lo.y; vu.z = hi.x; vu.w = hi.y;
                        o[dt] = MFMA(__builtin_bit_cast(bf16x8, vu), pb, o[dt]);
                    }
                }
        }
        if (kt + 2 < nkt) ASWRITE(b, 0)
        if (kt + 4 < nkt) AGLOAD(b, (kt + 4) * 64)
        LDS_BARRIER();
    }
#undef AGLOAD
#undef ASWRITE
    l += __shfl_xor(l, 32);
    const float inv = 1.f / l;
    bf16_t* Os = (bf16_t*)smem_os + (size_t)w * 32 * 72;
#pragma unroll
    for (int dt = 0; dt < 2; ++dt)
#pragma unroll
        for (int g = 0; g < 4; ++g) {
            uint2 u; u.x = pack2(o[dt][4 * g] * inv, o[dt][4 * g + 1] * inv); u.y = pack2(o[dt][4 * g + 2] * inv, o[dt][4 * g + 3] * inv);
            *(uint2*)(Os + r * 72 + dt * 32 + 8 * g + 4 * h) = u;
        }
    __syncthreads();
#pragma unroll
    for (int j = 0; j < 4; ++j) {
        int c = lane + 64 * j, row = c >> 3, cc = c & 7;
        uint4 u = *(const uint4*)(Os + row * 72 + cc * 8);
        *(uint4*)(Odst + (size_t)(w * 32 + row) * 1024 + cc * 8) = u;
    }
    __syncthreads();
}

DI void phase_attn(const Params& p, char* smem_all) {
    char* smem = smem_all;
    char* smem_os = smem_all + 65536 + HBI * 20480;
    bf16_t* O = (bf16_t*)(p.ws + OFF_H);
    for (int it0 = blockIdx.x * 2; it0 < 2304; it0 += gridDim.x * 2) {
        const int item = it0 + HBI;
        int b, kind, hq, qb, nkeys, sq0, orow;
        if (item < 2048) { qb = item & 15; hq = (item >> 4) & 7; kind = (item >> 7) & 1; b = item >> 8; sq0 = 256 + qb * 128; nkeys = 2304; orow = b * 2048 + qb * 128; }
        else { int it = item - 2048; qb = it & 1; hq = (it >> 1) & 7; kind = (it >> 4) & 1; b = it >> 5; sq0 = qb * 128; nkeys = 256; orow = 16384 + b * 256 + qb * 128; }
        bf16_t* od = O + (size_t)orow * 1024 + kind * 512 + hq * 64;
        if (kind == 0) {
            const bf16_t* Q = (const bf16_t*)(p.ws + OFF_QM) + ((size_t)(b * 2304 + sq0) * 8 + hq) * 96;
            const bf16_t* K = (const bf16_t*)(p.ws + OFF_KM) + ((size_t)(b * 2304) * 8 + hq) * 96;
            const bf16_t* VT = (const bf16_t*)(p.ws + OFF_VMT) + (size_t)(b * 8 + hq) * 64 * 2304;
            attn_body<96>(Q, 768, K, 768, VT, nkeys, od, smem, smem_os);
        } else {
            const int kvh = hq >> 2;
            const bf16_t* Q = (const bf16_t*)(p.ws + OFF_QG) + ((size_t)(b * 2304 + sq0) * 8 + hq) * 64;
            const bf16_t* K = (const bf16_t*)(p.ws + OFF_KG) + ((size_t)(b * 2304) * 2 + kvh) * 64;
            const bf16_t* VT = (const bf16_t*)(p.ws + OFF_VGT) + (size_t)(b * 2 + kvh) * 64 * 2304;
            attn_body<64>(Q, 512, K, 128, VT, nkeys, od, smem, smem_os);
        }
    }
}

DI void phase_proj_resid(const Params& p, const bf16_t* A, int K, const bf16_t* W, const float* mod, int gate_idx,
                         const float* srcLat, const float* srcCtx, float* dstLat, float* dstCtx, int mtiles2, bool ctx_small, char* smem_all) {
    for (int id = blockIdx.x; id < mtiles2 * 4; id += gridDim.x) {
        const int nt2 = id / mtiles2, mt2 = id % mtiles2;
        auto epi = [&](const float* Cs, int si, int sj, int tid) {
            const int nt = 2 * nt2 + sj, m0 = (2 * mt2 + si) * 128;
            const float* src; float* dst; int mb;
            if (m0 < 16384) { src = srcLat + (size_t)m0 * 1024; dst = dstLat + (size_t)m0 * 1024; mb = m0 >> 11; }
            else { src = srcCtx + (size_t)(m0 - 16384) * 1024; dst = dstCtx + (size_t)(m0 - 16384) * 1024; mb = 8; }
            epi_resid(Cs, src + nt * 128, dst + nt * 128, mod + (size_t)mb * 6144 + gate_idx * 1024 + nt * 128, tid);
        };
        const int r0 = g_row(0), r1 = g_row(1), r2 = g_row(2), r3 = g_row(3);
        const bf16_t* Ab = A + (size_t)mt2 * 256 * K;
        const bf16_t* Bb = W + (size_t)nt2 * 256 * K;
        gemm256(p.ws, Ab + (size_t)r0 * K + g_chunk(r0) * 8, Ab + (size_t)r1 * K + g_chunk(r1) * 8, Ab + (size_t)r2 * K + g_chunk(r2) * 8, Ab + (size_t)r3 * K + g_chunk(r3) * 8,
                Bb + (size_t)b_perm(r0) * K + g_chunk(r0) * 8, Bb + (size_t)b_perm(r1) * K + g_chunk(r1) * 8, Bb + (size_t)b_perm(r2) * K + g_chunk(r2) * 8, Bb + (size_t)b_perm(r3) * K + g_chunk(r3) * 8,
                K, smem_all, epi);
    }
    if (ctx_small) {
        char* smem = smem_all + HBI * HB_SMEM;
        for (int id0 = blockIdx.x * 2; id0 < 128; id0 += gridDim.x * 2) {
            const int id = id0 + HBI, nt = id >> 4, m0 = 16384 + (id & 15) * 128;
            auto epi = [&](const float* Cs, const float*) {
                epi_resid(Cs, srcCtx + (size_t)(m0 - 16384) * 1024 + nt * 128, dstCtx + (size_t)(m0 - 16384) * 1024 + nt * 128, mod + (size_t)8 * 6144 + gate_idx * 1024 + nt * 128, TID);
            };
            const bf16_t* Ar = A + (size_t)(m0 + (TID >> 3)) * K;
            gemm_tile<false, false>(Ar, Ar + (size_t)32 * K, Ar + (size_t)64 * K, Ar + (size_t)96 * K, 0u, 0u, 0u, 0u, W + (size_t)nt * 128 * K, K, K, smem, epi);
        }
    }
}

DI float4 conv4(float4 w0, float4 w1, float4 w2, float4 bb, float4 gm, float4 g0, float4 gp, float4 v) {
    float4 o;
    o.x = siluf_(w0.x * gm.x + w1.x * g0.x + w2.x * gp.x + bb.x) * v.x;
    o.y = siluf_(w0.y * gm.y + w1.y * g0.y + w2.y * gp.y + bb.y) * v.y;
    o.z = siluf_(w0.z * gm.z + w1.z * g0.z + w2.z * gp.z + bb.z) * v.z;
    o.w = siluf_(w0.w * gm.w + w1.w * g0.w + w2.w * gp.w + bb.w) * v.w;
    return o;
}
DI void halo_info(int mt, int& base, int& T, int& tstart) {
    int ti;
    if (mt < 136) { base = (mt / 17) * 2048; T = 2048; ti = mt % 17; }
    else { int q = mt - 136; base = 16384 + (q / 3) * 256; T = 256; ti = q % 3; }
    tstart = 126 * ti - 1;
}
DI const bf16_t* halo_ptr(const bf16_t* H, const bf16_t* Z, int mt2, int row) {
    int base, T, tstart; halo_info(2 * mt2 + (row >> 7), base, T, tstart);
    const int t = tstart + (row & 127);
    return (t >= 0 && t < T) ? H + (size_t)(base + t) * 1024 + g_chunk(row) * 8 : Z;
}
DI void phase_ffn_up(const Params& p, const bf16_t* W, const float* convw, const float* convb, int mtiles2, char* smem_all) {
    const bf16_t* H = (const bf16_t*)(p.ws + OFF_H);
    const bf16_t* Z = (const bf16_t*)(p.ws + OFF_ZROW);
    bf16_t* ACT = (bf16_t*)(p.ws + OFF_ACT);
    for (int id = blockIdx.x; id < mtiles2 * 22; id += gridDim.x) {
        const int nt2 = id / mtiles2, mt2 = id % mtiles2;
        auto epi = [&](const float* Cs, int si, int sj, int tid) {
            const int nt = 2 * nt2 + sj;
            int base, T, tstart; halo_info(2 * mt2 + si, base, T, tstart);
            const int cc = tid & 7;
            const int cg0 = nt * 64 + cc * 8;
            const float4 w0a = *(const float4*)(convw + cg0), w0b = *(const float4*)(convw + cg0 + 4);
            const float4 w1a = *(const float4*)(convw + 2816 + cg0), w1b = *(const float4*)(convw + 2816 + cg0 + 4);
            const float4 w2a = *(const float4*)(convw + 5632 + cg0), w2b = *(const float4*)(convw + 5632 + cg0 + 4);
            const float4 bba = *(const float4*)(convb + cg0), bbb = *(const float4*)(convb + cg0 + 4);
#pragma unroll
            for (int j = 0; j < 4; ++j) {
                const int rr = (tid >> 3) + 32 * j, t = tstart + rr;
                if (rr >= 1 && rr <= 126 && t < T) {
                    const float4* a = (const float4*)(Cs + (rr - 1) * CP + cc * 8);
                    const float4* bq = (const float4*)(Cs + rr * CP + cc * 8);
                    const float4* c = (const float4*)(Cs + (rr + 1) * CP + cc * 8);
                    const float4* d = (const float4*)(Cs + rr * CP + 64 + cc * 8);
                    const float4 oa = conv4(w0a, w1a, w2a, bba, a[0], bq[0], c[0], d[0]);
                    const float4 ob = conv4(w0b, w1b, w2b, bbb, a[1], bq[1], c[1], d[1]);
                    uint4 u; u.x = pack2(oa.x, oa.y); u.y = pack2(oa.z, oa.w); u.z = pack2(ob.x, ob.y); u.w = pack2(ob.z, ob.w);
                    *(uint4*)(ACT + (size_t)(base + t) * 2816 + cg0) = u;
                }
            }
        };
        const int r0 = g_row(0), r1 = g_row(1), r2 = g_row(2), r3 = g_row(3);
        const bf16_t* Bb = W + (size_t)nt2 * 256 * 1024;
        gemm256(p.ws, halo_ptr(H, Z, mt2, r0), halo_ptr(H, Z, mt2, r1), halo_ptr(H, Z, mt2, r2), halo_ptr(H, Z, mt2, r3),
                Bb + (size_t)b_perm(r0) * 1024 + g_chunk(r0) * 8, Bb + (size_t)b_perm(r1) * 1024 + g_chunk(r1) * 8, Bb + (size_t)b_perm(r2) * 1024 + g_chunk(r2) * 8, Bb + (size_t)b_perm(r3) * 1024 + g_chunk(r3) * 8,
                1024, smem_all, epi);
    }
}

DI void phase_inproj1(const Params& p, char* smem_all) {
    const bf16_t* H = (const bf16_t*)(p.ws + OFF_H);
    const bf16_t* W = (const bf16_t*)(p.ws + OFF_WT_IN1);
    for (int id = blockIdx.x; id < 72 * 13; id += gridDim.x) {
        const int nt2 = id / 72, mt2 = id % 72;
        if (mt2 >= 64 && nt2 >= 8 && nt2 < 12) continue;
        auto epi = [&](const float* Cs, int si, int sj, int tid) {
            const int nt = 2 * nt2 + sj, m0 = (2 * mt2 + si) * 128;
            if (nt < 8) epi_store_bf16(Cs, (bf16_t*)(p.ws + OFF_QKRAW) + (size_t)m0 * 1024 + nt * 128, 1024, tid);
            else if (nt < 16) epi_store_bf16(Cs, (bf16_t*)(p.ws + OFF_V1) + (size_t)m0 * 1024 + (nt - 8) * 128, 1024, tid);
            else if (nt < 24) epi_store_bf16(Cs, (bf16_t*)(p.ws + OFF_OG) + (size_t)m0 * 1024 + (nt - 16) * 128, 1024, tid);
            else if (nt == 24) {
                const int row = tid >> 1, half = tid & 1;
                float* dst = (float*)(p.ws + OFF_GATES) + (size_t)(m0 + row) * 32 + half * 16;
#pragma unroll
                for (int i = 0; i < 16; ++i) {
                    int c = half * 16 + i;
                    float v = Cs[row * CP + c] + p.ml_gate_b[c];
                    if (c & 8) v = logsigmoidf_(v);
                    dst[i] = v;
                }
            }
        };
        const int r0 = g_row(0), r1 = g_row(1), r2 = g_row(2), r3 = g_row(3);
        const bf16_t* Ab = H + (size_t)mt2 * 256 * 1024;
        const bf16_t* Bb = W + (size_t)nt2 * 256 * 1024;
        gemm256(p.ws, Ab + (size_t)r0 * 1024 + g_chunk(r0) * 8, Ab + (size_t)r1 * 1024 + g_chunk(r1) * 8, Ab + (size_t)r2 * 1024 + g_chunk(r2) * 8, Ab + (size_t)r3 * 1024 + g_chunk(r3) * 8,
                Bb + (size_t)b_perm(r0) * 1024 + g_chunk(r0) * 8, Bb + (size_t)b_perm(r1) * 1024 + g_chunk(r1) * 8, Bb + (size_t)b_perm(r2) * 1024 + g_chunk(r2) * 8, Bb + (size_t)b_perm(r3) * 1024 + g_chunk(r3) * 8,
                1024, smem_all, epi);
    }
}

DI void phase_qkconv(const Params& p) {
    const bf16_t* QK = (const bf16_t*)(p.ws + OFF_QKRAW);
    bf16_t* QC = (bf16_t*)(p.ws + OFF_H);
    {
        const int lane = threadIdx.x & 63, gw = blockIdx.x * 8 + (threadIdx.x >> 6);
        const float* GT = (const float*)(p.ws + OFF_GATES);
        float* SC = (float*)(p.ws + OFF_SCAN);
        for (int seg = gw; seg < 2304; seg += gridDim.x * 8) {
            const int step = seg % 18, dir = (seg / 18) & 1, hd = (seg / 36) & 7, b = seg / 288;
            int base, P0;
            if (step < 2) { base = 16384 + b * 256; P0 = (dir ? 1 - step : step) * 128; } else { base = b * 2048; P0 = (dir ? 17 - step : step - 2) * 128; }
            const int pa = dir ? P0 + 127 - lane : P0 + lane, pb = dir ? pa - 64 : pa + 64;
            const float* ga = GT + (size_t)(base + pa) * 32 + dir * 16 + hd; const float* gb = GT + (size_t)(base + pb) * 32 + dir * 16 + hd;
            const float i0 = ga[0], f0 = ga[8], i1 = gb[0], f1 = gb[8];
            float b0 = f0, b1 = f1;
#pragma unroll
            for (int off = 1; off < 64; off <<= 1) { float t0 = __shfl_up(b0, off), t1 = __shfl_up(b1, off); if (lane >= off) { b0 += t0; b1 += t1; } }
            b1 += __shfl(b0, 63);
            float p0 = i0 - b0, p1 = i1 - b1;
            const float c0 = p0, c1 = p1;
#pragma unroll
            for (int off = 1; off < 64; off <<= 1) { float t0 = __shfl_up(p0, off), t1 = __shfl_up(p1, off); if (lane >= off) { p0 = fmaxf(p0, t0); p1 = fmaxf(p1, t1); } }
            p1 = fmaxf(p1, __shfl(p0, 63));
            float* o = SC + (size_t)seg * 384;
            o[lane] = b0; o[64 + lane] = b1; o[128 + lane] = p0; o[192 + lane] = p1; o[256 + lane] = c0; o[320 + lane] = c1;
        }
    }
    for (int c = blockIdx.x * NTHREADS + threadIdx.x; c < 18432 * 128; c += gridDim.x * NTHREADS) {
        const int row = c >> 7, col = (c & 127) * 8;
        int T, t;
        if (row < 16384) { T = 2048; t = row & 2047; } else { T = 256; t = (row - 16384) & 255; }
        float acc[8];
        { const float4 b0 = *(const float4*)(p.ml_conv_b + col), b1 = *(const float4*)(p.ml_conv_b + col + 4);
          acc[0] = b0.x; acc[1] = b0.y; acc[2] = b0.z; acc[3] = b0.w; acc[4] = b1.x; acc[5] = b1.y; acc[6] = b1.z; acc[7] = b1.w; }
#pragma unroll
        for (int dj = 0; dj < 3; ++dj) {
            const int tt = t + dj - 1;
            const float on = (tt >= 0 && tt < T) ? 1.f : 0.f;
            const int rr = row + min(max(tt, 0), T - 1) - t;
            float f[8]; unpack8(*(const uint4*)(QK + (size_t)rr * 1024 + col), f);
            const float4 w0 = *(const float4*)(p.ml_conv_w + dj * 1024 + col), w1 = *(const float4*)(p.ml_conv_w + dj * 1024 + col + 4);
            acc[0] += w0.x * on * f[0]; acc[1] += w0.y * on * f[1]; acc[2] += w0.z * on * f[2]; acc[3] += w0.w * on * f[3];
            acc[4] += w1.x * on * f[4]; acc[5] += w1.y * on * f[5]; acc[6] += w1.z * on * f[6]; acc[7] += w1.w * on * f[7];
        }
        const float sc = col >= 512 ? 0.125f : 1.f;
#pragma unroll
        for (int i = 0; i < 8; ++i) acc[i] = siluf_(acc[i]) * sc;
        *(uint4*)(QC + (size_t)row * 1024 + col) = pack8(acc);
    }
}

DI void phase_mlstm(const Params& p, char* smem) {
    constexpr int LP = 72, TP = 136, L = 128;
    bf16_t* Qc = (bf16_t*)smem;
    bf16_t* Kc = Qc + L * LP;
    bf16_t* KcT = Kc + L * LP;
    bf16_t* VcT = KcT + 64 * TP;
    bf16_t* VwT = VcT + 64 * TP;
    bf16_t* Pm = VwT + 64 * TP;
    bf16_t* Cb = Pm + L * TP;
    float* fa = (float*)(Cb + 64 * LP);
    float* bcum = fa; float* ig = fa + 128; float* mtv = fa + 256; float* wint = fa + 384; float* denI = fa + 512; float* denX = fa + 640;
    float* wgt = fa + 768; float* nvec = fa + 896; float* scal = fa + 960; float* csv = fa + 1024; float* denP = fa + 1152;
    static_assert((2 * L * LP + 3 * 64 * TP + L * TP + 64 * LP) * 2 + 1408 * 4 <= SMEM_ALL, "mLSTM LDS");
    const int lane0 = threadIdx.x & 63, w = __builtin_amdgcn_readfirstlane(threadIdx.x >> 6);
    const bf16_t* QK = (const bf16_t*)(p.ws + OFF_H);
    const bf16_t* V1 = (const bf16_t*)(p.ws + OFF_V1);
    const float* GT = (const float*)(p.ws + OFF_GATES);
    for (int item = blockIdx.x; item < 256; item += gridDim.x) {
        const int vh = item & 1, dir = (item >> 1) & 1, hd = (item >> 2) & 7, b = item >> 5;
        bf16_t* Hout = (bf16_t*)(p.ws + (dir ? OFF_HB : OFF_HF));
        f32x16 accC = zero16();
        float m_prev = 0.f;
        for (int i = w * 64 + lane0; i < 64 * LP; i += 512) Cb[i] = 0;
        if (w == 0) nvec[lane0] = 0.f;
        int lane = lane0, tid = w * 64 + lane0, h = lane0 >> 5, r = lane0 & 31;
        int u = tid >> 2, part = tid & 3;
        uint4 rq0, rq1, rk0, rk1, rv0, rv1;
        float sc_b = 0.f, sc_p = 0.f, sc_c = 0.f, sc_bl = 0.f, sc_pl = 0.f;
#define ML_STEP_GEOM(st, base_, P0_) { if ((st) < 2) { base_ = 16384 + b * 256; P0_ = (dir ? 1 - (st) : (st)) * L; } else { base_ = b * 2048; P0_ = (dir ? 17 - (st) : (st) - 2) * L; } }
#define ML_PREFETCH(st) { int base_, P0_; ML_STEP_GEOM(st, base_, P0_) \
            const int pos_ = dir ? P0_ + L - 1 - u : P0_ + u; \
            { const bf16_t* rowp = QK + (size_t)(base_ + pos_) * 1024; \
              const int qcol = hd * 64 + part * 16, kcol = 512 + qcol; rq0 = *(const uint4*)(rowp + qcol); rq1 = *(const uint4*)(rowp + qcol + 8); rk0 = *(const uint4*)(rowp + kcol); rk1 = *(const uint4*)(rowp + kcol + 8); } \
            { const bf16_t* vp_ = V1 + (size_t)(base_ + pos_) * 1024 + hd * 128 + vh * 64 + part * 16; rv0 = *(const uint4*)vp_; rv1 = *(const uint4*)(vp_ + 8); } \
            if (w < 2) { const float* sp_ = (const float*)(p.ws + OFF_SCAN) + (size_t)((((b * 8 + hd) * 2 + dir) * 18) + (st)) * 384; \
                sc_b = sp_[tid]; sc_p = sp_[128 + tid]; sc_c = sp_[256 + tid]; sc_bl = sp_[127]; sc_pl = sp_[255]; } }
        ML_PREFETCH(0)
        __syncthreads();
#pragma unroll 1
        for (int step = 0; step < 18; ++step) {
            lane = lane0; asm volatile("" : "+v"(lane));
            tid = w * 64 + lane; h = lane >> 5; r = lane & 31; u = tid >> 2; part = tid & 3;
            int base, P0; ML_STEP_GEOM(step, base, P0)
            const bool full = step >= 2;
            if (w < 2) {
                const float mt = fmaxf(sc_b + m_prev, sc_b + sc_p);
                const float mnew = fmaxf(sc_bl + m_prev, sc_bl + sc_pl);
                bcum[tid] = sc_b; csv[tid] = sc_c; mtv[tid] = mt;
                wint[tid] = __expf(sc_b + m_prev - mt);
                wgt[tid] = __expf(sc_bl + sc_c - mnew);
                if (tid == 0) { scal[0] = mnew; scal[1] = __expf(sc_bl + m_prev - mnew); }
            }
            {
                *(uint4*)(Qc + u * LP + part * 16) = rq0; *(uint4*)(Qc + u * LP + part * 16 + 8) = rq1;
                *(uint4*)(Kc + u * LP + part * 16) = rk0; *(uint4*)(Kc + u * LP + part * 16 + 8) = rk1;
#define ML_T2(dstT, wv, ci) { dstT[(part * 16 + (ci)) * TP + u] = (bf16_t)((wv) & 0xffffu); dstT[(part * 16 + (ci) + 1) * TP + u] = (bf16_t)((wv) >> 16); }
                ML_T2(KcT, rk0.x, 0) ML_T2(KcT, rk0.y, 2) ML_T2(KcT, rk0.z, 4) ML_T2(KcT, rk0.w, 6) ML_T2(KcT, rk1.x, 8) ML_T2(KcT, rk1.y, 10) ML_T2(KcT, rk1.z, 12) ML_T2(KcT, rk1.w, 14)
                ML_T2(VcT, rv0.x, 0) ML_T2(VcT, rv0.y, 2) ML_T2(VcT, rv0.z, 4) ML_T2(VcT, rv0.w, 6) ML_T2(VcT, rv1.x, 8) ML_T2(VcT, rv1.y, 10) ML_T2(VcT, rv1.z, 12) ML_T2(VcT, rv1.w, 14)
#undef ML_T2
            }
            if (step + 1 < 18) ML_PREFETCH(step + 1)
            LDS_BARRIER();
            const float m_new = scal[0], decay = scal[1];
            {
                const int vv = tid >> 3, s0_ = (tid & 7) * 16;
#pragma unroll
                for (int q = 0; q < 2; ++q) {
                    float f[8]; unpack8(*(const uint4*)(VcT + vv * TP + s0_ + q * 8), f);
                    const float4 w0 = *(const float4*)(wgt + s0_ + q * 8), w1 = *(const float4*)(wgt + s0_ + q * 8 + 4);
                    f[0] *= w0.x; f[1] *= w0.y; f[2] *= w0.z; f[3] *= w0.w; f[4] *= w1.x; f[5] *= w1.y; f[6] *= w1.z; f[7] *= w1.w;
                    *(uint4*)(VwT + vv * TP + s0_ + q * 8) = pack8(f);
                }
            }
            if (full) {
                {
                    float sacc_ = 0.f;
#pragma unroll
                    for (int q = 0; q < 2; ++q) {
                        float f[8]; unpack8(*(const uint4*)(Qc + u * LP + part * 16 + q * 8), f);
                        const float4 n0 = *(const float4*)(nvec + part * 16 + q * 8), n1 = *(const float4*)(nvec + part * 16 + q * 8 + 4);
                        sacc_ += f[0] * n0.x + f[1] * n0.y + f[2] * n0.z + f[3] * n0.w + f[4] * n1.x + f[5] * n1.y + f[6] * n1.z + f[7] * n1.w;
                    }
                    sacc_ += __shfl_xor(sacc_, 1); sacc_ += __shfl_xor(sacc_, 2);
                    if (part == 0) denX[u] = sacc_;
                }
                const int ti = w >> 1, t = ti * 32 + r;
                const float bt = bcum[t] - mtv[t];
                float rs = 0.f;
#pragma unroll
                for (int q = 0; q < 2; ++q) {
                    const int si = 2 * (w & 1) + q;
                    if (si <= ti) {
                        f32x16 sacc = zero16();
#pragma unroll
                        for (int ks = 0; ks < 4; ++ks) {
                            bf16x8 a = *(const bf16x8*)(Kc + (si * 32 + r) * LP + ks * 16 + h * 8);
                            bf16x8 bb = *(const bf16x8*)(Qc + (ti * 32 + r) * LP + ks * 16 + h * 8);
                            sacc = MFMA(a, bb, sacc);
                        }
#pragma unroll
                        for (int g4 = 0; g4 < 4; ++g4) {
                            const int s0_ = si * 32 + 8 * g4 + 4 * h;
                            const float4 c4 = *(const float4*)(csv + s0_);
                            float p0 = s0_ + 0 <= t ? sacc[4 * g4 + 0] * __expf(bt + c4.x) : 0.f;
                            float p1 = s0_ + 1 <= t ? sacc[4 * g4 + 1] * __expf(bt + c4.y) : 0.f;
                            float p2 = s0_ + 2 <= t ? sacc[4 * g4 + 2] * __expf(bt + c4.z) : 0.f;
                            float p3 = s0_ + 3 <= t ? sacc[4 * g4 + 3] * __expf(bt + c4.w) : 0.f;
                            rs += (p0 + p1) + (p2 + p3);
                            uint2 pk; pk.x = pack2(p0, p1); pk.y = pack2(p2, p3);
                            *(uint2*)(Pm + t * TP + s0_) = pk;
                        }
                    } else {
#pragma unroll
                        for (int g4 = 0; g4 < 4; ++g4) *(uint2*)(Pm + t * TP + si * 32 + 8 * g4 + 4 * h) = make_uint2(0u, 0u);
                    }
                }
                rs += __shfl_xor(rs, 32);
                if (h == 0) denP[(w & 1) * 128 + t] = rs;
            }
            LDS_BARRIER();
            f32x16 hacc = zero16();
            const int ti = w >> 1, vi = w & 1;
            if (full) {
#pragma unroll
                for (int ks = 0; ks < 4; ++ks) {
                    bf16x8 a = *(const bf16x8*)(Cb + (vi * 32 + r) * LP + ks * 16 + h * 8);
                    bf16x8 bb = *(const bf16x8*)(Qc + (ti * 32 + r) * LP + ks * 16 + h * 8);
                    hacc = MFMA(a, bb, hacc);
                }
                const float wi = wint[ti * 32 + r];
#pragma unroll
                for (int g = 0; g < 16; ++g) hacc[g] *= wi;
#pragma unroll
                for (int ks = 0; ks < 8; ++ks) {
                    if (ks <= 2 * ti + 1) {
                        bf16x8 a = *(const bf16x8*)(VcT + (vi * 32 + r) * TP + ks * 16 + h * 8);
                        bf16x8 bb = *(const bf16x8*)(Pm + (ti * 32 + r) * TP + ks * 16 + h * 8);
                        hacc = MFMA(a, bb, hacc);
                    }
                }
            }
            LDS_BARRIER();
            if (full) {
                const int t = ti * 32 + r;
                const float den = wint[t] * denX[t] + denP[t] + denP[128 + t];
                const float inv = __builtin_amdgcn_rcpf(fmaxf(fabsf(den), __expf(-mtv[t])));
                bf16_t* hp = Pm + t * LP + vi * 32 + 4 * h;
#pragma unroll
                for (int g4 = 0; g4 < 4; ++g4) {
                    uint2 pk; pk.x = pack2(hacc[4 * g4] * inv, hacc[4 * g4 + 1] * inv); pk.y = pack2(hacc[4 * g4 + 2] * inv, hacc[4 * g4 + 3] * inv);
                    *(uint2*)(hp + 8 * g4) = pk;
                }
            }
            if (w < 4) {
                const int vi2 = w >> 1, di = w & 1;
#pragma unroll
                for (int g = 0; g < 16; ++g) accC[g] *= decay;
#pragma unroll
                for (int ks = 0; ks < 8; ++ks) {
                    bf16x8 a = *(const bf16x8*)(VwT + (vi2 * 32 + r) * TP + ks * 16 + h * 8);
                    bf16x8 bb = *(const bf16x8*)(KcT + (di * 32 + r) * TP + ks * 16 + h * 8);
                    accC = MFMA(a, bb, accC);
                }
#pragma unroll
                for (int g = 0; g < 16; ++g) Cb[(vi2 * 32 + crow(g, h)) * LP + di * 32 + r] = f2bf_sw(accC[g]);
            } else {
                const int t2 = tid - 256, d = t2 >> 2, pq = t2 & 3;
                float sacc_ = 0.f;
#pragma unroll
                for (int q = 0; q < 4; ++q) {
                    float f[8]; unpack8(*(const uint4*)(KcT + d * TP + pq * 32 + q * 8), f);
                    const float4 w0 = *(const float4*)(wgt + pq * 32 + q * 8), w1 = *(const float4*)(wgt + pq * 32 + q * 8 + 4);
                    sacc_ += f[0] * w0.x + f[1] * w0.y + f[2] * w0.z + f[3] * w0.w + f[4] * w1.x + f[5] * w1.y + f[6] * w1.z + f[7] * w1.w;
                }
                sacc_ += __shfl_xor(sacc_, 1); sacc_ += __shfl_xor(sacc_, 2);
                if (pq == 0) nvec[d] = decay * nvec[d] + sacc_;
            }
            m_prev = m_new;
            LDS_BARRIER();
            if (full) {
#pragma unroll
                for (int q = 0; q < 2; ++q) {
                    const int c = tid + 512 * q, t = c >> 3, ch = c & 7;
                    const int pos = dir ? P0 + L - 1 - t : P0 + t;
                    *(uint4*)(Hout + (size_t)(base + pos) * 1024 + hd * 128 + vh * 64 + ch * 8) = *(const uint4*)(Pm + t * LP + ch * 8);
                }
            }
        }
#undef ML_STEP_GEOM
#undef ML_PREFETCH
    }
}

DI void phase_mix(const Params& p) {
    const int lane = threadIdx.x & 63, w = threadIdx.x >> 6;
    const bf16_t* HF = (const bf16_t*)(p.ws + OFF_HF);
    const bf16_t* HB = (const bf16_t*)(p.ws + OFF_HB);
    const bf16_t* OG = (const bf16_t*)(p.ws + OFF_OG);
    bf16_t* H = (bf16_t*)(p.ws + OFF_H);
    for (int row = blockIdx.x * 8 + w; row < 16384; row += gridDim.x * 8) {
        const size_t o = (size_t)row * 1024 + lane * 16;
        float a[16], bq[16], og[16];
        unpack8(*(const uint4*)(HF + o), a); unpack8(*(const uint4*)(HF + o + 8), a + 8);
        unpack8(*(const uint4*)(HB + o), bq); unpack8(*(const uint4*)(HB + o + 8), bq + 8);
        unpack8(*(const uint4*)(OG + o), og); unpack8(*(const uint4*)(OG + o + 8), og + 8);
        float ss = 0.f;
#pragma unroll
        for (int i = 0; i < 16; ++i) { a[i] += bq[i]; ss += a[i] * a[i]; }
        ss += __shfl_xor(ss, 1); ss += __shfl_xor(ss, 2); ss += __shfl_xor(ss, 4);
        const float rstd = rsqrtf(ss * (1.f / 128.f) + EPSF);
        const float* g = p.ml_out_g + lane * 16;
#pragma unroll
        for (int i = 0; i < 16; ++i) a[i] = a[i] * rstd * g[i] * sigmoidf_(og[i]);
        *(uint4*)(H + o) = pack8(a); *(uint4*)(H + o + 8) = pack8(a + 8);
    }
}

#define XB_TMO      128
#define XB_XCNT(j)  (256  + 64 * (j))
#define XB_XSUB(j)  (1280 + 64 * (j))
#define XB_XGEN(j)  (2304 + 64 * (j))
#define XB_TOP      3328
#define XB_TOPGEN   3392
#define XCD_BAR_WORDS 3456
#define XB_SPIN_CAP (1u << 18)
#define LAS __attribute__((address_space(3)))

__device__ __forceinline__ unsigned xb_ld(unsigned* p)              { return __hip_atomic_load(p, __ATOMIC_RELAXED, __HIP_MEMORY_SCOPE_AGENT); }
__device__ __forceinline__ unsigned xb_add(unsigned* p, unsigned v) { return __hip_atomic_fetch_add(p, v, __ATOMIC_RELAXED, __HIP_MEMORY_SCOPE_AGENT); }
__device__ __forceinline__ unsigned xb_xcc_id() { return (unsigned)__builtin_amdgcn_s_getreg((3 << 11) | 20) & 0xFu; }
#define XB_SPIN(cond, bar) do { unsigned _sp = 0; while (cond) { __builtin_amdgcn_s_sleep(1); \
    if ((++_sp & 255u) == 0u) { if (xb_ld(&(bar)[XB_TMO])) break; if (_sp > XB_SPIN_CAP) { atomicAdd(&(bar)[XB_TMO], 1u); break; } } } } while (0)

struct XcdBarrier {
    unsigned* bar; unsigned x;
    volatile LAS unsigned* st;
};

__device__ __forceinline__ XcdBarrier xcd_barrier_post(unsigned* bar, volatile LAS unsigned* st) {
    XcdBarrier b; b.bar = bar; b.x = xb_xcc_id(); b.st = st;
    if (threadIdx.x == 0) (void)xb_add(&bar[XB_XCNT(b.x)], 1u);
    return b;
}
__device__ __forceinline__ void xcd_barrier_complete(unsigned* bar, unsigned x, unsigned& nloc, unsigned& nx) {
    const unsigned G = gridDim.x * gridDim.y * gridDim.z;
    unsigned sum, cnt, mine, sp = 0u;
    for (;;) {
        sum = 0u; cnt = 0u; mine = 0u;
#pragma unroll
        for (unsigned j = 0; j < 16; ++j) { const unsigned c = xb_ld(&bar[XB_XCNT(j)]); sum += c; cnt += (c > 0u) ? 1u : 0u; mine = (j == x) ? c : mine; }
        if (sum == G) break;
        __builtin_amdgcn_s_sleep(1);
        if ((++sp & 255u) == 0u) { if (xb_ld(&bar[XB_TMO])) break; if (sp > XB_SPIN_CAP) { atomicAdd(&bar[XB_TMO], 1u); break; } }
    }
    nloc = mine > 0u ? mine : 1u; nx = cnt > 0u ? cnt : 1u;
}

__device__ __forceinline__ void xcd_barrier(const XcdBarrier& b) {
    asm volatile("s_waitcnt vmcnt(0)" ::: "memory");
    __syncthreads();
    if (threadIdx.x == 0) {
        unsigned* bar = b.bar;
        __builtin_amdgcn_s_waitcnt(0);
        unsigned nloc = b.st[0], nx = b.st[1];
        if (nloc == 0u) { xcd_barrier_complete(bar, b.x, nloc, nx); b.st[0] = nloc; b.st[1] = nx; }
        const unsigned old = xb_add(&bar[XB_XSUB(b.x)], 1u);
        const unsigned gen = old / nloc;
        if (old + 1u == (gen + 1u) * nloc) {
            __builtin_amdgcn_fence(__ATOMIC_RELEASE, "agent");
            asm volatile("s_waitcnt vmcnt(0)" ::: "memory");
            const unsigned og = xb_add(&bar[XB_TOP], 1u);
            const unsigned tg = og / nx;
            if (og + 1u == (tg + 1u) * nx) xb_add(&bar[XB_TOPGEN], 1u);
            else XB_SPIN(xb_ld(&bar[XB_TOPGEN]) == tg, bar);
            __builtin_amdgcn_fence(__ATOMIC_ACQUIRE, "agent");
            xb_add(&bar[XB_XGEN(b.x)], 1u);
            asm volatile("s_waitcnt vmcnt(0)" ::: "memory");
        } else {
            XB_SPIN(xb_ld(&bar[XB_XGEN(b.x)]) == gen, bar);
            __builtin_amdgcn_fence(__ATOMIC_ACQUIRE, "agent");
            asm volatile("s_waitcnt vmcnt(0)" ::: "memory");
        }
    }
    __syncthreads();
}


__global__ void __launch_bounds__(NTHREADS, 2) __attribute__((amdgpu_waves_per_eu(2, 2))) fwd_megakernel(Params p) {
    __shared__ __attribute__((aligned(1024))) char smem[SMEM_ALL];
    cg::grid_group grid = cg::this_grid();
    __shared__ uint4 xb_words;
    if (threadIdx.x == 0) xb_words = make_uint4(0u, 0u, 0u, 0u);
    __syncthreads();
    XcdBarrier xb = xcd_barrier_post((unsigned*)(p.ws + OFF_BAR), (volatile LAS unsigned*)&xb_words);
    const float* MOD0 = (const float*)(p.ws + OFF_MOD);
    const float* MOD1 = MOD0 + 9 * 6144;
    float* XRC = (float*)(p.ws + OFF_XRC);
    const bf16_t* Hb = (const bf16_t*)(p.ws + OFF_H);

    phase0(p, smem);
    if (p.ws == nullptr) grid.sync();
    xcd_barrier(xb);
    phase_norm(p, p.x, p.ctx, p.norm1_g, MOD0, 0, 18432);
    xcd_barrier(xb);
    phase_inproj0(p, smem);
    xcd_barrier(xb);
    phase_mla_up(p, smem);
    xcd_barrier(xb);
    phase_attn(p, smem);
    xcd_barrier(xb);
    phase_proj_resid(p, Hb, 1024, (const bf16_t*)(p.ws + OFF_WT_OUT0), MOD0, 2, p.x, p.ctx, p.out, XRC, 64, true, smem);
    xcd_barrier(xb);
    phase_norm(p, p.out, XRC, p.norm2_g, MOD0, 3, 18432);
    xcd_barrier(xb);
    phase_ffn_up(p, (const bf16_t*)(p.ws + OFF_WT_UP0), p.ffn_conv_w, p.ffn_conv_b, 80, smem);
    xcd_barrier(xb);
    phase_proj_resid(p, (const bf16_t*)(p.ws + OFF_ACT), 2816, (const bf16_t*)(p.ws + OFF_WT_DOWN0), MOD0, 5, p.out, XRC, p.out, XRC, 64, true, smem);
    xcd_barrier(xb);
    phase_norm(p, p.out, XRC, p.norm1_g + 1024, MOD1, 0, 18432);
    xcd_barrier(xb);
    phase_inproj1(p, smem);
    xcd_barrier(xb);
    phase_qkconv(p);
    xcd_barrier(xb);
    phase_mlstm(p, smem);
    xcd_barrier(xb);
    phase_mix(p);
    xcd_barrier(xb);
    phase_proj_resid(p, Hb, 1024, (const bf16_t*)(p.ws + OFF_WT_OUT1), MOD1, 2, p.out, XRC, p.out, XRC, 64, false, smem);
    xcd_barrier(xb);
    phase_norm(p, p.out, XRC, p.norm2_g + 1024, MOD1, 3, 16384);
    xcd_barrier(xb);
    phase_ffn_up(p, (const bf16_t*)(p.ws + OFF_WT_UP1), p.ffn_conv_w + 3 * 2816, p.ffn_conv_b + 2816, 68, smem);
    xcd_barrier(xb);
    phase_proj_resid(p, (const bf16_t*)(p.ws + OFF_ACT), 2816, (const bf16_t*)(p.ws + OFF_WT_DOWN1), MOD1, 5, p.out, XRC, p.out, XRC, 64, false, smem);
}

extern "C" void kernel_launch(void* const* d_in, const int* in_sizes, int n_in, void* d_out, int out_size, void* d_ws, size_t ws_size,
                              hipStream_t stream) {
    static int grid_blocks = 0;
    if (!grid_blocks) {
        int dev = 0, cus = 0, per_cu = 0;
        hipGetDevice(&dev);
        hipDeviceGetAttribute(&cus, hipDeviceAttributeMultiprocessorCount, dev);
        hipOccupancyMaxActiveBlocksPerMultiprocessor(&per_cu, fwd_megakernel, NTHREADS, 0);
        if (per_cu < 1) per_cu = 1;
        if (per_cu > 1) per_cu = 1;
        grid_blocks = cus * per_cu;
        if (ws_size < WS_END) fprintf(stderr, "kernel_launch: workspace too small: %zu < %zu\n", ws_size, (size_t)WS_END);
    }
    Params p{};
    const float** pf = (const float**)&p;
    for (int i = 0; i < 28; ++i) pf[i] = (const float*)d_in[i];
    p.out = (float*)d_out;
    p.ws = (char*)d_ws;
    hipMemsetAsync((char*)d_ws + OFF_BAR, 0, 16384, stream);
    void* args[] = {&p};
    hipError_t e = hipLaunchCooperativeKernel((void*)fwd_megakernel, dim3(grid_blocks), dim3(NTHREADS), args, 0, stream);
    if (e != hipSuccess) fprintf(stderr, "cooperative launch failed: %s (grid %d)\n", hipGetErrorString(e), grid_blocks);
}
```

```cpp
#include <hip/hip_runtime.h>
#include <hip/hip_cooperative_groups.h>
#include <cstdio>
namespace cg = cooperative_groups;

typedef unsigned short bf16_t;
using bf16x8 = __attribute__((ext_vector_type(8))) short;
using f32x16 = __attribute__((ext_vector_type(16))) float;
using f32x4 = __attribute__((ext_vector_type(4))) float;
#define DI __device__ __forceinline__
#define MFMA(a, b, c) __builtin_amdgcn_mfma_f32_32x32x16_bf16((a), (b), (c), 0, 0, 0)
#define MFMA16(a, b, c) __builtin_amdgcn_mfma_f32_16x16x32_bf16((a), (b), (c), 0, 0, 0)
#define LDS_BARRIER() do { asm volatile("s_waitcnt lgkmcnt(0)" ::: "memory"); __builtin_amdgcn_s_barrier(); asm volatile("" ::: "memory"); } while (0)
#define TID ((int)(threadIdx.x & 255))
#define HBI ((int)(threadIdx.x >> 8))

constexpr float EPSF = 1e-6f;
constexpr float LOG2E = 1.4426950408889634f;
constexpr int NTHREADS = 512;
constexpr int HB_SMEM = 73728;
constexpr int SMEM_ALL = 2 * HB_SMEM;
constexpr int GP = 72;
constexpr int CP = 132;
constexpr int ROWSS_OFF = 67584;

constexpr size_t OFF_WT_UP1 = 0;
constexpr size_t OFF_WT_DOWN1 = OFF_WT_UP1 + 5632ull * 1024 * 2;
constexpr size_t OFF_WT_IN1 = OFF_WT_DOWN1 + 1024ull * 2816 * 2;
constexpr size_t OFF_WT_OUT1 = OFF_WT_IN1 + 3328ull * 1024 * 2;
constexpr size_t OFF_MOD = OFF_WT_OUT1 + 1024ull * 1024 * 2;
constexpr size_t OFF_TABG = OFF_MOD + 2ull * 9 * 6144 * 4;
constexpr size_t OFF_TABM = OFF_TABG + 64 * 16 * 2 * 4;
constexpr size_t OFF_ZROW = OFF_TABM + 64 * 8 * 2 * 4;
constexpr size_t OFF_W0 = OFF_ZROW + 8192;
constexpr size_t OFF_WT_IN0 = OFF_W0;
constexpr size_t OFF_WT_QB = OFF_WT_IN0 + 1536ull * 1024 * 2;
constexpr size_t OFF_WT_KVB = OFF_WT_QB + 1024ull * 384 * 2;
constexpr size_t OFF_WT_OUT0 = OFF_WT_KVB + 1024ull * 256 * 2;
constexpr size_t OFF_WT_UP0 = OFF_WT_OUT0 + 1024ull * 1024 * 2;
constexpr size_t OFF_WT_DOWN0 = OFF_WT_UP0 + 5632ull * 1024 * 2;
constexpr size_t OFF_XRC = OFF_WT_DOWN0 + 1024ull * 2816 * 2;
constexpr size_t OFF_R = OFF_XRC + 2048ull * 1024 * 4;
constexpr size_t OFF_QG = OFF_R;
constexpr size_t OFF_KG = OFF_QG + 18432ull * 512 * 2;
constexpr size_t OFF_VGT = OFF_KG + 18432ull * 128 * 2;
constexpr size_t OFF_CQ = OFF_VGT + 18432ull * 128 * 2;
constexpr size_t OFF_CKV = OFF_CQ + 18432ull * 384 * 2;
constexpr size_t OFF_KR = OFF_CKV + 18432ull * 256 * 2;
constexpr size_t OFF_QM = OFF_KR + 18432ull * 32 * 4;
constexpr size_t OFF_KM = OFF_QM + 18432ull * 768 * 2;
constexpr size_t OFF_VMT = OFF_KM + 18432ull * 768 * 2;
constexpr size_t END_L0 = OFF_VMT + 18432ull * 512 * 2;
constexpr size_t OFF_ACT = OFF_R;
constexpr size_t END_ACT = OFF_ACT + 18432ull * 2816 * 2;
constexpr size_t OFF_QKRAW = OFF_W0;
constexpr size_t OFF_V1 = OFF_QKRAW + 18432ull * 1024 * 2;
constexpr size_t OFF_OG = OFF_V1 + 18432ull * 1024 * 2;
constexpr size_t OFF_GATES = OFF_OG + 16384ull * 1024 * 2;
constexpr size_t OFF_HF = OFF_GATES + 18432ull * 32 * 4;
constexpr size_t OFF_HB = OFF_HF + 16384ull * 1024 * 2;
constexpr size_t END_L1 = OFF_HB + 16384ull * 1024 * 2;
constexpr size_t cmax(size_t a, size_t b) { return a > b ? a : b; }
constexpr size_t OFF_H = cmax(cmax(END_L0, END_ACT), END_L1);
constexpr size_t OFF_BAR = OFF_H + 18432ull * 1024 * 2;
constexpr size_t OFF_SCAN = OFF_BAR + 16384;
constexpr size_t WS_END = OFF_SCAN + 2304ull * 384 * 4;
static_assert(WS_END <= 268435456ull, "workspace too large");
static_assert(OFF_H % 256 == 0 && OFF_R % 256 == 0 && OFF_HF % 256 == 0, "align");

struct Params {
    const float *x, *c, *ctx, *c_ctx, *ada_w, *ada_b, *norm1_g, *norm2_g, *ffn_w_up, *ffn_conv_w, *ffn_conv_b, *ffn_w_down,
        *att_w_in, *mla_qa_g, *mla_w_qb, *mla_kva_g, *mla_w_kvb, *mla_q_g, *mla_k_g, *gqa_q_g, *gqa_k_g, *att_w_out,
        *ml_w_in, *ml_conv_w, *ml_conv_b, *ml_gate_b, *ml_out_g, *ml_w_out;
    float* out;
    char* ws;
};

DI unsigned short f2bf_sw(float x) { unsigned u = __float_as_uint(x); u += 0x7fffu + ((u >> 16) & 1u); return (unsigned short)(u >> 16); }
DI unsigned short f2bf(float x) { unsigned r; asm("v_cvt_pk_bf16_f32 %0, %1, %1" : "=v"(r) : "v"(x)); return (unsigned short)(r & 0xffffu); }
DI unsigned pack2(float a, float b) { unsigned r; asm("v_cvt_pk_bf16_f32 %0, %1, %2" : "=v"(r) : "v"(a), "v"(b)); return r; }
DI bf16x8 pack_frag(float a0, float a1, float a2, float a3, float a4, float a5, float a6, float a7) {
    using u32x4_ = __attribute__((ext_vector_type(4))) unsigned; u32x4_ p;
    asm volatile("v_cvt_pk_bf16_f32 %0, %4, %5\n\tv_cvt_pk_bf16_f32 %1, %6, %7\n\tv_cvt_pk_bf16_f32 %2, %8, %9\n\tv_cvt_pk_bf16_f32 %3, %10, %11\n\ts_nop 1"
                 : "=&v"(p[0]), "=&v"(p[1]), "=&v"(p[2]), "=&v"(p[3]) : "v"(a0), "v"(a1), "v"(a2), "v"(a3), "v"(a4), "v"(a5), "v"(a6), "v"(a7));
    return __builtin_bit_cast(bf16x8, p);
}
DI float bflo(unsigned v) { return __uint_as_float(v << 16); }
DI float bfhi(unsigned v) { return __uint_as_float(v & 0xffff0000u); }
DI float bf2f(unsigned short v) { return __uint_as_float(((unsigned)v) << 16); }
DI uint4 pack8(const float* v) { uint4 o; o.x = pack2(v[0], v[1]); o.y = pack2(v[2], v[3]); o.z = pack2(v[4], v[5]); o.w = pack2(v[6], v[7]); return o; }
DI void unpack8(uint4 u, float* v) { v[0] = bflo(u.x); v[1] = bfhi(u.x); v[2] = bflo(u.y); v[3] = bfhi(u.y); v[4] = bflo(u.z); v[5] = bfhi(u.z); v[6] = bflo(u.w); v[7] = bfhi(u.w); }
DI int crow(int reg, int h) { return (reg & 3) + 8 * (reg >> 2) + 4 * h; }
DI float sigmoidf_(float x) { return __builtin_amdgcn_rcpf(1.f + __expf(-x)); }
DI float siluf_(float x) { return x * __builtin_amdgcn_rcpf(1.f + __expf(-x)); }
DI float logsigmoidf_(float x) { return fminf(x, 0.f) - log1pf(__expf(-fabsf(x))); }
DI f32x16 zero16() { f32x16 z;
#pragma unroll
    for (int i = 0; i < 16; ++i) z[i] = 0.f; return z; }

DI void row_info(int m0, int& b, int& t0, bool& lat) {
    if (m0 < 16384) { b = m0 >> 11; t0 = m0 & 2047; lat = true; }
    else { int q = m0 - 16384; b = q >> 8; t0 = q & 255; lat = false; }
}

template <bool SS, bool HALO, class Epi>
DI void gemm_tile(const bf16_t* ap0, const bf16_t* ap1, const bf16_t* ap2, const bf16_t* ap3, unsigned mk0, unsigned mk1, unsigned mk2, unsigned mk3, const bf16_t* __restrict__ Bt, int ldb, int K, char* smem, Epi epi) {
    const int tid = TID, lane = tid & 63, w = tid >> 6, h = lane >> 5, r = lane & 31;
    const int wm = w >> 1, wn = w & 1;
    const int lr = tid >> 3, kc = tid & 7;
    ap0 += kc * 8; ap1 += kc * 8; ap2 += kc * 8; ap3 += kc * 8;
    const bf16_t* bp0 = Bt + (size_t)lr * ldb + kc * 8;
    const bf16_t* bp1 = bp0 + (size_t)32 * ldb; const bf16_t* bp2 = bp0 + (size_t)64 * ldb; const bf16_t* bp3 = bp0 + (size_t)96 * ldb;
    f32x16 acc00 = zero16(), acc01 = zero16(), acc10 = zero16(), acc11 = zero16();
    float ss0 = 0.f, ss1 = 0.f, ss2 = 0.f, ss3 = 0.f;
    uint4 ra0, ra1, ra2, ra3, rb0, rb1, rb2, rb3;
    const int nk = K >> 6;
#define GLOAD(k0) { ra0 = *(const uint4*)(ap0 + (k0)); ra1 = *(const uint4*)(ap1 + (k0)); ra2 = *(const uint4*)(ap2 + (k0)); ra3 = *(const uint4*)(ap3 + (k0)); \
                    rb0 = *(const uint4*)(bp0 + (k0)); rb1 = *(const uint4*)(bp1 + (k0)); rb2 = *(const uint4*)(bp2 + (k0)); rb3 = *(const uint4*)(bp3 + (k0)); }
#define SSQ(ssv, rv) { if (SS) { float f_[8]; unpack8(rv, f_); ssv += f_[0]*f_[0] + f_[1]*f_[1] + f_[2]*f_[2] + f_[3]*f_[3] + f_[4]*f_[4] + f_[5]*f_[5] + f_[6]*f_[6] + f_[7]*f_[7]; } }
#define MSK(rv, mk) { rv.x &= mk; rv.y &= mk; rv.z &= mk; rv.w &= mk; }
#define SWRITE(s_) { if (HALO) { MSK(ra0, mk0) MSK(ra1, mk1) MSK(ra2, mk2) MSK(ra3, mk3) } bf16_t* As_ = (bf16_t*)(smem + (s_) * 36864) + lr * GP + kc * 8; bf16_t* Bs_ = As_ + 128 * GP; \
                     *(uint4*)(As_) = ra0; *(uint4*)(As_ + 32 * GP) = ra1; *(uint4*)(As_ + 64 * GP) = ra2; *(uint4*)(As_ + 96 * GP) = ra3; \
                     *(uint4*)(Bs_) = rb0; *(uint4*)(Bs_ + 32 * GP) = rb1; *(uint4*)(Bs_ + 64 * GP) = rb2; *(uint4*)(Bs_ + 96 * GP) = rb3; \
                     SSQ(ss0, ra0) SSQ(ss1, ra1) SSQ(ss2, ra2) SSQ(ss3, ra3) }
    GLOAD(0) SWRITE(0) __syncthreads();
#pragma unroll 1
    for (int kt = 0; kt < nk; ++kt) {
        if (kt + 1 < nk) GLOAD((kt + 1) * 64)
        {
            const bf16_t* As = (const bf16_t*)(smem + (kt & 1) * 36864) + (wm * 64 + r) * GP + h * 8;
            const bf16_t* Bs = (const bf16_t*)(smem + (kt & 1) * 36864) + 128 * GP + (wn * 64 + r) * GP + h * 8;
#pragma unroll
            for (int ks = 0; ks < 4; ++ks) {
                const bf16x8 a0 = *(const bf16x8*)(As + ks * 16), a1 = *(const bf16x8*)(As + 32 * GP + ks * 16);
                const bf16x8 b0 = *(const bf16x8*)(Bs + ks * 16), b1 = *(const bf16x8*)(Bs + 32 * GP + ks * 16);
                acc00 = MFMA(a0, b0, acc00); acc01 = MFMA(a0, b1, acc01); acc10 = MFMA(a1, b0, acc10); acc11 = MFMA(a1, b1, acc11);
            }
        }
        if (kt + 1 < nk) SWRITE((kt + 1) & 1)
        __syncthreads();
    }
#undef GLOAD
#undef SWRITE
#undef SSQ
#undef MSK
    float* Cs = (float*)smem;
    {
        float* cb = Cs + (wm * 64 + 4 * h) * CP + wn * 64 + r;
#pragma unroll
        for (int g = 0; g < 16; ++g) {
            const int ro = (g & 3) + 8 * (g >> 2);
            cb[ro * CP] = acc00[g]; cb[ro * CP + 32] = acc01[g]; cb[(ro + 32) * CP] = acc10[g]; cb[(ro + 32) * CP + 32] = acc11[g];
        }
    }
    if (SS) {
        float* rowss = (float*)(smem + ROWSS_OFF);
        ss0 += __shfl_xor(ss0, 1); ss0 += __shfl_xor(ss0, 2); ss0 += __shfl_xor(ss0, 4);
        ss1 += __shfl_xor(ss1, 1); ss1 += __shfl_xor(ss1, 2); ss1 += __shfl_xor(ss1, 4);
        ss2 += __shfl_xor(ss2, 1); ss2 += __shfl_xor(ss2, 2); ss2 += __shfl_xor(ss2, 4);
        ss3 += __shfl_xor(ss3, 1); ss3 += __shfl_xor(ss3, 2); ss3 += __shfl_xor(ss3, 4);
        if (kc == 0) { rowss[lr] = ss0; rowss[lr + 32] = ss1; rowss[lr + 64] = ss2; rowss[lr + 96] = ss3; }
    }
    __syncthreads();
    epi((const float*)smem, (const float*)(smem + ROWSS_OFF));
    __syncthreads();
}


DI int g_row(int i) { return ((i * 8 + (int)(threadIdx.x >> 6)) * 8) + (int)((threadIdx.x & 63) >> 3); }
DI int b_perm(int row) { return ((row >> 5) & 1) * 128 + (row >> 6) * 32 + (row & 31); }
DI int g_chunk(int row) { return (int)(threadIdx.x & 7) ^ ((row >> 1) & 7); }
#define GLDS(g_, l_) __builtin_amdgcn_global_load_lds((const unsigned*)(g_), (unsigned*)(l_), 16, 0, 0)
template <class Epi>
DI void gemm256(const char* wsb, const bf16_t* a0p, const bf16_t* a1p, const bf16_t* a2p, const bf16_t* a3p,
                const bf16_t* b0p, const bf16_t* b1p, const bf16_t* b2p, const bf16_t* b3p, int K, char* smem_all, Epi epi) {
    const unsigned a0 = (unsigned)((const char*)a0p - wsb), a1 = (unsigned)((const char*)a1p - wsb), a2 = (unsigned)((const char*)a2p - wsb), a3 = (unsigned)((const char*)a3p - wsb);
    const unsigned b0 = (unsigned)((const char*)b0p - wsb), b1 = (unsigned)((const char*)b1p - wsb), b2 = (unsigned)((const char*)b2p - wsb), b3 = (unsigned)((const char*)b3p - wsb);
    const int lane = threadIdx.x & 63, wid = __builtin_amdgcn_readfirstlane(threadIdx.x >> 6), wr = wid >> 2, wc = wid & 3, fr = lane & 15, fq = lane >> 4;
    f32x4 acc[8][4];
#pragma unroll
    for (int m = 0; m < 8; ++m)
#pragma unroll
        for (int n = 0; n < 4; ++n) acc[m][n] = (f32x4){0.f, 0.f, 0.f, 0.f};
#define STAGE256(buf, k0) { char* sa_ = smem_all + (buf) * 65536 + wid * 1024; char* sb_ = sa_ + 32768; const char* wk_ = wsb + (size_t)(k0) * 2; \
        GLDS(wk_ + a0, sa_); GLDS(wk_ + a1, sa_ + 8192); GLDS(wk_ + a2, sa_ + 16384); GLDS(wk_ + a3, sa_ + 24576); \
        GLDS(wk_ + b0, sb_); GLDS(wk_ + b1, sb_ + 8192); GLDS(wk_ + b2, sb_ + 16384); GLDS(wk_ + b3, sb_ + 24576); }
    const int sw = (fr >> 1) & 7;
    const unsigned offA = (wr * 128 + fr) * 128, offB = 32768 + (wc * 64 + fr) * 128;
    const unsigned co0 = ((0 + fq) ^ sw) << 4, co1 = ((4 + fq) ^ sw) << 4;
    const unsigned lds0 = (unsigned)(size_t)smem_all;
    const int nt = K >> 6;
    STAGE256(0, 0)
    asm volatile("s_waitcnt vmcnt(0)" ::: "memory");
    __syncthreads();
#pragma unroll 1
    for (int t = 0; t < nt; ++t) {
        const int cur = t & 1;
        if (t + 1 < nt) STAGE256(cur ^ 1, (t + 1) * 64)
        const unsigned lb = lds0 + cur * 65536;
        const unsigned aA0 = lb + offA + co0, aA1 = lb + offA + co1, aB0 = lb + offB + co0, aB1 = lb + offB + co1;
        bf16x8 Bq0[4], Bq1[4], Aq0[2], Aq1[2];
#define DSR(dst, addr, off) asm volatile("ds_read_b128 %0, %1 offset:%2" : "=v"(dst) : "v"(addr), "n"(off) : "memory")
#define LDA2(dst, addr, mo) { DSR(dst[0], addr, (mo) * 2048); DSR(dst[1], addr, ((mo) + 1) * 2048); }
#define LDB4(dst, addr) { DSR(dst[0], addr, 0); DSR(dst[1], addr, 2048); DSR(dst[2], addr, 4096); DSR(dst[3], addr, 6144); }
#define WAIT_A(n, X) asm volatile("s_waitcnt lgkmcnt(" #n ")" : "+v"(X[0]), "+v"(X[1]) :: "memory")
#define WAIT_AB(n, X, Y) asm volatile("s_waitcnt lgkmcnt(" #n ")" : "+v"(X[0]), "+v"(X[1]), "+v"(Y[0]), "+v"(Y[1]), "+v"(Y[2]), "+v"(Y[3]) :: "memory")
#define MM8(Aq, Bq, mo) { _Pragma("unroll") for (int m = 0; m < 2; ++m) _Pragma("unroll") for (int n = 0; n < 4; ++n) acc[(mo) + m][n] = MFMA16(Bq[n], Aq[m], acc[(mo) + m][n]); }
        LDB4(Bq0, aB0) LDA2(Aq0, aA0, 0) LDA2(Aq1, aA0, 2)
        WAIT_AB(2, Aq0, Bq0);
        MM8(Aq0, Bq0, 0)
        LDA2(Aq0, aA0, 4)
        WAIT_A(2, Aq1);
        MM8(Aq1, Bq0, 2)
        LDA2(Aq1, aA0, 6) LDB4(Bq1, aB1)
        WAIT_A(6, Aq0);
        MM8(Aq0, Bq0, 4)
        LDA2(Aq0, aA1, 0)
        WAIT_A(6, Aq1);
        MM8(Aq1, Bq0, 6)
        LDA2(Aq1, aA1, 2)
        WAIT_AB(2, Aq0, Bq1);
        MM8(Aq0, Bq1, 0)
        LDA2(Aq0, aA1, 4)
        WAIT_A(2, Aq1);
        MM8(Aq1, Bq1, 2)
        LDA2(Aq1, aA1, 6)
        WAIT_A(2, Aq0);
        MM8(Aq0, Bq1, 4)
        WAIT_A(0, Aq1);
        MM8(Aq1, Bq1, 6)
#undef DSR
#undef LDA2
#undef LDB4
#undef WAIT_A
#undef WAIT_AB
#undef MM8
        asm volatile("s_waitcnt vmcnt(0)" ::: "memory");
        __syncthreads();
    }
#undef STAGE256
    int t_ = threadIdx.x;
    asm volatile("" : "+v"(t_));
    const int lane_ = t_ & 63, wid_ = t_ >> 6, wr_ = wid_ >> 2, wc_ = wid_ & 3, fr_ = lane_ & 15, fq_ = lane_ >> 4, hb_ = t_ >> 8;
#pragma unroll
    for (int p = 0; p < 2; ++p) {
        {
            float* Cs = (float*)(smem_all + wr_ * HB_SMEM) + fr_ * CP + wc_ * 32 + 4 * fq_;
#pragma unroll
            for (int m = 0; m < 8; ++m)
#pragma unroll
                for (int n = 0; n < 2; ++n) *(f32x4*)(Cs + (m * 16) * CP + n * 16) = acc[m][2 * p + n];
        }
        __syncthreads();
        epi((const float*)(smem_all + hb_ * HB_SMEM), hb_, p, t_ & 255);
        __syncthreads();
    }
}

DI void epi_store_bf16(const float* Cs, bf16_t* dst, int ld, int tid) {
#pragma unroll 2
    for (int j = 0; j < 8; ++j) {
        int c = tid + 256 * j, row = c >> 4, cc = c & 15;
        const float4* cp = (const float4*)(Cs + row * CP + cc * 8);
        float4 f0 = cp[0], f1 = cp[1];
        float v[8] = {f0.x, f0.y, f0.z, f0.w, f1.x, f1.y, f1.z, f1.w};
        *(uint4*)(dst + (size_t)row * ld + cc * 8) = pack8(v);
    }
}
DI void epi_resid(const float* Cs, const float* src, float* dst, const float* gate, int tid) {
#pragma unroll 4
    for (int j = 0; j < 16; ++j) {
        int c = tid + 256 * j, row = c >> 5, c4 = c & 31;
        float4 cv = *(const float4*)(Cs + row * CP + c4 * 4);
        float4 sv = *(const float4*)(src + (size_t)row * 1024 + c4 * 4);
        float4 gv = *(const float4*)(gate + c4 * 4);
        float4 o; o.x = sv.x + gv.x * cv.x; o.y = sv.y + gv.y * cv.y; o.z = sv.z + gv.z * cv.z; o.w = sv.w + gv.w * cv.w;
        *(float4*)(dst + (size_t)row * 1024 + c4 * 4) = o;
    }
}

DI int wsrc_col(int mode, int tn, int c) {
    if (mode == 0) return tn * 128 + c;
    if (mode == 1) {
        const int np = tn * 128;
        if (np < 512) return 672 + np + c;
        if (np < 640) return 1184 + np - 512 + c;
        if (np < 768) return 1312 + np - 640 + c;
        if (np < 1152) return np - 768 + c;
        if (np < 1408) return 384 + np - 1152 + c;
        return c < 32 ? 640 + c : -1;
    }
    if (mode == 2) return c < 96 ? tn * 96 + c : -1;
    return c < 64 ? 64 * tn + c : 2816 + 64 * tn + c - 64;
}
DI void wtile(const float* __restrict__ src, int Nsrc, const float* __restrict__ g, bf16_t* __restrict__ dst, int K, int k0, int tn, int mode, char* smem) {
    bf16_t* T = (bf16_t*)smem;
    const int tid = TID, lane = tid & 63, w = tid >> 6, rsub = lane >> 5, c4 = (lane & 31) * 4;
    int sc = wsrc_col(mode, tn, c4);
    if (sc >= Nsrc) sc = -1;
#pragma unroll 8
    for (int i = 0; i < 16; ++i) {
        const int rr = w * 32 + 2 * i + rsub;
        float4 v = make_float4(0.f, 0.f, 0.f, 0.f);
        if (sc >= 0) { v = *(const float4*)(src + (size_t)(k0 + rr) * Nsrc + sc); if (g) { const float gg = g[k0 + rr]; v.x *= gg; v.y *= gg; v.z *= gg; v.w *= gg; } }
        T[(c4 + 0) * 130 + rr] = f2bf(v.x);
        T[(c4 + 1) * 130 + rr] = f2bf(v.y);
        T[(c4 + 2) * 130 + rr] = f2bf(v.z);
        T[(c4 + 3) * 130 + rr] = f2bf(v.w);
    }
    __syncthreads();
#pragma unroll
    for (int j = 0; j < 8; ++j) {
        const int c = tid + 256 * j, n = c >> 4, kc = c & 15;
        const unsigned* s32 = (const unsigned*)(T + n * 130 + kc * 8);
        uint4 o; o.x = s32[0]; o.y = s32[1]; o.z = s32[2]; o.w = s32[3];
        *(uint4*)(dst + (size_t)(tn * 128 + n) * K + k0 + kc * 8) = o;
    }
    __syncthreads();
}

DI void mod_item(const Params& p, int item, char* smem) {
    const int tid = TID, lane = tid & 63, w = tid >> 6, hl = lane >> 5, cl = lane & 31;
    const int l = item / 192, n0 = (item % 192) * 32;
    float* sl = (float*)smem;
    for (int i = tid; i < 9216; i += 256) {
        int rr = i >> 10, k = i & 1023;
        float cv = rr < 8 ? p.c[rr * 1024 + k] : p.c_ctx[k];
        sl[i] = cv / (1.f + expf(-cv));
    }
    __syncthreads();
    float acc[9];
#pragma unroll
    for (int q = 0; q < 9; ++q) acc[q] = 0.f;
    const float* wp = p.ada_w + (size_t)l * 1024 * 6144 + n0 + cl;
#pragma unroll 16
    for (int kk = 0; kk < 128; ++kk) {
        const int k = w * 256 + 2 * kk + hl;
        float wv = wp[(size_t)k * 6144];
#pragma unroll
        for (int q = 0; q < 9; ++q) acc[q] += sl[q * 1024 + k] * wv;
    }
    float* red = (float*)(smem + 36864);
#pragma unroll
    for (int q = 0; q < 9; ++q) red[((w * 2 + hl) * 9 + q) * 32 + cl] = acc[q];
    __syncthreads();
    float* MOD = (float*)(p.ws + OFF_MOD);
    for (int i = tid; i < 288; i += 256) {
        int q = i >> 5, ln = i & 31;
        float sacc = 0.f;
#pragma unroll
        for (int u = 0; u < 8; ++u) sacc += red[(u * 9 + q) * 32 + ln];
        sacc += p.ada_b[l * 6144 + n0 + ln];
        MOD[(size_t)(l * 9 + q) * 6144 + n0 + ln] = sacc;
    }
    __syncthreads();
}

DI void sincos_d(double x, float& s, float& c) {
    const double TWO_PI = 6.283185307179586476925;
    double t = x / TWO_PI;
    t -= rint(t);
    double y = t * TWO_PI, y2 = y * y;
    double sv = y, cv = 1.0, ts = y, tc = 1.0;
#pragma unroll 1
    for (int k = 1; k <= 14; ++k) {
        tc *= -y2 / (double)((2 * k - 1) * (2 * k));
        ts *= -y2 / (double)((2 * k) * (2 * k + 1));
        cv += tc; sv += ts;
    }
    s = (float)sv; c = (float)cv;
}

DI void rope_tables(const Params& p) {
    float* TG = (float*)(p.ws + OFF_TABG);
    float* TM = (float*)(p.ws + OFF_TABM);
    for (int i = TID; i < 1024; i += 256) {
        int v = i >> 4, f = i & 15;
        float inv = exp2f(-(float)f / 16.f * 13.287712379549449f);
        float ang = (float)v * inv, s, c;
        sincos_d((double)ang, s, c);
        TG[i] = c; TG[1024 + i] = s;
    }
    for (int i = TID; i < 512; i += 256) {
        int v = i >> 3, f = i & 7;
        float inv = exp2f(-(float)f / 8.f * 13.287712379549449f);
        float ang = (float)v * inv, s, c;
        sincos_d((double)ang, s, c);
        TM[i] = c; TM[512 + i] = s;
    }
}

constexpr int NW = 10;
constexpr int N_WT = 8 * 12 + 3 * 8 + 2 * 8 + 8 * 8 + 8 * 44 + 22 * 8 + 8 * 44 + 22 * 8 + 8 * 26 + 8 * 8;
constexpr int N_MOD = 384;
constexpr int N_P0 = N_MOD + N_WT;
static_assert(N_P0 % 2 == 0 && N_MOD % 2 == 0, "phase 0 items are dealt to half-block pairs");

DI void phase0(const Params& p, char* smem_all) {
    char* smem = smem_all + HBI * HB_SMEM;
    if (blockIdx.x == gridDim.x - 1) {
        if (HBI == 0) rope_tables(p);
        else { for (int i = TID; i < 512; i += 256) ((uint4*)(p.ws + OFF_ZROW))[i] = make_uint4(0, 0, 0, 0); }
    }
    for (int it0 = blockIdx.x * 2; it0 < N_P0; it0 += gridDim.x * 2) {
        const int item = it0 + HBI;
        if (item < N_MOD) { mod_item(p, item, smem); continue; }
        int t = item - N_MOD;
        int wi = 0;
        int cnt[NW] = {8 * 12, 3 * 8, 2 * 8, 8 * 8, 8 * 44, 22 * 8, 8 * 44, 22 * 8, 8 * 26, 8 * 8};
#pragma unroll
        for (int i = 0; i < NW - 1; ++i) { if (wi == i && t >= cnt[i]) { t -= cnt[i]; wi = i + 1; } }
        const float* src; const float* g = nullptr; bf16_t* dst; int K, Nsrc, ntn, mode;
        switch (wi) {
            case 0: src = p.att_w_in; dst = (bf16_t*)(p.ws + OFF_WT_IN0); K = 1024; Nsrc = 1440; ntn = 12; mode = 1; break;
            case 1: src = p.mla_w_qb; g = p.mla_qa_g; dst = (bf16_t*)(p.ws + OFF_WT_QB); K = 384; Nsrc = 768; ntn = 8; mode = 2; break;
            case 2: src = p.mla_w_kvb; g = p.mla_kva_g; dst = (bf16_t*)(p.ws + OFF_WT_KVB); K = 256; Nsrc = 1024; ntn = 8; mode = 0; break;
            case 3: src = p.att_w_out; dst = (bf16_t*)(p.ws + OFF_WT_OUT0); K = 1024; Nsrc = 1024; ntn = 8; mode = 0; break;
            case 4: src = p.ffn_w_up; dst = (bf16_t*)(p.ws + OFF_WT_UP0); K = 1024; Nsrc = 5632; ntn = 44; mode = 3; break;
            case 5: src = p.ffn_w_down; dst = (bf16_t*)(p.ws + OFF_WT_DOWN0); K = 2816; Nsrc = 1024; ntn = 8; mode = 0; break;
            case 6: src = p.ffn_w_up + 1024ull * 5632; dst = (bf16_t*)(p.ws + OFF_WT_UP1); K = 1024; Nsrc = 5632; ntn = 44; mode = 3; break;
            case 7: src = p.ffn_w_down + 2816ull * 1024; dst = (bf16_t*)(p.ws + OFF_WT_DOWN1); K = 2816; Nsrc = 1024; ntn = 8; mode = 0; break;
            case 8: src = p.ml_w_in; dst = (bf16_t*)(p.ws + OFF_WT_IN1); K = 1024; Nsrc = 3104; ntn = 26; mode = 0; break;
            default: src = p.ml_w_out; dst = (bf16_t*)(p.ws + OFF_WT_OUT1); K = 1024; Nsrc = 1024; ntn = 8; mode = 0; break;
        }
        const int tn = t % ntn, tk = t / ntn;
        wtile(src, Nsrc, g, dst, K, tk * 128, tn, mode, smem);
    }
}

DI void norm_row_ptrs(int row, const float* srcLat, const float* srcCtx, const float* mod, int shift_idx, const float*& src, const float*& sh) {
    int mb;
    if (row < 16384) { src = srcLat + (size_t)row * 1024; mb = row >> 11; }
    else { src = srcCtx + (size_t)(row - 16384) * 1024; mb = 8; }
    sh = mod + (size_t)mb * 6144 + shift_idx * 1024;
}
DI void norm_row_finish(const float4 (&v)[4], float ss, const float* g, const float* sh, bf16_t* dst, int lane) {
#pragma unroll
    for (int o = 32; o >= 1; o >>= 1) ss += __shfl_xor(ss, o);
    const float rstd = rsqrtf(ss * (1.f / 1024.f) + EPSF);
    const float* sc = sh + 1024;
#pragma unroll
    for (int j = 0; j < 4; ++j) {
        const int c = j * 256 + lane * 4;
        const float4 gv = *(const float4*)(g + c), shv = *(const float4*)(sh + c), scv = *(const float4*)(sc + c);
        const float o0 = v[j].x * rstd * gv.x * (1.f + scv.x) + shv.x;
        const float o1 = v[j].y * rstd * gv.y * (1.f + scv.y) + shv.y;
        const float o2 = v[j].z * rstd * gv.z * (1.f + scv.z) + shv.z;
        const float o3 = v[j].w * rstd * gv.w * (1.f + scv.w) + shv.w;
        uint2 o; o.x = pack2(o0, o1); o.y = pack2(o2, o3);
        *(uint2*)(dst + c) = o;
    }
}
DI void phase_norm(const Params& p, const float* srcLat, const float* srcCtx, const float* g, const float* mod, int shift_idx, int nrows) {
    const int lane = threadIdx.x & 63, w = threadIdx.x >> 6;
    bf16_t* H = (bf16_t*)(p.ws + OFF_H);
    for (int row = (blockIdx.x * 8 + w) * 2; row < nrows; row += gridDim.x * 16) {
        const float *srcA, *shA, *srcB, *shB;
        norm_row_ptrs(row, srcLat, srcCtx, mod, shift_idx, srcA, shA);
        norm_row_ptrs(row + 1, srcLat, srcCtx, mod, shift_idx, srcB, shB);
        float4 va[4], vb[4];
        float sa = 0.f, sb = 0.f;
#pragma unroll
        for (int j = 0; j < 4; ++j) { va[j] = *(const float4*)(srcA + j * 256 + lane * 4); vb[j] = *(const float4*)(srcB + j * 256 + lane * 4); }
#pragma unroll
        for (int j = 0; j < 4; ++j) { sa += va[j].x * va[j].x + va[j].y * va[j].y + va[j].z * va[j].z + va[j].w * va[j].w; sb += vb[j].x * vb[j].x + vb[j].y * vb[j].y + vb[j].z * vb[j].z + vb[j].w * vb[j].w; }
        norm_row_finish(va, sa, g, shA, H + (size_t)row * 1024, lane);
        norm_row_finish(vb, sb, g, shB, H + (size_t)(row + 1) * 1024, lane);
    }
}

template <int Q>
DI void rope_apply(float* v, const float* tab, int rw, int cl) {
#pragma unroll
    for (int f = 0; f < Q; ++f) {
        float cr = tab[rw * Q + f], sr = tab[64 * Q + rw * Q + f], cc = tab[cl * Q + f], sc = tab[64 * Q + cl * Q + f];
        float a1 = v[f], a2 = v[Q + f], b1 = v[2 * Q + f], b2 = v[3 * Q + f];
        v[f] = a1 * cr - a2 * sr; v[Q + f] = a2 * cr + a1 * sr;
        v[2 * Q + f] = b1 * cc - b2 * sc; v[3 * Q + f] = b2 * cc + b1 * sc;
    }
}

DI void phase_inproj0(const Params& p, char* smem_all) {
    const bf16_t* H = (const bf16_t*)(p.ws + OFF_H);
    const bf16_t* W = (const bf16_t*)(p.ws + OFF_WT_IN0);
    const float* TG = (const float*)(p.ws + OFF_TABG);
    for (int id = blockIdx.x; id < 72 * 6; id += gridDim.x) {
        const int nt2 = id / 72, mt2 = id % 72;
        auto epi = [&](const float* Cs, int si, int sj, int tid) {
            const int nt = 2 * nt2 + sj, m0 = (2 * mt2 + si) * 128;
            int b, t0; bool lat; row_info(m0, b, t0, lat);
            const int s0 = lat ? 256 + t0 : t0;
            if (nt < 5) {
                const int row = tid & 127, half = tid >> 7;
                const float4* cp = (const float4*)(Cs + row * CP + half * 64);
                float ss = 0.f;
#pragma unroll
                for (int i = 0; i < 16; ++i) { float4 f = cp[i]; ss += f.x * f.x + f.y * f.y + f.z * f.z + f.w * f.w; }
                const float rstd = rsqrtf(ss * (1.f / 64.f) + EPSF);
                const float* g = nt < 4 ? p.gqa_q_g : p.gqa_k_g;
                const float osc = nt < 4 ? 0.125f * LOG2E : 1.f;
                bf16_t* dst;
                if (nt < 4) dst = (bf16_t*)(p.ws + OFF_QG) + ((size_t)(b * 2304 + s0 + row) * 8 + nt * 2 + half) * 64;
                else dst = (bf16_t*)(p.ws + OFF_KG) + ((size_t)(b * 2304 + s0 + row) * 2 + half) * 64;
                const int t = t0 + row;
#pragma unroll 1
                for (int hh = 0; hh < 2; ++hh) {
                    float v[32];
#pragma unroll
                    for (int i = 0; i < 8; ++i) { float4 f = cp[hh * 8 + i]; const float4 gv = *(const float4*)(g + hh * 32 + 4 * i);
                        v[4 * i] = f.x * rstd * gv.x; v[4 * i + 1] = f.y * rstd * gv.y; v[4 * i + 2] = f.z * rstd * gv.z; v[4 * i + 3] = f.w * rstd * gv.w; }
                    if (lat) {
                        const int pos = hh ? (t & 63) : (t >> 6);
#pragma unroll
                        for (int f = 0; f < 16; ++f) {
                            const float c_ = TG[pos * 16 + f], s_ = TG[1024 + pos * 16 + f];
                            const float x1 = v[f], x2 = v[16 + f];
                            v[f] = x1 * c_ - x2 * s_; v[16 + f] = x2 * c_ + x1 * s_;
                        }
                    }
#pragma unroll
                    for (int i = 0; i < 32; ++i) v[i] *= osc;
#pragma unroll
                    for (int i = 0; i < 4; ++i) *(uint4*)(dst + hh * 32 + i * 8) = pack8(v + i * 8);
                }
            } else if (nt == 5) {
                const int dall = tid & 127, ch0 = (tid >> 7) * 8;
                bf16_t* dst = (bf16_t*)(p.ws + OFF_VGT) + ((size_t)(b * 2 + (dall >> 6)) * 64 + (dall & 63)) * 2304 + s0;
#pragma unroll 2
                for (int ch = 0; ch < 8; ++ch) {
                    float v[8];
#pragma unroll
                    for (int i = 0; i < 8; ++i) v[i] = Cs[((ch0 + ch) * 8 + i) * CP + dall];
                    *(uint4*)(dst + (ch0 + ch) * 8) = pack8(v);
                }
            } else if (nt < 9) {
                epi_store_bf16(Cs, (bf16_t*)(p.ws + OFF_CQ) + (size_t)m0 * 384 + (nt - 6) * 128, 384, tid);
            } else if (nt < 11) {
                epi_store_bf16(Cs, (bf16_t*)(p.ws + OFF_CKV) + (size_t)m0 * 256 + (nt - 9) * 128, 256, tid);
            } else {
                const int row = tid >> 1, half = tid & 1;
                float* dst = (float*)(p.ws + OFF_KR) + (size_t)(m0 + row) * 32 + half * 16;
                const float4* cp = (const float4*)(Cs + row * CP + half * 16);
#pragma unroll
                for (int i = 0; i < 4; ++i) ((float4*)dst)[i] = cp[i];
            }
        };
        const int r0 = g_row(0), r1 = g_row(1), r2 = g_row(2), r3 = g_row(3);
        const bf16_t* Ab = H + (size_t)mt2 * 256 * 1024;
        const bf16_t* Bb = W + (size_t)nt2 * 256 * 1024;
        gemm256(p.ws, Ab + (size_t)r0 * 1024 + g_chunk(r0) * 8, Ab + (size_t)r1 * 1024 + g_chunk(r1) * 8, Ab + (size_t)r2 * 1024 + g_chunk(r2) * 8, Ab + (size_t)r3 * 1024 + g_chunk(r3) * 8,
                Bb + (size_t)b_perm(r0) * 1024 + g_chunk(r0) * 8, Bb + (size_t)b_perm(r1) * 1024 + g_chunk(r1) * 8, Bb + (size_t)b_perm(r2) * 1024 + g_chunk(r2) * 8, Bb + (size_t)b_perm(r3) * 1024 + g_chunk(r3) * 8,
                1024, smem_all, epi);
    }
}

DI void phase_mla_up(const Params& p, char* smem_all) {
    char* smem = smem_all + HBI * HB_SMEM;
    const float* TM = (const float*)(p.ws + OFF_TABM);
    for (int id0 = blockIdx.x * 2; id0 < 144 * 16; id0 += gridDim.x * 2) {
        const int id = id0 + HBI;
        const int nt = (id / 144) & 7, isKV = (id / 144) >> 3, mt = id % 144, m0 = mt * 128;
        int b, t0; bool lat; row_info(m0, b, t0, lat);
        const int s0 = lat ? 256 + t0 : t0;
        if (!isKV) {
            const bf16_t* A = (const bf16_t*)(p.ws + OFF_CQ);
#undef AROW
#define AROW(o_) (A + (size_t)(m0 + (TID >> 3) + (o_)) * 384)
            auto epi = [&](const float* Cs, const float* rowss) {
                const int tid = TID, row = tid >> 1, part = tid & 1;
                const float r1 = rsqrtf(rowss[row] * (1.f / 384.f) + EPSF);
                float v[48];
                const float4* cp = (const float4*)(Cs + row * CP + part * 48);
                float ss = 0.f;
#pragma unroll
                for (int i = 0; i < 12; ++i) { float4 f = cp[i]; v[4 * i] = f.x * r1; v[4 * i + 1] = f.y * r1; v[4 * i + 2] = f.z * r1; v[4 * i + 3] = f.w * r1; }
#pragma unroll
                for (int i = 0; i < 48; ++i) ss += v[i] * v[i];
                ss += __shfl_xor(ss, 1);
                const float r2 = rsqrtf(ss * (1.f / 96.f) + EPSF);
                const float* g = p.mla_q_g + part * 48;
#pragma unroll
                for (int i = 0; i < 48; ++i) v[i] = v[i] * r2 * g[i];
                if (lat && part == 1) { int t = t0 + row; rope_apply<8>(v + 16, TM, t >> 6, t & 63); }
                const float sc = 0.10206207261596575f * LOG2E;
#pragma unroll
                for (int i = 0; i < 48; ++i) v[i] *= sc;
                bf16_t* dst = (bf16_t*)(p.ws + OFF_QM) + ((size_t)(b * 2304 + s0 + row) * 8 + nt) * 96 + part * 48;
#pragma unroll
                for (int i = 0; i < 6; ++i) *(uint4*)(dst + i * 8) = pack8(v + i * 8);
            };
            gemm_tile<true, false>(AROW(0), AROW(32), AROW(64), AROW(96), 0u, 0u, 0u, 0u, (const bf16_t*)(p.ws + OFF_WT_QB) + (size_t)nt * 128 * 384, 384, 384, smem, epi);
        } else {
            const bf16_t* A = (const bf16_t*)(p.ws + OFF_CKV);
#undef AROW
#define AROW(o_) (A + (size_t)(m0 + (TID >> 3) + (o_)) * 256)
            auto epi = [&](const float* Cs, const float* rowss) {
                const int tid = TID;
                {
                    const int row = tid >> 1, part = tid & 1;
                    const float r1 = rsqrtf(rowss[row] * (1.f / 256.f) + EPSF);
                    float v[48];
                    if (part == 0) {
                        const float4* cp = (const float4*)(Cs + row * CP);
#pragma unroll
                        for (int i = 0; i < 12; ++i) { float4 f = cp[i]; v[4 * i] = f.x * r1; v[4 * i + 1] = f.y * r1; v[4 * i + 2] = f.z * r1; v[4 * i + 3] = f.w * r1; }
                    } else {
                        const float4* cp = (const float4*)(Cs + row * CP + 48);
#pragma unroll
                        for (int i = 0; i < 4; ++i) { float4 f = cp[i]; v[4 * i] = f.x * r1; v[4 * i + 1] = f.y * r1; v[4 * i + 2] = f.z * r1; v[4 * i + 3] = f.w * r1; }
                        const float4* kp = (const float4*)((const float*)(p.ws + OFF_KR) + (size_t)(m0 + row) * 32);
#pragma unroll
                        for (int i = 0; i < 8; ++i) { float4 f = kp[i]; v[16 + 4 * i] = f.x; v[16 + 4 * i + 1] = f.y; v[16 + 4 * i + 2] = f.z; v[16 + 4 * i + 3] = f.w; }
                    }
                    float ss = 0.f;
#pragma unroll
                    for (int i = 0; i < 48; ++i) ss += v[i] * v[i];
                    ss += __shfl_xor(ss, 1);
                    const float r2 = rsqrtf(ss * (1.f / 96.f) + EPSF);
                    const float* g = p.mla_k_g + part * 48;
#pragma unroll
                    for (int i = 0; i < 48; ++i) v[i] = v[i] * r2 * g[i];
                    if (lat && part == 1) { int t = t0 + row; rope_apply<8>(v + 16, TM, t >> 6, t & 63); }
                    bf16_t* dst = (bf16_t*)(p.ws + OFF_KM) + ((size_t)(b * 2304 + s0 + row) * 8 + nt) * 96 + part * 48;
#pragma unroll
                    for (int i = 0; i < 6; ++i) *(uint4*)(dst + i * 8) = pack8(v + i * 8);
                }
                {
                    const int d = tid & 63, cg4 = (tid >> 6) * 4;
                    bf16_t* dst = (bf16_t*)(p.ws + OFF_VMT) + ((size_t)(b * 8 + nt) * 64 + d) * 2304 + s0;
#pragma unroll 1
                    for (int ch = 0; ch < 4; ++ch) {
                        float v[8];
#pragma unroll
                        for (int i = 0; i < 8; ++i) { int rr = (cg4 + ch) * 8 + i; v[i] = Cs[rr * CP + 64 + d] * rsqrtf(rowss[rr] * (1.f / 256.f) + EPSF); }
                        *(uint4*)(dst + (cg4 + ch) * 8) = pack8(v);
                    }
                }
            };
            gemm_tile<true, false>(AROW(0), AROW(32), AROW(64), AROW(96), 0u, 0u, 0u, 0u, (const bf16_t*)(p.ws + OFF_WT_KVB) + (size_t)nt * 128 * 256, 256, 256, smem, epi);
        }
    }
}

template <int DK>
DI void attn_body(const bf16_t* __restrict__ Q, int qstride, const bf16_t* __restrict__ Kp, int kstride, const bf16_t* __restrict__ VT,
                  int nkeys, bf16_t* __restrict__ Odst, char* smem, char* smem_os) {
    constexpr int KP = DK + 8, VP = 72, NST = DK / 16, KCH = DK / 8;
    constexpr int NKL = (64 * KCH) / 256;
    constexpr int STAGE = 64 * KP * 2 + 64 * VP * 2;
    const int tid = TID, lane = tid & 63, w = tid >> 6, h = lane >> 5, r = lane & 31;
    bf16x8 qf[NST];
    {
        const bf16_t* qrow = Q + (size_t)(w * 32 + r) * qstride;
#pragma unroll
        for (int st = 0; st < NST; ++st) qf[st] = *(const bf16x8*)(qrow + st * 16 + h * 8);
    }
    f32x16 o[2]; o[0] = zero16(); o[1] = zero16();
    float m = 0.f, l = 0.f;
    uint4 ak0, ak1 = make_uint4(0, 0, 0, 0), av0, bk0, bk1 = make_uint4(0, 0, 0, 0), bv0;
    const int t5 = threadIdx.x;
    const int kr0 = t5 / KCH, kc0 = t5 % KCH, kr1 = (t5 + 512) / KCH, kc1 = (t5 + 512) % KCH;
    const bool k2 = t5 + 512 < 64 * KCH;
    const int vd0 = t5 >> 3, vc0 = t5 & 7;
#define AGLOAD(P_, key0) { P_##k0 = *(const uint4*)(Kp + (size_t)((key0) + kr0) * kstride + kc0 * 8); if (k2) P_##k1 = *(const uint4*)(Kp + (size_t)((key0) + kr1) * kstride + kc1 * 8); \
                       P_##v0 = *(const uint4*)(VT + (size_t)vd0 * 2304 + (key0) + vc0 * 8); }
#define ASWRITE(P_, s_) { bf16_t* Ks_ = (bf16_t*)(smem + (s_) * STAGE); bf16_t* Vs_ = Ks_ + 64 * KP; \
                      *(uint4*)(Ks_ + kr0 * KP + kc0 * 8) = P_##k0; if (k2) *(uint4*)(Ks_ + kr1 * KP + kc1 * 8) = P_##k1; \
                      *(uint4*)(Vs_ + vd0 * VP + vc0 * 8) = P_##v0; }
    const int nkt = nkeys >> 6;
    AGLOAD(a, 0) ASWRITE(a, 0) AGLOAD(a, 64) AGLOAD(b, 128) __syncthreads();
#pragma unroll 1
    for (int kt = 0; kt < nkt; kt += 2) {
        {
            const bf16_t* Ks = (const bf16_t*)(smem);
            const bf16_t* Vs = Ks + 64 * KP;
            f32x16 s[2];
#pragma unroll
            for (int i = 0; i < 16; ++i) { s[0][i] = -m; s[1][i] = -m; }
#pragma unroll
            for (int st = 0; st < NST; ++st)
#pragma unroll
                for (int kk = 0; kk < 2; ++kk) {
                    bf16x8 a = *(const bf16x8*)(Ks + (kk * 32 + r) * KP + st * 16 + h * 8);
                    s[kk] = MFMA(a, qf[st], s[kk]);
                }
            float mx = s[0][0];
#pragma unroll
            for (int i = 0; i < 16; ++i) { mx = fmaxf(mx, s[0][i]); mx = fmaxf(mx, s[1][i]); }
            mx = fmaxf(mx, __shfl_xor(mx, 32));
            if (__any(mx > 8.f)) {
                const float d = fmaxf(mx, 0.f);
                const float alpha = __builtin_amdgcn_exp2f(-d);
                l *= alpha;
#pragma unroll
                for (int i = 0; i < 16; ++i) { o[0][i] *= alpha; o[1][i] *= alpha; s[0][i] -= d; s[1][i] -= d; }
                m += d;
            }
            float ps = 0.f;
#pragma unroll
            for (int kk = 0; kk < 2; ++kk)
#pragma unroll
                for (int i = 0; i < 16; ++i) { float pv = __builtin_amdgcn_exp2f(s[kk][i]); s[kk][i] = pv; ps += pv; }
            l += ps;
#pragma unroll
            for (int kk = 0; kk < 2; ++kk)
#pragma unroll
                for (int s2 = 0; s2 < 2; ++s2) {
                    const bf16x8 pb = pack_frag(s[kk][8 * s2 + 0], s[kk][8 * s2 + 1], s[kk][8 * s2 + 2], s[kk][8 * s2 + 3], s[kk][8 * s2 + 4], s[kk][8 * s2 + 5], s[kk][8 * s2 + 6], s[kk][8 * s2 + 7]);
#pragma unroll
                    for (int dt = 0; dt < 2; ++dt) {
                        const bf16_t* vp = Vs + (dt * 32 + r) * VP + kk * 32 + 16 * s2 + 4 * h;
                        uint2 lo = *(const uint2*)vp, hi = *(const uint2*)(vp + 8);
                        uint4 vu; vu.x = lo.x; vu.y = lo.y; vu.z = hi.x; vu.w = hi.y;
                        o[dt] = MFMA(__builtin_bit_cast(bf16x8, vu), pb, o[dt]);
                    }
                }
        }
        ASWRITE(a, 1)
        if (kt + 3 < nkt) AGLOAD(a, (kt + 3) * 64)
        LDS_BARRIER();
        {
            const bf16_t* Ks = (const bf16_t*)(smem + STAGE);
            const bf16_t* Vs = Ks + 64 * KP;
            f32x16 s[2];
#pragma unroll
            for (int i = 0; i < 16; ++i) { s[0][i] = -m; s[1][i] = -m; }
#pragma unroll
            for (int st = 0; st < NST; ++st)
#pragma unroll
                for (int kk = 0; kk < 2; ++kk) {
                    bf16x8 a = *(const bf16x8*)(Ks + (kk * 32 + r) * KP + st * 16 + h * 8);
                    s[kk] = MFMA(a, qf[st], s[kk]);
                }
            float mx = s[0][0];
#pragma unroll
            for (int i = 0; i < 16; ++i) { mx = fmaxf(mx, s[0][i]); mx = fmaxf(mx, s[1][i]); }
            mx = fmaxf(mx, __shfl_xor(mx, 32));
            if (__any(mx > 8.f)) {
                const float d = fmaxf(mx, 0.f);
                const float alpha = __builtin_amdgcn_exp2f(-d);
                l *= alpha;
#pragma unroll
                for (int i = 0; i < 16; ++i) { o[0][i] *= alpha; o[1][i] *= alpha; s[0][i] -= d; s[1][i] -= d; }
                m += d;
            }
            float ps = 0.f;
#pragma unroll
            for (int kk = 0; kk < 2; ++kk)
#pragma unroll
                for (int i = 0; i < 16; ++i) { float pv = __builtin_amdgcn_exp2f(s[kk][i]); s[kk][i] = pv; ps += pv; }
            l += ps;
#pragma unroll
            for (int kk = 0; kk < 2; ++kk)
#pragma unroll
                for (int s2 = 0; s2 < 2; ++s2) {
                    const bf16x8 pb = pack_frag(s[kk][8 * s2 + 0], s[kk][8 * s2 + 1], s[kk][8 * s2 + 2], s[kk][8 * s2 + 3], s[kk][8 * s2 + 4], s[kk][8 * s2 + 5], s[kk][8 * s2 + 6], s[kk][8 * s2 + 7]);
#pragma unroll
                    for (int dt = 0; dt < 2; ++dt) {
                        const bf16_t* vp = Vs + (dt * 32 + r) * VP + kk * 32 + 16 * s2 + 4 * h;
                        uint2 lo = *(const uint2*)vp, hi = *(const uint2*)(vp + 8);
                        uint4 vu; vu.x = lo.x; vu.y = lo.y; vu.z = hi.x; vu.w = hi.y;
                        o[dt] = MFMA(__builtin_bit_cast(bf16x8, vu), pb, o[dt]);
                    }
                }
        }
        if (kt + 2 < nkt) ASWRITE(b, 0)
        if (kt + 4 < nkt) AGLOAD(b, (kt + 4) * 64)
        LDS_BARRIER();
    }
#undef AGLOAD
#undef ASWRITE
    l += __shfl_xor(l, 32);
    const float inv = 1.f / l;
    bf16_t* Os = (bf16_t*)smem_os + (size_t)w * 32 * 72;
#pragma unroll
    for (int dt = 0; dt < 2; ++dt)
#pragma unroll
        for (int g = 0; g < 4; ++g) {
            uint2 u; u.x = pack2(o[dt][4 * g] * inv, o[dt][4 * g + 1] * inv); u.y = pack2(o[dt][4 * g + 2] * inv, o[dt][4 * g + 3] * inv);
            *(uint2*)(Os + r * 72 + dt * 32 + 8 * g + 4 * h) = u;
        }
    __syncthreads();
#pragma unroll
    for (int j = 0; j < 4; ++j) {
        int c = lane + 64 * j, row = c >> 3, cc = c & 7;
        uint4 u = *(const uint4*)(Os + row * 72 + cc * 8);
        *(uint4*)(Odst + (size_t)(w * 32 + row) * 1024 + cc * 8) = u;
    }
    __syncthreads();
}

DI void phase_attn(const Params& p, char* smem_all) {
    char* smem = smem_all;
    char* smem_os = smem_all + 65536 + HBI * 20480;
    bf16_t* O = (bf16_t*)(p.ws + OFF_H);
    for (int it0 = blockIdx.x * 2; it0 < 2304; it0 += gridDim.x * 2) {
        const int item = it0 + HBI;
        int b, kind, hq, qb, nkeys, sq0, orow;
        if (item < 2048) { qb = item & 15; hq = (item >> 4) & 7; kind = (item >> 7) & 1; b = item >> 8; sq0 = 256 + qb * 128; nkeys = 2304; orow = b * 2048 + qb * 128; }
        else { int it = item - 2048; qb = it & 1; hq = (it >> 1) & 7; kind = (it >> 4) & 1; b = it >> 5; sq0 = qb * 128; nkeys = 256; orow = 16384 + b * 256 + qb * 128; }
        bf16_t* od = O + (size_t)orow * 1024 + kind * 512 + hq * 64;
        if (kind == 0) {
            const bf16_t* Q = (const bf16_t*)(p.ws + OFF_QM) + ((size_t)(b * 2304 + sq0) * 8 + hq) * 96;
            const bf16_t* K = (const bf16_t*)(p.ws + OFF_KM) + ((size_t)(b * 2304) * 8 + hq) * 96;
            const bf16_t* VT = (const bf16_t*)(p.ws + OFF_VMT) + (size_t)(b * 8 + hq) * 64 * 2304;
            attn_body<96>(Q, 768, K, 768, VT, nkeys, od, smem, smem_os);
        } else {
            const int kvh = hq >> 2;
            const bf16_t* Q = (const bf16_t*)(p.ws + OFF_QG) + ((size_t)(b * 2304 + sq0) * 8 + hq) * 64;
            const bf16_t* K = (const bf16_t*)(p.ws + OFF_KG) + ((size_t)(b * 2304) * 2 + kvh) * 64;
            const bf16_t* VT = (const bf16_t*)(p.ws + OFF_VGT) + (size_t)(b * 2 + kvh) * 64 * 2304;
            attn_body<64>(Q, 512, K, 128, VT, nkeys, od, smem, smem_os);
        }
    }
}

DI void phase_proj_resid(const Params& p, const bf16_t* A, int K, const bf16_t* W, const float* mod, int gate_idx,
                         const float* srcLat, const float* srcCtx, float* dstLat, float* dstCtx, int mtiles2, bool ctx_small, char* smem_all) {
    for (int id = blockIdx.x; id < mtiles2 * 4; id += gridDim.x) {
        const int nt2 = id / mtiles2, mt2 = id % mtiles2;
        auto epi = [&](const float* Cs, int si, int sj, int tid) {
            const int nt = 2 * nt2 + sj, m0 = (2 * mt2 + si) * 128;
            const float* src; float* dst; int mb;
            if (m0 < 16384) { src = srcLat + (size_t)m0 * 1024; dst = dstLat + (size_t)m0 * 1024; mb = m0 >> 11; }
            else { src = srcCtx + (size_t)(m0 - 16384) * 1024; dst = dstCtx + (size_t)(m0 - 16384) * 1024; mb = 8; }
            epi_resid(Cs, src + nt * 128, dst + nt * 128, mod + (size_t)mb * 6144 + gate_idx * 1024 + nt * 128, tid);
        };
        const int r0 = g_row(0), r1 = g_row(1), r2 = g_row(2), r3 = g_row(3);
        const bf16_t* Ab = A + (size_t)mt2 * 256 * K;
        const bf16_t* Bb = W + (size_t)nt2 * 256 * K;
        gemm256(p.ws, Ab + (size_t)r0 * K + g_chunk(r0) * 8, Ab + (size_t)r1 * K + g_chunk(r1) * 8, Ab + (size_t)r2 * K + g_chunk(r2) * 8, Ab + (size_t)r3 * K + g_chunk(r3) * 8,
                Bb + (size_t)b_perm(r0) * K + g_chunk(r0) * 8, Bb + (size_t)b_perm(r1) * K + g_chunk(r1) * 8, Bb + (size_t)b_perm(r2) * K + g_chunk(r2) * 8, Bb + (size_t)b_perm(r3) * K + g_chunk(r3) * 8,
                K, smem_all, epi);
    }
    if (ctx_small) {
        char* smem = smem_all + HBI * HB_SMEM;
        for (int id0 = blockIdx.x * 2; id0 < 128; id0 += gridDim.x * 2) {
            const int id = id0 + HBI, nt = id >> 4, m0 = 16384 + (id & 15) * 128;
            auto epi = [&](const float* Cs, const float*) {
                epi_resid(Cs, srcCtx + (size_t)(m0 - 16384) * 1024 + nt * 128, dstCtx + (size_t)(m0 - 16384) * 1024 + nt * 128, mod + (size_t)8 * 6144 + gate_idx * 1024 + nt * 128, TID);
            };
            const bf16_t* Ar = A + (size_t)(m0 + (TID >> 3)) * K;
            gemm_tile<false, false>(Ar, Ar + (size_t)32 * K, Ar + (size_t)64 * K, Ar + (size_t)96 * K, 0u, 0u, 0u, 0u, W + (size_t)nt * 128 * K, K, K, smem, epi);
        }
    }
}

DI float4 conv4(float4 w0, float4 w1, float4 w2, float4 bb, float4 gm, float4 g0, float4 gp, float4 v) {
    float4 o;
    o.x = siluf_(w0.x * gm.x + w1.x * g0.x + w2.x * gp.x + bb.x) * v.x;
    o.y = siluf_(w0.y * gm.y + w1.y * g0.y + w2.y * gp.y + bb.y) * v.y;
    o.z = siluf_(w0.z * gm.z + w1.z * g0.z + w2.z * gp.z + bb.z) * v.z;
    o.w = siluf_(w0.w * gm.w + w1.w * g0.w + w2.w * gp.w + bb.w) * v.w;
    return o;
}
DI void halo_info(int mt, int& base, int& T, int& tstart) {
    int ti;
    if (mt < 136) { base = (mt / 17) * 2048; T = 2048; ti = mt % 17; }
    else { int q = mt - 136; base = 16384 + (q / 3) * 256; T = 256; ti = q % 3; }
    tstart = 126 * ti - 1;
}
DI const bf16_t* halo_ptr(const bf16_t* H, const bf16_t* Z, int mt2, int row) {
    int base, T, tstart; halo_info(2 * mt2 + (row >> 7), base, T, tstart);
    const int t = tstart + (row & 127);
    return (t >= 0 && t < T) ? H + (size_t)(base + t) * 1024 + g_chunk(row) * 8 : Z;
}
DI void phase_ffn_up(const Params& p, const bf16_t* W, const float* convw, const float* convb, int mtiles2, char* smem_all) {
    const bf16_t* H = (const bf16_t*)(p.ws + OFF_H);
    const bf16_t* Z = (const bf16_t*)(p.ws + OFF_ZROW);
    bf16_t* ACT = (bf16_t*)(p.ws + OFF_ACT);
    for (int id = blockIdx.x; id < mtiles2 * 22; id += gridDim.x) {
        const int nt2 = id / mtiles2, mt2 = id % mtiles2;
        auto epi = [&](const float* Cs, int si, int sj, int tid) {
            const int nt = 2 * nt2 + sj;
            int base, T, tstart; halo_info(2 * mt2 + si, base, T, tstart);
            const int cc = tid & 7;
            const int cg0 = nt * 64 + cc * 8;
            const float4 w0a = *(const float4*)(convw + cg0), w0b = *(const float4*)(convw + cg0 + 4);
            const float4 w1a = *(const float4*)(convw + 2816 + cg0), w1b = *(const float4*)(convw + 2816 + cg0 + 4);
            const float4 w2a = *(const float4*)(convw + 5632 + cg0), w2b = *(const float4*)(convw + 5632 + cg0 + 4);
            const float4 bba = *(const float4*)(convb + cg0), bbb = *(const float4*)(convb + cg0 + 4);
#pragma unroll
            for (int j = 0; j < 4; ++j) {
                const int rr = (tid >> 3) + 32 * j, t = tstart + rr;
                if (rr >= 1 && rr <= 126 && t < T) {
                    const float4* a = (const float4*)(Cs + (rr - 1) * CP + cc * 8);
                    const float4* bq = (const float4*)(Cs + rr * CP + cc * 8);
                    const float4* c = (const float4*)(Cs + (rr + 1) * CP + cc * 8);
                    const float4* d = (const float4*)(Cs + rr * CP + 64 + cc * 8);
                    const float4 oa = conv4(w0a, w1a, w2a, bba, a[0], bq[0], c[0], d[0]);
                    const float4 ob = conv4(w0b, w1b, w2b, bbb, a[1], bq[1], c[1], d[1]);
                    uint4 u; u.x = pack2(oa.x, oa.y); u.y = pack2(oa.z, oa.w); u.z = pack2(ob.x, ob.y); u.w = pack2(ob.z, ob.w);
                    *(uint4*)(ACT + (size_t)(base + t) * 2816 + cg0) = u;
                }
            }
        };
        const int r0 = g_row(0), r1 = g_row(1), r2 = g_row(2), r3 = g_row(3);
        const bf16_t* Bb = W + (size_t)nt2 * 256 * 1024;
        gemm256(p.ws, halo_ptr(H, Z, mt2, r0), halo_ptr(H, Z, mt2, r1), halo_ptr(H, Z, mt2, r2), halo_ptr(H, Z, mt2, r3),
                Bb + (size_t)b_perm(r0) * 1024 + g_chunk(r0) * 8, Bb + (size_t)b_perm(r1) * 1024 + g_chunk(r1) * 8, Bb + (size_t)b_perm(r2) * 1024 + g_chunk(r2) * 8, Bb + (size_t)b_perm(r3) * 1024 + g_chunk(r3) * 8,
                1024, smem_all, epi);
    }
}

DI void phase_inproj1(const Params& p, char* smem_all) {
    const bf16_t* H = (const bf16_t*)(p.ws + OFF_H);
    const bf16_t* W = (const bf16_t*)(p.ws + OFF_WT_IN1);
    for (int id = blockIdx.x; id < 72 * 13; id += gridDim.x) {
        const int nt2 = id / 72, mt2 = id % 72;
        if (mt2 >= 64 && nt2 >= 8 && nt2 < 12) continue;
        auto epi = [&](const float* Cs, int si, int sj, int tid) {
            const int nt = 2 * nt2 + sj, m0 = (2 * mt2 + si) * 128;
            if (nt < 8) epi_store_bf16(Cs, (bf16_t*)(p.ws + OFF_QKRAW) + (size_t)m0 * 1024 + nt * 128, 1024, tid);
            else if (nt < 16) epi_store_bf16(Cs, (bf16_t*)(p.ws + OFF_V1) + (size_t)m0 * 1024 + (nt - 8) * 128, 1024, tid);
            else if (nt < 24) epi_store_bf16(Cs, (bf16_t*)(p.ws + OFF_OG) + (size_t)m0 * 1024 + (nt - 16) * 128, 1024, tid);
            else if (nt == 24) {
                const int row = tid >> 1, half = tid & 1;
                float* dst = (float*)(p.ws + OFF_GATES) + (size_t)(m0 + row) * 32 + half * 16;
#pragma unroll
                for (int i = 0; i < 16; ++i) {
                    int c = half * 16 + i;
                    float v = Cs[row * CP + c] + p.ml_gate_b[c];
                    if (c & 8) v = logsigmoidf_(v);
                    dst[i] = v;
                }
            }
        };
        const int r0 = g_row(0), r1 = g_row(1), r2 = g_row(2), r3 = g_row(3);
        const bf16_t* Ab = H + (size_t)mt2 * 256 * 1024;
        const bf16_t* Bb = W + (size_t)nt2 * 256 * 1024;
        gemm256(p.ws, Ab + (size_t)r0 * 1024 + g_chunk(r0) * 8, Ab + (size_t)r1 * 1024 + g_chunk(r1) * 8, Ab + (size_t)r2 * 1024 + g_chunk(r2) * 8, Ab + (size_t)r3 * 1024 + g_chunk(r3) * 8,
                Bb + (size_t)b_perm(r0) * 1024 + g_chunk(r0) * 8, Bb + (size_t)b_perm(r1) * 1024 + g_chunk(r1) * 8, Bb + (size_t)b_perm(r2) * 1024 + g_chunk(r2) * 8, Bb + (size_t)b_perm(r3) * 1024 + g_chunk(r3) * 8,
                1024, smem_all, epi);
    }
}

DI void phase_qkconv(const Params& p) {
    const bf16_t* QK = (const bf16_t*)(p.ws + OFF_QKRAW);
    bf16_t* QC = (bf16_t*)(p.ws + OFF_H);
    {
        const int lane = threadIdx.x & 63, gw = blockIdx.x * 8 + (threadIdx.x >> 6);
        const float* GT = (const float*)(p.ws + OFF_GATES);
        float* SC = (float*)(p.ws + OFF_SCAN);
        for (int seg = gw; seg < 2304; seg += gridDim.x * 8) {
            const int step = seg % 18, dir = (seg / 18) & 1, hd = (seg / 36) & 7, b = seg / 288;
            int base, P0;
            if (step < 2) { base = 16384 + b * 256; P0 = (dir ? 1 - step : step) * 128; } else { base = b * 2048; P0 = (dir ? 17 - step : step - 2) * 128; }
            const int pa = dir ? P0 + 127 - lane : P0 + lane, pb = dir ? pa - 64 : pa + 64;
            const float* ga = GT + (size_t)(base + pa) * 32 + dir * 16 + hd; const float* gb = GT + (size_t)(base + pb) * 32 + dir * 16 + hd;
            const float i0 = ga[0], f0 = ga[8], i1 = gb[0], f1 = gb[8];
            float b0 = f0, b1 = f1;
#pragma unroll
            for (int off = 1; off < 64; off <<= 1) { float t0 = __shfl_up(b0, off), t1 = __shfl_up(b1, off); if (lane >= off) { b0 += t0; b1 += t1; } }
            b1 += __shfl(b0, 63);
            float p0 = i0 - b0, p1 = i1 - b1;
            const float c0 = p0, c1 = p1;
#pragma unroll
            for (int off = 1; off < 64; off <<= 1) { float t0 = __shfl_up(p0, off), t1 = __shfl_up(p1, off); if (lane >= off) { p0 = fmaxf(p0, t0); p1 = fmaxf(p1, t1); } }
            p1 = fmaxf(p1, __shfl(p0, 63));
            float* o = SC + (size_t)seg * 384;
            o[lane] = b0; o[64 + lane] = b1; o[128 + lane] = p0; o[192 + lane] = p1; o[256 + lane] = c0; o[320 + lane] = c1;
        }
    }
    for (int c = blockIdx.x * NTHREADS + threadIdx.x; c < 18432 * 128; c += gridDim.x * NTHREADS) {
        const int row = c >> 7, col = (c & 127) * 8;
        int T, t;
        if (row < 16384) { T = 2048; t = row & 2047; } else { T = 256; t = (row - 16384) & 255; }
        float acc[8];
        { const float4 b0 = *(const float4*)(p.ml_conv_b + col), b1 = *(const float4*)(p.ml_conv_b + col + 4);
          acc[0] = b0.x; acc[1] = b0.y; acc[2] = b0.z; acc[3] = b0.w; acc[4] = b1.x; acc[5] = b1.y; acc[6] = b1.z; acc[7] = b1.w; }
#pragma unroll
        for (int dj = 0; dj < 3; ++dj) {
            const int tt = t + dj - 1;
            const float on = (tt >= 0 && tt < T) ? 1.f : 0.f;
            const int rr = row + min(max(tt, 0), T - 1) - t;
            float f[8]; unpack8(*(const uint4*)(QK + (size_t)rr * 1024 + col), f);
            const float4 w0 = *(const float4*)(p.ml_conv_w + dj * 1024 + col), w1 = *(const float4*)(p.ml_conv_w + dj * 1024 + col + 4);
            acc[0] += w0.x * on * f[0]; acc[1] += w0.y * on * f[1]; acc[2] += w0.z * on * f[2]; acc[3] += w0.w * on * f[3];
            acc[4] += w1.x * on * f[4]; acc[5] += w1.y * on * f[5]; acc[6] += w1.z * on * f[6]; acc[7] += w1.w * on * f[7];
        }
        const float sc = col >= 512 ? 0.125f : 1.f;
#pragma unroll
        for (int i = 0; i < 8; ++i) acc[i] = siluf_(acc[i]) * sc;
        *(uint4*)(QC + (size_t)row * 1024 + col) = pack8(acc);
    }
}

DI void phase_mlstm(const Params& p, char* smem) {
    constexpr int LP = 72, TP = 136, L = 128;
    bf16_t* Qc = (bf16_t*)smem;
    bf16_t* Kc = Qc + L * LP;
    bf16_t* KcT = Kc + L * LP;
    bf16_t* VcT = KcT + 64 * TP;
    bf16_t* VwT = VcT + 64 * TP;
    bf16_t* Pm = VwT + 64 * TP;
    bf16_t* Cb = Pm + L * TP;
    float* fa = (float*)(Cb + 64 * LP);
    float* bcum = fa; float* ig = fa + 128; float* mtv = fa + 256; float* wint = fa + 384; float* denI = fa + 512; float* denX = fa + 640;
    float* wgt = fa + 768; float* nvec = fa + 896; float* scal = fa + 960; float* csv = fa + 1024; float* denP = fa + 1152;
    static_assert((2 * L * LP + 3 * 64 * TP + L * TP + 64 * LP) * 2 + 1408 * 4 <= SMEM_ALL, "mLSTM LDS");
    const int lane0 = threadIdx.x & 63, w = __builtin_amdgcn_readfirstlane(threadIdx.x >> 6);
    const bf16_t* QK = (const bf16_t*)(p.ws + OFF_H);
    const bf16_t* V1 = (const bf16_t*)(p.ws + OFF_V1);
    const float* GT = (const float*)(p.ws + OFF_GATES);
    for (int item = blockIdx.x; item < 256; item += gridDim.x) {
        const int vh = item & 1, dir = (item >> 1) & 1, hd = (item >> 2) & 7, b = item >> 5;
        bf16_t* Hout = (bf16_t*)(p.ws + (dir ? OFF_HB : OFF_HF));
        f32x16 accC = zero16();
        float m_prev = 0.f;
        for (int i = w * 64 + lane0; i < 64 * LP; i += 512) Cb[i] = 0;
        if (w == 0) nvec[lane0] = 0.f;
        int lane = lane0, tid = w * 64 + lane0, h = lane0 >> 5, r = lane0 & 31;
        int u = tid >> 2, part = tid & 3;
        uint4 rq0, rq1, rk0, rk1, rv0, rv1;
        float sc_b = 0.f, sc_p = 0.f, sc_c = 0.f, sc_bl = 0.f, sc_pl = 0.f;
#define ML_STEP_GEOM(st, base_, P0_) { if ((st) < 2) { base_ = 16384 + b * 256; P0_ = (dir ? 1 - (st) : (st)) * L; } else { base_ = b * 2048; P0_ = (dir ? 17 - (st) : (st) - 2) * L; } }
#define ML_PREFETCH(st) { int base_, P0_; ML_STEP_GEOM(st, base_, P0_) \
            const int pos_ = dir ? P0_ + L - 1 - u : P0_ + u; \
            { const bf16_t* rowp = QK + (size_t)(base_ + pos_) * 1024; \
              const int qcol = hd * 64 + part * 16, kcol = 512 + qcol; rq0 = *(const uint4*)(rowp + qcol); rq1 = *(const uint4*)(rowp + qcol + 8); rk0 = *(const uint4*)(rowp + kcol); rk1 = *(const uint4*)(rowp + kcol + 8); } \
            { const bf16_t* vp_ = V1 + (size_t)(base_ + pos_) * 1024 + hd * 128 + vh * 64 + part * 16; rv0 = *(const uint4*)vp_; rv1 = *(const uint4*)(vp_ + 8); } \
            if (w < 2) { const float* sp_ = (const float*)(p.ws + OFF_SCAN) + (size_t)((((b * 8 + hd) * 2 + dir) * 18) + (st)) * 384; \
                sc_b = sp_[tid]; sc_p = sp_[128 + tid]; sc_c = sp_[256 + tid]; sc_bl = sp_[127]; sc_pl = sp_[255]; } }
        ML_PREFETCH(0)
        __syncthreads();
#pragma unroll 1
        for (int step = 0; step < 18; ++step) {
            lane = lane0; asm volatile("" : "+v"(lane));
            tid = w * 64 + lane; h = lane >> 5; r = lane & 31; u = tid >> 2; part = tid & 3;
            int base, P0; ML_STEP_GEOM(step, base, P0)
            const bool full = step >= 2;
            if (w < 2) {
                const float mt = fmaxf(sc_b + m_prev, sc_b + sc_p);
                const float mnew = fmaxf(sc_bl + m_prev, sc_bl + sc_pl);
                bcum[tid] = sc_b; csv[tid] = sc_c; mtv[tid] = mt;
                wint[tid] = __expf(sc_b + m_prev - mt);
                wgt[tid] = __expf(sc_bl + sc_c - mnew);
                if (tid == 0) { scal[0] = mnew; scal[1] = __expf(sc_bl + m_prev - mnew); }
            }
            {
                *(uint4*)(Qc + u * LP + part * 16) = rq0; *(uint4*)(Qc + u * LP + part * 16 + 8) = rq1;
                *(uint4*)(Kc + u * LP + part * 16) = rk0; *(uint4*)(Kc + u * LP + part * 16 + 8) = rk1;
#define ML_T2(dstT, wv, ci) { dstT[(part * 16 + (ci)) * TP + u] = (bf16_t)((wv) & 0xffffu); dstT[(part * 16 + (ci) + 1) * TP + u] = (bf16_t)((wv) >> 16); }
                ML_T2(KcT, rk0.x, 0) ML_T2(KcT, rk0.y, 2) ML_T2(KcT, rk0.z, 4) ML_T2(KcT, rk0.w, 6) ML_T2(KcT, rk1.x, 8) ML_T2(KcT, rk1.y, 10) ML_T2(KcT, rk1.z, 12) ML_T2(KcT, rk1.w, 14)
                ML_T2(VcT, rv0.x, 0) ML_T2(VcT, rv0.y, 2) ML_T2(VcT, rv0.z, 4) ML_T2(VcT, rv0.w, 6) ML_T2(VcT, rv1.x, 8) ML_T2(VcT, rv1.y, 10) ML_T2(VcT, rv1.z, 12) ML_T2(VcT, rv1.w, 14)
#undef ML_T2
            }
            if (step + 1 < 18) ML_PREFETCH(step + 1)
            LDS_BARRIER();
            const float m_new = scal[0], decay = scal[1];
            {
                const int vv = tid >> 3, s0_ = (tid & 7) * 16;
#pragma unroll
                for (int q = 0; q < 2; ++q) {
                    float f[8]; unpack8(*(const uint4*)(VcT + vv * TP + s0_ + q * 8), f);
                    const float4 w0 = *(const float4*)(wgt + s0_ + q * 8), w1 = *(const float4*)(wgt + s0_ + q * 8 + 4);
                    f[0] *= w0.x; f[1] *= w0.y; f[2] *= w0.z; f[3] *= w0.w; f[4] *= w1.x; f[5] *= w1.y; f[6] *= w1.z; f[7] *= w1.w;
                    *(uint4*)(VwT + vv * TP + s0_ + q * 8) = pack8(f);
                }
            }
            if (full) {
                {
                    float sacc_ = 0.f;
#pragma unroll
                    for (int q = 0; q < 2; ++q) {
                        float f[8]; unpack8(*(const uint4*)(Qc + u * LP + part * 16 + q * 8), f);
                        const float4 n0 = *(const float4*)(nvec + part * 16 + q * 8), n1 = *(const float4*)(nvec + part * 16 + q * 8 + 4);
                        sacc_ += f[0] * n0.x + f[1] * n0.y + f[2] * n0.z + f[3] * n0.w + f[4] * n1.x + f[5] * n1.y + f[6] * n1.z + f[7] * n1.w;
                    }
                    sacc_ += __shfl_xor(sacc_, 1); sacc_ += __shfl_xor(sacc_, 2);
                    if (part == 0) denX[u] = sacc_;
                }
                const int ti = w >> 1, t = ti * 32 + r;
                const float bt = bcum[t] - mtv[t];
                float rs = 0.f;
#pragma unroll
                for (int q = 0; q < 2; ++q) {
                    const int si = 2 * (w & 1) + q;
                    if (si <= ti) {
                        f32x16 sacc = zero16();
#pragma unroll
                        for (int ks = 0; ks < 4; ++ks) {
                            bf16x8 a = *(const bf16x8*)(Kc + (si * 32 + r) * LP + ks * 16 + h * 8);
                            bf16x8 bb = *(const bf16x8*)(Qc + (ti * 32 + r) * LP + ks * 16 + h * 8);
                            sacc = MFMA(a, bb, sacc);
                        }
#pragma unroll
                        for (int g4 = 0; g4 < 4; ++g4) {
                            const int s0_ = si * 32 + 8 * g4 + 4 * h;
                            const float4 c4 = *(const float4*)(csv + s0_);
                            float p0 = s0_ + 0 <= t ? sacc[4 * g4 + 0] * __expf(bt + c4.x) : 0.f;
                            float p1 = s0_ + 1 <= t ? sacc[4 * g4 + 1] * __expf(bt + c4.y) : 0.f;
                            float p2 = s0_ + 2 <= t ? sacc[4 * g4 + 2] * __expf(bt + c4.z) : 0.f;
                            float p3 = s0_ + 3 <= t ? sacc[4 * g4 + 3] * __expf(bt + c4.w) : 0.f;
                            rs += (p0 + p1) + (p2 + p3);
                            uint2 pk; pk.x = pack2(p0, p1); pk.y = pack2(p2, p3);
                            *(uint2*)(Pm + t * TP + s0_) = pk;
                        }
                    } else {
#pragma unroll
                        for (int g4 = 0; g4 < 4; ++g4) *(uint2*)(Pm + t * TP + si * 32 + 8 * g4 + 4 * h) = make_uint2(0u, 0u);
                    }
                }
                rs += __shfl_xor(rs, 32);
                if (h == 0) denP[(w & 1) * 128 + t] = rs;
            }
            LDS_BARRIER();
            f32x16 hacc = zero16();
            const int ti = w >> 1, vi = w & 1;
            if (full) {
#pragma unroll
                for (int ks = 0; ks < 4; ++ks) {
                    bf16x8 a = *(const bf16x8*)(Cb + (vi * 32 + r) * LP + ks * 16 + h * 8);
                    bf16x8 bb = *(const bf16x8*)(Qc + (ti * 32 + r) * LP + ks * 16 + h * 8);
                    hacc = MFMA(a, bb, hacc);
                }
                const float wi = wint[ti * 32 + r];
#pragma unroll
                for (int g = 0; g < 16; ++g) hacc[g] *= wi;
#pragma unroll
                for (int ks = 0; ks < 8; ++ks) {
                    if (ks <= 2 * ti + 1) {
                        bf16x8 a = *(const bf16x8*)(VcT + (vi * 32 + r) * TP + ks * 16 + h * 8);
                        bf16x8 bb = *(const bf16x8*)(Pm + (ti * 32 + r) * TP + ks * 16 + h * 8);
                        hacc = MFMA(a, bb, hacc);
                    }
                }
            }
            LDS_BARRIER();
            if (full) {
                const int t = ti * 32 + r;
                const float den = wint[t] * denX[t] + denP[t] + denP[128 + t];
                const float inv = __builtin_amdgcn_rcpf(fmaxf(fabsf(den), __expf(-mtv[t])));
                bf16_t* hp = Pm + t * LP + vi * 32 + 4 * h;
#pragma unroll
                for (int g4 = 0; g4 < 4; ++g4) {
                    uint2 pk; pk.x = pack2(hacc[4 * g4] * inv, hacc[4 * g4 + 1] * inv); pk.y = pack2(hacc[4 * g4 + 2] * inv, hacc[4 * g4 + 3] * inv);
                    *(uint2*)(hp + 8 * g4) = pk;
                }
            }
            if (w < 4) {
                const int vi2 = w >> 1, di = w & 1;
#pragma unroll
                for (int g = 0; g < 16; ++g) accC[g] *= decay;
#pragma unroll
                for (int ks = 0; ks < 8; ++ks) {
                    bf16x8 a = *(const bf16x8*)(VwT + (vi2 * 32 + r) * TP + ks * 16 + h * 8);
                    bf16x8 bb = *(const bf16x8*)(KcT + (di * 32 + r) * TP + ks * 16 + h * 8);
                    accC = MFMA(a, bb, accC);
                }
#pragma unroll
                for (int g = 0; g < 16; ++g) Cb[(vi2 * 32 + crow(g, h)) * LP + di * 32 + r] = f2bf_sw(accC[g]);
            } else {
                const int t2 = tid - 256, d = t2 >> 2, pq = t2 & 3;
                float sacc_ = 0.f;
#pragma unroll
                for (int q = 0; q < 4; ++q) {
                    float f[8]; unpack8(*(const uint4*)(KcT + d * TP + pq * 32 + q * 8), f);
                    const float4 w0 = *(const float4*)(wgt + pq * 32 + q * 8), w1 = *(const float4*)(wgt + pq * 32 + q * 8 + 4);
                    sacc_ += f[0] * w0.x + f[1] * w0.y + f[2] * w0.z + f[3] * w0.w + f[4] * w1.x + f[5] * w1.y + f[6] * w1.z + f[7] * w1.w;
                }
                sacc_ += __shfl_xor(sacc_, 1); sacc_ += __shfl_xor(sacc_, 2);
                if (pq == 0) nvec[d] = decay * nvec[d] + sacc_;
            }
            m_prev = m_new;
            LDS_BARRIER();
            if (full) {
#pragma unroll
                for (int q = 0; q < 2; ++q) {
                    const int c = tid + 512 * q, t = c >> 3, ch = c & 7;
                    const int pos = dir ? P0 + L - 1 - t : P0 + t;
                    *(uint4*)(Hout + (size_t)(base + pos) * 1024 + hd * 128 + vh * 64 + ch * 8) = *(const uint4*)(Pm + t * LP + ch * 8);
                }
            }
        }
#undef ML_STEP_GEOM
#undef ML_PREFETCH
    }
}

DI void phase_mix(const Params& p) {
    const int lane = threadIdx.x & 63, w = threadIdx.x >> 6;
    const bf16_t* HF = (const bf16_t*)(p.ws + OFF_HF);
    const bf16_t* HB = (const bf16_t*)(p.ws + OFF_HB);
    const bf16_t* OG = (const bf16_t*)(p.ws + OFF_OG);
    bf16_t* H = (bf16_t*)(p.ws + OFF_H);
    for (int row = blockIdx.x * 8 + w; row < 16384; row += gridDim.x * 8) {
        const size_t o = (size_t)row * 1024 + lane * 16;
        float a[16], bq[16], og[16];
        unpack8(*(const uint4*)(HF + o), a); unpack8(*(const uint4*)(HF + o + 8), a + 8);
        unpack8(*(const uint4*)(HB + o), bq); unpack8(*(const uint4*)(HB + o + 8), bq + 8);
        unpack8(*(const uint4*)(OG + o), og); unpack8(*(const uint4*)(OG + o + 8), og + 8);
        float ss = 0.f;
#pragma unroll
        for (int i = 0; i < 16; ++i) { a[i] += bq[i]; ss += a[i] * a[i]; }
        ss += __shfl_xor(ss, 1); ss += __shfl_xor(ss, 2); ss += __shfl_xor(ss, 4);
        const float rstd = rsqrtf(ss * (1.f / 128.f) + EPSF);
        const float* g = p.ml_out_g + lane * 16;
#pragma unroll
        for (int i = 0; i < 16; ++i) a[i] = a[i] * rstd * g[i] * sigmoidf_(og[i]);
        *(uint4*)(H + o) = pack8(a); *(uint4*)(H + o + 8) = pack8(a + 8);
    }
}

#define XB_TMO      128
#define XB_XCNT(j)  (256  + 64 * (j))
#define XB_XSUB(j)  (1280 + 64 * (j))
#define XB_XGEN(j)  (2304 + 64 * (j))
#define XB_TOP      3328
#define XB_TOPGEN   3392
#define XCD_BAR_WORDS 3456
#define XB_SPIN_CAP (1u << 18)
#define LAS __attribute__((address_space(3)))

__device__ __forceinline__ unsigned xb_ld(unsigned* p)              { return __hip_atomic_load(p, __ATOMIC_RELAXED, __HIP_MEMORY_SCOPE_AGENT); }
__device__ __forceinline__ unsigned xb_add(unsigned* p, unsigned v) { return __hip_atomic_fetch_add(p, v, __ATOMIC_RELAXED, __HIP_MEMORY_SCOPE_AGENT); }
__device__ __forceinline__ unsigned xb_xcc_id() { return (unsigned)__builtin_amdgcn_s_getreg((3 << 11) | 20) & 0xFu; }
#define XB_SPIN(cond, bar) do { unsigned _sp = 0; while (cond) { __builtin_amdgcn_s_sleep(1); \
    if ((++_sp & 255u) == 0u) { if (xb_ld(&(bar)[XB_TMO])) break; if (_sp > XB_SPIN_CAP) { atomicAdd(&(bar)[XB_TMO], 1u); break; } } } } while (0)

struct XcdBarrier {
    unsigned* bar; unsigned x;
    volatile LAS unsigned* st;
};

__device__ __forceinline__ XcdBarrier xcd_barrier_post(unsigned* bar, volatile LAS unsigned* st) {
    XcdBarrier b; b.bar = bar; b.x = xb_xcc_id(); b.st = st;
    if (threadIdx.x == 0) (void)xb_add(&bar[XB_XCNT(b.x)], 1u);
    return b;
}
__device__ __forceinline__ void xcd_barrier_complete(unsigned* bar, unsigned x, unsigned& nloc, unsigned& nx) {
    const unsigned G = gridDim.x * gridDim.y * gridDim.z;
    unsigned sum, cnt, mine, sp = 0u;
    for (;;) {
        sum = 0u; cnt = 0u; mine = 0u;
#pragma unroll
        for (unsigned j = 0; j < 16; ++j) { const unsigned c = xb_ld(&bar[XB_XCNT(j)]); sum += c; cnt += (c > 0u) ? 1u : 0u; mine = (j == x) ? c : mine; }
        if (sum == G) break;
        __builtin_amdgcn_s_sleep(1);
        if ((++sp & 255u) == 0u) { if (xb_ld(&bar[XB_TMO])) break; if (sp > XB_SPIN_CAP) { atomicAdd(&bar[XB_TMO], 1u); break; } }
    }
    nloc = mine > 0u ? mine : 1u; nx = cnt > 0u ? cnt : 1u;
}

__device__ __forceinline__ void xcd_barrier(const XcdBarrier& b) {
    asm volatile("s_waitcnt vmcnt(0)" ::: "memory");
    __syncthreads();
    if (threadIdx.x == 0) {
        unsigned* bar = b.bar;
        __builtin_amdgcn_s_waitcnt(0);
        unsigned nloc = b.st[0], nx = b.st[1];
        if (nloc == 0u) { xcd_barrier_complete(bar, b.x, nloc, nx); b.st[0] = nloc; b.st[1] = nx; }
        const unsigned old = xb_add(&bar[XB_XSUB(b.x)], 1u);
        const unsigned gen = old / nloc;
        if (old + 1u == (gen + 1u) * nloc) {
            __builtin_amdgcn_fence(__ATOMIC_RELEASE, "agent");
            asm volatile("s_waitcnt vmcnt(0)" ::: "memory");
            const unsigned og = xb_add(&bar[XB_TOP], 1u);
            const unsigned tg = og / nx;
            if (og + 1u == (tg + 1u) * nx) xb_add(&bar[XB_TOPGEN], 1u);
            else XB_SPIN(xb_ld(&bar[XB_TOPGEN]) == tg, bar);
            __builtin_amdgcn_fence(__ATOMIC_ACQUIRE, "agent");
            xb_add(&bar[XB_XGEN(b.x)], 1u);
            asm volatile("s_waitcnt vmcnt(0)" ::: "memory");
        } else {
            XB_SPIN(xb_ld(&bar[XB_XGEN(b.x)]) == gen, bar);
            __builtin_amdgcn_fence(__ATOMIC_ACQUIRE, "agent");
            asm volatile("s_waitcnt vmcnt(0)" ::: "memory");
        }
    }
    __syncthreads();
}


__global__ void __launch_bounds__(NTHREADS, 2) __attribute__((amdgpu_waves_per_eu(2, 2))) fwd_megakernel(Params p) {
    __shared__ __attribute__((aligned(1024))) char smem[SMEM_ALL];
    cg::grid_group grid = cg::this_grid();
    __shared__ uint4 xb_words;
    if (threadIdx.x == 0) xb_words = make_uint4(0u, 0u, 0u, 0u);
    __syncthreads();
    XcdBarrier xb = xcd_barrier_post((unsigned*)(p.ws + OFF_BAR), (volatile LAS unsigned*)&xb_words);
    const float* MOD0 = (const float*)(p.ws + OFF_MOD);
    const float* MOD1 = MOD0 + 9 * 6144;
    float* XRC = (float*)(p.ws + OFF_XRC);
    const bf16_t* Hb = (const bf16_t*)(p.ws + OFF_H);

    phase0(p, smem);
    if (p.ws == nullptr) grid.sync();
    xcd_barrier(xb);
    phase_norm(p, p.x, p.ctx, p.norm1_g, MOD0, 0, 18432);
    xcd_barrier(xb);
    phase_inproj0(p, smem);
    xcd_barrier(xb);
    phase_mla_up(p, smem);
    xcd_barrier(xb);
    phase_attn(p, smem);
    xcd_barrier(xb);
    phase_proj_resid(p, Hb, 1024, (const bf16_t*)(p.ws + OFF_WT_OUT0), MOD0, 2, p.x, p.ctx, p.out, XRC, 64, true, smem);
    xcd_barrier(xb);
    phase_norm(p, p.out, XRC, p.norm2_g, MOD0, 3, 18432);
    xcd_barrier(xb);
    phase_ffn_up(p, (const bf16_t*)(p.ws + OFF_WT_UP0), p.ffn_conv_w, p.ffn_conv_b, 80, smem);
    xcd_barrier(xb);
    phase_proj_resid(p, (const bf16_t*)(p.ws + OFF_ACT), 2816, (const bf16_t*)(p.ws + OFF_WT_DOWN0), MOD0, 5, p.out, XRC, p.out, XRC, 64, true, smem);
    xcd_barrier(xb);
    phase_norm(p, p.out, XRC, p.norm1_g + 1024, MOD1, 0, 18432);
    xcd_barrier(xb);
    phase_inproj1(p, smem);
    xcd_barrier(xb);
    phase_qkconv(p);
    xcd_barrier(xb);
    phase_mlstm(p, smem);
    xcd_barrier(xb);
    phase_mix(p);
    xcd_barrier(xb);
    phase_proj_resid(p, Hb, 1024, (const bf16_t*)(p.ws + OFF_WT_OUT1), MOD1, 2, p.out, XRC, p.out, XRC, 64, false, smem);
    xcd_barrier(xb);
    phase_norm(p, p.out, XRC, p.norm2_g + 1024, MOD1, 3, 16384);
    xcd_barrier(xb);
    phase_ffn_up(p, (const bf16_t*)(p.ws + OFF_WT_UP1), p.ffn_conv_w + 3 * 2816, p.ffn_conv_b + 2816, 68, smem);
    xcd_barrier(xb);
    phase_proj_resid(p, (const bf16_t*)(p.ws + OFF_ACT), 2816, (const bf16_t*)(p.ws + OFF_WT_DOWN1), MOD1, 5, p.out, XRC, p.out, XRC, 64, false, smem);
}

extern "C" void kernel_launch(void* const* d_in, const int* in_sizes, int n_in, void* d_out, int out_size, void* d_ws, size_t ws_size,
                              hipStream_t stream) {
    static int grid_blocks = 0;
    if (!grid_blocks) {
        int dev = 0, cus = 0, per_cu = 0;
        hipGetDevice(&dev);
        hipDeviceGetAttribute(&cus, hipDeviceAttributeMultiprocessorCount, dev);
        hipOccupancyMaxActiveBlocksPerMultiprocessor(&per_cu, fwd_megakernel, NTHREADS, 0);
        if (per_cu < 1) per_cu = 1;
        if (per_cu > 1) per_cu = 1;
        grid_blocks = cus * per_cu;
        if (ws_size < WS_END) fprintf(stderr, "kernel_launch: workspace too small: %zu < %zu\n", ws_size, (size_t)WS_END);
    }
    Params p{};
    const float** pf = (const float**)&p;
    for (int i = 0; i < 28; ++i) pf[i] = (const float*)d_in[i];
    p.out = (float*)d_out;
    p.ws = (char*)d_ws;
    hipMemsetAsync((char*)d_ws + OFF_BAR, 0, 16384, stream);
    void* args[] = {&p};
    hipError_t e = hipLaunchCooperativeKernel((void*)fwd_megakernel, dim3(grid_blocks), dim3(NTHREADS), args, 0, stream);
    if (e != hipSuccess) fprintf(stderr, "cooperative launch failed: %s (grid %d)\n", hipGetErrorString(e), grid_blocks);
}
```

```cpp
#include <hip/hip_runtime.h>
#include <hip/hip_cooperative_groups.h>
#include <cstdio>
namespace cg = cooperative_groups;

typedef unsigned short bf16_t;
using bf16x8 = __attribute__((ext_vector_type(8))) short;
using f32x16 = __attribute__((ext_vector_type(16))) float;
using f32x4 = __attribute__((ext_vector_type(4))) float;
#define DI __device__ __forceinline__
#define MFMA(a, b, c) __builtin_amdgcn_mfma_f32_32x32x16_bf16((a), (b), (c), 0, 0, 0)
#define MFMA16(a, b, c) __builtin_amdgcn_mfma_f32_16x16x32_bf16((a), (b), (c), 0, 0, 0)
#define LDS_BARRIER() do { asm volatile("s_waitcnt lgkmcnt(0)" ::: "memory"); __builtin_amdgcn_s_barrier(); asm volatile("" ::: "memory"); } while (0)
#define TID ((int)(threadIdx.x & 255))
#define HBI ((int)(threadIdx.x >> 8))

constexpr float EPSF = 1e-6f;
constexpr float LOG2E = 1.4426950408889634f;
constexpr int NTHREADS = 512;
constexpr int HB_SMEM = 73728;
constexpr int SMEM_ALL = 2 * HB_SMEM;
constexpr int GP = 72;
constexpr int CP = 132;
constexpr int ROWSS_OFF = 67584;

constexpr size_t OFF_WT_UP1 = 0;
constexpr size_t OFF_WT_DOWN1 = OFF_WT_UP1 + 5632ull * 1024 * 2;
constexpr size_t OFF_WT_IN1 = OFF_WT_DOWN1 + 1024ull * 2816 * 2;
constexpr size_t OFF_WT_OUT1 = OFF_WT_IN1 + 3328ull * 1024 * 2;
constexpr size_t OFF_MOD = OFF_WT_OUT1 + 1024ull * 1024 * 2;
constexpr size_t OFF_TABG = OFF_MOD + 2ull * 9 * 6144 * 4;
constexpr size_t OFF_TABM = OFF_TABG + 64 * 16 * 2 * 4;
constexpr size_t OFF_ZROW = OFF_TABM + 64 * 8 * 2 * 4;
constexpr size_t OFF_W0 = OFF_ZROW + 8192;
constexpr size_t OFF_WT_IN0 = OFF_W0;
constexpr size_t OFF_WT_QB = OFF_WT_IN0 + 1536ull * 1024 * 2;
constexpr size_t OFF_WT_KVB = OFF_WT_QB + 1024ull * 384 * 2;
constexpr size_t OFF_WT_OUT0 = OFF_WT_KVB + 1024ull * 256 * 2;
constexpr size_t OFF_WT_UP0 = OFF_WT_OUT0 + 1024ull * 1024 * 2;
constexpr size_t OFF_WT_DOWN0 = OFF_WT_UP0 + 5632ull * 1024 * 2;
constexpr size_t OFF_XRC = OFF_WT_DOWN0 + 1024ull * 2816 * 2;
constexpr size_t OFF_R = OFF_XRC + 2048ull * 1024 * 4;
constexpr size_t OFF_QG = OFF_R;
constexpr size_t OFF_KG = OFF_QG + 18432ull * 512 * 2;
constexpr size_t OFF_VGT = OFF_KG + 18432ull * 128 * 2;
constexpr size_t OFF_CQ = OFF_VGT + 18432ull * 128 * 2;
constexpr size_t OFF_CKV = OFF_CQ + 18432ull * 384 * 2;
constexpr size_t OFF_KR = OFF_CKV + 18432ull * 256 * 2;
constexpr size_t OFF_QM = OFF_KR + 18432ull * 32 * 4;
constexpr size_t OFF_KM = OFF_QM + 18432ull * 768 * 2;
constexpr size_t OFF_VMT = OFF_KM + 18432ull * 768 * 2;
constexpr size_t END_L0 = OFF_VMT + 18432ull * 512 * 2;
constexpr size_t OFF_ACT = OFF_R;
constexpr size_t END_ACT = OFF_ACT + 18432ull * 2816 * 2;
constexpr size_t OFF_QKRAW = OFF_W0;
constexpr size_t OFF_V1 = OFF_QKRAW + 18432ull * 1024 * 2;
constexpr size_t OFF_OG = OFF_V1 + 18432ull * 1024 * 2;
constexpr size_t OFF_GATES = OFF_OG + 16384ull * 1024 * 2;
constexpr size_t OFF_HF = OFF_GATES + 18432ull * 32 * 4;
constexpr size_t OFF_HB = OFF_HF + 16384ull * 1024 * 2;
constexpr size_t END_L1 = OFF_HB + 16384ull * 1024 * 2;
constexpr size_t cmax(size_t a, size_t b) { return a > b ? a : b; }
constexpr size_t OFF_H = cmax(cmax(END_L0, END_ACT), END_L1);
constexpr size_t OFF_BAR = OFF_H + 18432ull * 1024 * 2;
constexpr size_t OFF_SCAN = OFF_BAR + 16384;
constexpr size_t WS_END = OFF_SCAN + 2304ull * 384 * 4;
static_assert(WS_END <= 268435456ull, "workspace too large");
static_assert(OFF_H % 256 == 0 && OFF_R % 256 == 0 && OFF_HF % 256 == 0, "align");

struct Params {
    const float *x, *c, *ctx, *c_ctx, *ada_w, *ada_b, *norm1_g, *norm2_g, *ffn_w_up, *ffn_conv_w, *ffn_conv_b, *ffn_w_down,
        *att_w_in, *mla_qa_g, *mla_w_qb, *mla_kva_g, *mla_w_kvb, *mla_q_g, *mla_k_g, *gqa_q_g, *gqa_k_g, *att_w_out,
        *ml_w_in, *ml_conv_w, *ml_conv_b, *ml_gate_b, *ml_out_g, *ml_w_out;
    float* out;
    char* ws;
};

DI unsigned short f2bf_sw(float x) { unsigned u = __float_as_uint(x); u += 0x7fffu + ((u >> 16) & 1u); return (unsigned short)(u >> 16); }
DI unsigned short f2bf(float x) { unsigned r; asm("v_cvt_pk_bf16_f32 %0, %1, %1" : "=v"(r) : "v"(x)); return (unsigned short)(r & 0xffffu); }
DI unsigned pack2(float a, float b) { unsigned r; asm("v_cvt_pk_bf16_f32 %0, %1, %2" : "=v"(r) : "v"(a), "v"(b)); return r; }
DI bf16x8 pack_frag(float a0, float a1, float a2, float a3, float a4, float a5, float a6, float a7) {
    using u32x4_ = __attribute__((ext_vector_type(4))) unsigned; u32x4_ p;
    asm volatile("v_cvt_pk_bf16_f32 %0, %4, %5\n\tv_cvt_pk_bf16_f32 %1, %6, %7\n\tv_cvt_pk_bf16_f32 %2, %8, %9\n\tv_cvt_pk_bf16_f32 %3, %10, %11\n\ts_nop 1"
                 : "=&v"(p[0]), "=&v"(p[1]), "=&v"(p[2]), "=&v"(p[3]) : "v"(a0), "v"(a1), "v"(a2), "v"(a3), "v"(a4), "v"(a5), "v"(a6), "v"(a7));
    return __builtin_bit_cast(bf16x8, p);
}
DI float bflo(unsigned v) { return __uint_as_float(v << 16); }
DI float bfhi(unsigned v) { return __uint_as_float(v & 0xffff0000u); }
DI float bf2f(unsigned short v) { return __uint_as_float(((unsigned)v) << 16); }
DI uint4 pack8(const float* v) { uint4 o; o.x = pack2(v[0], v[1]); o.y = pack2(v[2], v[3]); o.z = pack2(v[4], v[5]); o.w = pack2(v[6], v[7]); return o; }
DI void unpack8(uint4 u, float* v) { v[0] = bflo(u.x); v[1] = bfhi(u.x); v[2] = bflo(u.y); v[3] = bfhi(u.y); v[4] = bflo(u.z); v[5] = bfhi(u.z); v[6] = bflo(u.w); v[7] = bfhi(u.w); }
DI int crow(int reg, int h) { return (reg & 3) + 8 * (reg >> 2) + 4 * h; }
DI float sigmoidf_(float x) { return __builtin_amdgcn_rcpf(1.f + __expf(-x)); }
DI float siluf_(float x) { return x * __builtin_amdgcn_rcpf(1.f + __expf(-x)); }
DI float logsigmoidf_(float x) { return fminf(x, 0.f) - log1pf(__expf(-fabsf(x))); }
DI f32x16 zero16() { f32x16 z;
#pragma unroll
    for (int i = 0; i < 16; ++i) z[i] = 0.f; return z; }

DI void row_info(int m0, int& b, int& t0, bool& lat) {
    if (m0 < 16384) { b = m0 >> 11; t0 = m0 & 2047; lat = true; }
    else { int q = m0 - 16384; b = q >> 8; t0 = q & 255; lat = false; }
}

template <bool SS, bool HALO, class Epi>
DI void gemm_tile(const bf16_t* ap0, const bf16_t* ap1, const bf16_t* ap2, const bf16_t* ap3, unsigned mk0, unsigned mk1, unsigned mk2, unsigned mk3, const bf16_t* __restrict__ Bt, int ldb, int K, char* smem, Epi epi) {
    const int tid = TID, lane = tid & 63, w = tid >> 6, h = lane >> 5, r = lane & 31;
    const int wm = w >> 1, wn = w & 1;
    const int lr = tid >> 3, kc = tid & 7;
    ap0 += kc * 8; ap1 += kc * 8; ap2 += kc * 8; ap3 += kc * 8;
    const bf16_t* bp0 = Bt + (size_t)lr * ldb + kc * 8;
    const bf16_t* bp1 = bp0 + (size_t)32 * ldb; const bf16_t* bp2 = bp0 + (size_t)64 * ldb; const bf16_t* bp3 = bp0 + (size_t)96 * ldb;
    f32x16 acc00 = zero16(), acc01 = zero16(), acc10 = zero16(), acc11 = zero16();
    float ss0 = 0.f, ss1 = 0.f, ss2 = 0.f, ss3 = 0.f;
    uint4 ra0, ra1, ra2, ra3, rb0, rb1, rb2, rb3;
    const int nk = K >> 6;
#define GLOAD(k0) { ra0 = *(const uint4*)(ap0 + (k0)); ra1 = *(const uint4*)(ap1 + (k0)); ra2 = *(const uint4*)(ap2 + (k0)); ra3 = *(const uint4*)(ap3 + (k0)); \
                    rb0 = *(const uint4*)(bp0 + (k0)); rb1 = *(const uint4*)(bp1 + (k0)); rb2 = *(const uint4*)(bp2 + (k0)); rb3 = *(const uint4*)(bp3 + (k0)); }
#define SSQ(ssv, rv) { if (SS) { float f_[8]; unpack8(rv, f_); ssv += f_[0]*f_[0] + f_[1]*f_[1] + f_[2]*f_[2] + f_[3]*f_[3] + f_[4]*f_[4] + f_[5]*f_[5] + f_[6]*f_[6] + f_[7]*f_[7]; } }
#define MSK(rv, mk) { rv.x &= mk; rv.y &= mk; rv.z &= mk; rv.w &= mk; }
#define SWRITE(s_) { if (HALO) { MSK(ra0, mk0) MSK(ra1, mk1) MSK(ra2, mk2) MSK(ra3, mk3) } bf16_t* As_ = (bf16_t*)(smem + (s_) * 36864) + lr * GP + kc * 8; bf16_t* Bs_ = As_ + 128 * GP; \
                     *(uint4*)(As_) = ra0; *(uint4*)(As_ + 32 * GP) = ra1; *(uint4*)(As_ + 64 * GP) = ra2; *(uint4*)(As_ + 96 * GP) = ra3; \
                     *(uint4*)(Bs_) = rb0; *(uint4*)(Bs_ + 32 * GP) = rb1; *(uint4*)(Bs_ + 64 * GP) = rb2; *(uint4*)(Bs_ + 96 * GP) = rb3; \
                     SSQ(ss0, ra0) SSQ(ss1, ra1) SSQ(ss2, ra2) SSQ(ss3, ra3) }
    GLOAD(0) SWRITE(0) __syncthreads();
#pragma unroll 1
    for (int kt = 0; kt < nk; ++kt) {
        if (kt + 1 < nk) GLOAD((kt + 1) * 64)
        {
            const bf16_t* As = (const bf16_t*)(smem + (kt & 1) * 36864) + (wm * 64 + r) * GP + h * 8;
            const bf16_t* Bs = (const bf16_t*)(smem + (kt & 1) * 36864) + 128 * GP + (wn * 64 + r) * GP + h * 8;
#pragma unroll
            for (int ks = 0; ks < 4; ++ks) {
                const bf16x8 a0 = *(const bf16x8*)(As + ks * 16), a1 = *(const bf16x8*)(As + 32 * GP + ks * 16);
                const bf16x8 b0 = *(const bf16x8*)(Bs + ks * 16), b1 = *(const bf16x8*)(Bs + 32 * GP + ks * 16);
                acc00 = MFMA(a0, b0, acc00); acc01 = MFMA(a0, b1, acc01); acc10 = MFMA(a1, b0, acc10); acc11 = MFMA(a1, b1, acc11);
            }
        }
        if (kt + 1 < nk) SWRITE((kt + 1) & 1)
        __syncthreads();
    }
#undef GLOAD
#undef SWRITE
#undef SSQ
#undef MSK
    float* Cs = (float*)smem;
    {
        float* cb = Cs + (wm * 64 + 4 * h) * CP + wn * 64 + r;
#pragma unroll
        for (int g = 0; g < 16; ++g) {
            const int ro = (g & 3) + 8 * (g >> 2);
            cb[ro * CP] = acc00[g]; cb[ro * CP + 32] = acc01[g]; cb[(ro + 32) * CP] = acc10[g]; cb[(ro + 32) * CP + 32] = acc11[g];
        }
    }
    if (SS) {
        float* rowss = (float*)(smem + ROWSS_OFF);
        ss0 += __shfl_xor(ss0, 1); ss0 += __shfl_xor(ss0, 2); ss0 += __shfl_xor(ss0, 4);
        ss1 += __shfl_xor(ss1, 1); ss1 += __shfl_xor(ss1, 2); ss1 += __shfl_xor(ss1, 4);
        ss2 += __shfl_xor(ss2, 1); ss2 += __shfl_xor(ss2, 2); ss2 += __shfl_xor(ss2, 4);
        ss3 += __shfl_xor(ss3, 1); ss3 += __shfl_xor(ss3, 2); ss3 += __shfl_xor(ss3, 4);
        if (kc == 0) { rowss[lr] = ss0; rowss[lr + 32] = ss1; rowss[lr + 64] = ss2; rowss[lr + 96] = ss3; }
    }
    __syncthreads();
    epi((const float*)smem, (const float*)(smem + ROWSS_OFF));
    __syncthreads();
}


DI int g_row(int i) { return ((i * 8 + (int)(threadIdx.x >> 6)) * 8) + (int)((threadIdx.x & 63) >> 3); }
DI int b_perm(int row) { return ((row >> 5) & 1) * 128 + (row >> 6) * 32 + (row & 31); }
DI int g_chunk(int row) { return (int)(threadIdx.x & 7) ^ ((row >> 1) & 7); }
#define GLDS(g_, l_) __builtin_amdgcn_global_load_lds((const unsigned*)(g_), (unsigned*)(l_), 16, 0, 0)
template <int NH = -1, class Epi>
DI void gemm256(const char* wsb, const bf16_t* a0p, const bf16_t* a1p, const bf16_t* a2p, const bf16_t* a3p,
                const bf16_t* b0p, const bf16_t* b1p, const bf16_t* b2p, const bf16_t* b3p, int K, char* smem_all, Epi epi) {
    const unsigned a0 = (unsigned)((const char*)a0p - wsb), a1 = (unsigned)((const char*)a1p - wsb), a2 = (unsigned)((const char*)a2p - wsb), a3 = (unsigned)((const char*)a3p - wsb);
    const unsigned b0 = (unsigned)((const char*)b0p - wsb), b1 = (unsigned)((const char*)b1p - wsb), b2 = (unsigned)((const char*)b2p - wsb), b3 = (unsigned)((const char*)b3p - wsb);
    const int lane = threadIdx.x & 63, wid = __builtin_amdgcn_readfirstlane(threadIdx.x >> 6), wr = wid >> 2, wc = wid & 3, fr = lane & 15, fq = lane >> 4;
    f32x4 acc[8][4];
#pragma unroll
    for (int m = 0; m < 8; ++m)
#pragma unroll
        for (int n = 0; n < 4; ++n) acc[m][n] = (f32x4){0.f, 0.f, 0.f, 0.f};
#define STAGE256(buf, k0) { char* sa_ = smem_all + (buf) * 65536 + wid * 1024; char* sb_ = sa_ + 32768; const char* wk_ = wsb + (size_t)(k0) * 2; \
        GLDS(wk_ + a0, sa_); GLDS(wk_ + a1, sa_ + 8192); GLDS(wk_ + a2, sa_ + 16384); GLDS(wk_ + a3, sa_ + 24576); \
        if (NH < 0 || (wid >> 2) == NH) { GLDS(wk_ + b0, sb_); GLDS(wk_ + b1, sb_ + 8192); GLDS(wk_ + b2, sb_ + 16384); GLDS(wk_ + b3, sb_ + 24576); } }
    const int sw = (fr >> 1) & 7;
    const unsigned offA = (wr * 128 + fr) * 128, offB = 32768 + (wc * 64 + fr) * 128;
    const unsigned co0 = ((0 + fq) ^ sw) << 4, co1 = ((4 + fq) ^ sw) << 4;
    const unsigned lds0 = (unsigned)(size_t)smem_all;
    const int nt = K >> 6;
    STAGE256(0, 0)
    asm volatile("s_waitcnt vmcnt(0)" ::: "memory");
    __syncthreads();
#pragma unroll 1
    for (int t = 0; t < nt; ++t) {
        const int cur = t & 1;
        if (t + 1 < nt) STAGE256(cur ^ 1, (t + 1) * 64)
        const unsigned lb = lds0 + cur * 65536;
        const unsigned aA0 = lb + offA + co0, aA1 = lb + offA + co1, aB0 = lb + offB + co0, aB1 = lb + offB + co1;
        bf16x8 Bq0[4], Bq1[4], Aq0[2], Aq1[2];
#define DSR(dst, addr, off) asm volatile("ds_read_b128 %0, %1 offset:%2" : "=v"(dst) : "v"(addr), "n"(off) : "memory")
#define LDA2(dst, addr, mo) { DSR(dst[0], addr, (mo) * 2048); DSR(dst[1], addr, ((mo) + 1) * 2048); }
#define LDB4(dst, addr) { DSR(dst[0], addr, 0); DSR(dst[1], addr, 2048); DSR(dst[2], addr, 4096); DSR(dst[3], addr, 6144); }
#define WAIT_A(n, X) asm volatile("s_waitcnt lgkmcnt(" #n ")" : "+v"(X[0]), "+v"(X[1]) :: "memory")
#define WAIT_AB(n, X, Y) asm volatile("s_waitcnt lgkmcnt(" #n ")" : "+v"(X[0]), "+v"(X[1]), "+v"(Y[0]), "+v"(Y[1]), "+v"(Y[2]), "+v"(Y[3]) :: "memory")
#define MM8(Aq, Bq, mo) { _Pragma("unroll") for (int m = 0; m < 2; ++m) _Pragma("unroll") for (int n = 0; n < 4; ++n) if (NH < 0 || (n >> 1) == NH) acc[(mo) + m][n] = MFMA16(Bq[n], Aq[m], acc[(mo) + m][n]); }
        LDB4(Bq0, aB0) LDA2(Aq0, aA0, 0) LDA2(Aq1, aA0, 2)
        WAIT_AB(2, Aq0, Bq0);
        MM8(Aq0, Bq0, 0)
        LDA2(Aq0, aA0, 4)
        WAIT_A(2, Aq1);
        MM8(Aq1, Bq0, 2)
        LDA2(Aq1, aA0, 6) LDB4(Bq1, aB1)
        WAIT_A(6, Aq0);
        MM8(Aq0, Bq0, 4)
        LDA2(Aq0, aA1, 0)
        WAIT_A(6, Aq1);
        MM8(Aq1, Bq0, 6)
        LDA2(Aq1, aA1, 2)
        WAIT_AB(2, Aq0, Bq1);
        MM8(Aq0, Bq1, 0)
        LDA2(Aq0, aA1, 4)
        WAIT_A(2, Aq1);
        MM8(Aq1, Bq1, 2)
        LDA2(Aq1, aA1, 6)
        WAIT_A(2, Aq0);
        MM8(Aq0, Bq1, 4)
        WAIT_A(0, Aq1);
        MM8(Aq1, Bq1, 6)
#undef DSR
#undef LDA2
#undef LDB4
#undef WAIT_A
#undef WAIT_AB
#undef MM8
        asm volatile("s_waitcnt vmcnt(0)" ::: "memory");
        __syncthreads();
    }
#undef STAGE256
    int t_ = threadIdx.x;
    asm volatile("" : "+v"(t_));
    const int lane_ = t_ & 63, wid_ = t_ >> 6, wr_ = wid_ >> 2, wc_ = wid_ & 3, fr_ = lane_ & 15, fq_ = lane_ >> 4, hb_ = t_ >> 8;
#pragma unroll
    for (int p = 0; p < 2; ++p) {
        if (NH >= 0 && p != NH) continue;
        {
            float* Cs = (float*)(smem_all + wr_ * HB_SMEM) + fr_ * CP + wc_ * 32 + 4 * fq_;
#pragma unroll
            for (int m = 0; m < 8; ++m)
#pragma unroll
                for (int n = 0; n < 2; ++n) *(f32x4*)(Cs + (m * 16) * CP + n * 16) = acc[m][2 * p + n];
        }
        __syncthreads();
        epi((const float*)(smem_all + hb_ * HB_SMEM), hb_, p, t_ & 255);
        __syncthreads();
    }
}

DI void epi_store_bf16(const float* Cs, bf16_t* dst, int ld, int tid) {
#pragma unroll 2
    for (int j = 0; j < 8; ++j) {
        int c = tid + 256 * j, row = c >> 4, cc = c & 15;
        const float4* cp = (const float4*)(Cs + row * CP + cc * 8);
        float4 f0 = cp[0], f1 = cp[1];
        float v[8] = {f0.x, f0.y, f0.z, f0.w, f1.x, f1.y, f1.z, f1.w};
        *(uint4*)(dst + (size_t)row * ld + cc * 8) = pack8(v);
    }
}
DI void epi_resid(const float* Cs, const float* src, float* dst, const float* gate, int tid) {
#pragma unroll 4
    for (int j = 0; j < 16; ++j) {
        int c = tid + 256 * j, row = c >> 5, c4 = c & 31;
        float4 cv = *(const float4*)(Cs + row * CP + c4 * 4);
        float4 sv = *(const float4*)(src + (size_t)row * 1024 + c4 * 4);
        float4 gv = *(const float4*)(gate + c4 * 4);
        float4 o; o.x = sv.x + gv.x * cv.x; o.y = sv.y + gv.y * cv.y; o.z = sv.z + gv.z * cv.z; o.w = sv.w + gv.w * cv.w;
        *(float4*)(dst + (size_t)row * 1024 + c4 * 4) = o;
    }
}

DI int wsrc_col(int mode, int tn, int c) {
    if (mode == 0) return tn * 128 + c;
    if (mode == 1) {
        const int np = tn * 128;
        if (np < 512) return 672 + np + c;
        if (np < 640) return 1184 + np - 512 + c;
        if (np < 768) return 1312 + np - 640 + c;
        if (np < 1152) return np - 768 + c;
        if (np < 1408) return 384 + np - 1152 + c;
        return c < 32 ? 640 + c : -1;
    }
    if (mode == 2) return c < 96 ? tn * 96 + c : -1;
    return c < 64 ? 64 * tn + c : 2816 + 64 * tn + c - 64;
}
DI void wtile(const float* __restrict__ src, int Nsrc, const float* __restrict__ g, bf16_t* __restrict__ dst, int K, int k0, int tn, int mode, char* smem) {
    bf16_t* T = (bf16_t*)smem;
    const int tid = TID, lane = tid & 63, w = tid >> 6, rsub = lane >> 5, c4 = (lane & 31) * 4;
    int sc = wsrc_col(mode, tn, c4);
    if (sc >= Nsrc) sc = -1;
#pragma unroll 8
    for (int i = 0; i < 16; ++i) {
        const int rr = w * 32 + 2 * i + rsub;
        float4 v = make_float4(0.f, 0.f, 0.f, 0.f);
        if (sc >= 0) { v = *(const float4*)(src + (size_t)(k0 + rr) * Nsrc + sc); if (g) { const float gg = g[k0 + rr]; v.x *= gg; v.y *= gg; v.z *= gg; v.w *= gg; } }
        T[(c4 + 0) * 130 + rr] = f2bf(v.x);
        T[(c4 + 1) * 130 + rr] = f2bf(v.y);
        T[(c4 + 2) * 130 + rr] = f2bf(v.z);
        T[(c4 + 3) * 130 + rr] = f2bf(v.w);
    }
    __syncthreads();
#pragma unroll
    for (int j = 0; j < 8; ++j) {
        const int c = tid + 256 * j, n = c >> 4, kc = c & 15;
        const unsigned* s32 = (const unsigned*)(T + n * 130 + kc * 8);
        uint4 o; o.x = s32[0]; o.y = s32[1]; o.z = s32[2]; o.w = s32[3];
        *(uint4*)(dst + (size_t)(tn * 128 + n) * K + k0 + kc * 8) = o;
    }
    __syncthreads();
}

DI void mod_item(const Params& p, int item, char* smem) {
    const int tid = TID, lane = tid & 63, w = tid >> 6, hl = lane >> 5, cl = lane & 31;
    const int l = item / 192, n0 = (item % 192) * 32;
    float* sl = (float*)smem;
    for (int i = tid; i < 9216; i += 256) {
        int rr = i >> 10, k = i & 1023;
        float cv = rr < 8 ? p.c[rr * 1024 + k] : p.c_ctx[k];
        sl[i] = cv / (1.f + expf(-cv));
    }
    __syncthreads();
    float acc[9];
#pragma unroll
    for (int q = 0; q < 9; ++q) acc[q] = 0.f;
    const float* wp = p.ada_w + (size_t)l * 1024 * 6144 + n0 + cl;
#pragma unroll 16
    for (int kk = 0; kk < 128; ++kk) {
        const int k = w * 256 + 2 * kk + hl;
        float wv = wp[(size_t)k * 6144];
#pragma unroll
        for (int q = 0; q < 9; ++q) acc[q] += sl[q * 1024 + k] * wv;
    }
    float* red = (float*)(smem + 36864);
#pragma unroll
    for (int q = 0; q < 9; ++q) red[((w * 2 + hl) * 9 + q) * 32 + cl] = acc[q];
    __syncthreads();
    float* MOD = (float*)(p.ws + OFF_MOD);
    for (int i = tid; i < 288; i += 256) {
        int q = i >> 5, ln = i & 31;
        float sacc = 0.f;
#pragma unroll
        for (int u = 0; u < 8; ++u) sacc += red[(u * 9 + q) * 32 + ln];
        sacc += p.ada_b[l * 6144 + n0 + ln];
        MOD[(size_t)(l * 9 + q) * 6144 + n0 + ln] = sacc;
    }
    __syncthreads();
}

DI void sincos_d(double x, float& s, float& c) {
    const double TWO_PI = 6.283185307179586476925;
    double t = x / TWO_PI;
    t -= rint(t);
    double y = t * TWO_PI, y2 = y * y;
    double sv = y, cv = 1.0, ts = y, tc = 1.0;
#pragma unroll 1
    for (int k = 1; k <= 14; ++k) {
        tc *= -y2 / (double)((2 * k - 1) * (2 * k));
        ts *= -y2 / (double)((2 * k) * (2 * k + 1));
        cv += tc; sv += ts;
    }
    s = (float)sv; c = (float)cv;
}

DI void rope_tables(const Params& p) {
    float* TG = (float*)(p.ws + OFF_TABG);
    float* TM = (float*)(p.ws + OFF_TABM);
    for (int i = TID; i < 1024; i += 256) {
        int v = i >> 4, f = i & 15;
        float inv = exp2f(-(float)f / 16.f * 13.287712379549449f);
        float ang = (float)v * inv, s, c;
        sincos_d((double)ang, s, c);
        TG[i] = c; TG[1024 + i] = s;
    }
    for (int i = TID; i < 512; i += 256) {
        int v = i >> 3, f = i & 7;
        float inv = exp2f(-(float)f / 8.f * 13.287712379549449f);
        float ang = (float)v * inv, s, c;
        sincos_d((double)ang, s, c);
        TM[i] = c; TM[512 + i] = s;
    }
}

constexpr int NW = 10;
constexpr int N_WT = 8 * 12 + 3 * 8 + 2 * 8 + 8 * 8 + 8 * 44 + 22 * 8 + 8 * 44 + 22 * 8 + 8 * 26 + 8 * 8;
constexpr int N_MOD = 384;
constexpr int N_P0 = N_MOD + N_WT;
static_assert(N_P0 % 2 == 0 && N_MOD % 2 == 0, "phase 0 items are dealt to half-block pairs");

DI void phase0(const Params& p, char* smem_all) {
    char* smem = smem_all + HBI * HB_SMEM;
    if (blockIdx.x == gridDim.x - 1) {
        if (HBI == 0) rope_tables(p);
        else { for (int i = TID; i < 512; i += 256) ((uint4*)(p.ws + OFF_ZROW))[i] = make_uint4(0, 0, 0, 0); }
    }
    for (int it0 = blockIdx.x * 2; it0 < N_P0; it0 += gridDim.x * 2) {
        const int item = it0 + HBI;
        if (item < N_MOD) { mod_item(p, item, smem); continue; }
        int t = item - N_MOD;
        int wi = 0;
        int cnt[NW] = {8 * 12, 3 * 8, 2 * 8, 8 * 8, 8 * 44, 22 * 8, 8 * 44, 22 * 8, 8 * 26, 8 * 8};
#pragma unroll
        for (int i = 0; i < NW - 1; ++i) { if (wi == i && t >= cnt[i]) { t -= cnt[i]; wi = i + 1; } }
        const float* src; const float* g = nullptr; bf16_t* dst; int K, Nsrc, ntn, mode;
        switch (wi) {
            case 0: src = p.att_w_in; dst = (bf16_t*)(p.ws + OFF_WT_IN0); K = 1024; Nsrc = 1440; ntn = 12; mode = 1; break;
            case 1: src = p.mla_w_qb; g = p.mla_qa_g; dst = (bf16_t*)(p.ws + OFF_WT_QB); K = 384; Nsrc = 768; ntn = 8; mode = 2; break;
            case 2: src = p.mla_w_kvb; g = p.mla_kva_g; dst = (bf16_t*)(p.ws + OFF_WT_KVB); K = 256; Nsrc = 1024; ntn = 8; mode = 0; break;
            case 3: src = p.att_w_out; dst = (bf16_t*)(p.ws + OFF_WT_OUT0); K = 1024; Nsrc = 1024; ntn = 8; mode = 0; break;
            case 4: src = p.ffn_w_up; dst = (bf16_t*)(p.ws + OFF_WT_UP0); K = 1024; Nsrc = 5632; ntn = 44; mode = 3; break;
            case 5: src = p.ffn_w_down; dst = (bf16_t*)(p.ws + OFF_WT_DOWN0); K = 2816; Nsrc = 1024; ntn = 8; mode = 0; break;
            case 6: src = p.ffn_w_up + 1024ull * 5632; dst = (bf16_t*)(p.ws + OFF_WT_UP1); K = 1024; Nsrc = 5632; ntn = 44; mode = 3; break;
            case 7: src = p.ffn_w_down + 2816ull * 1024; dst = (bf16_t*)(p.ws + OFF_WT_DOWN1); K = 2816; Nsrc = 1024; ntn = 8; mode = 0; break;
            case 8: src = p.ml_w_in; dst = (bf16_t*)(p.ws + OFF_WT_IN1); K = 1024; Nsrc = 3104; ntn = 26; mode = 0; break;
            default: src = p.ml_w_out; dst = (bf16_t*)(p.ws + OFF_WT_OUT1); K = 1024; Nsrc = 1024; ntn = 8; mode = 0; break;
        }
        const int tn = t % ntn, tk = t / ntn;
        wtile(src, Nsrc, g, dst, K, tk * 128, tn, mode, smem);
    }
}

DI void norm_row_ptrs(int row, const float* srcLat, const float* srcCtx, const float* mod, int shift_idx, const float*& src, const float*& sh) {
    int mb;
    if (row < 16384) { src = srcLat + (size_t)row * 1024; mb = row >> 11; }
    else { src = srcCtx + (size_t)(row - 16384) * 1024; mb = 8; }
    sh = mod + (size_t)mb * 6144 + shift_idx * 1024;
}
DI void norm_row_finish(const float4 (&v)[4], float ss, const float* g, const float* sh, bf16_t* dst, int lane) {
#pragma unroll
    for (int o = 32; o >= 1; o >>= 1) ss += __shfl_xor(ss, o);
    const float rstd = rsqrtf(ss * (1.f / 1024.f) + EPSF);
    const float* sc = sh + 1024;
#pragma unroll
    for (int j = 0; j < 4; ++j) {
        const int c = j * 256 + lane * 4;
        const float4 gv = *(const float4*)(g + c), shv = *(const float4*)(sh + c), scv = *(const float4*)(sc + c);
        const float o0 = v[j].x * rstd * gv.x * (1.f + scv.x) + shv.x;
        const float o1 = v[j].y * rstd * gv.y * (1.f + scv.y) + shv.y;
        const float o2 = v[j].z * rstd * gv.z * (1.f + scv.z) + shv.z;
        const float o3 = v[j].w * rstd * gv.w * (1.f + scv.w) + shv.w;
        uint2 o; o.x = pack2(o0, o1); o.y = pack2(o2, o3);
        *(uint2*)(dst + c) = o;
    }
}
DI void phase_norm(const Params& p, const float* srcLat, const float* srcCtx, const float* g, const float* mod, int shift_idx, int nrows) {
    const int lane = threadIdx.x & 63, w = threadIdx.x >> 6;
    bf16_t* H = (bf16_t*)(p.ws + OFF_H);
    for (int row = (blockIdx.x * 8 + w) * 2; row < nrows; row += gridDim.x * 16) {
        const float *srcA, *shA, *srcB, *shB;
        norm_row_ptrs(row, srcLat, srcCtx, mod, shift_idx, srcA, shA);
        norm_row_ptrs(row + 1, srcLat, srcCtx, mod, shift_idx, srcB, shB);
        float4 va[4], vb[4];
        float sa = 0.f, sb = 0.f;
#pragma unroll
        for (int j = 0; j < 4; ++j) { va[j] = *(const float4*)(srcA + j * 256 + lane * 4); vb[j] = *(const float4*)(srcB + j * 256 + lane * 4); }
#pragma unroll
        for (int j = 0; j < 4; ++j) { sa += va[j].x * va[j].x + va[j].y * va[j].y + va[j].z * va[j].z + va[j].w * va[j].w; sb += vb[j].x * vb[j].x + vb[j].y * vb[j].y + vb[j].z * vb[j].z + vb[j].w * vb[j].w; }
        norm_row_finish(va, sa, g, shA, H + (size_t)row * 1024, lane);
        norm_row_finish(vb, sb, g, shB, H + (size_t)(row + 1) * 1024, lane);
    }
}

template <int Q>
DI void rope_apply(float* v, const float* tab, int rw, int cl) {
#pragma unroll
    for (int f = 0; f < Q; ++f) {
        float cr = tab[rw * Q + f], sr = tab[64 * Q + rw * Q + f], cc = tab[cl * Q + f], sc = tab[64 * Q + cl * Q + f];
        float a1 = v[f], a2 = v[Q + f], b1 = v[2 * Q + f], b2 = v[3 * Q + f];
        v[f] = a1 * cr - a2 * sr; v[Q + f] = a2 * cr + a1 * sr;
        v[2 * Q + f] = b1 * cc - b2 * sc; v[3 * Q + f] = b2 * cc + b1 * sc;
    }
}

DI void phase_inproj0(const Params& p, char* smem_all) {
    const bf16_t* H = (const bf16_t*)(p.ws + OFF_H);
    const bf16_t* W = (const bf16_t*)(p.ws + OFF_WT_IN0);
    const float* TG = (const float*)(p.ws + OFF_TABG);
    for (int id = blockIdx.x; id < 72 * 6; id += gridDim.x) {
        const int nt2 = id / 72, mt2 = id % 72;
        auto epi = [&](const float* Cs, int si, int sj, int tid) {
            const int nt = 2 * nt2 + sj, m0 = (2 * mt2 + si) * 128;
            int b, t0; bool lat; row_info(m0, b, t0, lat);
            const int s0 = lat ? 256 + t0 : t0;
            if (nt < 5) {
                const int row = tid & 127, half = tid >> 7;
                const float4* cp = (const float4*)(Cs + row * CP + half * 64);
                float ss = 0.f;
#pragma unroll
                for (int i = 0; i < 16; ++i) { float4 f = cp[i]; ss += f.x * f.x + f.y * f.y + f.z * f.z + f.w * f.w; }
                const float rstd = rsqrtf(ss * (1.f / 64.f) + EPSF);
                const float* g = nt < 4 ? p.gqa_q_g : p.gqa_k_g;
                const float osc = nt < 4 ? 0.125f * LOG2E : 1.f;
                bf16_t* dst;
                if (nt < 4) dst = (bf16_t*)(p.ws + OFF_QG) + ((size_t)(b * 2304 + s0 + row) * 8 + nt * 2 + half) * 64;
                else dst = (bf16_t*)(p.ws + OFF_KG) + ((size_t)(b * 2304 + s0 + row) * 2 + half) * 64;
                const int t = t0 + row;
#pragma unroll 1
                for (int hh = 0; hh < 2; ++hh) {
                    float v[32];
#pragma unroll
                    for (int i = 0; i < 8; ++i) { float4 f = cp[hh * 8 + i]; const float4 gv = *(const float4*)(g + hh * 32 + 4 * i);
                        v[4 * i] = f.x * rstd * gv.x; v[4 * i + 1] = f.y * rstd * gv.y; v[4 * i + 2] = f.z * rstd * gv.z; v[4 * i + 3] = f.w * rstd * gv.w; }
                    if (lat) {
                        const int pos = hh ? (t & 63) : (t >> 6);
#pragma unroll
                        for (int f = 0; f < 16; ++f) {
                            const float c_ = TG[pos * 16 + f], s_ = TG[1024 + pos * 16 + f];
                            const float x1 = v[f], x2 = v[16 + f];
                            v[f] = x1 * c_ - x2 * s_; v[16 + f] = x2 * c_ + x1 * s_;
                        }
                    }
#pragma unroll
                    for (int i = 0; i < 32; ++i) v[i] *= osc;
#pragma unroll
                    for (int i = 0; i < 4; ++i) *(uint4*)(dst + hh * 32 + i * 8) = pack8(v + i * 8);
                }
            } else if (nt == 5) {
                const int dall = tid & 127, ch0 = (tid >> 7) * 8;
                bf16_t* dst = (bf16_t*)(p.ws + OFF_VGT) + ((size_t)(b * 2 + (dall >> 6)) * 64 + (dall & 63)) * 2304 + s0;
#pragma unroll 2
                for (int ch = 0; ch < 8; ++ch) {
                    float v[8];
#pragma unroll
                    for (int i = 0; i < 8; ++i) v[i] = Cs[((ch0 + ch) * 8 + i) * CP + dall];
                    *(uint4*)(dst + (ch0 + ch) * 8) = pack8(v);
                }
            } else if (nt < 9) {
                epi_store_bf16(Cs, (bf16_t*)(p.ws + OFF_CQ) + (size_t)m0 * 384 + (nt - 6) * 128, 384, tid);
            } else if (nt < 11) {
                epi_store_bf16(Cs, (bf16_t*)(p.ws + OFF_CKV) + (size_t)m0 * 256 + (nt - 9) * 128, 256, tid);
            } else {
                const int row = tid >> 1, half = tid & 1;
                float* dst = (float*)(p.ws + OFF_KR) + (size_t)(m0 + row) * 32 + half * 16;
                const float4* cp = (const float4*)(Cs + row * CP + half * 16);
#pragma unroll
                for (int i = 0; i < 4; ++i) ((float4*)dst)[i] = cp[i];
            }
        };
        const int r0 = g_row(0), r1 = g_row(1), r2 = g_row(2), r3 = g_row(3);
        const bf16_t* Ab = H + (size_t)mt2 * 256 * 1024;
        const bf16_t* Bb = W + (size_t)nt2 * 256 * 1024;
        gemm256(p.ws, Ab + (size_t)r0 * 1024 + g_chunk(r0) * 8, Ab + (size_t)r1 * 1024 + g_chunk(r1) * 8, Ab + (size_t)r2 * 1024 + g_chunk(r2) * 8, Ab + (size_t)r3 * 1024 + g_chunk(r3) * 8,
                Bb + (size_t)b_perm(r0) * 1024 + g_chunk(r0) * 8, Bb + (size_t)b_perm(r1) * 1024 + g_chunk(r1) * 8, Bb + (size_t)b_perm(r2) * 1024 + g_chunk(r2) * 8, Bb + (size_t)b_perm(r3) * 1024 + g_chunk(r3) * 8,
                1024, smem_all, epi);
    }
}

DI void phase_mla_up(const Params& p, char* smem_all) {
    char* smem = smem_all + HBI * HB_SMEM;
    const float* TM = (const float*)(p.ws + OFF_TABM);
    for (int id0 = blockIdx.x * 2; id0 < 144 * 16; id0 += gridDim.x * 2) {
        const int id = id0 + HBI;
        const int nt = (id / 144) & 7, isKV = (id / 144) >> 3, mt = id % 144, m0 = mt * 128;
        int b, t0; bool lat; row_info(m0, b, t0, lat);
        const int s0 = lat ? 256 + t0 : t0;
        if (!isKV) {
            const bf16_t* A = (const bf16_t*)(p.ws + OFF_CQ);
#undef AROW
#define AROW(o_) (A + (size_t)(m0 + (TID >> 3) + (o_)) * 384)
            auto epi = [&](const float* Cs, const float* rowss) {
                const int tid = TID, row = tid >> 1, part = tid & 1;
                const float r1 = rsqrtf(rowss[row] * (1.f / 384.f) + EPSF);
                float v[48];
                const float4* cp = (const float4*)(Cs + row * CP + part * 48);
                float ss = 0.f;
#pragma unroll
                for (int i = 0; i < 12; ++i) { float4 f = cp[i]; v[4 * i] = f.x * r1; v[4 * i + 1] = f.y * r1; v[4 * i + 2] = f.z * r1; v[4 * i + 3] = f.w * r1; }
#pragma unroll
                for (int i = 0; i < 48; ++i) ss += v[i] * v[i];
                ss += __shfl_xor(ss, 1);
                const float r2 = rsqrtf(ss * (1.f / 96.f) + EPSF);
                const float* g = p.mla_q_g + part * 48;
#pragma unroll
                for (int i = 0; i < 48; ++i) v[i] = v[i] * r2 * g[i];
                if (lat && part == 1) { int t = t0 + row; rope_apply<8>(v + 16, TM, t >> 6, t & 63); }
                const float sc = 0.10206207261596575f * LOG2E;
#pragma unroll
                for (int i = 0; i < 48; ++i) v[i] *= sc;
                bf16_t* dst = (bf16_t*)(p.ws + OFF_QM) + ((size_t)(b * 2304 + s0 + row) * 8 + nt) * 96 + part * 48;
#pragma unroll
                for (int i = 0; i < 6; ++i) *(uint4*)(dst + i * 8) = pack8(v + i * 8);
            };
            gemm_tile<true, false>(AROW(0), AROW(32), AROW(64), AROW(96), 0u, 0u, 0u, 0u, (const bf16_t*)(p.ws + OFF_WT_QB) + (size_t)nt * 128 * 384, 384, 384, smem, epi);
        } else {
            const bf16_t* A = (const bf16_t*)(p.ws + OFF_CKV);
#undef AROW
#define AROW(o_) (A + (size_t)(m0 + (TID >> 3) + (o_)) * 256)
            auto epi = [&](const float* Cs, const float* rowss) {
                const int tid = TID;
                {
                    const int row = tid >> 1, part = tid & 1;
                    const float r1 = rsqrtf(rowss[row] * (1.f / 256.f) + EPSF);
                    float v[48];
                    if (part == 0) {
                        const float4* cp = (const float4*)(Cs + row * CP);
#pragma unroll
                        for (int i = 0; i < 12; ++i) { float4 f = cp[i]; v[4 * i] = f.x * r1; v[4 * i + 1] = f.y * r1; v[4 * i + 2] = f.z * r1; v[4 * i + 3] = f.w * r1; }
                    } else {
                        const float4* cp = (const float4*)(Cs + row * CP + 48);
#pragma unroll
                        for (int i = 0; i < 4; ++i) { float4 f = cp[i]; v[4 * i] = f.x * r1; v[4 * i + 1] = f.y * r1; v[4 * i + 2] = f.z * r1; v[4 * i + 3] = f.w * r1; }
                        const float4* kp = (const float4*)((const float*)(p.ws + OFF_KR) + (size_t)(m0 + row) * 32);
#pragma unroll
                        for (int i = 0; i < 8; ++i) { float4 f = kp[i]; v[16 + 4 * i] = f.x; v[16 + 4 * i + 1] = f.y; v[16 + 4 * i + 2] = f.z; v[16 + 4 * i + 3] = f.w; }
                    }
                    float ss = 0.f;
#pragma unroll
                    for (int i = 0; i < 48; ++i) ss += v[i] * v[i];
                    ss += __shfl_xor(ss, 1);
                    const float r2 = rsqrtf(ss * (1.f / 96.f) + EPSF);
                    const float* g = p.mla_k_g + part * 48;
#pragma unroll
                    for (int i = 0; i < 48; ++i) v[i] = v[i] * r2 * g[i];
                    if (lat && part == 1) { int t = t0 + row; rope_apply<8>(v + 16, TM, t >> 6, t & 63); }
                    bf16_t* dst = (bf16_t*)(p.ws + OFF_KM) + ((size_t)(b * 2304 + s0 + row) * 8 + nt) * 96 + part * 48;
#pragma unroll
                    for (int i = 0; i < 6; ++i) *(uint4*)(dst + i * 8) = pack8(v + i * 8);
                }
                {
                    const int d = tid & 63, cg4 = (tid >> 6) * 4;
                    bf16_t* dst = (bf16_t*)(p.ws + OFF_VMT) + ((size_t)(b * 8 + nt) * 64 + d) * 2304 + s0;
#pragma unroll 1
                    for (int ch = 0; ch < 4; ++ch) {
                        float v[8];
#pragma unroll
                        for (int i = 0; i < 8; ++i) { int rr = (cg4 + ch) * 8 + i; v[i] = Cs[rr * CP + 64 + d] * rsqrtf(rowss[rr] * (1.f / 256.f) + EPSF); }
                        *(uint4*)(dst + (cg4 + ch) * 8) = pack8(v);
                    }
                }
            };
            gemm_tile<true, false>(AROW(0), AROW(32), AROW(64), AROW(96), 0u, 0u, 0u, 0u, (const bf16_t*)(p.ws + OFF_WT_KVB) + (size_t)nt * 128 * 256, 256, 256, smem, epi);
        }
    }
}

template <int DK>
DI void attn_body(const bf16_t* __restrict__ Q, int qstride, const bf16_t* __restrict__ Kp, int kstride, const bf16_t* __restrict__ VT,
                  int nkeys, bf16_t* __restrict__ Odst, char* smem, char* smem_os) {
    constexpr int KP = DK + 8, VP = 72, NST = DK / 16, KCH = DK / 8;
    constexpr int NKL = (64 * KCH) / 256;
    constexpr int STAGE = 64 * KP * 2 + 64 * VP * 2;
    const int tid = TID, lane = tid & 63, w = tid >> 6, h = lane >> 5, r = lane & 31;
    bf16x8 qf[NST];
    {
        const bf16_t* qrow = Q + (size_t)(w * 32 + r) * qstride;
#pragma unroll
        for (int st = 0; st < NST; ++st) qf[st] = *(const bf16x8*)(qrow + st * 16 + h * 8);
    }
    f32x16 o[2]; o[0] = zero16(); o[1] = zero16();
    float m = 0.f, l = 0.f;
    uint4 ak0, ak1 = make_uint4(0, 0, 0, 0), av0, bk0, bk1 = make_uint4(0, 0, 0, 0), bv0;
    const int t5 = threadIdx.x;
    const int kr0 = t5 / KCH, kc0 = t5 % KCH, kr1 = (t5 + 512) / KCH, kc1 = (t5 + 512) % KCH;
    const bool k2 = t5 + 512 < 64 * KCH;
    const int vd0 = t5 >> 3, vc0 = t5 & 7;
#define AGLOAD(P_, key0) { P_##k0 = *(const uint4*)(Kp + (size_t)((key0) + kr0) * kstride + kc0 * 8); if (k2) P_##k1 = *(const uint4*)(Kp + (size_t)((key0) + kr1) * kstride + kc1 * 8); \
                       P_##v0 = *(const uint4*)(VT + (size_t)vd0 * 2304 + (key0) + vc0 * 8); }
#define ASWRITE(P_, s_) { bf16_t* Ks_ = (bf16_t*)(smem + (s_) * STAGE); bf16_t* Vs_ = Ks_ + 64 * KP; \
                      *(uint4*)(Ks_ + kr0 * KP + kc0 * 8) = P_##k0; if (k2) *(uint4*)(Ks_ + kr1 * KP + kc1 * 8) = P_##k1; \
                      *(uint4*)(Vs_ + vd0 * VP + vc0 * 8) = P_##v0; }
    const int nkt = nkeys >> 6;
    AGLOAD(a, 0) ASWRITE(a, 0) AGLOAD(a, 64) AGLOAD(b, 128) __syncthreads();
#pragma unroll 1
    for (int kt = 0; kt < nkt; kt += 2) {
        {
            const bf16_t* Ks = (const bf16_t*)(smem);
            const bf16_t* Vs = Ks + 64 * KP;
            f32x16 s[2];
#pragma unroll
            for (int i = 0; i < 16; ++i) { s[0][i] = -m; s[1][i] = -m; }
#pragma unroll
            for (int st = 0; st < NST; ++st)
#pragma unroll
                for (int kk = 0; kk < 2; ++kk) {
                    bf16x8 a = *(const bf16x8*)(Ks + (kk * 32 + r) * KP + st * 16 + h * 8);
                    s[kk] = MFMA(a, qf[st], s[kk]);
                }
            float mx = s[0][0];
#pragma unroll
            for (int i = 0; i < 16; ++i) { mx = fmaxf(mx, s[0][i]); mx = fmaxf(mx, s[1][i]); }
            mx = fmaxf(mx, __shfl_xor(mx, 32));
            if (__any(mx > 8.f)) {
                const float d = fmaxf(mx, 0.f);
                const float alpha = __builtin_amdgcn_exp2f(-d);
                l *= alpha;
#pragma unroll
                for (int i = 0; i < 16; ++i) { o[0][i] *= alpha; o[1][i] *= alpha; s[0][i] -= d; s[1][i] -= d; }
                m += d;
            }
            float ps = 0.f;
#pragma unroll
            for (int kk = 0; kk < 2; ++kk)
#pragma unroll
                for (int i = 0; i < 16; ++i) { float pv = __builtin_amdgcn_exp2f(s[kk][i]); s[kk][i] = pv; ps += pv; }
            l += ps;
#pragma unroll
            for (int kk = 0; kk < 2; ++kk)
#pragma unroll
                for (int s2 = 0; s2 < 2; ++s2) {
                    const bf16x8 pb = pack_frag(s[kk][8 * s2 + 0], s[kk][8 * s2 + 1], s[kk][8 * s2 + 2], s[kk][8 * s2 + 3], s[kk][8 * s2 + 4], s[kk][8 * s2 + 5], s[kk][8 * s2 + 6], s[kk][8 * s2 + 7]);
#pragma unroll
                    for (int dt = 0; dt < 2; ++dt) {
                        const bf16_t* vp = Vs + (dt * 32 + r) * VP + kk * 32 + 16 * s2 + 4 * h;
                        uint2 lo = *(const uint2*)vp, hi = *(const uint2*)(vp + 8);
                        uint4 vu; vu.x = lo.x; vu.y = lo.y; vu.z = hi.x; vu.w = hi.y;
                        o[dt] = MFMA(__builtin_bit_cast(bf16x8, vu), pb, o[dt]);
                    }
                }
        }
        ASWRITE(a, 1)
        if (kt + 3 < nkt) AGLOAD(a, (kt + 3) * 64)
        LDS_BARRIER();
        {
            const bf16_t* Ks = (const bf16_t*)(smem + STAGE);
            const bf16_t* Vs = Ks + 64 * KP;
            f32x16 s[2];
#pragma unroll
            for (int i = 0; i < 16; ++i) { s[0][i] = -m; s[1][i] = -m; }
#pragma unroll
            for (int st = 0; st < NST; ++st)
#pragma unroll
                for (int kk = 0; kk < 2; ++kk) {
                    bf16x8 a = *(const bf16x8*)(Ks + (kk * 32 + r) * KP + st * 16 + h * 8);
                    s[kk] = MFMA(a, qf[st], s[kk]);
                }
            float mx = s[0][0];
#pragma unroll
            for (int i = 0; i < 16; ++i) { mx = fmaxf(mx, s[0][i]); mx = fmaxf(mx, s[1][i]); }
            mx = fmaxf(mx, __shfl_xor(mx, 32));
            if (__any(mx > 8.f)) {
                const float d = fmaxf(mx, 0.f);
                const float alpha = __builtin_amdgcn_exp2f(-d);
                l *= alpha;
#pragma unroll
                for (int i = 0; i < 16; ++i) { o[0][i] *= alpha; o[1][i] *= alpha; s[0][i] -= d; s[1][i] -= d; }
                m += d;
            }
            float ps = 0.f;
#pragma unroll
            for (int kk = 0; kk < 2; ++kk)
#pragma unroll
                for (int i = 0; i < 16; ++i) { float pv = __builtin_amdgcn_exp2f(s[kk][i]); s[kk][i] = pv; ps += pv; }
            l += ps;
#pragma unroll
            for (int kk = 0; kk < 2; ++kk)
#pragma unroll
                for (int s2 = 0; s2 < 2; ++s2) {
                    const bf16x8 pb = pack_frag(s[kk][8 * s2 + 0], s[kk][8 * s2 + 1], s[kk][8 * s2 + 2], s[kk][8 * s2 + 3], s[kk][8 * s2 + 4], s[kk][8 * s2 + 5], s[kk][8 * s2 + 6], s[kk][8 * s2 + 7]);
#pragma unroll
                    for (int dt = 0; dt < 2; ++dt) {
                        const bf16_t* vp = Vs + (dt * 32 + r) * VP + kk * 32 + 16 * s2 + 4 * h;
                        uint2 lo = *(const uint2*)vp, hi = *(const uint2*)(vp + 8);
                        uint4 vu; vu.x = lo.x; vu.y = lo.y; vu.z = hi.x; vu.w = hi.y;
                        o[dt] = MFMA(__builtin_bit_cast(bf16x8, vu), pb, o[dt]);
                    }
                }
        }
        if (kt + 2 < nkt) ASWRITE(b, 0)
        if (kt + 4 < nkt) AGLOAD(b, (kt + 4) * 64)
        LDS_BARRIER();
    }
#undef AGLOAD
#undef ASWRITE
    l += __shfl_xor(l, 32);
    const float inv = 1.f / l;
    bf16_t* Os = (bf16_t*)smem_os + (size_t)w * 32 * 72;
#pragma unroll
    for (int dt = 0; dt < 2; ++dt)
#pragma unroll
        for (int g = 0; g < 4; ++g) {
            uint2 u; u.x = pack2(o[dt][4 * g] * inv, o[dt][4 * g + 1] * inv); u.y = pack2(o[dt][4 * g + 2] * inv, o[dt][4 * g + 3] * inv);
            *(uint2*)(Os + r * 72 + dt * 32 + 8 * g + 4 * h) = u;
        }
    __syncthreads();
#pragma unroll
    for (int j = 0; j < 4; ++j) {
        int c = lane + 64 * j, row = c >> 3, cc = c & 7;
        uint4 u = *(const uint4*)(Os + row * 72 + cc * 8);
        *(uint4*)(Odst + (size_t)(w * 32 + row) * 1024 + cc * 8) = u;
    }
    __syncthreads();
}

DI void phase_attn(const Params& p, char* smem_all) {
    char* smem = smem_all;
    char* smem_os = smem_all + 65536 + HBI * 20480;
    bf16_t* O = (bf16_t*)(p.ws + OFF_H);
    for (int it0 = blockIdx.x * 2; it0 < 2304; it0 += gridDim.x * 2) {
        const int item = it0 + HBI;
        int b, kind, hq, qb, nkeys, sq0, orow;
        if (item < 2048) { qb = item & 15; hq = (item >> 4) & 7; kind = (item >> 7) & 1; b = item >> 8; sq0 = 256 + qb * 128; nkeys = 2304; orow = b * 2048 + qb * 128; }
        else { int it = item - 2048; qb = it & 1; hq = (it >> 1) & 7; kind = (it >> 4) & 1; b = it >> 5; sq0 = qb * 128; nkeys = 256; orow = 16384 + b * 256 + qb * 128; }
        bf16_t* od = O + (size_t)orow * 1024 + kind * 512 + hq * 64;
        if (kind == 0) {
            const bf16_t* Q = (const bf16_t*)(p.ws + OFF_QM) + ((size_t)(b * 2304 + sq0) * 8 + hq) * 96;
            const bf16_t* K = (const bf16_t*)(p.ws + OFF_KM) + ((size_t)(b * 2304) * 8 + hq) * 96;
            const bf16_t* VT = (const bf16_t*)(p.ws + OFF_VMT) + (size_t)(b * 8 + hq) * 64 * 2304;
            attn_body<96>(Q, 768, K, 768, VT, nkeys, od, smem, smem_os);
        } else {
            const int kvh = hq >> 2;
            const bf16_t* Q = (const bf16_t*)(p.ws + OFF_QG) + ((size_t)(b * 2304 + sq0) * 8 + hq) * 64;
            const bf16_t* K = (const bf16_t*)(p.ws + OFF_KG) + ((size_t)(b * 2304) * 2 + kvh) * 64;
            const bf16_t* VT = (const bf16_t*)(p.ws + OFF_VGT) + (size_t)(b * 2 + kvh) * 64 * 2304;
            attn_body<64>(Q, 512, K, 128, VT, nkeys, od, smem, smem_os);
        }
    }
}

DI void phase_proj_resid(const Params& p, const bf16_t* A, int K, const bf16_t* W, const float* mod, int gate_idx,
                         const float* srcLat, const float* srcCtx, float* dstLat, float* dstCtx, int mtiles2, bool ctx_small, char* smem_all) {
    for (int id = blockIdx.x; id < mtiles2 * 4; id += gridDim.x) {
        const int nt2 = id / mtiles2, mt2 = id % mtiles2;
        auto epi = [&](const float* Cs, int si, int sj, int tid) {
            const int nt = 2 * nt2 + sj, m0 = (2 * mt2 + si) * 128;
            const float* src; float* dst; int mb;
            if (m0 < 16384) { src = srcLat + (size_t)m0 * 1024; dst = dstLat + (size_t)m0 * 1024; mb = m0 >> 11; }
            else { src = srcCtx + (size_t)(m0 - 16384) * 1024; dst = dstCtx + (size_t)(m0 - 16384) * 1024; mb = 8; }
            epi_resid(Cs, src + nt * 128, dst + nt * 128, mod + (size_t)mb * 6144 + gate_idx * 1024 + nt * 128, tid);
        };
        const int r0 = g_row(0), r1 = g_row(1), r2 = g_row(2), r3 = g_row(3);
        const bf16_t* Ab = A + (size_t)mt2 * 256 * K;
        const bf16_t* Bb = W + (size_t)nt2 * 256 * K;
        gemm256(p.ws, Ab + (size_t)r0 * K + g_chunk(r0) * 8, Ab + (size_t)r1 * K + g_chunk(r1) * 8, Ab + (size_t)r2 * K + g_chunk(r2) * 8, Ab + (size_t)r3 * K + g_chunk(r3) * 8,
                Bb + (size_t)b_perm(r0) * K + g_chunk(r0) * 8, Bb + (size_t)b_perm(r1) * K + g_chunk(r1) * 8, Bb + (size_t)b_perm(r2) * K + g_chunk(r2) * 8, Bb + (size_t)b_perm(r3) * K + g_chunk(r3) * 8,
                K, smem_all, epi);
    }
    if (ctx_small) {
        char* smem = smem_all + HBI * HB_SMEM;
        for (int id0 = blockIdx.x * 2; id0 < 128; id0 += gridDim.x * 2) {
            const int id = id0 + HBI, nt = id >> 4, m0 = 16384 + (id & 15) * 128;
            auto epi = [&](const float* Cs, const float*) {
                epi_resid(Cs, srcCtx + (size_t)(m0 - 16384) * 1024 + nt * 128, dstCtx + (size_t)(m0 - 16384) * 1024 + nt * 128, mod + (size_t)8 * 6144 + gate_idx * 1024 + nt * 128, TID);
            };
            const bf16_t* Ar = A + (size_t)(m0 + (TID >> 3)) * K;
            gemm_tile<false, false>(Ar, Ar + (size_t)32 * K, Ar + (size_t)64 * K, Ar + (size_t)96 * K, 0u, 0u, 0u, 0u, W + (size_t)nt * 128 * K, K, K, smem, epi);
        }
    }
}

DI float4 conv4(float4 w0, float4 w1, float4 w2, float4 bb, float4 gm, float4 g0, float4 gp, float4 v) {
    float4 o;
    o.x = siluf_(w0.x * gm.x + w1.x * g0.x + w2.x * gp.x + bb.x) * v.x;
    o.y = siluf_(w0.y * gm.y + w1.y * g0.y + w2.y * gp.y + bb.y) * v.y;
    o.z = siluf_(w0.z * gm.z + w1.z * g0.z + w2.z * gp.z + bb.z) * v.z;
    o.w = siluf_(w0.w * gm.w + w1.w * g0.w + w2.w * gp.w + bb.w) * v.w;
    return o;
}
DI void halo_info(int mt, int& base, int& T, int& tstart) {
    int ti;
    if (mt < 136) { base = (mt / 17) * 2048; T = 2048; ti = mt % 17; }
    else { int q = mt - 136; base = 16384 + (q / 3) * 256; T = 256; ti = q % 3; }
    tstart = 126 * ti - 1;
}
DI const bf16_t* halo_ptr(const bf16_t* H, const bf16_t* Z, int mt2, int row) {
    int base, T, tstart; halo_info(2 * mt2 + (row >> 7), base, T, tstart);
    const int t = tstart + (row & 127);
    return (t >= 0 && t < T) ? H + (size_t)(base + t) * 1024 + g_chunk(row) * 8 : Z;
}
DI void phase_ffn_up(const Params& p, const bf16_t* W, const float* convw, const float* convb, int mtiles2, char* smem_all) {
    const bf16_t* H = (const bf16_t*)(p.ws + OFF_H);
    const bf16_t* Z = (const bf16_t*)(p.ws + OFF_ZROW);
    bf16_t* ACT = (bf16_t*)(p.ws + OFF_ACT);
    for (int id = blockIdx.x; id < mtiles2 * 22; id += gridDim.x) {
        const int nt2 = id / mtiles2, mt2 = id % mtiles2;
        auto epi = [&](const float* Cs, int si, int sj, int tid) {
            const int nt = 2 * nt2 + sj;
            int base, T, tstart; halo_info(2 * mt2 + si, base, T, tstart);
            const int cc = tid & 7;
            const int cg0 = nt * 64 + cc * 8;
            const float4 w0a = *(const float4*)(convw + cg0), w0b = *(const float4*)(convw + cg0 + 4);
            const float4 w1a = *(const float4*)(convw + 2816 + cg0), w1b = *(const float4*)(convw + 2816 + cg0 + 4);
            const float4 w2a = *(const float4*)(convw + 5632 + cg0), w2b = *(const float4*)(convw + 5632 + cg0 + 4);
            const float4 bba = *(const float4*)(convb + cg0), bbb = *(const float4*)(convb + cg0 + 4);
#pragma unroll
            for (int j = 0; j < 4; ++j) {
                const int rr = (tid >> 3) + 32 * j, t = tstart + rr;
                if (rr >= 1 && rr <= 126 && t < T) {
                    const float4* a = (const float4*)(Cs + (rr - 1) * CP + cc * 8);
                    const float4* bq = (const float4*)(Cs + rr * CP + cc * 8);
                    const float4* c = (const float4*)(Cs + (rr + 1) * CP + cc * 8);
                    const float4* d = (const float4*)(Cs + rr * CP + 64 + cc * 8);
                    const float4 oa = conv4(w0a, w1a, w2a, bba, a[0], bq[0], c[0], d[0]);
                    const float4 ob = conv4(w0b, w1b, w2b, bbb, a[1], bq[1], c[1], d[1]);
                    uint4 u; u.x = pack2(oa.x, oa.y); u.y = pack2(oa.z, oa.w); u.z = pack2(ob.x, ob.y); u.w = pack2(ob.z, ob.w);
                    *(uint4*)(ACT + (size_t)(base + t) * 2816 + cg0) = u;
                }
            }
        };
        const int r0 = g_row(0), r1 = g_row(1), r2 = g_row(2), r3 = g_row(3);
        const bf16_t* Bb = W + (size_t)nt2 * 256 * 1024;
        gemm256(p.ws, halo_ptr(H, Z, mt2, r0), halo_ptr(H, Z, mt2, r1), halo_ptr(H, Z, mt2, r2), halo_ptr(H, Z, mt2, r3),
                Bb + (size_t)b_perm(r0) * 1024 + g_chunk(r0) * 8, Bb + (size_t)b_perm(r1) * 1024 + g_chunk(r1) * 8, Bb + (size_t)b_perm(r2) * 1024 + g_chunk(r2) * 8, Bb + (size_t)b_perm(r3) * 1024 + g_chunk(r3) * 8,
                1024, smem_all, epi);
    }
}

DI void inproj1_epi(const Params& p, const float* Cs, int nt, int m0, int tid) {
    if (nt < 8) epi_store_bf16(Cs, (bf16_t*)(p.ws + OFF_QKRAW) + (size_t)m0 * 1024 + nt * 128, 1024, tid);
    else if (nt < 16) epi_store_bf16(Cs, (bf16_t*)(p.ws + OFF_V1) + (size_t)m0 * 1024 + (nt - 8) * 128, 1024, tid);
    else if (nt < 24) epi_store_bf16(Cs, (bf16_t*)(p.ws + OFF_OG) + (size_t)m0 * 1024 + (nt - 16) * 128, 1024, tid);
    else if (nt == 24) {
        const int row = tid >> 1, half = tid & 1;
        float* dst = (float*)(p.ws + OFF_GATES) + (size_t)(m0 + row) * 32 + half * 16;
#pragma unroll 4
        for (int i = 0; i < 16; ++i) {
            int c = half * 16 + i;
            float v = Cs[row * CP + c] + p.ml_gate_b[c];
            if (c & 8) v = logsigmoidf_(v);
            dst[i] = v;
        }
    }
}
DI void inproj1_tile_of(int f, int& nt2, int& mt2) { if (f < 576) { nt2 = f / 72; mt2 = f % 72; } else { const int g = f - 576; nt2 = 8 + g / 64; mt2 = g % 64; } }
DI void phase_inproj1(const Params& p, char* smem_all) {
    const bf16_t* H = (const bf16_t*)(p.ws + OFF_H);
    const bf16_t* W = (const bf16_t*)(p.ws + OFF_WT_IN1);
    const int G = gridDim.x, nfr = 832 / G, rem = 832 - nfr * G, nhalf = 2 * rem + 72;
    const int r0 = g_row(0), r1 = g_row(1), r2 = g_row(2), r3 = g_row(3);
#define IN1_ARGS p.ws, Ab + (size_t)r0 * 1024 + g_chunk(r0) * 8, Ab + (size_t)r1 * 1024 + g_chunk(r1) * 8, Ab + (size_t)r2 * 1024 + g_chunk(r2) * 8, Ab + (size_t)r3 * 1024 + g_chunk(r3) * 8, \
                Bb + (size_t)b_perm(r0) * 1024 + g_chunk(r0) * 8, Bb + (size_t)b_perm(r1) * 1024 + g_chunk(r1) * 8, Bb + (size_t)b_perm(r2) * 1024 + g_chunk(r2) * 8, Bb + (size_t)b_perm(r3) * 1024 + g_chunk(r3) * 8, \
                1024, smem_all, epi
    for (int trip = 0; trip < nfr; ++trip) {
        int nt2, mt2; inproj1_tile_of(trip * G + blockIdx.x, nt2, mt2);
        auto epi = [&](const float* Cs, int si, int sj, int tid) { inproj1_epi(p, Cs, 2 * nt2 + sj, (2 * mt2 + si) * 128, tid); };
        const bf16_t* Ab = H + (size_t)mt2 * 256 * 1024;
        const bf16_t* Bb = W + (size_t)nt2 * 256 * 1024;
        gemm256<-1>(IN1_ARGS);
    }
    for (int hq = blockIdx.x; hq < nhalf; hq += G) {
        int nt2, mt2, nh;
        if (hq < 2 * rem) { inproj1_tile_of(nfr * G + (hq >> 1), nt2, mt2); nh = hq & 1; } else { nt2 = 12; mt2 = hq - 2 * rem; nh = 0; }
        auto epi = [&](const float* Cs, int si, int, int tid) { inproj1_epi(p, Cs, 2 * nt2 + nh, (2 * mt2 + si) * 128, tid); };
        const bf16_t* Ab = H + (size_t)mt2 * 256 * 1024;
        const bf16_t* Bb = W + ((size_t)nt2 * 256 + nh * 128) * 1024;
        gemm256<0>(IN1_ARGS);
    }
#undef IN1_ARGS
}

DI void phase_qkconv(const Params& p) {
    const bf16_t* QK = (const bf16_t*)(p.ws + OFF_QKRAW);
    bf16_t* QC = (bf16_t*)(p.ws + OFF_H);
    {
        const int lane = threadIdx.x & 63, gw = blockIdx.x * 8 + (threadIdx.x >> 6);
        const float* GT = (const float*)(p.ws + OFF_GATES);
        float* SC = (float*)(p.ws + OFF_SCAN);
        for (int seg = gw; seg < 2304; seg += gridDim.x * 8) {
            const int step = seg % 18, dir = (seg / 18) & 1, hd = (seg / 36) & 7, b = seg / 288;
            int base, P0;
            if (step < 2) { base = 16384 + b * 256; P0 = (dir ? 1 - step : step) * 128; } else { base = b * 2048; P0 = (dir ? 17 - step : step - 2) * 128; }
            const int pa = dir ? P0 + 127 - lane : P0 + lane, pb = dir ? pa - 64 : pa + 64;
            const float* ga = GT + (size_t)(base + pa) * 32 + dir * 16 + hd; const float* gb = GT + (size_t)(base + pb) * 32 + dir * 16 + hd;
            const float i0 = ga[0], f0 = ga[8], i1 = gb[0], f1 = gb[8];
            float b0 = f0, b1 = f1;
#pragma unroll
            for (int off = 1; off < 64; off <<= 1) { float t0 = __shfl_up(b0, off), t1 = __shfl_up(b1, off); if (lane >= off) { b0 += t0; b1 += t1; } }
            b1 += __shfl(b0, 63);
            float p0 = i0 - b0, p1 = i1 - b1;
            const float c0 = p0, c1 = p1;
#pragma unroll
            for (int off = 1; off < 64; off <<= 1) { float t0 = __shfl_up(p0, off), t1 = __shfl_up(p1, off); if (lane >= off) { p0 = fmaxf(p0, t0); p1 = fmaxf(p1, t1); } }
            p1 = fmaxf(p1, __shfl(p0, 63));
            float* o = SC + (size_t)seg * 384;
            o[lane] = b0; o[64 + lane] = b1; o[128 + lane] = p0; o[192 + lane] = p1; o[256 + lane] = c0; o[320 + lane] = c1;
        }
    }
    for (int c = blockIdx.x * NTHREADS + threadIdx.x; c < 18432 * 128; c += gridDim.x * NTHREADS) {
        const int row = c >> 7, col = (c & 127) * 8;
        int T, t;
        if (row < 16384) { T = 2048; t = row & 2047; } else { T = 256; t = (row - 16384) & 255; }
        float acc[8];
        { const float4 b0 = *(const float4*)(p.ml_conv_b + col), b1 = *(const float4*)(p.ml_conv_b + col + 4);
          acc[0] = b0.x; acc[1] = b0.y; acc[2] = b0.z; acc[3] = b0.w; acc[4] = b1.x; acc[5] = b1.y; acc[6] = b1.z; acc[7] = b1.w; }
#pragma unroll
        for (int dj = 0; dj < 3; ++dj) {
            const int tt = t + dj - 1;
            const float on = (tt >= 0 && tt < T) ? 1.f : 0.f;
            const int rr = row + min(max(tt, 0), T - 1) - t;
            float f[8]; unpack8(*(const uint4*)(QK + (size_t)rr * 1024 + col), f);
            const float4 w0 = *(const float4*)(p.ml_conv_w + dj * 1024 + col), w1 = *(const float4*)(p.ml_conv_w + dj * 1024 + col + 4);
            acc[0] += w0.x * on * f[0]; acc[1] += w0.y * on * f[1]; acc[2] += w0.z * on * f[2]; acc[3] += w0.w * on * f[3];
            acc[4] += w1.x * on * f[4]; acc[5] += w1.y * on * f[5]; acc[6] += w1.z * on * f[6]; acc[7] += w1.w * on * f[7];
        }
        const float sc = col >= 512 ? 0.125f : 1.f;
#pragma unroll
        for (int i = 0; i < 8; ++i) acc[i] = siluf_(acc[i]) * sc;
        *(uint4*)(QC + (size_t)row * 1024 + col) = pack8(acc);
    }
}

DI void phase_mlstm(const Params& p, char* smem) {
    constexpr int LP = 72, TP = 136, L = 128;
    bf16_t* Qc = (bf16_t*)smem;
    bf16_t* Kc = Qc + L * LP;
    bf16_t* KcT = Kc + L * LP;
    bf16_t* VcT = KcT + 64 * TP;
    bf16_t* VwT = VcT + 64 * TP;
    bf16_t* Pm = VwT + 64 * TP;
    bf16_t* Cb = Pm + L * TP;
    float* fa = (float*)(Cb + 64 * LP);
    float* bcum = fa; float* ig = fa + 128; float* mtv = fa + 256; float* wint = fa + 384; float* denI = fa + 512; float* denX = fa + 640;
    float* wgt = fa + 768; float* nvec = fa + 896; float* scal = fa + 960; float* csv = fa + 1024; float* denP = fa + 1152;
    static_assert((2 * L * LP + 3 * 64 * TP + L * TP + 64 * LP) * 2 + 1408 * 4 <= SMEM_ALL, "mLSTM LDS");
    const int lane0 = threadIdx.x & 63, w = __builtin_amdgcn_readfirstlane(threadIdx.x >> 6);
    const bf16_t* QK = (const bf16_t*)(p.ws + OFF_H);
    const bf16_t* V1 = (const bf16_t*)(p.ws + OFF_V1);
    const float* GT = (const float*)(p.ws + OFF_GATES);
    for (int item = blockIdx.x; item < 256; item += gridDim.x) {
        const int vh = item & 1, dir = (item >> 1) & 1, hd = (item >> 2) & 7, b = item >> 5;
        bf16_t* Hout = (bf16_t*)(p.ws + (dir ? OFF_HB : OFF_HF));
        f32x16 accC = zero16();
        float m_prev = 0.f;
        for (int i = w * 64 + lane0; i < 64 * LP; i += 512) Cb[i] = 0;
        if (w == 0) nvec[lane0] = 0.f;
        int lane = lane0, tid = w * 64 + lane0, h = lane0 >> 5, r = lane0 & 31;
        int u = tid >> 2, part = tid & 3;
        uint4 rq0, rq1, rk0, rk1, rv0, rv1;
        float sc_b = 0.f, sc_p = 0.f, sc_c = 0.f, sc_bl = 0.f, sc_pl = 0.f;
#define ML_STEP_GEOM(st, base_, P0_) { if ((st) < 2) { base_ = 16384 + b * 256; P0_ = (dir ? 1 - (st) : (st)) * L; } else { base_ = b * 2048; P0_ = (dir ? 17 - (st) : (st) - 2) * L; } }
#define ML_PREFETCH(st) { int base_, P0_; ML_STEP_GEOM(st, base_, P0_) \
            const int pos_ = dir ? P0_ + L - 1 - u : P0_ + u; \
            { const bf16_t* rowp = QK + (size_t)(base_ + pos_) * 1024; \
              const int qcol = hd * 64 + part * 16, kcol = 512 + qcol; rq0 = *(const uint4*)(rowp + qcol); rq1 = *(const uint4*)(rowp + qcol + 8); rk0 = *(const uint4*)(rowp + kcol); rk1 = *(const uint4*)(rowp + kcol + 8); } \
            { const bf16_t* vp_ = V1 + (size_t)(base_ + pos_) * 1024 + hd * 128 + vh * 64 + part * 16; rv0 = *(const uint4*)vp_; rv1 = *(const uint4*)(vp_ + 8); } \
            if (w < 2) { const float* sp_ = (const float*)(p.ws + OFF_SCAN) + (size_t)((((b * 8 + hd) * 2 + dir) * 18) + (st)) * 384; \
                sc_b = sp_[tid]; sc_p = sp_[128 + tid]; sc_c = sp_[256 + tid]; sc_bl = sp_[127]; sc_pl = sp_[255]; } }
        ML_PREFETCH(0)
        __syncthreads();
#pragma unroll 1
        for (int step = 0; step < 18; ++step) {
            lane = lane0; asm volatile("" : "+v"(lane));
            tid = w * 64 + lane; h = lane >> 5; r = lane & 31; u = tid >> 2; part = tid & 3;
            int base, P0; ML_STEP_GEOM(step, base, P0)
            const bool full = step >= 2;
            if (w < 2) {
                const float mt = fmaxf(sc_b + m_prev, sc_b + sc_p);
                const float mnew = fmaxf(sc_bl + m_prev, sc_bl + sc_pl);
                bcum[tid] = sc_b; csv[tid] = sc_c; mtv[tid] = mt;
                wint[tid] = __expf(sc_b + m_prev - mt);
                wgt[tid] = __expf(sc_bl + sc_c - mnew);
                if (tid == 0) { scal[0] = mnew; scal[1] = __expf(sc_bl + m_prev - mnew); }
            }
            {
                *(uint4*)(Qc + u * LP + part * 16) = rq0; *(uint4*)(Qc + u * LP + part * 16 + 8) = rq1;
                *(uint4*)(Kc + u * LP + part * 16) = rk0; *(uint4*)(Kc + u * LP + part * 16 + 8) = rk1;
#define ML_T2(dstT, wv, ci) { dstT[(part * 16 + (ci)) * TP + u] = (bf16_t)((wv) & 0xffffu); dstT[(part * 16 + (ci) + 1) * TP + u] = (bf16_t)((wv) >> 16); }
                ML_T2(KcT, rk0.x, 0) ML_T2(KcT, rk0.y, 2) ML_T2(KcT, rk0.z, 4) ML_T2(KcT, rk0.w, 6) ML_T2(KcT, rk1.x, 8) ML_T2(KcT, rk1.y, 10) ML_T2(KcT, rk1.z, 12) ML_T2(KcT, rk1.w, 14)
                ML_T2(VcT, rv0.x, 0) ML_T2(VcT, rv0.y, 2) ML_T2(VcT, rv0.z, 4) ML_T2(VcT, rv0.w, 6) ML_T2(VcT, rv1.x, 8) ML_T2(VcT, rv1.y, 10) ML_T2(VcT, rv1.z, 12) ML_T2(VcT, rv1.w, 14)
#undef ML_T2
            }
            if (step + 1 < 18) ML_PREFETCH(step + 1)
            LDS_BARRIER();
            const float m_new = scal[0], decay = scal[1];
            {
                const int vv = tid >> 3, s0_ = (tid & 7) * 16;
#pragma unroll
                for (int q = 0; q < 2; ++q) {
                    float f[8]; unpack8(*(const uint4*)(VcT + vv * TP + s0_ + q * 8), f);
                    const float4 w0 = *(const float4*)(wgt + s0_ + q * 8), w1 = *(const float4*)(wgt + s0_ + q * 8 + 4);
                    f[0] *= w0.x; f[1] *= w0.y; f[2] *= w0.z; f[3] *= w0.w; f[4] *= w1.x; f[5] *= w1.y; f[6] *= w1.z; f[7] *= w1.w;
                    *(uint4*)(VwT + vv * TP + s0_ + q * 8) = pack8(f);
                }
            }
            if (full) {
                {
                    float sacc_ = 0.f;
#pragma unroll
                    for (int q = 0; q < 2; ++q) {
                        float f[8]; unpack8(*(const uint4*)(Qc + u * LP + part * 16 + q * 8), f);
                        const float4 n0 = *(const float4*)(nvec + part * 16 + q * 8), n1 = *(const float4*)(nvec + part * 16 + q * 8 + 4);
                        sacc_ += f[0] * n0.x + f[1] * n0.y + f[2] * n0.z + f[3] * n0.w + f[4] * n1.x + f[5] * n1.y + f[6] * n1.z + f[7] * n1.w;
                    }
                    sacc_ += __shfl_xor(sacc_, 1); sacc_ += __shfl_xor(sacc_, 2);
                    if (part == 0) denX[u] = sacc_;
                }
                const int ti = w >> 1, t = ti * 32 + r;
                const float bt = bcum[t] - mtv[t];
                float rs = 0.f;
#pragma unroll
                for (int q = 0; q < 2; ++q) {
                    const int si = 2 * (w & 1) + q;
                    if (si <= ti) {
                        f32x16 sacc = zero16();
#pragma unroll
                        for (int ks = 0; ks < 4; ++ks) {
                            bf16x8 a = *(const bf16x8*)(Kc + (si * 32 + r) * LP + ks * 16 + h * 8);
                            bf16x8 bb = *(const bf16x8*)(Qc + (ti * 32 + r) * LP + ks * 16 + h * 8);
                            sacc = MFMA(a, bb, sacc);
                        }
#pragma unroll
                        for (int g4 = 0; g4 < 4; ++g4) {
                            const int s0_ = si * 32 + 8 * g4 + 4 * h;
                            const float4 c4 = *(const float4*)(csv + s0_);
                            float p0 = s0_ + 0 <= t ? sacc[4 * g4 + 0] * __expf(bt + c4.x) : 0.f;
                            float p1 = s0_ + 1 <= t ? sacc[4 * g4 + 1] * __expf(bt + c4.y) : 0.f;
                            float p2 = s0_ + 2 <= t ? sacc[4 * g4 + 2] * __expf(bt + c4.z) : 0.f;
                            float p3 = s0_ + 3 <= t ? sacc[4 * g4 + 3] * __expf(bt + c4.w) : 0.f;
                            rs += (p0 + p1) + (p2 + p3);
                            uint2 pk; pk.x = pack2(p0, p1); pk.y = pack2(p2, p3);
                            *(uint2*)(Pm + t * TP + s0_) = pk;
                        }
                    } else {
#pragma unroll
                        for (int g4 = 0; g4 < 4; ++g4) *(uint2*)(Pm + t * TP + si * 32 + 8 * g4 + 4 * h) = make_uint2(0u, 0u);
                    }
                }
                rs += __shfl_xor(rs, 32);
                if (h == 0) denP[(w & 1) * 128 + t] = rs;
            }
            LDS_BARRIER();
            f32x16 hacc = zero16();
            const int ti = w >> 1, vi = w & 1;
            if (full) {
#pragma unroll
                for (int ks = 0; ks < 4; ++ks) {
                    bf16x8 a = *(const bf16x8*)(Cb + (vi * 32 + r) * LP + ks * 16 + h * 8);
                    bf16x8 bb = *(const bf16x8*)(Qc + (ti * 32 + r) * LP + ks * 16 + h * 8);
                    hacc = MFMA(a, bb, hacc);
                }
                const float wi = wint[ti * 32 + r];
#pragma unroll
                for (int g = 0; g < 16; ++g) hacc[g] *= wi;
#pragma unroll
                for (int ks = 0; ks < 8; ++ks) {
                    if (ks <= 2 * ti + 1) {
                        bf16x8 a = *(const bf16x8*)(VcT + (vi * 32 + r) * TP + ks * 16 + h * 8);
                        bf16x8 bb = *(const bf16x8*)(Pm + (ti * 32 + r) * TP + ks * 16 + h * 8);
                        hacc = MFMA(a, bb, hacc);
                    }
                }
            }
            LDS_BARRIER();
            if (full) {
                const int t = ti * 32 + r;
                const float den = wint[t] * denX[t] + denP[t] + denP[128 + t];
                const float inv = __builtin_amdgcn_rcpf(fmaxf(fabsf(den), __expf(-mtv[t])));
                bf16_t* hp = Pm + t * LP + vi * 32 + 4 * h;
#pragma unroll
                for (int g4 = 0; g4 < 4; ++g4) {
                    uint2 pk; pk.x = pack2(hacc[4 * g4] * inv, hacc[4 * g4 + 1] * inv); pk.y = pack2(hacc[4 * g4 + 2] * inv, hacc[4 * g4 + 3] * inv);
                    *(uint2*)(hp + 8 * g4) = pk;
                }
            }
            if (w < 4) {
                const int vi2 = w >> 1, di = w & 1;
#pragma unroll
                for (int g = 0; g < 16; ++g) accC[g] *= decay;
#pragma unroll
                for (int ks = 0; ks < 8; ++ks) {
                    bf16x8 a = *(const bf16x8*)(VwT + (vi2 * 32 + r) * TP + ks * 16 + h * 8);
                    bf16x8 bb = *(const bf16x8*)(KcT + (di * 32 + r) * TP + ks * 16 + h * 8);
                    accC = MFMA(a, bb, accC);
                }
#pragma unroll
                for (int g = 0; g < 16; ++g) Cb[(vi2 * 32 + crow(g, h)) * LP + di * 32 + r] = f2bf_sw(accC[g]);
            } else {
                const int t2 = tid - 256, d = t2 >> 2, pq = t2 & 3;
                float sacc_ = 0.f;
#pragma unroll
                for (int q = 0; q < 4; ++q) {
                    float f[8]; unpack8(*(const uint4*)(KcT + d * TP + pq * 32 + q * 8), f);
                    const float4 w0 = *(const float4*)(wgt + pq * 32 + q * 8), w1 = *(const float4*)(wgt + pq * 32 + q * 8 + 4);
                    sacc_ += f[0] * w0.x + f[1] * w0.y + f[2] * w0.z + f[3] * w0.w + f[4] * w1.x + f[5] * w1.y + f[6] * w1.z + f[7] * w1.w;
                }
                sacc_ += __shfl_xor(sacc_, 1); sacc_ += __shfl_xor(sacc_, 2);
                if (pq == 0) nvec[d] = decay * nvec[d] + sacc_;
            }
            m_prev = m_new;
            LDS_BARRIER();
            if (full) {
#pragma unroll
                for (int q = 0; q < 2; ++q) {
                    const int c = tid + 512 * q, t = c >> 3, ch = c & 7;
                    const int pos = dir ? P0 + L - 1 - t : P0 + t;
                    *(uint4*)(Hout + (size_t)(base + pos) * 1024 + hd * 128 + vh * 64 + ch * 8) = *(const uint4*)(Pm + t * LP + ch * 8);
                }
            }
        }
#undef ML_STEP_GEOM
#undef ML_PREFETCH
    }
}

DI void phase_mix(const Params& p) {
    const int lane = threadIdx.x & 63, w = threadIdx.x >> 6;
    const bf16_t* HF = (const bf16_t*)(p.ws + OFF_HF);
    const bf16_t* HB = (const bf16_t*)(p.ws + OFF_HB);
    const bf16_t* OG = (const bf16_t*)(p.ws + OFF_OG);
    bf16_t* H = (bf16_t*)(p.ws + OFF_H);
    for (int row = blockIdx.x * 8 + w; row < 16384; row += gridDim.x * 8) {
        const size_t o = (size_t)row * 1024 + lane * 16;
        float a[16], bq[16], og[16];
        unpack8(*(const uint4*)(HF + o), a); unpack8(*(const uint4*)(HF + o + 8), a + 8);
        unpack8(*(const uint4*)(HB + o), bq); unpack8(*(const uint4*)(HB + o + 8), bq + 8);
        unpack8(*(const uint4*)(OG + o), og); unpack8(*(const uint4*)(OG + o + 8), og + 8);
        float ss = 0.f;
#pragma unroll
        for (int i = 0; i < 16; ++i) { a[i] += bq[i]; ss += a[i] * a[i]; }
        ss += __shfl_xor(ss, 1); ss += __shfl_xor(ss, 2); ss += __shfl_xor(ss, 4);
        const float rstd = rsqrtf(ss * (1.f / 128.f) + EPSF);
        const float* g = p.ml_out_g + lane * 16;
#pragma unroll
        for (int i = 0; i < 16; ++i) a[i] = a[i] * rstd * g[i] * sigmoidf_(og[i]);
        *(uint4*)(H + o) = pack8(a); *(uint4*)(H + o + 8) = pack8(a + 8);
    }
}

#define XB_TMO      128
#define XB_XCNT(j)  (256  + 64 * (j))
#define XB_XSUB(j)  (1280 + 64 * (j))
#define XB_XGEN(j)  (2304 + 64 * (j))
#define XB_TOP      3328
#define XB_TOPGEN   3392
#define XCD_BAR_WORDS 3456
#define XB_SPIN_CAP (1u << 18)
#define LAS __attribute__((address_space(3)))

__device__ __forceinline__ unsigned xb_ld(unsigned* p)              { return __hip_atomic_load(p, __ATOMIC_RELAXED, __HIP_MEMORY_SCOPE_AGENT); }
__device__ __forceinline__ unsigned xb_add(unsigned* p, unsigned v) { return __hip_atomic_fetch_add(p, v, __ATOMIC_RELAXED, __HIP_MEMORY_SCOPE_AGENT); }
__device__ __forceinline__ unsigned xb_xcc_id() { return (unsigned)__builtin_amdgcn_s_getreg((3 << 11) | 20) & 0xFu; }
#define XB_SPIN(cond, bar) do { unsigned _sp = 0; while (cond) { __builtin_amdgcn_s_sleep(1); \
    if ((++_sp & 255u) == 0u) { if (xb_ld(&(bar)[XB_TMO])) break; if (_sp > XB_SPIN_CAP) { atomicAdd(&(bar)[XB_TMO], 1u); break; } } } } while (0)

struct XcdBarrier {
    unsigned* bar; unsigned x;
    volatile LAS unsigned* st;
};

__device__ __forceinline__ XcdBarrier xcd_barrier_post(unsigned* bar, volatile LAS unsigned* st) {
    XcdBarrier b; b.bar = bar; b.x = xb_xcc_id(); b.st = st;
    if (threadIdx.x == 0) (void)xb_add(&bar[XB_XCNT(b.x)], 1u);
    return b;
}
__device__ __forceinline__ void xcd_barrier_complete(unsigned* bar, unsigned x, unsigned& nloc, unsigned& nx) {
    const unsigned G = gridDim.x * gridDim.y * gridDim.z;
    unsigned sum, cnt, mine, sp = 0u;
    for (;;) {
        sum = 0u; cnt = 0u; mine = 0u;
#pragma unroll
        for (unsigned j = 0; j < 16; ++j) { const unsigned c = xb_ld(&bar[XB_XCNT(j)]); sum += c; cnt += (c > 0u) ? 1u : 0u; mine = (j == x) ? c : mine; }
        if (sum == G) break;
        __builtin_amdgcn_s_sleep(1);
        if ((++sp & 255u) == 0u) { if (xb_ld(&bar[XB_TMO])) break; if (sp > XB_SPIN_CAP) { atomicAdd(&bar[XB_TMO], 1u); break; } }
    }
    nloc = mine > 0u ? mine : 1u; nx = cnt > 0u ? cnt : 1u;
}

__device__ __forceinline__ void xcd_barrier(const XcdBarrier& b) {
    asm volatile("s_waitcnt vmcnt(0)" ::: "memory");
    __syncthreads();
    if (threadIdx.x == 0) {
        unsigned* bar = b.bar;
        __builtin_amdgcn_s_waitcnt(0);
        unsigned nloc = b.st[0], nx = b.st[1];
        if (nloc == 0u) { xcd_barrier_complete(bar, b.x, nloc, nx); b.st[0] = nloc; b.st[1] = nx; }
        const unsigned old = xb_add(&bar[XB_XSUB(b.x)], 1u);
        const unsigned gen = old / nloc;
        if (old + 1u == (gen + 1u) * nloc) {
            __builtin_amdgcn_fence(__ATOMIC_RELEASE, "agent");
            asm volatile("s_waitcnt vmcnt(0)" ::: "memory");
            const unsigned og = xb_add(&bar[XB_TOP], 1u);
            const unsigned tg = og / nx;
            if (og + 1u == (tg + 1u) * nx) xb_add(&bar[XB_TOPGEN], 1u);
            else XB_SPIN(xb_ld(&bar[XB_TOPGEN]) == tg, bar);
            __builtin_amdgcn_fence(__ATOMIC_ACQUIRE, "agent");
            xb_add(&bar[XB_XGEN(b.x)], 1u);
            asm volatile("s_waitcnt vmcnt(0)" ::: "memory");
        } else {
            XB_SPIN(xb_ld(&bar[XB_XGEN(b.x)]) == gen, bar);
            __builtin_amdgcn_fence(__ATOMIC_ACQUIRE, "agent");
            asm volatile("s_waitcnt vmcnt(0)" ::: "memory");
        }
    }
    __syncthreads();
}


__global__ void __launch_bounds__(NTHREADS, 2) __attribute__((amdgpu_waves_per_eu(2, 2))) fwd_megakernel(Params p) {
    __shared__ __attribute__((aligned(1024))) char smem[SMEM_ALL];
    cg::grid_group grid = cg::this_grid();
    __shared__ uint4 xb_words;
    if (threadIdx.x == 0) xb_words = make_uint4(0u, 0u, 0u, 0u);
    __syncthreads();
    XcdBarrier xb = xcd_barrier_post((unsigned*)(p.ws + OFF_BAR), (volatile LAS unsigned*)&xb_words);
    const float* MOD0 = (const float*)(p.ws + OFF_MOD);
    const float* MOD1 = MOD0 + 9 * 6144;
    float* XRC = (float*)(p.ws + OFF_XRC);
    const bf16_t* Hb = (const bf16_t*)(p.ws + OFF_H);

    phase0(p, smem);
    if (p.ws == nullptr) grid.sync();
    xcd_barrier(xb);
    phase_norm(p, p.x, p.ctx, p.norm1_g, MOD0, 0, 18432);
    xcd_barrier(xb);
    phase_inproj0(p, smem);
    xcd_barrier(xb);
    phase_mla_up(p, smem);
    xcd_barrier(xb);
    phase_attn(p, smem);
    xcd_barrier(xb);
    phase_proj_resid(p, Hb, 1024, (const bf16_t*)(p.ws + OFF_WT_OUT0), MOD0, 2, p.x, p.ctx, p.out, XRC, 64, true, smem);
    xcd_barrier(xb);
    phase_norm(p, p.out, XRC, p.norm2_g, MOD0, 3, 18432);
    xcd_barrier(xb);
    phase_ffn_up(p, (const bf16_t*)(p.ws + OFF_WT_UP0), p.ffn_conv_w, p.ffn_conv_b, 80, smem);
    xcd_barrier(xb);
    phase_proj_resid(p, (const bf16_t*)(p.ws + OFF_ACT), 2816, (const bf16_t*)(p.ws + OFF_WT_DOWN0), MOD0, 5, p.out, XRC, p.out, XRC, 64, true, smem);
    xcd_barrier(xb);
    phase_norm(p, p.out, XRC, p.norm1_g + 1024, MOD1, 0, 18432);
    xcd_barrier(xb);
    phase_inproj1(p, smem);
    xcd_barrier(xb);
    phase_qkconv(p);
    xcd_barrier(xb);
    phase_mlstm(p, smem);
    xcd_barrier(xb);
    phase_mix(p);
    xcd_barrier(xb);
    phase_proj_resid(p, Hb, 1024, (const bf16_t*)(p.ws + OFF_WT_OUT1), MOD1, 2, p.out, XRC, p.out, XRC, 64, false, smem);
    xcd_barrier(xb);
    phase_norm(p, p.out, XRC, p.norm2_g + 1024, MOD1, 3, 16384);
    xcd_barrier(xb);
    phase_ffn_up(p, (const bf16_t*)(p.ws + OFF_WT_UP1), p.ffn_conv_w + 3 * 2816, p.ffn_conv_b + 2816, 68, smem);
    xcd_barrier(xb);
    phase_proj_resid(p, (const bf16_t*)(p.ws + OFF_ACT), 2816, (const bf16_t*)(p.ws + OFF_WT_DOWN1), MOD1, 5, p.out, XRC, p.out, XRC, 64, false, smem);
}

extern "C" void kernel_launch(void* const* d_in, const int* in_sizes, int n_in, void* d_out, int out_size, void* d_ws, size_t ws_size,
                              hipStream_t stream) {
    static int grid_blocks = 0;
    if (!grid_blocks) {
        int dev = 0, cus = 0, per_cu = 0;
        hipGetDevice(&dev);
        hipDeviceGetAttribute(&cus, hipDeviceAttributeMultiprocessorCount, dev);
        hipOccupancyMaxActiveBlocksPerMultiprocessor(&per_cu, fwd_megakernel, NTHREADS, 0);
        if (per_cu < 1) per_cu = 1;
        if (per_cu > 1) per_cu = 1;
        grid_blocks = cus * per_cu;
        if (ws_size < WS_END) fprintf(stderr, "kernel_launch: workspace too small: %zu < %zu\n", ws_size, (size_t)WS_END);
    }
    Params p{};
    const float** pf = (const float**)&p;
    for (int i = 0; i < 28; ++i) pf[i] = (const float*)d_in[i];
    p.out = (float*)d_out;
    p.ws = (char*)d_ws;
    hipMemsetAsync((char*)d_ws + OFF_BAR, 0, 16384, stream);
    void* args[] = {&p};
    hipError_t e = hipLaunchCooperativeKernel((void*)fwd_megakernel, dim3(grid_blocks), dim3(NTHREADS), args, 0, stream);
    if (e != hipSuccess) fprintf(stderr, "cooperative launch failed: %s (grid %d)\n", hipGetErrorString(e), grid_blocks);
}
```

```cpp
#include <hip/hip_runtime.h>
#include <hip/hip_cooperative_groups.h>
#include <cstdio>
namespace cg = cooperative_groups;

typedef unsigned short bf16_t;
using bf16x8 = __attribute__((ext_vector_type(8))) short;
using f32x16 = __attribute__((ext_vector_type(16))) float;
using f32x4 = __attribute__((ext_vector_type(4))) float;
#define DI __device__ __forceinline__
#define MFMA(a, b, c) __builtin_amdgcn_mfma_f32_32x32x16_bf16((a), (b), (c), 0, 0, 0)
#define MFMA16(a, b, c) __builtin_amdgcn_mfma_f32_16x16x32_bf16((a), (b), (c), 0, 0, 0)
#define LDS_BARRIER() do { asm volatile("s_waitcnt lgkmcnt(0)" ::: "memory"); __builtin_amdgcn_s_barrier(); asm volatile("" ::: "memory"); } while (0)
#define TID ((int)(threadIdx.x & 255))
#define HBI ((int)(threadIdx.x >> 8))

constexpr float EPSF = 1e-6f;
constexpr float LOG2E = 1.4426950408889634f;
constexpr int NTHREADS = 512;
constexpr int HB_SMEM = 73728;
constexpr int SMEM_ALL = 2 * HB_SMEM;
constexpr int GP = 72;
constexpr int CP = 132;
constexpr int ROWSS_OFF = 67584;

constexpr size_t OFF_WT_UP1 = 0;
constexpr size_t OFF_WT_DOWN1 = OFF_WT_UP1 + 5632ull * 1024 * 2;
constexpr size_t OFF_WT_IN1 = OFF_WT_DOWN1 + 1024ull * 2816 * 2;
constexpr size_t OFF_WT_OUT1 = OFF_WT_IN1 + 3328ull * 1024 * 2;
constexpr size_t OFF_MOD = OFF_WT_OUT1 + 1024ull * 1024 * 2;
constexpr size_t OFF_TABG = OFF_MOD + 2ull * 9 * 6144 * 4;
constexpr size_t OFF_TABM = OFF_TABG + 64 * 16 * 2 * 4;
constexpr size_t OFF_ZROW = OFF_TABM + 64 * 8 * 2 * 4;
constexpr size_t OFF_W0 = OFF_ZROW + 8192;
constexpr size_t OFF_WT_IN0 = OFF_W0;
constexpr size_t OFF_WT_QB = OFF_WT_IN0 + 1536ull * 1024 * 2;
constexpr size_t OFF_WT_KVB = OFF_WT_QB + 1024ull * 384 * 2;
constexpr size_t OFF_WT_OUT0 = OFF_WT_KVB + 1024ull * 256 * 2;
constexpr size_t OFF_WT_UP0 = OFF_WT_OUT0 + 1024ull * 1024 * 2;
constexpr size_t OFF_WT_DOWN0 = OFF_WT_UP0 + 5632ull * 1024 * 2;
constexpr size_t OFF_XRC = OFF_WT_DOWN0 + 1024ull * 2816 * 2;
constexpr size_t OFF_R = OFF_XRC + 2048ull * 1024 * 4;
constexpr size_t OFF_QG = OFF_R;
constexpr size_t OFF_KG = OFF_QG + 18432ull * 512 * 2;
constexpr size_t OFF_VGT = OFF_KG + 18432ull * 128 * 2;
constexpr size_t OFF_CQ = OFF_VGT + 18432ull * 128 * 2;
constexpr size_t OFF_CKV = OFF_CQ + 18432ull * 384 * 2;
constexpr size_t OFF_KR = OFF_CKV + 18432ull * 256 * 2;
constexpr size_t OFF_QM = OFF_KR + 18432ull * 32 * 4;
constexpr size_t OFF_KM = OFF_QM + 18432ull * 768 * 2;
constexpr size_t OFF_VMT = OFF_KM + 18432ull * 768 * 2;
constexpr size_t END_L0 = OFF_VMT + 18432ull * 512 * 2;
constexpr size_t OFF_ACT = OFF_R;
constexpr size_t END_ACT = OFF_ACT + 18432ull * 2816 * 2;
constexpr size_t OFF_QKRAW = OFF_W0;
constexpr size_t OFF_V1 = OFF_QKRAW + 18432ull * 1024 * 2;
constexpr size_t OFF_OG = OFF_V1 + 18432ull * 1024 * 2;
constexpr size_t OFF_GATES = OFF_OG + 16384ull * 1024 * 2;
constexpr size_t OFF_HF = OFF_GATES + 18432ull * 32 * 4;
constexpr size_t OFF_HB = OFF_HF + 16384ull * 1024 * 2;
constexpr size_t END_L1 = OFF_HB + 16384ull * 1024 * 2;
constexpr size_t cmax(size_t a, size_t b) { return a > b ? a : b; }
constexpr size_t OFF_H = cmax(cmax(END_L0, END_ACT), END_L1);
constexpr size_t OFF_BAR = OFF_H + 18432ull * 1024 * 2;
constexpr size_t OFF_SCAN = OFF_BAR + 16384;
constexpr size_t WS_END = OFF_SCAN + 2304ull * 384 * 4;
static_assert(WS_END <= 268435456ull, "workspace too large");
static_assert(OFF_H % 256 == 0 && OFF_R % 256 == 0 && OFF_HF % 256 == 0, "align");

struct Params {
    const float *x, *c, *ctx, *c_ctx, *ada_w, *ada_b, *norm1_g, *norm2_g, *ffn_w_up, *ffn_conv_w, *ffn_conv_b, *ffn_w_down,
        *att_w_in, *mla_qa_g, *mla_w_qb, *mla_kva_g, *mla_w_kvb, *mla_q_g, *mla_k_g, *gqa_q_g, *gqa_k_g, *att_w_out,
        *ml_w_in, *ml_conv_w, *ml_conv_b, *ml_gate_b, *ml_out_g, *ml_w_out;
    float* out;
    char* ws;
};

DI unsigned short f2bf_sw(float x) { unsigned u = __float_as_uint(x); u += 0x7fffu + ((u >> 16) & 1u); return (unsigned short)(u >> 16); }
DI unsigned short f2bf(float x) { unsigned r; asm("v_cvt_pk_bf16_f32 %0, %1, %1" : "=v"(r) : "v"(x)); return (unsigned short)(r & 0xffffu); }
DI unsigned pack2(float a, float b) { unsigned r; asm("v_cvt_pk_bf16_f32 %0, %1, %2" : "=v"(r) : "v"(a), "v"(b)); return r; }
DI bf16x8 pack_frag(float a0, float a1, float a2, float a3, float a4, float a5, float a6, float a7) {
    using u32x4_ = __attribute__((ext_vector_type(4))) unsigned; u32x4_ p;
    asm volatile("v_cvt_pk_bf16_f32 %0, %4, %5\n\tv_cvt_pk_bf16_f32 %1, %6, %7\n\tv_cvt_pk_bf16_f32 %2, %8, %9\n\tv_cvt_pk_bf16_f32 %3, %10, %11\n\ts_nop 1"
                 : "=&v"(p[0]), "=&v"(p[1]), "=&v"(p[2]), "=&v"(p[3]) : "v"(a0), "v"(a1), "v"(a2), "v"(a3), "v"(a4), "v"(a5), "v"(a6), "v"(a7));
    return __builtin_bit_cast(bf16x8, p);
}
DI float bflo(unsigned v) { return __uint_as_float(v << 16); }
DI float bfhi(unsigned v) { return __uint_as_float(v & 0xffff0000u); }
DI float bf2f(unsigned short v) { return __uint_as_float(((unsigned)v) << 16); }
DI uint4 pack8(const float* v) { uint4 o; o.x = pack2(v[0], v[1]); o.y = pack2(v[2], v[3]); o.z = pack2(v[4], v[5]); o.w = pack2(v[6], v[7]); return o; }
DI void unpack8(uint4 u, float* v) { v[0] = bflo(u.x); v[1] = bfhi(u.x); v[2] = bflo(u.y); v[3] = bfhi(u.y); v[4] = bflo(u.z); v[5] = bfhi(u.z); v[6] = bflo(u.w); v[7] = bfhi(u.w); }
DI int crow(int reg, int h) { return (reg & 3) + 8 * (reg >> 2) + 4 * h; }
DI float sigmoidf_(float x) { return __builtin_amdgcn_rcpf(1.f + __expf(-x)); }
DI float siluf_(float x) { return x * __builtin_amdgcn_rcpf(1.f + __expf(-x)); }
DI float logsigmoidf_(float x) { return fminf(x, 0.f) - log1pf(__expf(-fabsf(x))); }
DI f32x16 zero16() { f32x16 z;
#pragma unroll
    for (int i = 0; i < 16; ++i) z[i] = 0.f; return z; }

DI void row_info(int m0, int& b, int& t0, bool& lat) {
    if (m0 < 16384) { b = m0 >> 11; t0 = m0 & 2047; lat = true; }
    else { int q = m0 - 16384; b = q >> 8; t0 = q & 255; lat = false; }
}

template <bool SS, bool HALO, class Epi>
DI void gemm_tile(const bf16_t* ap0, const bf16_t* ap1, const bf16_t* ap2, const bf16_t* ap3, unsigned mk0, unsigned mk1, unsigned mk2, unsigned mk3, const bf16_t* __restrict__ Bt, int ldb, int K, char* smem, Epi epi) {
    const int tid = TID, lane = tid & 63, w = tid >> 6, h = lane >> 5, r = lane & 31;
    const int wm = w >> 1, wn = w & 1;
    const int lr = tid >> 3, kc = tid & 7;
    ap0 += kc * 8; ap1 += kc * 8; ap2 += kc * 8; ap3 += kc * 8;
    const bf16_t* bp0 = Bt + (size_t)lr * ldb + kc * 8;
    const bf16_t* bp1 = bp0 + (size_t)32 * ldb; const bf16_t* bp2 = bp0 + (size_t)64 * ldb; const bf16_t* bp3 = bp0 + (size_t)96 * ldb;
    f32x16 acc00 = zero16(), acc01 = zero16(), acc10 = zero16(), acc11 = zero16();
    float ss0 = 0.f, ss1 = 0.f, ss2 = 0.f, ss3 = 0.f;
    uint4 ra0, ra1, ra2, ra3, rb0, rb1, rb2, rb3;
    const int nk = K >> 6;
#define GLOAD(k0) { ra0 = *(const uint4*)(ap0 + (k0)); ra1 = *(const uint4*)(ap1 + (k0)); ra2 = *(const uint4*)(ap2 + (k0)); ra3 = *(const uint4*)(ap3 + (k0)); \
                    rb0 = *(const uint4*)(bp0 + (k0)); rb1 = *(const uint4*)(bp1 + (k0)); rb2 = *(const uint4*)(bp2 + (k0)); rb3 = *(const uint4*)(bp3 + (k0)); }
#define SSQ(ssv, rv) { if (SS) { float f_[8]; unpack8(rv, f_); ssv += f_[0]*f_[0] + f_[1]*f_[1] + f_[2]*f_[2] + f_[3]*f_[3] + f_[4]*f_[4] + f_[5]*f_[5] + f_[6]*f_[6] + f_[7]*f_[7]; } }
#define MSK(rv, mk) { rv.x &= mk; rv.y &= mk; rv.z &= mk; rv.w &= mk; }
#define SWRITE(s_) { if (HALO) { MSK(ra0, mk0) MSK(ra1, mk1) MSK(ra2, mk2) MSK(ra3, mk3) } bf16_t* As_ = (bf16_t*)(smem + (s_) * 36864) + lr * GP + kc * 8; bf16_t* Bs_ = As_ + 128 * GP; \
                     *(uint4*)(As_) = ra0; *(uint4*)(As_ + 32 * GP) = ra1; *(uint4*)(As_ + 64 * GP) = ra2; *(uint4*)(As_ + 96 * GP) = ra3; \
                     *(uint4*)(Bs_) = rb0; *(uint4*)(Bs_ + 32 * GP) = rb1; *(uint4*)(Bs_ + 64 * GP) = rb2; *(uint4*)(Bs_ + 96 * GP) = rb3; \
                     SSQ(ss0, ra0) SSQ(ss1, ra1) SSQ(ss2, ra2) SSQ(ss3, ra3) }
    GLOAD(0) SWRITE(0) __syncthreads();
#pragma unroll 1
    for (int kt = 0; kt < nk; ++kt) {
        if (kt + 1 < nk) GLOAD((kt + 1) * 64)
        {
            const bf16_t* As = (const bf16_t*)(smem + (kt & 1) * 36864) + (wm * 64 + r) * GP + h * 8;
            const bf16_t* Bs = (const bf16_t*)(smem + (kt & 1) * 36864) + 128 * GP + (wn * 64 + r) * GP + h * 8;
#pragma unroll
            for (int ks = 0; ks < 4; ++ks) {
                const bf16x8 a0 = *(const bf16x8*)(As + ks * 16), a1 = *(const bf16x8*)(As + 32 * GP + ks * 16);
                const bf16x8 b0 = *(const bf16x8*)(Bs + ks * 16), b1 = *(const bf16x8*)(Bs + 32 * GP + ks * 16);
                acc00 = MFMA(a0, b0, acc00); acc01 = MFMA(a0, b1, acc01); acc10 = MFMA(a1, b0, acc10); acc11 = MFMA(a1, b1, acc11);
            }
        }
        if (kt + 1 < nk) SWRITE((kt + 1) & 1)
        __syncthreads();
    }
#undef GLOAD
#undef SWRITE
#undef SSQ
#undef MSK
    float* Cs = (float*)smem;
    {
        float* cb = Cs + (wm * 64 + 4 * h) * CP + wn * 64 + r;
#pragma unroll
        for (int g = 0; g < 16; ++g) {
            const int ro = (g & 3) + 8 * (g >> 2);
            cb[ro * CP] = acc00[g]; cb[ro * CP + 32] = acc01[g]; cb[(ro + 32) * CP] = acc10[g]; cb[(ro + 32) * CP + 32] = acc11[g];
        }
    }
    if (SS) {
        float* rowss = (float*)(smem + ROWSS_OFF);
        ss0 += __shfl_xor(ss0, 1); ss0 += __shfl_xor(ss0, 2); ss0 += __shfl_xor(ss0, 4);
        ss1 += __shfl_xor(ss1, 1); ss1 += __shfl_xor(ss1, 2); ss1 += __shfl_xor(ss1, 4);
        ss2 += __shfl_xor(ss2, 1); ss2 += __shfl_xor(ss2, 2); ss2 += __shfl_xor(ss2, 4);
        ss3 += __shfl_xor(ss3, 1); ss3 += __shfl_xor(ss3, 2); ss3 += __shfl_xor(ss3, 4);
        if (kc == 0) { rowss[lr] = ss0; rowss[lr + 32] = ss1; rowss[lr + 64] = ss2; rowss[lr + 96] = ss3; }
    }
    __syncthreads();
    epi((const float*)smem, (const float*)(smem + ROWSS_OFF));
    __syncthreads();
}


DI int g_row(int i) { return ((i * 8 + (int)(threadIdx.x >> 6)) * 8) + (int)((threadIdx.x & 63) >> 3); }
DI int b_perm(int row) { return ((row >> 5) & 1) * 128 + (row >> 6) * 32 + (row & 31); }
DI int g_chunk(int row) { return (int)(threadIdx.x & 7) ^ ((row >> 1) & 7); }
#define GLDS(g_, l_) __builtin_amdgcn_global_load_lds((const unsigned*)(g_), (unsigned*)(l_), 16, 0, 0)
template <int NH = -1, class Epi>
DI void gemm256(const char* wsb, const bf16_t* a0p, const bf16_t* a1p, const bf16_t* a2p, const bf16_t* a3p,
                const bf16_t* b0p, const bf16_t* b1p, const bf16_t* b2p, const bf16_t* b3p, int K, char* smem_all, Epi epi) {
    const unsigned a0 = (unsigned)((const char*)a0p - wsb), a1 = (unsigned)((const char*)a1p - wsb), a2 = (unsigned)((const char*)a2p - wsb), a3 = (unsigned)((const char*)a3p - wsb);
    const unsigned b0 = (unsigned)((const char*)b0p - wsb), b1 = (unsigned)((const char*)b1p - wsb), b2 = (unsigned)((const char*)b2p - wsb), b3 = (unsigned)((const char*)b3p - wsb);
    const int lane = threadIdx.x & 63, wid = __builtin_amdgcn_readfirstlane(threadIdx.x >> 6), wr = wid >> 2, wc = wid & 3, fr = lane & 15, fq = lane >> 4;
    f32x4 acc[8][4];
#pragma unroll
    for (int m = 0; m < 8; ++m)
#pragma unroll
        for (int n = 0; n < 4; ++n) acc[m][n] = (f32x4){0.f, 0.f, 0.f, 0.f};
#define STAGE256(buf, k0) { char* sa_ = smem_all + (buf) * 65536 + wid * 1024; char* sb_ = sa_ + 32768; const char* wk_ = wsb + (size_t)(k0) * 2; \
        GLDS(wk_ + a0, sa_); GLDS(wk_ + a1, sa_ + 8192); GLDS(wk_ + a2, sa_ + 16384); GLDS(wk_ + a3, sa_ + 24576); \
        if (NH < 0 || (wid >> 2) == NH) { GLDS(wk_ + b0, sb_); GLDS(wk_ + b1, sb_ + 8192); GLDS(wk_ + b2, sb_ + 16384); GLDS(wk_ + b3, sb_ + 24576); } }
    const int sw = (fr >> 1) & 7;
    const unsigned offA = (wr * 128 + fr) * 128, offB = 32768 + (wc * 64 + fr) * 128;
    const unsigned co0 = ((0 + fq) ^ sw) << 4, co1 = ((4 + fq) ^ sw) << 4;
    const unsigned lds0 = (unsigned)(size_t)smem_all;
    const int nt = K >> 6;
    STAGE256(0, 0)
    asm volatile("s_waitcnt vmcnt(0)" ::: "memory");
    __syncthreads();
#pragma unroll 1
    for (int t = 0; t < nt; ++t) {
        const int cur = t & 1;
        if (t + 1 < nt) STAGE256(cur ^ 1, (t + 1) * 64)
        const unsigned lb = lds0 + cur * 65536;
        const unsigned aA0 = lb + offA + co0, aA1 = lb + offA + co1, aB0 = lb + offB + co0, aB1 = lb + offB + co1;
        bf16x8 Bq0[4], Bq1[4], Aq0[2], Aq1[2];
#define DSR(dst, addr, off) asm volatile("ds_read_b128 %0, %1 offset:%2" : "=v"(dst) : "v"(addr), "n"(off) : "memory")
#define LDA2(dst, addr, mo) { DSR(dst[0], addr, (mo) * 2048); DSR(dst[1], addr, ((mo) + 1) * 2048); }
#define LDB4(dst, addr) { DSR(dst[0], addr, 0); DSR(dst[1], addr, 2048); DSR(dst[2], addr, 4096); DSR(dst[3], addr, 6144); }
#define WAIT_A(n, X) asm volatile("s_waitcnt lgkmcnt(" #n ")" : "+v"(X[0]), "+v"(X[1]) :: "memory")
#define WAIT_AB(n, X, Y) asm volatile("s_waitcnt lgkmcnt(" #n ")" : "+v"(X[0]), "+v"(X[1]), "+v"(Y[0]), "+v"(Y[1]), "+v"(Y[2]), "+v"(Y[3]) :: "memory")
#define MM8(Aq, Bq, mo) { _Pragma("unroll") for (int m = 0; m < 2; ++m) _Pragma("unroll") for (int n = 0; n < 4; ++n) if (NH < 0 || (n >> 1) == NH) acc[(mo) + m][n] = MFMA16(Bq[n], Aq[m], acc[(mo) + m][n]); }
        LDB4(Bq0, aB0) LDA2(Aq0, aA0, 0) LDA2(Aq1, aA0, 2)
        WAIT_AB(2, Aq0, Bq0);
        MM8(Aq0, Bq0, 0)
        LDA2(Aq0, aA0, 4)
        WAIT_A(2, Aq1);
        MM8(Aq1, Bq0, 2)
        LDA2(Aq1, aA0, 6) LDB4(Bq1, aB1)
        WAIT_A(6, Aq0);
        MM8(Aq0, Bq0, 4)
        LDA2(Aq0, aA1, 0)
        WAIT_A(6, Aq1);
        MM8(Aq1, Bq0, 6)
        LDA2(Aq1, aA1, 2)
        WAIT_AB(2, Aq0, Bq1);
        MM8(Aq0, Bq1, 0)
        LDA2(Aq0, aA1, 4)
        WAIT_A(2, Aq1);
        MM8(Aq1, Bq1, 2)
        LDA2(Aq1, aA1, 6)
        WAIT_A(2, Aq0);
        MM8(Aq0, Bq1, 4)
        WAIT_A(0, Aq1);
        MM8(Aq1, Bq1, 6)
#undef DSR
#undef LDA2
#undef LDB4
#undef WAIT_A
#undef WAIT_AB
#undef MM8
        asm volatile("s_waitcnt vmcnt(0)" ::: "memory");
        __syncthreads();
    }
#undef STAGE256
    int t_ = threadIdx.x;
    asm volatile("" : "+v"(t_));
    const int lane_ = t_ & 63, wid_ = t_ >> 6, wr_ = wid_ >> 2, wc_ = wid_ & 3, fr_ = lane_ & 15, fq_ = lane_ >> 4, hb_ = t_ >> 8;
#pragma unroll
    for (int p = 0; p < 2; ++p) {
        if (NH >= 0 && p != NH) continue;
        {
            float* Cs = (float*)(smem_all + wr_ * HB_SMEM) + fr_ * CP + wc_ * 32 + 4 * fq_;
#pragma unroll
            for (int m = 0; m < 8; ++m)
#pragma unroll
                for (int n = 0; n < 2; ++n) *(f32x4*)(Cs + (m * 16) * CP + n * 16) = acc[m][2 * p + n];
        }
        __syncthreads();
        epi((const float*)(smem_all + hb_ * HB_SMEM), hb_, p, t_ & 255);
        __syncthreads();
    }
}

DI void epi_store_bf16(const float* Cs, bf16_t* dst, int ld, int tid) {
#pragma unroll 2
    for (int j = 0; j < 8; ++j) {
        int c = tid + 256 * j, row = c >> 4, cc = c & 15;
        const float4* cp = (const float4*)(Cs + row * CP + cc * 8);
        float4 f0 = cp[0], f1 = cp[1];
        float v[8] = {f0.x, f0.y, f0.z, f0.w, f1.x, f1.y, f1.z, f1.w};
        *(uint4*)(dst + (size_t)row * ld + cc * 8) = pack8(v);
    }
}
DI void epi_resid(const float* Cs, const float* src, float* dst, const float* gate, int tid) {
#pragma unroll 4
    for (int j = 0; j < 16; ++j) {
        int c = tid + 256 * j, row = c >> 5, c4 = c & 31;
        float4 cv = *(const float4*)(Cs + row * CP + c4 * 4);
        float4 sv = *(const float4*)(src + (size_t)row * 1024 + c4 * 4);
        float4 gv = *(const float4*)(gate + c4 * 4);
        float4 o; o.x = sv.x + gv.x * cv.x; o.y = sv.y + gv.y * cv.y; o.z = sv.z + gv.z * cv.z; o.w = sv.w + gv.w * cv.w;
        *(float4*)(dst + (size_t)row * 1024 + c4 * 4) = o;
    }
}

DI int wsrc_col(int mode, int tn, int c) {
    if (mode == 0) return tn * 128 + c;
    if (mode == 1) {
        const int np = tn * 128;
        if (np < 512) return 672 + np + c;
        if (np < 640) return 1184 + np - 512 + c;
        if (np < 768) return 1312 + np - 640 + c;
        if (np < 1152) return np - 768 + c;
        if (np < 1408) return 384 + np - 1152 + c;
        return c < 32 ? 640 + c : -1;
    }
    if (mode == 2) return c < 96 ? tn * 96 + c : -1;
    return c < 64 ? 64 * tn + c : 2816 + 64 * tn + c - 64;
}
DI void wtile(const float* __restrict__ src, int Nsrc, const float* __restrict__ g, bf16_t* __restrict__ dst, int K, int k0, int tn, int mode, char* smem) {
    bf16_t* T = (bf16_t*)smem;
    const int tid = TID, lane = tid & 63, w = tid >> 6, rsub = lane >> 5, c4 = (lane & 31) * 4;
    int sc = wsrc_col(mode, tn, c4);
    if (sc >= Nsrc) sc = -1;
#pragma unroll 8
    for (int i = 0; i < 16; ++i) {
        const int rr = w * 32 + 2 * i + rsub;
        float4 v = make_float4(0.f, 0.f, 0.f, 0.f);
        if (sc >= 0) { v = *(const float4*)(src + (size_t)(k0 + rr) * Nsrc + sc); if (g) { const float gg = g[k0 + rr]; v.x *= gg; v.y *= gg; v.z *= gg; v.w *= gg; } }
        T[(c4 + 0) * 130 + rr] = f2bf(v.x);
        T[(c4 + 1) * 130 + rr] = f2bf(v.y);
        T[(c4 + 2) * 130 + rr] = f2bf(v.z);
        T[(c4 + 3) * 130 + rr] = f2bf(v.w);
    }
    __syncthreads();
#pragma unroll
    for (int j = 0; j < 8; ++j) {
        const int c = tid + 256 * j, n = c >> 4, kc = c & 15;
        const unsigned* s32 = (const unsigned*)(T + n * 130 + kc * 8);
        uint4 o; o.x = s32[0]; o.y = s32[1]; o.z = s32[2]; o.w = s32[3];
        *(uint4*)(dst + (size_t)(tn * 128 + n) * K + k0 + kc * 8) = o;
    }
    __syncthreads();
}

DI void mod_item(const Params& p, int item, char* smem) {
    const int tid = TID, lane = tid & 63, w = tid >> 6, hl = lane >> 5, cl = lane & 31;
    const int l = item / 192, n0 = (item % 192) * 32;
    float* sl = (float*)smem;
    for (int i = tid; i < 9216; i += 256) {
        int rr = i >> 10, k = i & 1023;
        float cv = rr < 8 ? p.c[rr * 1024 + k] : p.c_ctx[k];
        sl[i] = cv / (1.f + expf(-cv));
    }
    __syncthreads();
    float acc[9];
#pragma unroll
    for (int q = 0; q < 9; ++q) acc[q] = 0.f;
    const float* wp = p.ada_w + (size_t)l * 1024 * 6144 + n0 + cl;
#pragma unroll 16
    for (int kk = 0; kk < 128; ++kk) {
        const int k = w * 256 + 2 * kk + hl;
        float wv = wp[(size_t)k * 6144];
#pragma unroll
        for (int q = 0; q < 9; ++q) acc[q] += sl[q * 1024 + k] * wv;
    }
    float* red = (float*)(smem + 36864);
#pragma unroll
    for (int q = 0; q < 9; ++q) red[((w * 2 + hl) * 9 + q) * 32 + cl] = acc[q];
    __syncthreads();
    float* MOD = (float*)(p.ws + OFF_MOD);
    for (int i = tid; i < 288; i += 256) {
        int q = i >> 5, ln = i & 31;
        float sacc = 0.f;
#pragma unroll
        for (int u = 0; u < 8; ++u) sacc += red[(u * 9 + q) * 32 + ln];
        sacc += p.ada_b[l * 6144 + n0 + ln];
        MOD[(size_t)(l * 9 + q) * 6144 + n0 + ln] = sacc;
    }
    __syncthreads();
}

DI void sincos_d(double x, float& s, float& c) {
    const double TWO_PI = 6.283185307179586476925;
    double t = x / TWO_PI;
    t -= rint(t);
    double y = t * TWO_PI, y2 = y * y;
    double sv = y, cv = 1.0, ts = y, tc = 1.0;
#pragma unroll 1
    for (int k = 1; k <= 14; ++k) {
        tc *= -y2 / (double)((2 * k - 1) * (2 * k));
        ts *= -y2 / (double)((2 * k) * (2 * k + 1));
        cv += tc; sv += ts;
    }
    s = (float)sv; c = (float)cv;
}

DI void rope_tables(const Params& p) {
    float* TG = (float*)(p.ws + OFF_TABG);
    float* TM = (float*)(p.ws + OFF_TABM);
    for (int i = TID; i < 1024; i += 256) {
        int v = i >> 4, f = i & 15;
        float inv = exp2f(-(float)f / 16.f * 13.287712379549449f);
        float ang = (float)v * inv, s, c;
        sincos_d((double)ang, s, c);
        TG[i] = c; TG[1024 + i] = s;
    }
    for (int i = TID; i < 512; i += 256) {
        int v = i >> 3, f = i & 7;
        float inv = exp2f(-(float)f / 8.f * 13.287712379549449f);
        float ang = (float)v * inv, s, c;
        sincos_d((double)ang, s, c);
        TM[i] = c; TM[512 + i] = s;
    }
}

constexpr int NW = 10;
constexpr int N_WT = 8 * 12 + 3 * 8 + 2 * 8 + 8 * 8 + 8 * 44 + 22 * 8 + 8 * 44 + 22 * 8 + 8 * 26 + 8 * 8;
constexpr int N_MOD = 384;
constexpr int N_P0 = N_MOD + N_WT;
static_assert(N_P0 % 2 == 0 && N_MOD % 2 == 0, "phase 0 items are dealt to half-block pairs");

DI void phase0(const Params& p, char* smem_all) {
    char* smem = smem_all + HBI * HB_SMEM;
    if (blockIdx.x == gridDim.x - 1) {
        if (HBI == 0) rope_tables(p);
        else { for (int i = TID; i < 512; i += 256) ((uint4*)(p.ws + OFF_ZROW))[i] = make_uint4(0, 0, 0, 0); }
    }
    for (int it0 = blockIdx.x * 2; it0 < N_P0; it0 += gridDim.x * 2) {
        const int item = it0 + HBI;
        if (item < N_MOD) { mod_item(p, item, smem); continue; }
        int t = item - N_MOD;
        int wi = 0;
        int cnt[NW] = {8 * 12, 3 * 8, 2 * 8, 8 * 8, 8 * 44, 22 * 8, 8 * 44, 22 * 8, 8 * 26, 8 * 8};
#pragma unroll
        for (int i = 0; i < NW - 1; ++i) { if (wi == i && t >= cnt[i]) { t -= cnt[i]; wi = i + 1; } }
        const float* src; const float* g = nullptr; bf16_t* dst; int K, Nsrc, ntn, mode;
        switch (wi) {
            case 0: src = p.att_w_in; dst = (bf16_t*)(p.ws + OFF_WT_IN0); K = 1024; Nsrc = 1440; ntn = 12; mode = 1; break;
            case 1: src = p.mla_w_qb; g = p.mla_qa_g; dst = (bf16_t*)(p.ws + OFF_WT_QB); K = 384; Nsrc = 768; ntn = 8; mode = 2; break;
            case 2: src = p.mla_w_kvb; g = p.mla_kva_g; dst = (bf16_t*)(p.ws + OFF_WT_KVB); K = 256; Nsrc = 1024; ntn = 8; mode = 0; break;
            case 3: src = p.att_w_out; dst = (bf16_t*)(p.ws + OFF_WT_OUT0); K = 1024; Nsrc = 1024; ntn = 8; mode = 0; break;
            case 4: src = p.ffn_w_up; dst = (bf16_t*)(p.ws + OFF_WT_UP0); K = 1024; Nsrc = 5632; ntn = 44; mode = 3; break;
            case 5: src = p.ffn_w_down; dst = (bf16_t*)(p.ws + OFF_WT_DOWN0); K = 2816; Nsrc = 1024; ntn = 8; mode = 0; break;
            case 6: src = p.ffn_w_up + 1024ull * 5632; dst = (bf16_t*)(p.ws + OFF_WT_UP1); K = 1024; Nsrc = 5632; ntn = 44; mode = 3; break;
            case 7: src = p.ffn_w_down + 2816ull * 1024; dst = (bf16_t*)(p.ws + OFF_WT_DOWN1); K = 2816; Nsrc = 1024; ntn = 8; mode = 0; break;
            case 8: src = p.ml_w_in; dst = (bf16_t*)(p.ws + OFF_WT_IN1); K = 1024; Nsrc = 3104; ntn = 26; mode = 0; break;
            default: src = p.ml_w_out; dst = (bf16_t*)(p.ws + OFF_WT_OUT1); K = 1024; Nsrc = 1024; ntn = 8; mode = 0; break;
        }
        const int tn = t % ntn, tk = t / ntn;
        wtile(src, Nsrc, g, dst, K, tk * 128, tn, mode, smem);
    }
}

DI void norm_row_ptrs(int row, const float* srcLat, const float* srcCtx, const float* mod, int shift_idx, const float*& src, const float*& sh) {
    int mb;
    if (row < 16384) { src = srcLat + (size_t)row * 1024; mb = row >> 11; }
    else { src = srcCtx + (size_t)(row - 16384) * 1024; mb = 8; }
    sh = mod + (size_t)mb * 6144 + shift_idx * 1024;
}
DI void norm_row_finish(const float4 (&v)[4], float ss, const float* g, const float* sh, bf16_t* dst, int lane) {
#pragma unroll
    for (int o = 32; o >= 1; o >>= 1) ss += __shfl_xor(ss, o);
    const float rstd = rsqrtf(ss * (1.f / 1024.f) + EPSF);
    const float* sc = sh + 1024;
#pragma unroll
    for (int j = 0; j < 4; ++j) {
        const int c = j * 256 + lane * 4;
        const float4 gv = *(const float4*)(g + c), shv = *(const float4*)(sh + c), scv = *(const float4*)(sc + c);
        const float o0 = v[j].x * rstd * gv.x * (1.f + scv.x) + shv.x;
        const float o1 = v[j].y * rstd * gv.y * (1.f + scv.y) + shv.y;
        const float o2 = v[j].z * rstd * gv.z * (1.f + scv.z) + shv.z;
        const float o3 = v[j].w * rstd * gv.w * (1.f + scv.w) + shv.w;
        uint2 o; o.x = pack2(o0, o1); o.y = pack2(o2, o3);
        *(uint2*)(dst + c) = o;
    }
}
DI void phase_norm(const Params& p, const float* srcLat, const float* srcCtx, const float* g, const float* mod, int shift_idx, int nrows) {
    const int lane = threadIdx.x & 63, w = threadIdx.x >> 6;
    bf16_t* H = (bf16_t*)(p.ws + OFF_H);
    for (int row = (blockIdx.x * 8 + w) * 2; row < nrows; row += gridDim.x * 16) {
        const float *srcA, *shA, *srcB, *shB;
        norm_row_ptrs(row, srcLat, srcCtx, mod, shift_idx, srcA, shA);
        norm_row_ptrs(row + 1, srcLat, srcCtx, mod, shift_idx, srcB, shB);
        float4 va[4], vb[4];
        float sa = 0.f, sb = 0.f;
#pragma unroll
        for (int j = 0; j < 4; ++j) { va[j] = *(const float4*)(srcA + j * 256 + lane * 4); vb[j] = *(const float4*)(srcB + j * 256 + lane * 4); }
#pragma unroll
        for (int j = 0; j < 4; ++j) { sa += va[j].x * va[j].x + va[j].y * va[j].y + va[j].z * va[j].z + va[j].w * va[j].w; sb += vb[j].x * vb[j].x + vb[j].y * vb[j].y + vb[j].z * vb[j].z + vb[j].w * vb[j].w; }
        norm_row_finish(va, sa, g, shA, H + (size_t)row * 1024, lane);
        norm_row_finish(vb, sb, g, shB, H + (size_t)(row + 1) * 1024, lane);
    }
}

template <int Q>
DI void rope_apply(float* v, const float* tab, int rw, int cl) {
#pragma unroll
    for (int f = 0; f < Q; ++f) {
        float cr = tab[rw * Q + f], sr = tab[64 * Q + rw * Q + f], cc = tab[cl * Q + f], sc = tab[64 * Q + cl * Q + f];
        float a1 = v[f], a2 = v[Q + f], b1 = v[2 * Q + f], b2 = v[3 * Q + f];
        v[f] = a1 * cr - a2 * sr; v[Q + f] = a2 * cr + a1 * sr;
        v[2 * Q + f] = b1 * cc - b2 * sc; v[3 * Q + f] = b2 * cc + b1 * sc;
    }
}

DI void phase_inproj0(const Params& p, char* smem_all) {
    const bf16_t* H = (const bf16_t*)(p.ws + OFF_H);
    const bf16_t* W = (const bf16_t*)(p.ws + OFF_WT_IN0);
    const float* TG = (const float*)(p.ws + OFF_TABG);
    for (int id = blockIdx.x; id < 72 * 6; id += gridDim.x) {
        const int nt2 = id / 72, mt2 = id % 72;
        auto epi = [&](const float* Cs, int si, int sj, int tid) {
            const int nt = 2 * nt2 + sj, m0 = (2 * mt2 + si) * 128;
            int b, t0; bool lat; row_info(m0, b, t0, lat);
            const int s0 = lat ? 256 + t0 : t0;
            if (nt < 5) {
                const int row = tid & 127, half = tid >> 7;
                const float4* cp = (const float4*)(Cs + row * CP + half * 64);
                float ss = 0.f;
#pragma unroll
                for (int i = 0; i < 16; ++i) { float4 f = cp[i]; ss += f.x * f.x + f.y * f.y + f.z * f.z + f.w * f.w; }
                const float rstd = rsqrtf(ss * (1.f / 64.f) + EPSF);
                const float* g = nt < 4 ? p.gqa_q_g : p.gqa_k_g;
                const float osc = nt < 4 ? 0.125f * LOG2E : 1.f;
                bf16_t* dst;
                if (nt < 4) dst = (bf16_t*)(p.ws + OFF_QG) + ((size_t)(b * 2304 + s0 + row) * 8 + nt * 2 + half) * 64;
                else dst = (bf16_t*)(p.ws + OFF_KG) + ((size_t)(b * 2304 + s0 + row) * 2 + half) * 64;
                const int t = t0 + row;
#pragma unroll 1
                for (int hh = 0; hh < 2; ++hh) {
                    float v[32];
#pragma unroll
                    for (int i = 0; i < 8; ++i) { float4 f = cp[hh * 8 + i]; const float4 gv = *(const float4*)(g + hh * 32 + 4 * i);
                        v[4 * i] = f.x * rstd * gv.x; v[4 * i + 1] = f.y * rstd * gv.y; v[4 * i + 2] = f.z * rstd * gv.z; v[4 * i + 3] = f.w * rstd * gv.w; }
                    if (lat) {
                        const int pos = hh ? (t & 63) : (t >> 6);
#pragma unroll
                        for (int f = 0; f < 16; ++f) {
                            const float c_ = TG[pos * 16 + f], s_ = TG[1024 + pos * 16 + f];
                            const float x1 = v[f], x2 = v[16 + f];
                            v[f] = x1 * c_ - x2 * s_; v[16 + f] = x2 * c_ + x1 * s_;
                        }
                    }
#pragma unroll
                    for (int i = 0; i < 32; ++i) v[i] *= osc;
#pragma unroll
                    for (int i = 0; i < 4; ++i) *(uint4*)(dst + hh * 32 + i * 8) = pack8(v + i * 8);
                }
            } else if (nt == 5) {
                const int dall = tid & 127, ch0 = (tid >> 7) * 8;
                bf16_t* dst = (bf16_t*)(p.ws + OFF_VGT) + ((size_t)(b * 2 + (dall >> 6)) * 64 + (dall & 63)) * 2304 + s0;
#pragma unroll 2
                for (int ch = 0; ch < 8; ++ch) {
                    float v[8];
#pragma unroll
                    for (int i = 0; i < 8; ++i) v[i] = Cs[((ch0 + ch) * 8 + i) * CP + dall];
                    *(uint4*)(dst + (ch0 + ch) * 8) = pack8(v);
                }
            } else if (nt < 9) {
                epi_store_bf16(Cs, (bf16_t*)(p.ws + OFF_CQ) + (size_t)m0 * 384 + (nt - 6) * 128, 384, tid);
            } else if (nt < 11) {
                epi_store_bf16(Cs, (bf16_t*)(p.ws + OFF_CKV) + (size_t)m0 * 256 + (nt - 9) * 128, 256, tid);
            } else {
                const int row = tid >> 1, half = tid & 1;
                float* dst = (float*)(p.ws + OFF_KR) + (size_t)(m0 + row) * 32 + half * 16;
                const float4* cp = (const float4*)(Cs + row * CP + half * 16);
#pragma unroll
                for (int i = 0; i < 4; ++i) ((float4*)dst)[i] = cp[i];
            }
        };
        const int r0 = g_row(0), r1 = g_row(1), r2 = g_row(2), r3 = g_row(3);
        const bf16_t* Ab = H + (size_t)mt2 * 256 * 1024;
        const bf16_t* Bb = W + (size_t)nt2 * 256 * 1024;
        gemm256(p.ws, Ab + (size_t)r0 * 1024 + g_chunk(r0) * 8, Ab + (size_t)r1 * 1024 + g_chunk(r1) * 8, Ab + (size_t)r2 * 1024 + g_chunk(r2) * 8, Ab + (size_t)r3 * 1024 + g_chunk(r3) * 8,
                Bb + (size_t)b_perm(r0) * 1024 + g_chunk(r0) * 8, Bb + (size_t)b_perm(r1) * 1024 + g_chunk(r1) * 8, Bb + (size_t)b_perm(r2) * 1024 + g_chunk(r2) * 8, Bb + (size_t)b_perm(r3) * 1024 + g_chunk(r3) * 8,
                1024, smem_all, epi);
    }
}

DI void phase_mla_up(const Params& p, char* smem_all) {
    char* smem = smem_all + HBI * HB_SMEM;
    const float* TM = (const float*)(p.ws + OFF_TABM);
    for (int id0 = blockIdx.x * 2; id0 < 144 * 16; id0 += gridDim.x * 2) {
        const int id = id0 + HBI;
        const int nt = (id / 144) & 7, isKV = (id / 144) >> 3, mt = id % 144, m0 = mt * 128;
        int b, t0; bool lat; row_info(m0, b, t0, lat);
        const int s0 = lat ? 256 + t0 : t0;
        if (!isKV) {
            const bf16_t* A = (const bf16_t*)(p.ws + OFF_CQ);
#undef AROW
#define AROW(o_) (A + (size_t)(m0 + (TID >> 3) + (o_)) * 384)
            auto epi = [&](const float* Cs, const float* rowss) {
                const int tid = TID, row = tid >> 1, part = tid & 1;
                const float r1 = rsqrtf(rowss[row] * (1.f / 384.f) + EPSF);
                float v[48];
                const float4* cp = (const float4*)(Cs + row * CP + part * 48);
                float ss = 0.f;
#pragma unroll
                for (int i = 0; i < 12; ++i) { float4 f = cp[i]; v[4 * i] = f.x * r1; v[4 * i + 1] = f.y * r1; v[4 * i + 2] = f.z * r1; v[4 * i + 3] = f.w * r1; }
#pragma unroll
                for (int i = 0; i < 48; ++i) ss += v[i] * v[i];
                ss += __shfl_xor(ss, 1);
                const float r2 = rsqrtf(ss * (1.f / 96.f) + EPSF);
                const float* g = p.mla_q_g + part * 48;
#pragma unroll
                for (int i = 0; i < 48; ++i) v[i] = v[i] * r2 * g[i];
                if (lat && part == 1) { int t = t0 + row; rope_apply<8>(v + 16, TM, t >> 6, t & 63); }
                const float sc = 0.10206207261596575f * LOG2E;
#pragma unroll
                for (int i = 0; i < 48; ++i) v[i] *= sc;
                bf16_t* dst = (bf16_t*)(p.ws + OFF_QM) + ((size_t)(b * 2304 + s0 + row) * 8 + nt) * 96 + part * 48;
#pragma unroll
                for (int i = 0; i < 6; ++i) *(uint4*)(dst + i * 8) = pack8(v + i * 8);
            };
            gemm_tile<true, false>(AROW(0), AROW(32), AROW(64), AROW(96), 0u, 0u, 0u, 0u, (const bf16_t*)(p.ws + OFF_WT_QB) + (size_t)nt * 128 * 384, 384, 384, smem, epi);
        } else {
            const bf16_t* A = (const bf16_t*)(p.ws + OFF_CKV);
#undef AROW
#define AROW(o_) (A + (size_t)(m0 + (TID >> 3) + (o_)) * 256)
            auto epi = [&](const float* Cs, const float* rowss) {
                const int tid = TID;
                {
                    const int row = tid >> 1, part = tid & 1;
                    const float r1 = rsqrtf(rowss[row] * (1.f / 256.f) + EPSF);
                    float v[48];
                    if (part == 0) {
                        const float4* cp = (const float4*)(Cs + row * CP);
#pragma unroll
                        for (int i = 0; i < 12; ++i) { float4 f = cp[i]; v[4 * i] = f.x * r1; v[4 * i + 1] = f.y * r1; v[4 * i + 2] = f.z * r1; v[4 * i + 3] = f.w * r1; }
                    } else {
                        const float4* cp = (const float4*)(Cs + row * CP + 48);
#pragma unroll
                        for (int i = 0; i < 4; ++i) { float4 f = cp[i]; v[4 * i] = f.x * r1; v[4 * i + 1] = f.y * r1; v[4 * i + 2] = f.z * r1; v[4 * i + 3] = f.w * r1; }
                        const float4* kp = (const float4*)((const float*)(p.ws + OFF_KR) + (size_t)(m0 + row) * 32);
#pragma unroll
                        for (int i = 0; i < 8; ++i) { float4 f = kp[i]; v[16 + 4 * i] = f.x; v[16 + 4 * i + 1] = f.y; v[16 + 4 * i + 2] = f.z; v[16 + 4 * i + 3] = f.w; }
                    }
                    float ss = 0.f;
#pragma unroll
                    for (int i = 0; i < 48; ++i) ss += v[i] * v[i];
                    ss += __shfl_xor(ss, 1);
                    const float r2 = rsqrtf(ss * (1.f / 96.f) + EPSF);
                    const float* g = p.mla_k_g + part * 48;
#pragma unroll
                    for (int i = 0; i < 48; ++i) v[i] = v[i] * r2 * g[i];
                    if (lat && part == 1) { int t = t0 + row; rope_apply<8>(v + 16, TM, t >> 6, t & 63); }
                    bf16_t* dst = (bf16_t*)(p.ws + OFF_KM) + ((size_t)(b * 2304 + s0 + row) * 8 + nt) * 96 + part * 48;
#pragma unroll
                    for (int i = 0; i < 6; ++i) *(uint4*)(dst + i * 8) = pack8(v + i * 8);
                }
                {
                    const int d = tid & 63, cg4 = (tid >> 6) * 4;
                    bf16_t* dst = (bf16_t*)(p.ws + OFF_VMT) + ((size_t)(b * 8 + nt) * 64 + d) * 2304 + s0;
#pragma unroll 1
                    for (int ch = 0; ch < 4; ++ch) {
                        float v[8];
#pragma unroll
                        for (int i = 0; i < 8; ++i) { int rr = (cg4 + ch) * 8 + i; v[i] = Cs[rr * CP + 64 + d] * rsqrtf(rowss[rr] * (1.f / 256.f) + EPSF); }
                        *(uint4*)(dst + (cg4 + ch) * 8) = pack8(v);
                    }
                }
            };
            gemm_tile<true, false>(AROW(0), AROW(32), AROW(64), AROW(96), 0u, 0u, 0u, 0u, (const bf16_t*)(p.ws + OFF_WT_KVB) + (size_t)nt * 128 * 256, 256, 256, smem, epi);
        }
    }
}

template <int DK>
DI void attn_body(const bf16_t* __restrict__ Q, int qstride, const bf16_t* __restrict__ Kp, int kstride, const bf16_t* __restrict__ VT,
                  int nkeys, bf16_t* __restrict__ Odst, char* smem, char* smem_os) {
    constexpr int KP = DK + 8, VP = 72, NST = DK / 16, KCH = DK / 8;
    constexpr int NKL = (64 * KCH) / 256;
    constexpr int STAGE = 64 * KP * 2 + 64 * VP * 2;
    const int tid = TID, lane = tid & 63, w = tid >> 6, h = lane >> 5, r = lane & 31;
    bf16x8 qf[NST];
    {
        const bf16_t* qrow = Q + (size_t)(w * 32 + r) * qstride;
#pragma unroll
        for (int st = 0; st < NST; ++st) qf[st] = *(const bf16x8*)(qrow + st * 16 + h * 8);
    }
    f32x16 o[2]; o[0] = zero16(); o[1] = zero16();
    float m = 0.f, l = 0.f;
    uint4 ak0, ak1 = make_uint4(0, 0, 0, 0), av0, bk0, bk1 = make_uint4(0, 0, 0, 0), bv0;
    const int t5 = threadIdx.x;
    const int kr0 = t5 / KCH, kc0 = t5 % KCH, kr1 = (t5 + 512) / KCH, kc1 = (t5 + 512) % KCH;
    const bool k2 = t5 + 512 < 64 * KCH;
    const int vd0 = t5 >> 3, vc0 = t5 & 7;
#define AGLOAD(P_, key0) { P_##k0 = *(const uint4*)(Kp + (size_t)((key0) + kr0) * kstride + kc0 * 8); if (k2) P_##k1 = *(const uint4*)(Kp + (size_t)((key0) + kr1) * kstride + kc1 * 8); \
                       P_##v0 = *(const uint4*)(VT + (size_t)vd0 * 2304 + (key0) + vc0 * 8); }
#define ASWRITE(P_, s_) { bf16_t* Ks_ = (bf16_t*)(smem + (s_) * STAGE); bf16_t* Vs_ = Ks_ + 64 * KP; \
                      *(uint4*)(Ks_ + kr0 * KP + kc0 * 8) = P_##k0; if (k2) *(uint4*)(Ks_ + kr1 * KP + kc1 * 8) = P_##k1; \
                      *(uint4*)(Vs_ + vd0 * VP + vc0 * 8) = P_##v0; }
    const int nkt = nkeys >> 6;
    AGLOAD(a, 0) ASWRITE(a, 0) AGLOAD(a, 64) AGLOAD(b, 128) __syncthreads();
#pragma unroll 1
    for (int kt = 0; kt < nkt; kt += 2) {
        {
            const bf16_t* Ks = (const bf16_t*)(smem);
            const bf16_t* Vs = Ks + 64 * KP;
            f32x16 s[2];
#pragma unroll
            for (int i = 0; i < 16; ++i) { s[0][i] = -m; s[1][i] = -m; }
#pragma unroll
            for (int st = 0; st < NST; ++st)
#pragma unroll
                for (int kk = 0; kk < 2; ++kk) {
                    bf16x8 a = *(const bf16x8*)(Ks + (kk * 32 + r) * KP + st * 16 + h * 8);
                    s[kk] = MFMA(a, qf[st], s[kk]);
                }
            float mx = s[0][0];
#pragma unroll
            for (int i = 0; i < 16; ++i) { mx = fmaxf(mx, s[0][i]); mx = fmaxf(mx, s[1][i]); }
            mx = fmaxf(mx, __shfl_xor(mx, 32));
            if (__any(mx > 8.f)) {
                const float d = fmaxf(mx, 0.f);
                const float alpha = __builtin_amdgcn_exp2f(-d);
                l *= alpha;
#pragma unroll
                for (int i = 0; i < 16; ++i) { o[0][i] *= alpha; o[1][i] *= alpha; s[0][i] -= d; s[1][i] -= d; }
                m += d;
            }
            float ps = 0.f;
#pragma unroll
            for (int kk = 0; kk < 2; ++kk)
#pragma unroll
                for (int i = 0; i < 16; ++i) { float pv = __builtin_amdgcn_exp2f(s[kk][i]); s[kk][i] = pv; ps += pv; }
            l += ps;
#pragma unroll
            for (int kk = 0; kk < 2; ++kk)
#pragma unroll
                for (int s2 = 0; s2 < 2; ++s2) {
                    const bf16x8 pb = pack_frag(s[kk][8 * s2 + 0], s[kk][8 * s2 + 1], s[kk][8 * s2 + 2], s[kk][8 * s2 + 3], s[kk][8 * s2 + 4], s[kk][8 * s2 + 5], s[kk][8 * s2 + 6], s[kk][8 * s2 + 7]);
#pragma unroll
                    for (int dt = 0; dt < 2; ++dt) {
                        const bf16_t* vp = Vs + (dt * 32 + r) * VP + kk * 32 + 16 * s2 + 4 * h;
                        uint2 lo = *(const uint2*)vp, hi = *(const uint2*)(vp + 8);
                        uint4 vu; vu.x = lo.x; vu.y = lo.y; vu.z = hi.x; vu.w = hi.y;
                        o[dt] = MFMA(__builtin_bit_cast(bf16x8, vu), pb, o[dt]);
                    }
                }
        }
        ASWRITE(a, 1)
        if (kt + 3 < nkt) AGLOAD(a, (kt + 3) * 64)
        LDS_BARRIER();
        {
            const bf16_t* Ks = (const bf16_t*)(smem + STAGE);
            const bf16_t* Vs = Ks + 64 * KP;
            f32x16 s[2];
#pragma unroll
            for (int i = 0; i < 16; ++i) { s[0][i] = -m; s[1][i] = -m; }
#pragma unroll
            for (int st = 0; st < NST; ++st)
#pragma unroll
                for (int kk = 0; kk < 2; ++kk) {
                    bf16x8 a = *(const bf16x8*)(Ks + (kk * 32 + r) * KP + st * 16 + h * 8);
                    s[kk] = MFMA(a, qf[st], s[kk]);
                }
            float mx = s[0][0];
#pragma unroll
            for (int i = 0; i < 16; ++i) { mx = fmaxf(mx, s[0][i]); mx = fmaxf(mx, s[1][i]); }
            mx = fmaxf(mx, __shfl_xor(mx, 32));
            if (__any(mx > 8.f)) {
                const float d = fmaxf(mx, 0.f);
                const float alpha = __builtin_amdgcn_exp2f(-d);
                l *= alpha;
#pragma unroll
                for (int i = 0; i < 16; ++i) { o[0][i] *= alpha; o[1][i] *= alpha; s[0][i] -= d; s[1][i] -= d; }
                m += d;
            }
            float ps = 0.f;
#pragma unroll
            for (int kk = 0; kk < 2; ++kk)
#pragma unroll
                for (int i = 0; i < 16; ++i) { float pv = __builtin_amdgcn_exp2f(s[kk][i]); s[kk][i] = pv; ps += pv; }
            l += ps;
#pragma unroll
            for (int kk = 0; kk < 2; ++kk)
#pragma unroll
                for (int s2 = 0; s2 < 2; ++s2) {
                    const bf16x8 pb = pack_frag(s[kk][8 * s2 + 0], s[kk][8 * s2 + 1], s[kk][8 * s2 + 2], s[kk][8 * s2 + 3], s[kk][8 * s2 + 4], s[kk][8 * s2 + 5], s[kk][8 * s2 + 6], s[kk][8 * s2 + 7]);
#pragma unroll
                    for (int dt = 0; dt < 2; ++dt) {
                        const bf16_t* vp = Vs + (dt * 32 + r) * VP + kk * 32 + 16 * s2 + 4 * h;
                        uint2 lo = *(const uint2*)vp, hi = *(const uint2*)(vp + 8);
                        uint4 vu; vu.x = lo.x; vu.y = lo.y; vu.z = hi.x; vu.w = hi.y;
                        o[dt] = MFMA(__builtin_bit_cast(bf16x8, vu), pb, o[dt]);
                    }
                }
        }
        if (kt + 2 < nkt) ASWRITE(b, 0)
        if (kt + 4 < nkt) AGLOAD(b, (kt + 4) * 64)
        LDS_BARRIER();
    }
#undef AGLOAD
#undef ASWRITE
    l += __shfl_xor(l, 32);
    const float inv = 1.f / l;
    bf16_t* Os = (bf16_t*)smem_os + (size_t)w * 32 * 72;
#pragma unroll
    for (int dt = 0; dt < 2; ++dt)
#pragma unroll
        for (int g = 0; g < 4; ++g) {
            uint2 u; u.x = pack2(o[dt][4 * g] * inv, o[dt][4 * g + 1] * inv); u.y = pack2(o[dt][4 * g + 2] * inv, o[dt][4 * g + 3] * inv);
            *(uint2*)(Os + r * 72 + dt * 32 + 8 * g + 4 * h) = u;
        }
    __syncthreads();
#pragma unroll
    for (int j = 0; j < 4; ++j) {
        int c = lane + 64 * j, row = c >> 3, cc = c & 7;
        uint4 u = *(const uint4*)(Os + row * 72 + cc * 8);
        *(uint4*)(Odst + (size_t)(w * 32 + row) * 1024 + cc * 8) = u;
    }
    __syncthreads();
}

DI void phase_attn(const Params& p, char* smem_all) {
    char* smem = smem_all;
    char* smem_os = smem_all + 65536 + HBI * 20480;
    bf16_t* O = (bf16_t*)(p.ws + OFF_H);
    for (int it0 = blockIdx.x * 2; it0 < 2304; it0 += gridDim.x * 2) {
        const int item = it0 + HBI;
        int b, kind, hq, qb, nkeys, sq0, orow;
        if (item < 2048) { qb = item & 15; hq = (item >> 4) & 7; kind = (item >> 7) & 1; b = item >> 8; sq0 = 256 + qb * 128; nkeys = 2304; orow = b * 2048 + qb * 128; }
        else { int it = item - 2048; qb = it & 1; hq = (it >> 1) & 7; kind = (it >> 4) & 1; b = it >> 5; sq0 = qb * 128; nkeys = 256; orow = 16384 + b * 256 + qb * 128; }
        bf16_t* od = O + (size_t)orow * 1024 + kind * 512 + hq * 64;
        if (kind == 0) {
            const bf16_t* Q = (const bf16_t*)(p.ws + OFF_QM) + ((size_t)(b * 2304 + sq0) * 8 + hq) * 96;
            const bf16_t* K = (const bf16_t*)(p.ws + OFF_KM) + ((size_t)(b * 2304) * 8 + hq) * 96;
            const bf16_t* VT = (const bf16_t*)(p.ws + OFF_VMT) + (size_t)(b * 8 + hq) * 64 * 2304;
            attn_body<96>(Q, 768, K, 768, VT, nkeys, od, smem, smem_os);
        } else {
            const int kvh = hq >> 2;
            const bf16_t* Q = (const bf16_t*)(p.ws + OFF_QG) + ((size_t)(b * 2304 + sq0) * 8 + hq) * 64;
            const bf16_t* K = (const bf16_t*)(p.ws + OFF_KG) + ((size_t)(b * 2304) * 2 + kvh) * 64;
            const bf16_t* VT = (const bf16_t*)(p.ws + OFF_VGT) + (size_t)(b * 2 + kvh) * 64 * 2304;
            attn_body<64>(Q, 512, K, 128, VT, nkeys, od, smem, smem_os);
        }
    }
}

DI void phase_proj_resid(const Params& p, const bf16_t* A, int K, const bf16_t* W, const float* mod, int gate_idx,
                         const float* srcLat, const float* srcCtx, float* dstLat, float* dstCtx, int mtiles2, bool ctx_small, char* smem_all) {
    for (int id = blockIdx.x; id < mtiles2 * 4; id += gridDim.x) {
        const int nt2 = id / mtiles2, mt2 = id % mtiles2;
        auto epi = [&](const float* Cs, int si, int sj, int tid) {
            const int nt = 2 * nt2 + sj, m0 = (2 * mt2 + si) * 128;
            const float* src; float* dst; int mb;
            if (m0 < 16384) { src = srcLat + (size_t)m0 * 1024; dst = dstLat + (size_t)m0 * 1024; mb = m0 >> 11; }
            else { src = srcCtx + (size_t)(m0 - 16384) * 1024; dst = dstCtx + (size_t)(m0 - 16384) * 1024; mb = 8; }
            epi_resid(Cs, src + nt * 128, dst + nt * 128, mod + (size_t)mb * 6144 + gate_idx * 1024 + nt * 128, tid);
        };
        const int r0 = g_row(0), r1 = g_row(1), r2 = g_row(2), r3 = g_row(3);
        const bf16_t* Ab = A + (size_t)mt2 * 256 * K;
        const bf16_t* Bb = W + (size_t)nt2 * 256 * K;
        gemm256(p.ws, Ab + (size_t)r0 * K + g_chunk(r0) * 8, Ab + (size_t)r1 * K + g_chunk(r1) * 8, Ab + (size_t)r2 * K + g_chunk(r2) * 8, Ab + (size_t)r3 * K + g_chunk(r3) * 8,
                Bb + (size_t)b_perm(r0) * K + g_chunk(r0) * 8, Bb + (size_t)b_perm(r1) * K + g_chunk(r1) * 8, Bb + (size_t)b_perm(r2) * K + g_chunk(r2) * 8, Bb + (size_t)b_perm(r3) * K + g_chunk(r3) * 8,
                K, smem_all, epi);
    }
    if (ctx_small) {
        for (int hq = blockIdx.x; hq < 64; hq += gridDim.x) {
            const int mt2 = 64 + (hq >> 3), nt = hq & 7;
            auto epi = [&](const float* Cs, int si, int, int tid) {
                const int m0 = (2 * mt2 + si) * 128 - 16384;
                epi_resid(Cs, srcCtx + (size_t)m0 * 1024 + nt * 128, dstCtx + (size_t)m0 * 1024 + nt * 128, mod + (size_t)8 * 6144 + gate_idx * 1024 + nt * 128, tid);
            };
            const int r0 = g_row(0), r1 = g_row(1), r2 = g_row(2), r3 = g_row(3);
            const bf16_t* Ab = A + (size_t)mt2 * 256 * K;
            const bf16_t* Bb = W + (size_t)nt * 128 * K;
            gemm256<0>(p.ws, Ab + (size_t)r0 * K + g_chunk(r0) * 8, Ab + (size_t)r1 * K + g_chunk(r1) * 8, Ab + (size_t)r2 * K + g_chunk(r2) * 8, Ab + (size_t)r3 * K + g_chunk(r3) * 8,
                       Bb + (size_t)b_perm(r0) * K + g_chunk(r0) * 8, Bb + (size_t)b_perm(r1) * K + g_chunk(r1) * 8, Bb + (size_t)b_perm(r2) * K + g_chunk(r2) * 8, Bb + (size_t)b_perm(r3) * K + g_chunk(r3) * 8,
                       K, smem_all, epi);
        }
    }
}

DI float4 conv4(float4 w0, float4 w1, float4 w2, float4 bb, float4 gm, float4 g0, float4 gp, float4 v) {
    float4 o;
    o.x = siluf_(w0.x * gm.x + w1.x * g0.x + w2.x * gp.x + bb.x) * v.x;
    o.y = siluf_(w0.y * gm.y + w1.y * g0.y + w2.y * gp.y + bb.y) * v.y;
    o.z = siluf_(w0.z * gm.z + w1.z * g0.z + w2.z * gp.z + bb.z) * v.z;
    o.w = siluf_(w0.w * gm.w + w1.w * g0.w + w2.w * gp.w + bb.w) * v.w;
    return o;
}
DI void halo_info(int mt, int& base, int& T, int& tstart) {
    int ti;
    if (mt < 136) { base = (mt / 17) * 2048; T = 2048; ti = mt % 17; }
    else { int q = mt - 136; base = 16384 + (q / 3) * 256; T = 256; ti = q % 3; }
    tstart = 126 * ti - 1;
}
DI const bf16_t* halo_ptr(const bf16_t* H, const bf16_t* Z, int mt2, int row) {
    int base, T, tstart; halo_info(2 * mt2 + (row >> 7), base, T, tstart);
    const int t = tstart + (row & 127);
    return (t >= 0 && t < T) ? H + (size_t)(base + t) * 1024 + g_chunk(row) * 8 : Z;
}
DI void phase_ffn_up(const Params& p, const bf16_t* W, const float* convw, const float* convb, int mtiles2, char* smem_all) {
    const bf16_t* H = (const bf16_t*)(p.ws + OFF_H);
    const bf16_t* Z = (const bf16_t*)(p.ws + OFF_ZROW);
    bf16_t* ACT = (bf16_t*)(p.ws + OFF_ACT);
    for (int id = blockIdx.x; id < mtiles2 * 22; id += gridDim.x) {
        const int nt2 = id / mtiles2, mt2 = id % mtiles2;
        auto epi = [&](const float* Cs, int si, int sj, int tid) {
            const int nt = 2 * nt2 + sj;
            int base, T, tstart; halo_info(2 * mt2 + si, base, T, tstart);
            const int cc = tid & 7;
            const int cg0 = nt * 64 + cc * 8;
            const float4 w0a = *(const float4*)(convw + cg0), w0b = *(const float4*)(convw + cg0 + 4);
            const float4 w1a = *(const float4*)(convw + 2816 + cg0), w1b = *(const float4*)(convw + 2816 + cg0 + 4);
            const float4 w2a = *(const float4*)(convw + 5632 + cg0), w2b = *(const float4*)(convw + 5632 + cg0 + 4);
            const float4 bba = *(const float4*)(convb + cg0), bbb = *(const float4*)(convb + cg0 + 4);
#pragma unroll
            for (int j = 0; j < 4; ++j) {
                const int rr = (tid >> 3) + 32 * j, t = tstart + rr;
                if (rr >= 1 && rr <= 126 && t < T) {
                    const float4* a = (const float4*)(Cs + (rr - 1) * CP + cc * 8);
                    const float4* bq = (const float4*)(Cs + rr * CP + cc * 8);
                    const float4* c = (const float4*)(Cs + (rr + 1) * CP + cc * 8);
                    const float4* d = (const float4*)(Cs + rr * CP + 64 + cc * 8);
                    const float4 oa = conv4(w0a, w1a, w2a, bba, a[0], bq[0], c[0], d[0]);
                    const float4 ob = conv4(w0b, w1b, w2b, bbb, a[1], bq[1], c[1], d[1]);
                    uint4 u; u.x = pack2(oa.x, oa.y); u.y = pack2(oa.z, oa.w); u.z = pack2(ob.x, ob.y); u.w = pack2(ob.z, ob.w);
                    *(uint4*)(ACT + (size_t)(base + t) * 2816 + cg0) = u;
                }
            }
        };
        const int r0 = g_row(0), r1 = g_row(1), r2 = g_row(2), r3 = g_row(3);
        const bf16_t* Bb = W + (size_t)nt2 * 256 * 1024;
        gemm256(p.ws, halo_ptr(H, Z, mt2, r0), halo_ptr(H, Z, mt2, r1), halo_ptr(H, Z, mt2, r2), halo_ptr(H, Z, mt2, r3),
                Bb + (size_t)b_perm(r0) * 1024 + g_chunk(r0) * 8, Bb + (size_t)b_perm(r1) * 1024 + g_chunk(r1) * 8, Bb + (size_t)b_perm(r2) * 1024 + g_chunk(r2) * 8, Bb + (size_t)b_perm(r3) * 1024 + g_chunk(r3) * 8,
                1024, smem_all, epi);
    }
}

DI void inproj1_epi(const Params& p, const float* Cs, int nt, int m0, int tid) {
    if (nt < 8) epi_store_bf16(Cs, (bf16_t*)(p.ws + OFF_QKRAW) + (size_t)m0 * 1024 + nt * 128, 1024, tid);
    else if (nt < 16) epi_store_bf16(Cs, (bf16_t*)(p.ws + OFF_V1) + (size_t)m0 * 1024 + (nt - 8) * 128, 1024, tid);
    else if (nt < 24) epi_store_bf16(Cs, (bf16_t*)(p.ws + OFF_OG) + (size_t)m0 * 1024 + (nt - 16) * 128, 1024, tid);
    else if (nt == 24) {
        const int row = tid >> 1, half = tid & 1;
        float* dst = (float*)(p.ws + OFF_GATES) + (size_t)(m0 + row) * 32 + half * 16;
#pragma unroll 4
        for (int i = 0; i < 16; ++i) {
            int c = half * 16 + i;
            float v = Cs[row * CP + c] + p.ml_gate_b[c];
            if (c & 8) v = logsigmoidf_(v);
            dst[i] = v;
        }
    }
}
DI void inproj1_tile_of(int f, int& nt2, int& mt2) { if (f < 576) { nt2 = f / 72; mt2 = f % 72; } else { const int g = f - 576; nt2 = 8 + g / 64; mt2 = g % 64; } }
DI void phase_inproj1(const Params& p, char* smem_all) {
    const bf16_t* H = (const bf16_t*)(p.ws + OFF_H);
    const bf16_t* W = (const bf16_t*)(p.ws + OFF_WT_IN1);
    const int G = gridDim.x, nfr = 832 / G, rem = 832 - nfr * G, nhalf = 2 * rem + 72;
    const int r0 = g_row(0), r1 = g_row(1), r2 = g_row(2), r3 = g_row(3);
#define IN1_ARGS p.ws, Ab + (size_t)r0 * 1024 + g_chunk(r0) * 8, Ab + (size_t)r1 * 1024 + g_chunk(r1) * 8, Ab + (size_t)r2 * 1024 + g_chunk(r2) * 8, Ab + (size_t)r3 * 1024 + g_chunk(r3) * 8, \
                Bb + (size_t)b_perm(r0) * 1024 + g_chunk(r0) * 8, Bb + (size_t)b_perm(r1) * 1024 + g_chunk(r1) * 8, Bb + (size_t)b_perm(r2) * 1024 + g_chunk(r2) * 8, Bb + (size_t)b_perm(r3) * 1024 + g_chunk(r3) * 8, \
                1024, smem_all, epi
    for (int trip = 0; trip < nfr; ++trip) {
        int nt2, mt2; inproj1_tile_of(trip * G + blockIdx.x, nt2, mt2);
        auto epi = [&](const float* Cs, int si, int sj, int tid) { inproj1_epi(p, Cs, 2 * nt2 + sj, (2 * mt2 + si) * 128, tid); };
        const bf16_t* Ab = H + (size_t)mt2 * 256 * 1024;
        const bf16_t* Bb = W + (size_t)nt2 * 256 * 1024;
        gemm256<-1>(IN1_ARGS);
    }
    for (int hq = blockIdx.x; hq < nhalf; hq += G) {
        int nt2, mt2, nh;
        if (hq < 2 * rem) { inproj1_tile_of(nfr * G + (hq >> 1), nt2, mt2); nh = hq & 1; } else { nt2 = 12; mt2 = hq - 2 * rem; nh = 0; }
        auto epi = [&](const float* Cs, int si, int, int tid) { inproj1_epi(p, Cs, 2 * nt2 + nh, (2 * mt2 + si) * 128, tid); };
        const bf16_t* Ab = H + (size_t)mt2 * 256 * 1024;
        const bf16_t* Bb = W + ((size_t)nt2 * 256 + nh * 128) * 1024;
        gemm256<0>(IN1_ARGS);
    }
#undef IN1_ARGS
}

DI void phase_qkconv(const Params& p) {
    const bf16_t* QK = (const bf16_t*)(p.ws + OFF_QKRAW);
    bf16_t* QC = (bf16_t*)(p.ws + OFF_H);
    {
        const int lane = threadIdx.x & 63, gw = blockIdx.x * 8 + (threadIdx.x >> 6);
        const float* GT = (const float*)(p.ws + OFF_GATES);
        float* SC = (float*)(p.ws + OFF_SCAN);
        for (int seg = gw; seg < 2304; seg += gridDim.x * 8) {
            const int step = seg % 18, dir = (seg / 18) & 1, hd = (seg / 36) & 7, b = seg / 288;
            int base, P0;
            if (step < 2) { base = 16384 + b * 256; P0 = (dir ? 1 - step : step) * 128; } else { base = b * 2048; P0 = (dir ? 17 - step : step - 2) * 128; }
            const int pa = dir ? P0 + 127 - lane : P0 + lane, pb = dir ? pa - 64 : pa + 64;
            const float* ga = GT + (size_t)(base + pa) * 32 + dir * 16 + hd; const float* gb = GT + (size_t)(base + pb) * 32 + dir * 16 + hd;
            const float i0 = ga[0], f0 = ga[8], i1 = gb[0], f1 = gb[8];
            float b0 = f0, b1 = f1;
#pragma unroll
            for (int off = 1; off < 64; off <<= 1) { float t0 = __shfl_up(b0, off), t1 = __shfl_up(b1, off); if (lane >= off) { b0 += t0; b1 += t1; } }
            b1 += __shfl(b0, 63);
            float p0 = i0 - b0, p1 = i1 - b1;
            const float c0 = p0, c1 = p1;
#pragma unroll
            for (int off = 1; off < 64; off <<= 1) { float t0 = __shfl_up(p0, off), t1 = __shfl_up(p1, off); if (lane >= off) { p0 = fmaxf(p0, t0); p1 = fmaxf(p1, t1); } }
            p1 = fmaxf(p1, __shfl(p0, 63));
            float* o = SC + (size_t)seg * 384;
            o[lane] = b0; o[64 + lane] = b1; o[128 + lane] = p0; o[192 + lane] = p1; o[256 + lane] = c0; o[320 + lane] = c1;
        }
    }
    for (int c = blockIdx.x * NTHREADS + threadIdx.x; c < 18432 * 128; c += gridDim.x * NTHREADS) {
        const int row = c >> 7, col = (c & 127) * 8;
        int T, t;
        if (row < 16384) { T = 2048; t = row & 2047; } else { T = 256; t = (row - 16384) & 255; }
        float acc[8];
        { const float4 b0 = *(const float4*)(p.ml_conv_b + col), b1 = *(const float4*)(p.ml_conv_b + col + 4);
          acc[0] = b0.x; acc[1] = b0.y; acc[2] = b0.z; acc[3] = b0.w; acc[4] = b1.x; acc[5] = b1.y; acc[6] = b1.z; acc[7] = b1.w; }
#pragma unroll
        for (int dj = 0; dj < 3; ++dj) {
            const int tt = t + dj - 1;
            const float on = (tt >= 0 && tt < T) ? 1.f : 0.f;
            const int rr = row + min(max(tt, 0), T - 1) - t;
            float f[8]; unpack8(*(const uint4*)(QK + (size_t)rr * 1024 + col), f);
            const float4 w0 = *(const float4*)(p.ml_conv_w + dj * 1024 + col), w1 = *(const float4*)(p.ml_conv_w + dj * 1024 + col + 4);
            acc[0] += w0.x * on * f[0]; acc[1] += w0.y * on * f[1]; acc[2] += w0.z * on * f[2]; acc[3] += w0.w * on * f[3];
            acc[4] += w1.x * on * f[4]; acc[5] += w1.y * on * f[5]; acc[6] += w1.z * on * f[6]; acc[7] += w1.w * on * f[7];
        }
        const float sc = col >= 512 ? 0.125f : 1.f;
#pragma unroll
        for (int i = 0; i < 8; ++i) acc[i] = siluf_(acc[i]) * sc;
        *(uint4*)(QC + (size_t)row * 1024 + col) = pack8(acc);
    }
}

DI void phase_mlstm(const Params& p, char* smem) {
    constexpr int LP = 72, TP = 136, L = 128;
    bf16_t* Qc = (bf16_t*)smem;
    bf16_t* Kc = Qc + L * LP;
    bf16_t* KcT = Kc + L * LP;
    bf16_t* VcT = KcT + 64 * TP;
    bf16_t* VwT = VcT + 64 * TP;
    bf16_t* Pm = VwT + 64 * TP;
    bf16_t* Cb = Pm + L * TP;
    float* fa = (float*)(Cb + 64 * LP);
    float* bcum = fa; float* ig = fa + 128; float* mtv = fa + 256; float* wint = fa + 384; float* denI = fa + 512; float* denX = fa + 640;
    float* wgt = fa + 768; float* nvec = fa + 896; float* scal = fa + 960; float* csv = fa + 1024; float* denP = fa + 1152;
    static_assert((2 * L * LP + 3 * 64 * TP + L * TP + 64 * LP) * 2 + 1408 * 4 <= SMEM_ALL, "mLSTM LDS");
    const int lane0 = threadIdx.x & 63, w = __builtin_amdgcn_readfirstlane(threadIdx.x >> 6);
    const bf16_t* QK = (const bf16_t*)(p.ws + OFF_H);
    const bf16_t* V1 = (const bf16_t*)(p.ws + OFF_V1);
    const float* GT = (const float*)(p.ws + OFF_GATES);
    for (int item = blockIdx.x; item < 256; item += gridDim.x) {
        const int vh = item & 1, dir = (item >> 1) & 1, hd = (item >> 2) & 7, b = item >> 5;
        bf16_t* Hout = (bf16_t*)(p.ws + (dir ? OFF_HB : OFF_HF));
        f32x16 accC = zero16();
        float m_prev = 0.f;
        for (int i = w * 64 + lane0; i < 64 * LP; i += 512) Cb[i] = 0;
        if (w == 0) nvec[lane0] = 0.f;
        int lane = lane0, tid = w * 64 + lane0, h = lane0 >> 5, r = lane0 & 31;
        int u = tid >> 2, part = tid & 3;
        uint4 rq0, rq1, rk0, rk1, rv0, rv1;
        float sc_b = 0.f, sc_p = 0.f, sc_c = 0.f, sc_bl = 0.f, sc_pl = 0.f;
#define ML_STEP_GEOM(st, base_, P0_) { if ((st) < 2) { base_ = 16384 + b * 256; P0_ = (dir ? 1 - (st) : (st)) * L; } else { base_ = b * 2048; P0_ = (dir ? 17 - (st) : (st) - 2) * L; } }
#define ML_PREFETCH(st) { int base_, P0_; ML_STEP_GEOM(st, base_, P0_) \
            const int pos_ = dir ? P0_ + L - 1 - u : P0_ + u; \
            { const bf16_t* rowp = QK + (size_t)(base_ + pos_) * 1024; \
              const int qcol = hd * 64 + part * 16, kcol = 512 + qcol; rq0 = *(const uint4*)(rowp + qcol); rq1 = *(const uint4*)(rowp + qcol + 8); rk0 = *(const uint4*)(rowp + kcol); rk1 = *(const uint4*)(rowp + kcol + 8); } \
            { const bf16_t* vp_ = V1 + (size_t)(base_ + pos_) * 1024 + hd * 128 + vh * 64 + part * 16; rv0 = *(const uint4*)vp_; rv1 = *(const uint4*)(vp_ + 8); } \
            if (w < 2) { const float* sp_ = (const float*)(p.ws + OFF_SCAN) + (size_t)((((b * 8 + hd) * 2 + dir) * 18) + (st)) * 384; \
                sc_b = sp_[tid]; sc_p = sp_[128 + tid]; sc_c = sp_[256 + tid]; sc_bl = sp_[127]; sc_pl = sp_[255]; } }
        ML_PREFETCH(0)
        __syncthreads();
#pragma unroll 1
        for (int step = 0; step < 18; ++step) {
            lane = lane0; asm volatile("" : "+v"(lane));
            tid = w * 64 + lane; h = lane >> 5; r = lane & 31; u = tid >> 2; part = tid & 3;
            int base, P0; ML_STEP_GEOM(step, base, P0)
            const bool full = step >= 2;
            if (w < 2) {
                const float mt = fmaxf(sc_b + m_prev, sc_b + sc_p);
                const float mnew = fmaxf(sc_bl + m_prev, sc_bl + sc_pl);
                bcum[tid] = sc_b; csv[tid] = sc_c; mtv[tid] = mt;
                wint[tid] = __expf(sc_b + m_prev - mt);
                wgt[tid] = __expf(sc_bl + sc_c - mnew);
                if (tid == 0) { scal[0] = mnew; scal[1] = __expf(sc_bl + m_prev - mnew); }
            }
            {
                *(uint4*)(Qc + u * LP + part * 16) = rq0; *(uint4*)(Qc + u * LP + part * 16 + 8) = rq1;
                *(uint4*)(Kc + u * LP + part * 16) = rk0; *(uint4*)(Kc + u * LP + part * 16 + 8) = rk1;
#define ML_T2(dstT, wv, ci) { dstT[(part * 16 + (ci)) * TP + u] = (bf16_t)((wv) & 0xffffu); dstT[(part * 16 + (ci) + 1) * TP + u] = (bf16_t)((wv) >> 16); }
                ML_T2(KcT, rk0.x, 0) ML_T2(KcT, rk0.y, 2) ML_T2(KcT, rk0.z, 4) ML_T2(KcT, rk0.w, 6) ML_T2(KcT, rk1.x, 8) ML_T2(KcT, rk1.y, 10) ML_T2(KcT, rk1.z, 12) ML_T2(KcT, rk1.w, 14)
                ML_T2(VcT, rv0.x, 0) ML_T2(VcT, rv0.y, 2) ML_T2(VcT, rv0.z, 4) ML_T2(VcT, rv0.w, 6) ML_T2(VcT, rv1.x, 8) ML_T2(VcT, rv1.y, 10) ML_T2(VcT, rv1.z, 12) ML_T2(VcT, rv1.w, 14)
#undef ML_T2
            }
            if (step + 1 < 18) ML_PREFETCH(step + 1)
            LDS_BARRIER();
            const float m_new = scal[0], decay = scal[1];
            {
                const int vv = tid >> 3, s0_ = (tid & 7) * 16;
#pragma unroll
                for (int q = 0; q < 2; ++q) {
                    float f[8]; unpack8(*(const uint4*)(VcT + vv * TP + s0_ + q * 8), f);
                    const float4 w0 = *(const float4*)(wgt + s0_ + q * 8), w1 = *(const float4*)(wgt + s0_ + q * 8 + 4);
                    f[0] *= w0.x; f[1] *= w0.y; f[2] *= w0.z; f[3] *= w0.w; f[4] *= w1.x; f[5] *= w1.y; f[6] *= w1.z; f[7] *= w1.w;
                    *(uint4*)(VwT + vv * TP + s0_ + q * 8) = pack8(f);
                }
            }
            if (full) {
                {
                    float sacc_ = 0.f;
#pragma unroll
                    for (int q = 0; q < 2; ++q) {
                        float f[8]; unpack8(*(const uint4*)(Qc + u * LP + part * 16 + q * 8), f);
                        const float4 n0 = *(const float4*)(nvec + part * 16 + q * 8), n1 = *(const float4*)(nvec + part * 16 + q * 8 + 4);
                        sacc_ += f[0] * n0.x + f[1] * n0.y + f[2] * n0.z + f[3] * n0.w + f[4] * n1.x + f[5] * n1.y + f[6] * n1.z + f[7] * n1.w;
                    }
                    sacc_ += __shfl_xor(sacc_, 1); sacc_ += __shfl_xor(sacc_, 2);
                    if (part == 0) denX[u] = sacc_;
                }
                const int ti = w >> 1, t = ti * 32 + r;
                const float bt = bcum[t] - mtv[t];
                float rs = 0.f;
#pragma unroll
                for (int q = 0; q < 2; ++q) {
                    const int si = 2 * (w & 1) + q;
                    if (si <= ti) {
                        f32x16 sacc = zero16();
#pragma unroll
                        for (int ks = 0; ks < 4; ++ks) {
                            bf16x8 a = *(const bf16x8*)(Kc + (si * 32 + r) * LP + ks * 16 + h * 8);
                            bf16x8 bb = *(const bf16x8*)(Qc + (ti * 32 + r) * LP + ks * 16 + h * 8);
                            sacc = MFMA(a, bb, sacc);
                        }
#pragma unroll
                        for (int g4 = 0; g4 < 4; ++g4) {
                            const int s0_ = si * 32 + 8 * g4 + 4 * h;
                            const float4 c4 = *(const float4*)(csv + s0_);
                            float p0 = s0_ + 0 <= t ? sacc[4 * g4 + 0] * __expf(bt + c4.x) : 0.f;
                            float p1 = s0_ + 1 <= t ? sacc[4 * g4 + 1] * __expf(bt + c4.y) : 0.f;
                            float p2 = s0_ + 2 <= t ? sacc[4 * g4 + 2] * __expf(bt + c4.z) : 0.f;
                            float p3 = s0_ + 3 <= t ? sacc[4 * g4 + 3] * __expf(bt + c4.w) : 0.f;
                            rs += (p0 + p1) + (p2 + p3);
                            uint2 pk; pk.x = pack2(p0, p1); pk.y = pack2(p2, p3);
                            *(uint2*)(Pm + t * TP + s0_) = pk;
                        }
                    } else {
#pragma unroll
                        for (int g4 = 0; g4 < 4; ++g4) *(uint2*)(Pm + t * TP + si * 32 + 8 * g4 + 4 * h) = make_uint2(0u, 0u);
                    }
                }
                rs += __shfl_xor(rs, 32);
                if (h == 0) denP[(w & 1) * 128 + t] = rs;
            }
            LDS_BARRIER();
            f32x16 hacc = zero16();
            const int ti = w >> 1, vi = w & 1;
            if (full) {
#pragma unroll
                for (int ks = 0; ks < 4; ++ks) {
                    bf16x8 a = *(const bf16x8*)(Cb + (vi * 32 + r) * LP + ks * 16 + h * 8);
                    bf16x8 bb = *(const bf16x8*)(Qc + (ti * 32 + r) * LP + ks * 16 + h * 8);
                    hacc = MFMA(a, bb, hacc);
                }
                const float wi = wint[ti * 32 + r];
#pragma unroll
                for (int g = 0; g < 16; ++g) hacc[g] *= wi;
#pragma unroll
                for (int ks = 0; ks < 8; ++ks) {
                    if (ks <= 2 * ti + 1) {
                        bf16x8 a = *(const bf16x8*)(VcT + (vi * 32 + r) * TP + ks * 16 + h * 8);
                        bf16x8 bb = *(const bf16x8*)(Pm + (ti * 32 + r) * TP + ks * 16 + h * 8);
                        hacc = MFMA(a, bb, hacc);
                    }
                }
            }
            LDS_BARRIER();
            if (full) {
                const int t = ti * 32 + r;
                const float den = wint[t] * denX[t] + denP[t] + denP[128 + t];
                const float inv = __builtin_amdgcn_rcpf(fmaxf(fabsf(den), __expf(-mtv[t])));
                bf16_t* hp = Pm + t * LP + vi * 32 + 4 * h;
#pragma unroll
                for (int g4 = 0; g4 < 4; ++g4) {
                    uint2 pk; pk.x = pack2(hacc[4 * g4] * inv, hacc[4 * g4 + 1] * inv); pk.y = pack2(hacc[4 * g4 + 2] * inv, hacc[4 * g4 + 3] * inv);
                    *(uint2*)(hp + 8 * g4) = pk;
                }
            }
            if (w < 4) {
                const int vi2 = w >> 1, di = w & 1;
#pragma unroll
                for (int g = 0; g < 16; ++g) accC[g] *= decay;
#pragma unroll
                for (int ks = 0; ks < 8; ++ks) {
                    bf16x8 a = *(const bf16x8*)(VwT + (vi2 * 32 + r) * TP + ks * 16 + h * 8);
                    bf16x8 bb = *(const bf16x8*)(KcT + (di * 32 + r) * TP + ks * 16 + h * 8);
                    accC = MFMA(a, bb, accC);
                }
#pragma unroll
                for (int g = 0; g < 16; ++g) Cb[(vi2 * 32 + crow(g, h)) * LP + di * 32 + r] = f2bf_sw(accC[g]);
            } else {
                const int t2 = tid - 256, d = t2 >> 2, pq = t2 & 3;
                float sacc_ = 0.f;
#pragma unroll
                for (int q = 0; q < 4; ++q) {
                    float f[8]; unpack8(*(const uint4*)(KcT + d * TP + pq * 32 + q * 8), f);
                    const float4 w0 = *(const float4*)(wgt + pq * 32 + q * 8), w1 = *(const float4*)(wgt + pq * 32 + q * 8 + 4);
                    sacc_ += f[0] * w0.x + f[1] * w0.y + f[2] * w0.z + f[3] * w0.w + f[4] * w1.x + f[5] * w1.y + f[6] * w1.z + f[7] * w1.w;
                }
                sacc_ += __shfl_xor(sacc_, 1); sacc_ += __shfl_xor(sacc_, 2);
                if (pq == 0) nvec[d] = decay * nvec[d] + sacc_;
            }
            m_prev = m_new;
            LDS_BARRIER();
            if (full) {
#pragma unroll
                for (int q = 0; q < 2; ++q) {
                    const int c = tid + 512 * q, t = c >> 3, ch = c & 7;
                    const int pos = dir ? P0 + L - 1 - t : P0 + t;
                    *(uint4*)(Hout + (size_t)(base + pos) * 1024 + hd * 128 + vh * 64 + ch * 8) = *(const uint4*)(Pm + t * LP + ch * 8);
                }
            }
        }
#undef ML_STEP_GEOM
#undef ML_PREFETCH
    }
}

DI void phase_mix(const Params& p) {
    const int lane = threadIdx.x & 63, w = threadIdx.x >> 6;
    const bf16_t* HF = (const bf16_t*)(p.ws + OFF_HF);
    const bf16_t* HB = (const bf16_t*)(p.ws + OFF_HB);
    const bf16_t* OG = (const bf16_t*)(p.ws + OFF_OG);
    bf16_t* H = (bf16_t*)(p.ws + OFF_H);
    for (int row = blockIdx.x * 8 + w; row < 16384; row += gridDim.x * 8) {
        const size_t o = (size_t)row * 1024 + lane * 16;
        float a[16], bq[16], og[16];
        unpack8(*(const uint4*)(HF + o), a); unpack8(*(const uint4*)(HF + o + 8), a + 8);
        unpack8(*(const uint4*)(HB + o), bq); unpack8(*(const uint4*)(HB + o + 8), bq + 8);
        unpack8(*(const uint4*)(OG + o), og); unpack8(*(const uint4*)(OG + o + 8), og + 8);
        float ss = 0.f;
#pragma unroll
        for (int i = 0; i < 16; ++i) { a[i] += bq[i]; ss += a[i] * a[i]; }
        ss += __shfl_xor(ss, 1); ss += __shfl_xor(ss, 2); ss += __shfl_xor(ss, 4);
        const float rstd = rsqrtf(ss * (1.f / 128.f) + EPSF);
        const float* g = p.ml_out_g + lane * 16;
#pragma unroll
        for (int i = 0; i < 16; ++i) a[i] = a[i] * rstd * g[i] * sigmoidf_(og[i]);
        *(uint4*)(H + o) = pack8(a); *(uint4*)(H + o + 8) = pack8(a + 8);
    }
}

#define XB_TMO      128
#define XB_XCNT(j)  (256  + 64 * (j))
#define XB_XSUB(j)  (1280 + 64 * (j))
#define XB_XGEN(j)  (2304 + 64 * (j))
#define XB_TOP      3328
#define XB_TOPGEN   3392
#define XCD_BAR_WORDS 3456
#define XB_SPIN_CAP (1u << 18)
#define LAS __attribute__((address_space(3)))

__device__ __forceinline__ unsigned xb_ld(unsigned* p)              { return __hip_atomic_load(p, __ATOMIC_RELAXED, __HIP_MEMORY_SCOPE_AGENT); }
__device__ __forceinline__ unsigned xb_add(unsigned* p, unsigned v) { return __hip_atomic_fetch_add(p, v, __ATOMIC_RELAXED, __HIP_MEMORY_SCOPE_AGENT); }
__device__ __forceinline__ unsigned xb_xcc_id() { return (unsigned)__builtin_amdgcn_s_getreg((3 << 11) | 20) & 0xFu; }
#define XB_SPIN(cond, bar) do { unsigned _sp = 0; while (cond) { __builtin_amdgcn_s_sleep(1); \
    if ((++_sp & 255u) == 0u) { if (xb_ld(&(bar)[XB_TMO])) break; if (_sp > XB_SPIN_CAP) { atomicAdd(&(bar)[XB_TMO], 1u); break; } } } } while (0)

struct XcdBarrier {
    unsigned* bar; unsigned x;
    volatile LAS unsigned* st;
};

__device__ __forceinline__ XcdBarrier xcd_barrier_post(unsigned* bar, volatile LAS unsigned* st) {
    XcdBarrier b; b.bar = bar; b.x = xb_xcc_id(); b.st = st;
    if (threadIdx.x == 0) (void)xb_add(&bar[XB_XCNT(b.x)], 1u);
    return b;
}
__device__ __forceinline__ void xcd_barrier_complete(unsigned* bar, unsigned x, unsigned& nloc, unsigned& nx) {
    const unsigned G = gridDim.x * gridDim.y * gridDim.z;
    unsigned sum, cnt, mine, sp = 0u;
    for (;;) {
        sum = 0u; cnt = 0u; mine = 0u;
#pragma unroll
        for (unsigned j = 0; j < 16; ++j) { const unsigned c = xb_ld(&bar[XB_XCNT(j)]); sum += c; cnt += (c > 0u) ? 1u : 0u; mine = (j == x) ? c : mine; }
        if (sum == G) break;
        __builtin_amdgcn_s_sleep(1);
        if ((++sp & 255u) == 0u) { if (xb_ld(&bar[XB_TMO])) break; if (sp > XB_SPIN_CAP) { atomicAdd(&bar[XB_TMO], 1u); break; } }
    }
    nloc = mine > 0u ? mine : 1u; nx = cnt > 0u ? cnt : 1u;
}

__device__ __forceinline__ void xcd_barrier(const XcdBarrier& b) {
    asm volatile("s_waitcnt vmcnt(0)" ::: "memory");
    __syncthreads();
    if (threadIdx.x == 0) {
        unsigned* bar = b.bar;
        __builtin_amdgcn_s_waitcnt(0);
        unsigned nloc = b.st[0], nx = b.st[1];
        if (nloc == 0u) { xcd_barrier_complete(bar, b.x, nloc, nx); b.st[0] = nloc; b.st[1] = nx; }
        const unsigned old = xb_add(&bar[XB_XSUB(b.x)], 1u);
        const unsigned gen = old / nloc;
        if (old + 1u == (gen + 1u) * nloc) {
            __builtin_amdgcn_fence(__ATOMIC_RELEASE, "agent");
            asm volatile("s_waitcnt vmcnt(0)" ::: "memory");
            const unsigned og = xb_add(&bar[XB_TOP], 1u);
            const unsigned tg = og / nx;
            if (og + 1u == (tg + 1u) * nx) xb_add(&bar[XB_TOPGEN], 1u);
            else XB_SPIN(xb_ld(&bar[XB_TOPGEN]) == tg, bar);
            __builtin_amdgcn_fence(__ATOMIC_ACQUIRE, "agent");
            xb_add(&bar[XB_XGEN(b.x)], 1u);
            asm volatile("s_waitcnt vmcnt(0)" ::: "memory");
        } else {
            XB_SPIN(xb_ld(&bar[XB_XGEN(b.x)]) == gen, bar);
            __builtin_amdgcn_fence(__ATOMIC_ACQUIRE, "agent");
            asm volatile("s_waitcnt vmcnt(0)" ::: "memory");
        }
    }
    __syncthreads();
}


__global__ void __launch_bounds__(NTHREADS, 2) __attribute__((amdgpu_waves_per_eu(2, 2))) fwd_megakernel(Params p) {
    __shared__ __attribute__((aligned(1024))) char smem[SMEM_ALL];
    cg::grid_group grid = cg::this_grid();
    __shared__ uint4 xb_words;
    if (threadIdx.x == 0) xb_words = make_uint4(0u, 0u, 0u, 0u);
    __syncthreads();
    XcdBarrier xb = xcd_barrier_post((unsigned*)(p.ws + OFF_BAR), (volatile LAS unsigned*)&xb_words);
    const float* MOD0 = (const float*)(p.ws + OFF_MOD);
    const float* MOD1 = MOD0 + 9 * 6144;
    float* XRC = (float*)(p.ws + OFF_XRC);
    const bf16_t* Hb = (const bf16_t*)(p.ws + OFF_H);

    phase0(p, smem);
    if (p.ws == nullptr) grid.sync();
    xcd_barrier(xb);
    phase_norm(p, p.x, p.ctx, p.norm1_g, MOD0, 0, 18432);
    xcd_barrier(xb);
    phase_inproj0(p, smem);
    xcd_barrier(xb);
    phase_mla_up(p, smem);
    xcd_barrier(xb);
    phase_attn(p, smem);
    xcd_barrier(xb);
    phase_proj_resid(p, Hb, 1024, (const bf16_t*)(p.ws + OFF_WT_OUT0), MOD0, 2, p.x, p.ctx, p.out, XRC, 64, true, smem);
    xcd_barrier(xb);
    phase_norm(p, p.out, XRC, p.norm2_g, MOD0, 3, 18432);
    xcd_barrier(xb);
    phase_ffn_up(p, (const bf16_t*)(p.ws + OFF_WT_UP0), p.ffn_conv_w, p.ffn_conv_b, 80, smem);
    xcd_barrier(xb);
    phase_proj_resid(p, (const bf16_t*)(p.ws + OFF_ACT), 2816, (const bf16_t*)(p.ws + OFF_WT_DOWN0), MOD0, 5, p.out, XRC, p.out, XRC, 64, true, smem);
    xcd_barrier(xb);
    phase_norm(p, p.out, XRC, p.norm1_g + 1024, MOD1, 0, 18432);
    xcd_barrier(xb);
    phase_inproj1(p, smem);
    xcd_barrier(xb);
    phase_qkconv(p);
    xcd_barrier(xb);
    phase_mlstm(p, smem);
    xcd_barrier(xb);
    phase_mix(p);
    xcd_barrier(xb);
    phase_proj_resid(p, Hb, 1024, (const bf16_t*)(p.ws + OFF_WT_OUT1), MOD1, 2, p.out, XRC, p.out, XRC, 64, false, smem);
    xcd_barrier(xb);
    phase_norm(p, p.out, XRC, p.norm2_g + 1024, MOD1, 3, 16384);
    xcd_barrier(xb);
    phase_ffn_up(p, (const bf16_t*)(p.ws + OFF_WT_UP1), p.ffn_conv_w + 3 * 2816, p.ffn_conv_b + 2816, 68, smem);
    xcd_barrier(xb);
    phase_proj_resid(p, (const bf16_t*)(p.ws + OFF_ACT), 2816, (const bf16_t*)(p.ws + OFF_WT_DOWN1), MOD1, 5, p.out, XRC, p.out, XRC, 64, false, smem);
}

extern "C" void kernel_launch(void* const* d_in, const int* in_sizes, int n_in, void* d_out, int out_size, void* d_ws, size_t ws_size,
                              hipStream_t stream) {
    static int grid_blocks = 0;
    if (!grid_blocks) {
        int dev = 0, cus = 0, per_cu = 0;
        hipGetDevice(&dev);
        hipDeviceGetAttribute(&cus, hipDeviceAttributeMultiprocessorCount, dev);
        hipOccupancyMaxActiveBlocksPerMultiprocessor(&per_cu, fwd_megakernel, NTHREADS, 0);
        if (per_cu < 1) per_cu = 1;
        if (per_cu > 1) per_cu = 1;
        grid_blocks = cus * per_cu;
        if (ws_size < WS_END) fprintf(stderr, "kernel_launch: workspace too small: %zu < %zu\n", ws_size, (size_t)WS_END);
    }
    Params p{};
    const float** pf = (const float**)&p;
    for (int i = 0; i < 28; ++i) pf[i] = (const float*)d_in[i];
    p.out = (float*)d_out;
    p.ws = (char*)d_ws;
    hipMemsetAsync((char*)d_ws + OFF_BAR, 0, 16384, stream);
    void* args[] = {&p};
    hipError_t e = hipLaunchCooperativeKernel((void*)fwd_megakernel, dim3(grid_blocks), dim3(NTHREADS), args, 0, stream);
    if (e != hipSuccess) fprintf(stderr, "cooperative launch failed: %s (grid %d)\n", hipGetErrorString(e), grid_blocks);
}
```

```cpp
#include <hip/hip_runtime.h>
#include <hip/hip_cooperative_groups.h>
#include <cstdio>
namespace cg = cooperative_groups;

typedef unsigned short bf16_t;
using bf16x8 = __attribute__((ext_vector_type(8))) short;
using f32x16 = __attribute__((ext_vector_type(16))) float;
using f32x4 = __attribute__((ext_vector_type(4))) float;
#define DI __device__ __forceinline__
#define MFMA(a, b, c) __builtin_amdgcn_mfma_f32_32x32x16_bf16((a), (b), (c), 0, 0, 0)
#define MFMA16(a, b, c) __builtin_amdgcn_mfma_f32_16x16x32_bf16((a), (b), (c), 0, 0, 0)
#define LDS_BARRIER() do { asm volatile("s_waitcnt lgkmcnt(0)" ::: "memory"); __builtin_amdgcn_s_barrier(); asm volatile("" ::: "memory"); } while (0)
#define TID ((int)(threadIdx.x & 255))
#define HBI ((int)(threadIdx.x >> 8))

constexpr float EPSF = 1e-6f;
constexpr float LOG2E = 1.4426950408889634f;
constexpr int NTHREADS = 512;
constexpr int HB_SMEM = 73728;
constexpr int SMEM_ALL = 2 * HB_SMEM;
constexpr int GP = 72;
constexpr int CP = 132;
constexpr int ROWSS_OFF = 67584;

constexpr size_t OFF_WT_UP1 = 0;
constexpr size_t OFF_WT_DOWN1 = OFF_WT_UP1 + 5632ull * 1024 * 2;
constexpr size_t OFF_WT_IN1 = OFF_WT_DOWN1 + 1024ull * 2816 * 2;
constexpr size_t OFF_WT_OUT1 = OFF_WT_IN1 + 3328ull * 1024 * 2;
constexpr size_t OFF_MOD = OFF_WT_OUT1 + 1024ull * 1024 * 2;
constexpr size_t OFF_TABG = OFF_MOD + 2ull * 9 * 6144 * 4;
constexpr size_t OFF_TABM = OFF_TABG + 64 * 16 * 2 * 4;
constexpr size_t OFF_ZROW = OFF_TABM + 64 * 8 * 2 * 4;
constexpr size_t OFF_W0 = OFF_ZROW + 8192;
constexpr size_t OFF_WT_IN0 = OFF_W0;
constexpr size_t OFF_WT_QB = OFF_WT_IN0 + 1536ull * 1024 * 2;
constexpr size_t OFF_WT_KVB = OFF_WT_QB + 1024ull * 384 * 2;
constexpr size_t OFF_WT_OUT0 = OFF_WT_KVB + 1024ull * 256 * 2;
constexpr size_t OFF_WT_UP0 = OFF_WT_OUT0 + 1024ull * 1024 * 2;
constexpr size_t OFF_WT_DOWN0 = OFF_WT_UP0 + 5632ull * 1024 * 2;
constexpr size_t OFF_XRC = OFF_WT_DOWN0 + 1024ull * 2816 * 2;
constexpr size_t OFF_R = OFF_XRC + 2048ull * 1024 * 4;
constexpr size_t OFF_QG = OFF_R;
constexpr size_t OFF_KG = OFF_QG + 18432ull * 512 * 2;
constexpr size_t OFF_VGT = OFF_KG + 18432ull * 128 * 2;
constexpr size_t OFF_CQ = OFF_VGT + 18432ull * 128 * 2;
constexpr size_t OFF_CKV = OFF_CQ + 18432ull * 384 * 2;
constexpr size_t OFF_KR = OFF_CKV + 18432ull * 256 * 2;
constexpr size_t OFF_QM = OFF_KR + 18432ull * 32 * 4;
constexpr size_t OFF_KM = OFF_QM + 18432ull * 768 * 2;
constexpr size_t OFF_VMT = OFF_KM + 18432ull * 768 * 2;
constexpr size_t END_L0 = OFF_VMT + 18432ull * 512 * 2;
constexpr size_t OFF_ACT = OFF_R;
constexpr size_t END_ACT = OFF_ACT + 18432ull * 2816 * 2;
constexpr size_t OFF_QKRAW = OFF_W0;
constexpr size_t OFF_V1 = OFF_QKRAW + 18432ull * 1024 * 2;
constexpr size_t OFF_OG = OFF_V1 + 18432ull * 1024 * 2;
constexpr size_t OFF_GATES = OFF_OG + 16384ull * 1024 * 2;
constexpr size_t OFF_HF = OFF_GATES + 18432ull * 32 * 4;
constexpr size_t OFF_HB = OFF_HF + 16384ull * 1024 * 2;
constexpr size_t END_L1 = OFF_HB + 16384ull * 1024 * 2;
constexpr size_t cmax(size_t a, size_t b) { return a > b ? a : b; }
constexpr size_t OFF_H = cmax(cmax(END_L0, END_ACT), END_L1);
constexpr size_t OFF_BAR = OFF_H + 18432ull * 1024 * 2;
constexpr size_t OFF_SCAN = OFF_BAR + 16384;
constexpr size_t WS_END = OFF_SCAN + 2304ull * 384 * 4;
static_assert(WS_END <= 268435456ull, "workspace too large");
static_assert(OFF_H % 256 == 0 && OFF_R % 256 == 0 && OFF_HF % 256 == 0, "align");

struct Params {
    const float *x, *c, *ctx, *c_ctx, *ada_w, *ada_b, *norm1_g, *norm2_g, *ffn_w_up, *ffn_conv_w, *ffn_conv_b, *ffn_w_down,
        *att_w_in, *mla_qa_g, *mla_w_qb, *mla_kva_g, *mla_w_kvb, *mla_q_g, *mla_k_g, *gqa_q_g, *gqa_k_g, *att_w_out,
        *ml_w_in, *ml_conv_w, *ml_conv_b, *ml_gate_b, *ml_out_g, *ml_w_out;
    float* out;
    char* ws;
};

DI unsigned short f2bf_sw(float x) { unsigned u = __float_as_uint(x); u += 0x7fffu + ((u >> 16) & 1u); return (unsigned short)(u >> 16); }
DI unsigned short f2bf(float x) { unsigned r; asm("v_cvt_pk_bf16_f32 %0, %1, %1" : "=v"(r) : "v"(x)); return (unsigned short)(r & 0xffffu); }
DI unsigned pack2(float a, float b) { unsigned r; asm("v_cvt_pk_bf16_f32 %0, %1, %2" : "=v"(r) : "v"(a), "v"(b)); return r; }
DI bf16x8 pack_frag(float a0, float a1, float a2, float a3, float a4, float a5, float a6, float a7) {
    using u32x4_ = __attribute__((ext_vector_type(4))) unsigned; u32x4_ p;
    asm volatile("v_cvt_pk_bf16_f32 %0, %4, %5\n\tv_cvt_pk_bf16_f32 %1, %6, %7\n\tv_cvt_pk_bf16_f32 %2, %8, %9\n\tv_cvt_pk_bf16_f32 %3, %10, %11\n\ts_nop 1"
                 : "=&v"(p[0]), "=&v"(p[1]), "=&v"(p[2]), "=&v"(p[3]) : "v"(a0), "v"(a1), "v"(a2), "v"(a3), "v"(a4), "v"(a5), "v"(a6), "v"(a7));
    return __builtin_bit_cast(bf16x8, p);
}
DI float bflo(unsigned v) { return __uint_as_float(v << 16); }
DI float bfhi(unsigned v) { return __uint_as_float(v & 0xffff0000u); }
DI float bf2f(unsigned short v) { return __uint_as_float(((unsigned)v) << 16); }
DI uint4 pack8(const float* v) { uint4 o; o.x = pack2(v[0], v[1]); o.y = pack2(v[2], v[3]); o.z = pack2(v[4], v[5]); o.w = pack2(v[6], v[7]); return o; }
DI void unpack8(uint4 u, float* v) { v[0] = bflo(u.x); v[1] = bfhi(u.x); v[2] = bflo(u.y); v[3] = bfhi(u.y); v[4] = bflo(u.z); v[5] = bfhi(u.z); v[6] = bflo(u.w); v[7] = bfhi(u.w); }
DI int crow(int reg, int h) { return (reg & 3) + 8 * (reg >> 2) + 4 * h; }
DI float sigmoidf_(float x) { return __builtin_amdgcn_rcpf(1.f + __expf(-x)); }
DI float siluf_(float x) { return x * __builtin_amdgcn_rcpf(1.f + __expf(-x)); }
DI float logsigmoidf_(float x) { return fminf(x, 0.f) - log1pf(__expf(-fabsf(x))); }
DI f32x16 zero16() { f32x16 z;
#pragma unroll
    for (int i = 0; i < 16; ++i) z[i] = 0.f; return z; }

DI void row_info(int m0, int& b, int& t0, bool& lat) {
    if (m0 < 16384) { b = m0 >> 11; t0 = m0 & 2047; lat = true; }
    else { int q = m0 - 16384; b = q >> 8; t0 = q & 255; lat = false; }
}

template <bool SS, bool HALO, class Epi>
DI void gemm_tile(const bf16_t* ap0, const bf16_t* ap1, const bf16_t* ap2, const bf16_t* ap3, unsigned mk0, unsigned mk1, unsigned mk2, unsigned mk3, const bf16_t* __restrict__ Bt, int ldb, int K, char* smem, Epi epi) {
    const int tid = TID, lane = tid & 63, w = tid >> 6, h = lane >> 5, r = lane & 31;
    const int wm = w >> 1, wn = w & 1;
    const int lr = tid >> 3, kc = tid & 7;
    ap0 += kc * 8; ap1 += kc * 8; ap2 += kc * 8; ap3 += kc * 8;
    const bf16_t* bp0 = Bt + (size_t)lr * ldb + kc * 8;
    const bf16_t* bp1 = bp0 + (size_t)32 * ldb; const bf16_t* bp2 = bp0 + (size_t)64 * ldb; const bf16_t* bp3 = bp0 + (size_t)96 * ldb;
    f32x16 acc00 = zero16(), acc01 = zero16(), acc10 = zero16(), acc11 = zero16();
    float ss0 = 0.f, ss1 = 0.f, ss2 = 0.f, ss3 = 0.f;
    uint4 ra0, ra1, ra2, ra3, rb0, rb1, rb2, rb3;
    const int nk = K >> 6;
#define GLOAD(k0) { ra0 = *(const uint4*)(ap0 + (k0)); ra1 = *(const uint4*)(ap1 + (k0)); ra2 = *(const uint4*)(ap2 + (k0)); ra3 = *(const uint4*)(ap3 + (k0)); \
                    rb0 = *(const uint4*)(bp0 + (k0)); rb1 = *(const uint4*)(bp1 + (k0)); rb2 = *(const uint4*)(bp2 + (k0)); rb3 = *(const uint4*)(bp3 + (k0)); }
#define SSQ(ssv, rv) { if (SS) { float f_[8]; unpack8(rv, f_); ssv += f_[0]*f_[0] + f_[1]*f_[1] + f_[2]*f_[2] + f_[3]*f_[3] + f_[4]*f_[4] + f_[5]*f_[5] + f_[6]*f_[6] + f_[7]*f_[7]; } }
#define MSK(rv, mk) { rv.x &= mk; rv.y &= mk; rv.z &= mk; rv.w &= mk; }
#define SWRITE(s_) { if (HALO) { MSK(ra0, mk0) MSK(ra1, mk1) MSK(ra2, mk2) MSK(ra3, mk3) } bf16_t* As_ = (bf16_t*)(smem + (s_) * 36864) + lr * GP + kc * 8; bf16_t* Bs_ = As_ + 128 * GP; \
                     *(uint4*)(As_) = ra0; *(uint4*)(As_ + 32 * GP) = ra1; *(uint4*)(As_ + 64 * GP) = ra2; *(uint4*)(As_ + 96 * GP) = ra3; \
                     *(uint4*)(Bs_) = rb0; *(uint4*)(Bs_ + 32 * GP) = rb1; *(uint4*)(Bs_ + 64 * GP) = rb2; *(uint4*)(Bs_ + 96 * GP) = rb3; \
                     SSQ(ss0, ra0) SSQ(ss1, ra1) SSQ(ss2, ra2) SSQ(ss3, ra3) }
    GLOAD(0) SWRITE(0) __syncthreads();
#pragma unroll 1
    for (int kt = 0; kt < nk; ++kt) {
        if (kt + 1 < nk) GLOAD((kt + 1) * 64)
        {
            const bf16_t* As = (const bf16_t*)(smem + (kt & 1) * 36864) + (wm * 64 + r) * GP + h * 8;
            const bf16_t* Bs = (const bf16_t*)(smem + (kt & 1) * 36864) + 128 * GP + (wn * 64 + r) * GP + h * 8;
#pragma unroll
            for (int ks = 0; ks < 4; ++ks) {
                const bf16x8 a0 = *(const bf16x8*)(As + ks * 16), a1 = *(const bf16x8*)(As + 32 * GP + ks * 16);
                const bf16x8 b0 = *(const bf16x8*)(Bs + ks * 16), b1 = *(const bf16x8*)(Bs + 32 * GP + ks * 16);
                acc00 = MFMA(a0, b0, acc00); acc01 = MFMA(a0, b1, acc01); acc10 = MFMA(a1, b0, acc10); acc11 = MFMA(a1, b1, acc11);
            }
        }
        if (kt + 1 < nk) SWRITE((kt + 1) & 1)
        __syncthreads();
    }
#undef GLOAD
#undef SWRITE
#undef SSQ
#undef MSK
    float* Cs = (float*)smem;
    {
        float* cb = Cs + (wm * 64 + 4 * h) * CP + wn * 64 + r;
#pragma unroll
        for (int g = 0; g < 16; ++g) {
            const int ro = (g & 3) + 8 * (g >> 2);
            cb[ro * CP] = acc00[g]; cb[ro * CP + 32] = acc01[g]; cb[(ro + 32) * CP] = acc10[g]; cb[(ro + 32) * CP + 32] = acc11[g];
        }
    }
    if (SS) {
        float* rowss = (float*)(smem + ROWSS_OFF);
        ss0 += __shfl_xor(ss0, 1); ss0 += __shfl_xor(ss0, 2); ss0 += __shfl_xor(ss0, 4);
        ss1 += __shfl_xor(ss1, 1); ss1 += __shfl_xor(ss1, 2); ss1 += __shfl_xor(ss1, 4);
        ss2 += __shfl_xor(ss2, 1); ss2 += __shfl_xor(ss2, 2); ss2 += __shfl_xor(ss2, 4);
        ss3 += __shfl_xor(ss3, 1); ss3 += __shfl_xor(ss3, 2); ss3 += __shfl_xor(ss3, 4);
        if (kc == 0) { rowss[lr] = ss0; rowss[lr + 32] = ss1; rowss[lr + 64] = ss2; rowss[lr + 96] = ss3; }
    }
    __syncthreads();
    epi((const float*)smem, (const float*)(smem + ROWSS_OFF));
    __syncthreads();
}


DI int g_row(int i) { return ((i * 8 + (int)(threadIdx.x >> 6)) * 8) + (int)((threadIdx.x & 63) >> 3); }
DI int b_perm(int row) { return ((row >> 5) & 1) * 128 + (row >> 6) * 32 + (row & 31); }
DI int g_chunk(int row) { return (int)(threadIdx.x & 7) ^ ((row >> 1) & 7); }
#define GLDS(g_, l_) __builtin_amdgcn_global_load_lds((const unsigned*)(g_), (unsigned*)(l_), 16, 0, 0)
template <int NH = -1, class Epi>
DI void gemm256(const char* wsb, const bf16_t* a0p, const bf16_t* a1p, const bf16_t* a2p, const bf16_t* a3p,
                const bf16_t* b0p, const bf16_t* b1p, const bf16_t* b2p, const bf16_t* b3p, int K, char* smem_all, Epi epi) {
    const unsigned a0 = (unsigned)((const char*)a0p - wsb), a1 = (unsigned)((const char*)a1p - wsb), a2 = (unsigned)((const char*)a2p - wsb), a3 = (unsigned)((const char*)a3p - wsb);
    const unsigned b0 = (unsigned)((const char*)b0p - wsb), b1 = (unsigned)((const char*)b1p - wsb), b2 = (unsigned)((const char*)b2p - wsb), b3 = (unsigned)((const char*)b3p - wsb);
    const int lane = threadIdx.x & 63, wid = __builtin_amdgcn_readfirstlane(threadIdx.x >> 6), wr = wid >> 2, wc = wid & 3, fr = lane & 15, fq = lane >> 4;
    f32x4 acc[8][4];
#pragma unroll
    for (int m = 0; m < 8; ++m)
#pragma unroll
        for (int n = 0; n < 4; ++n) acc[m][n] = (f32x4){0.f, 0.f, 0.f, 0.f};
#define STAGE256(buf, k0) { char* sa_ = smem_all + (buf) * 65536 + wid * 1024; char* sb_ = sa_ + 32768; const char* wk_ = wsb + (size_t)(k0) * 2; \
        GLDS(wk_ + a0, sa_); GLDS(wk_ + a1, sa_ + 8192); GLDS(wk_ + a2, sa_ + 16384); GLDS(wk_ + a3, sa_ + 24576); \
        if (NH < 0 || (wid >> 2) == NH) { GLDS(wk_ + b0, sb_); GLDS(wk_ + b1, sb_ + 8192); GLDS(wk_ + b2, sb_ + 16384); GLDS(wk_ + b3, sb_ + 24576); } }
    const int sw = (fr >> 1) & 7;
    const unsigned offA = (wr * 128 + fr) * 128, offB = 32768 + (wc * 64 + fr) * 128;
    const unsigned co0 = ((0 + fq) ^ sw) << 4, co1 = ((4 + fq) ^ sw) << 4;
    const unsigned lds0 = (unsigned)(size_t)smem_all;
    const int nt = K >> 6;
    STAGE256(0, 0)
    asm volatile("s_waitcnt vmcnt(0)" ::: "memory");
    __syncthreads();
#pragma unroll 1
    for (int t = 0; t < nt; ++t) {
        const int cur = t & 1;
        if (t + 1 < nt) STAGE256(cur ^ 1, (t + 1) * 64)
        const unsigned lb = lds0 + cur * 65536;
        const unsigned aA0 = lb + offA + co0, aA1 = lb + offA + co1, aB0 = lb + offB + co0, aB1 = lb + offB + co1;
        bf16x8 Bq0[4], Bq1[4], Aq0[2], Aq1[2];
#define DSR(dst, addr, off) asm volatile("ds_read_b128 %0, %1 offset:%2" : "=v"(dst) : "v"(addr), "n"(off) : "memory")
#define LDA2(dst, addr, mo) { DSR(dst[0], addr, (mo) * 2048); DSR(dst[1], addr, ((mo) + 1) * 2048); }
#define LDB4(dst, addr) { DSR(dst[0], addr, 0); DSR(dst[1], addr, 2048); DSR(dst[2], addr, 4096); DSR(dst[3], addr, 6144); }
#define WAIT_A(n, X) asm volatile("s_waitcnt lgkmcnt(" #n ")" : "+v"(X[0]), "+v"(X[1]) :: "memory")
#define WAIT_AB(n, X, Y) asm volatile("s_waitcnt lgkmcnt(" #n ")" : "+v"(X[0]), "+v"(X[1]), "+v"(Y[0]), "+v"(Y[1]), "+v"(Y[2]), "+v"(Y[3]) :: "memory")
#define MM8(Aq, Bq, mo) { _Pragma("unroll") for (int m = 0; m < 2; ++m) _Pragma("unroll") for (int n = 0; n < 4; ++n) if (NH < 0 || (n >> 1) == NH) acc[(mo) + m][n] = MFMA16(Bq[n], Aq[m], acc[(mo) + m][n]); }
        LDB4(Bq0, aB0) LDA2(Aq0, aA0, 0) LDA2(Aq1, aA0, 2)
        WAIT_AB(2, Aq0, Bq0);
        MM8(Aq0, Bq0, 0)
        LDA2(Aq0, aA0, 4)
        WAIT_A(2, Aq1);
        MM8(Aq1, Bq0, 2)
        LDA2(Aq1, aA0, 6) LDB4(Bq1, aB1)
        WAIT_A(6, Aq0);
        MM8(Aq0, Bq0, 4)
        LDA2(Aq0, aA1, 0)
        WAIT_A(6, Aq1);
        MM8(Aq1, Bq0, 6)
        LDA2(Aq1, aA1, 2)
        WAIT_AB(2, Aq0, Bq1);
        MM8(Aq0, Bq1, 0)
        LDA2(Aq0, aA1, 4)
        WAIT_A(2, Aq1);
        MM8(Aq1, Bq1, 2)
        LDA2(Aq1, aA1, 6)
        WAIT_A(2, Aq0);
        MM8(Aq0, Bq1, 4)
        WAIT_A(0, Aq1);
        MM8(Aq1, Bq1, 6)
#undef DSR
#undef LDA2
#undef LDB4
#undef WAIT_A
#undef WAIT_AB
#undef MM8
        asm volatile("s_waitcnt vmcnt(0)" ::: "memory");
        __syncthreads();
    }
#undef STAGE256
    int t_ = threadIdx.x;
    asm volatile("" : "+v"(t_));
    const int lane_ = t_ & 63, wid_ = t_ >> 6, wr_ = wid_ >> 2, wc_ = wid_ & 3, fr_ = lane_ & 15, fq_ = lane_ >> 4, hb_ = t_ >> 8;
#pragma unroll
    for (int p = 0; p < 2; ++p) {
        if (NH >= 0 && p != NH) continue;
        {
            float* Cs = (float*)(smem_all + wr_ * HB_SMEM) + fr_ * CP + wc_ * 32 + 4 * fq_;
#pragma unroll
            for (int m = 0; m < 8; ++m)
#pragma unroll
                for (int n = 0; n < 2; ++n) *(f32x4*)(Cs + (m * 16) * CP + n * 16) = acc[m][2 * p + n];
        }
        __syncthreads();
        epi((const float*)(smem_all + hb_ * HB_SMEM), hb_, p, t_ & 255);
        __syncthreads();
    }
}

DI void epi_store_bf16(const float* Cs, bf16_t* dst, int ld, int tid) {
#pragma unroll 2
    for (int j = 0; j < 8; ++j) {
        int c = tid + 256 * j, row = c >> 4, cc = c & 15;
        const float4* cp = (const float4*)(Cs + row * CP + cc * 8);
        float4 f0 = cp[0], f1 = cp[1];
        float v[8] = {f0.x, f0.y, f0.z, f0.w, f1.x, f1.y, f1.z, f1.w};
        *(uint4*)(dst + (size_t)row * ld + cc * 8) = pack8(v);
    }
}
DI void epi_resid(const float* Cs, const float* src, float* dst, const float* gate, int tid) {
#pragma unroll 4
    for (int j = 0; j < 16; ++j) {
        int c = tid + 256 * j, row = c >> 5, c4 = c & 31;
        float4 cv = *(const float4*)(Cs + row * CP + c4 * 4);
        float4 sv = *(const float4*)(src + (size_t)row * 1024 + c4 * 4);
        float4 gv = *(const float4*)(gate + c4 * 4);
        float4 o; o.x = sv.x + gv.x * cv.x; o.y = sv.y + gv.y * cv.y; o.z = sv.z + gv.z * cv.z; o.w = sv.w + gv.w * cv.w;
        *(float4*)(dst + (size_t)row * 1024 + c4 * 4) = o;
    }
}

DI int wsrc_col(int mode, int tn, int c) {
    if (mode == 0) return tn * 128 + c;
    if (mode == 1) {
        const int np = tn * 128;
        if (np < 512) return 672 + np + c;
        if (np < 640) return 1184 + np - 512 + c;
        if (np < 768) return 1312 + np - 640 + c;
        if (np < 1152) return np - 768 + c;
        if (np < 1408) return 384 + np - 1152 + c;
        return c < 32 ? 640 + c : -1;
    }
    if (mode == 2) return c < 96 ? tn * 96 + c : -1;
    return c < 64 ? 64 * tn + c : 2816 + 64 * tn + c - 64;
}
DI void wtile(const float* __restrict__ src, int Nsrc, const float* __restrict__ g, bf16_t* __restrict__ dst, int K, int k0, int tn, int mode, char* smem) {
    bf16_t* T = (bf16_t*)smem;
    const int tid = TID, lane = tid & 63, w = tid >> 6, rsub = lane >> 5, c4 = (lane & 31) * 4;
    int sc = wsrc_col(mode, tn, c4);
    if (sc >= Nsrc) sc = -1;
#pragma unroll 8
    for (int i = 0; i < 16; ++i) {
        const int rr = w * 32 + 2 * i + rsub;
        float4 v = make_float4(0.f, 0.f, 0.f, 0.f);
        if (sc >= 0) { v = *(const float4*)(src + (size_t)(k0 + rr) * Nsrc + sc); if (g) { const float gg = g[k0 + rr]; v.x *= gg; v.y *= gg; v.z *= gg; v.w *= gg; } }
        T[(c4 + 0) * 130 + rr] = f2bf(v.x);
        T[(c4 + 1) * 130 + rr] = f2bf(v.y);
        T[(c4 + 2) * 130 + rr] = f2bf(v.z);
        T[(c4 + 3) * 130 + rr] = f2bf(v.w);
    }
    __syncthreads();
#pragma unroll
    for (int j = 0; j < 8; ++j) {
        const int c = tid + 256 * j, n = c >> 4, kc = c & 15;
        const unsigned* s32 = (const unsigned*)(T + n * 130 + kc * 8);
        uint4 o; o.x = s32[0]; o.y = s32[1]; o.z = s32[2]; o.w = s32[3];
        *(uint4*)(dst + (size_t)(tn * 128 + n) * K + k0 + kc * 8) = o;
    }
    __syncthreads();
}

DI void mod_item(const Params& p, int item, char* smem) {
    const int tid = TID, lane = tid & 63, w = tid >> 6, hl = lane >> 5, cl = lane & 31;
    const int l = item / 192, n0 = (item % 192) * 32;
    float* sl = (float*)smem;
    for (int i = tid; i < 9216; i += 256) {
        int rr = i >> 10, k = i & 1023;
        float cv = rr < 8 ? p.c[rr * 1024 + k] : p.c_ctx[k];
        sl[i] = cv / (1.f + expf(-cv));
    }
    __syncthreads();
    float acc[9];
#pragma unroll
    for (int q = 0; q < 9; ++q) acc[q] = 0.f;
    const float* wp = p.ada_w + (size_t)l * 1024 * 6144 + n0 + cl;
#pragma unroll 16
    for (int kk = 0; kk < 128; ++kk) {
        const int k = w * 256 + 2 * kk + hl;
        float wv = wp[(size_t)k * 6144];
#pragma unroll
        for (int q = 0; q < 9; ++q) acc[q] += sl[q * 1024 + k] * wv;
    }
    float* red = (float*)(smem + 36864);
#pragma unroll
    for (int q = 0; q < 9; ++q) red[((w * 2 + hl) * 9 + q) * 32 + cl] = acc[q];
    __syncthreads();
    float* MOD = (float*)(p.ws + OFF_MOD);
    for (int i = tid; i < 288; i += 256) {
        int q = i >> 5, ln = i & 31;
        float sacc = 0.f;
#pragma unroll
        for (int u = 0; u < 8; ++u) sacc += red[(u * 9 + q) * 32 + ln];
        sacc += p.ada_b[l * 6144 + n0 + ln];
        MOD[(size_t)(l * 9 + q) * 6144 + n0 + ln] = sacc;
    }
    __syncthreads();
}

DI void sincos_d(double x, float& s, float& c) {
    const double TWO_PI = 6.283185307179586476925;
    double t = x / TWO_PI;
    t -= rint(t);
    double y = t * TWO_PI, y2 = y * y;
    double sv = y, cv = 1.0, ts = y, tc = 1.0;
#pragma unroll 1
    for (int k = 1; k <= 14; ++k) {
        tc *= -y2 / (double)((2 * k - 1) * (2 * k));
        ts *= -y2 / (double)((2 * k) * (2 * k + 1));
        cv += tc; sv += ts;
    }
    s = (float)sv; c = (float)cv;
}

DI void rope_tables(const Params& p) {
    float* TG = (float*)(p.ws + OFF_TABG);
    float* TM = (float*)(p.ws + OFF_TABM);
    for (int i = TID; i < 1024; i += 256) {
        int v = i >> 4, f = i & 15;
        float inv = exp2f(-(float)f / 16.f * 13.287712379549449f);
        float ang = (float)v * inv, s, c;
        sincos_d((double)ang, s, c);
        TG[i] = c; TG[1024 + i] = s;
    }
    for (int i = TID; i < 512; i += 256) {
        int v = i >> 3, f = i & 7;
        float inv = exp2f(-(float)f / 8.f * 13.287712379549449f);
        float ang = (float)v * inv, s, c;
        sincos_d((double)ang, s, c);
        TM[i] = c; TM[512 + i] = s;
    }
}

constexpr int NW = 10;
constexpr int N_WT0 = 8 * 12 + 3 * 8 + 2 * 8 + 8 * 8 + 8 * 44 + 22 * 8;
constexpr int N_WT1 = 8 * 44 + 22 * 8 + 8 * 26 + 8 * 8;
constexpr int N_MOD = 384;
constexpr int N_P0 = N_MOD + N_WT0;
static_assert(N_P0 % 2 == 0 && N_MOD % 2 == 0 && N_WT1 % 2 == 0, "items are dealt to half-block pairs");

DI void wtile_item(const Params& p, int t, char* smem) {
    int wi = 0;
    int cnt[NW] = {8 * 12, 3 * 8, 2 * 8, 8 * 8, 8 * 44, 22 * 8, 8 * 44, 22 * 8, 8 * 26, 8 * 8};
#pragma unroll
    for (int i = 0; i < NW - 1; ++i) { if (wi == i && t >= cnt[i]) { t -= cnt[i]; wi = i + 1; } }
    const float* src; const float* g = nullptr; bf16_t* dst; int K, Nsrc, ntn, mode;
    switch (wi) {
        case 0: src = p.att_w_in; dst = (bf16_t*)(p.ws + OFF_WT_IN0); K = 1024; Nsrc = 1440; ntn = 12; mode = 1; break;
        case 1: src = p.mla_w_qb; g = p.mla_qa_g; dst = (bf16_t*)(p.ws + OFF_WT_QB); K = 384; Nsrc = 768; ntn = 8; mode = 2; break;
        case 2: src = p.mla_w_kvb; g = p.mla_kva_g; dst = (bf16_t*)(p.ws + OFF_WT_KVB); K = 256; Nsrc = 1024; ntn = 8; mode = 0; break;
        case 3: src = p.att_w_out; dst = (bf16_t*)(p.ws + OFF_WT_OUT0); K = 1024; Nsrc = 1024; ntn = 8; mode = 0; break;
        case 4: src = p.ffn_w_up; dst = (bf16_t*)(p.ws + OFF_WT_UP0); K = 1024; Nsrc = 5632; ntn = 44; mode = 3; break;
        case 5: src = p.ffn_w_down; dst = (bf16_t*)(p.ws + OFF_WT_DOWN0); K = 2816; Nsrc = 1024; ntn = 8; mode = 0; break;
        case 6: src = p.ffn_w_up + 1024ull * 5632; dst = (bf16_t*)(p.ws + OFF_WT_UP1); K = 1024; Nsrc = 5632; ntn = 44; mode = 3; break;
        case 7: src = p.ffn_w_down + 2816ull * 1024; dst = (bf16_t*)(p.ws + OFF_WT_DOWN1); K = 2816; Nsrc = 1024; ntn = 8; mode = 0; break;
        case 8: src = p.ml_w_in; dst = (bf16_t*)(p.ws + OFF_WT_IN1); K = 1024; Nsrc = 3104; ntn = 26; mode = 0; break;
        default: src = p.ml_w_out; dst = (bf16_t*)(p.ws + OFF_WT_OUT1); K = 1024; Nsrc = 1024; ntn = 8; mode = 0; break;
    }
    const int tn = t % ntn, tk = t / ntn;
    wtile(src, Nsrc, g, dst, K, tk * 128, tn, mode, smem);
}

DI void phase0(const Params& p, char* smem_all) {
    char* smem = smem_all + HBI * HB_SMEM;
    if (blockIdx.x == gridDim.x - 1) {
        if (HBI == 0) rope_tables(p);
        else { for (int i = TID; i < 512; i += 256) ((uint4*)(p.ws + OFF_ZROW))[i] = make_uint4(0, 0, 0, 0); }
    }
    for (int it0 = blockIdx.x * 2; it0 < N_P0; it0 += gridDim.x * 2) {
        const int item = it0 + HBI;
        if (item < N_MOD) mod_item(p, item, smem);
        else wtile_item(p, item - N_MOD, smem);
    }
}
DI void convert_l1_weights(const Params& p, char* smem_all) {
    char* smem = smem_all + HBI * HB_SMEM;
    const int G = gridDim.x, first = G > 64 ? 64 : 0, nfree = G - first;
    if ((int)blockIdx.x < first) return;
    for (int it0 = ((int)blockIdx.x - first) * 2; it0 < N_WT1; it0 += nfree * 2) wtile_item(p, N_WT0 + it0 + HBI, smem);
}

DI void norm_row_ptrs(int row, const float* srcLat, const float* srcCtx, const float* mod, int shift_idx, const float*& src, const float*& sh) {
    int mb;
    if (row < 16384) { src = srcLat + (size_t)row * 1024; mb = row >> 11; }
    else { src = srcCtx + (size_t)(row - 16384) * 1024; mb = 8; }
    sh = mod + (size_t)mb * 6144 + shift_idx * 1024;
}
DI void norm_row_finish(const float4 (&v)[4], float ss, const float* g, const float* sh, bf16_t* dst, int lane) {
#pragma unroll
    for (int o = 32; o >= 1; o >>= 1) ss += __shfl_xor(ss, o);
    const float rstd = rsqrtf(ss * (1.f / 1024.f) + EPSF);
    const float* sc = sh + 1024;
#pragma unroll
    for (int j = 0; j < 4; ++j) {
        const int c = j * 256 + lane * 4;
        const float4 gv = *(const float4*)(g + c), shv = *(const float4*)(sh + c), scv = *(const float4*)(sc + c);
        const float o0 = v[j].x * rstd * gv.x * (1.f + scv.x) + shv.x;
        const float o1 = v[j].y * rstd * gv.y * (1.f + scv.y) + shv.y;
        const float o2 = v[j].z * rstd * gv.z * (1.f + scv.z) + shv.z;
        const float o3 = v[j].w * rstd * gv.w * (1.f + scv.w) + shv.w;
        uint2 o; o.x = pack2(o0, o1); o.y = pack2(o2, o3);
        *(uint2*)(dst + c) = o;
    }
}
DI void phase_norm(const Params& p, const float* srcLat, const float* srcCtx, const float* g, const float* mod, int shift_idx, int nrows) {
    const int lane = threadIdx.x & 63, w = threadIdx.x >> 6;
    bf16_t* H = (bf16_t*)(p.ws + OFF_H);
    for (int row = (blockIdx.x * 8 + w) * 2; row < nrows; row += gridDim.x * 16) {
        const float *srcA, *shA, *srcB, *shB;
        norm_row_ptrs(row, srcLat, srcCtx, mod, shift_idx, srcA, shA);
        norm_row_ptrs(row + 1, srcLat, srcCtx, mod, shift_idx, srcB, shB);
        float4 va[4], vb[4];
        float sa = 0.f, sb = 0.f;
#pragma unroll
        for (int j = 0; j < 4; ++j) { va[j] = *(const float4*)(srcA + j * 256 + lane * 4); vb[j] = *(const float4*)(srcB + j * 256 + lane * 4); }
#pragma unroll
        for (int j = 0; j < 4; ++j) { sa += va[j].x * va[j].x + va[j].y * va[j].y + va[j].z * va[j].z + va[j].w * va[j].w; sb += vb[j].x * vb[j].x + vb[j].y * vb[j].y + vb[j].z * vb[j].z + vb[j].w * vb[j].w; }
        norm_row_finish(va, sa, g, shA, H + (size_t)row * 1024, lane);
        norm_row_finish(vb, sb, g, shB, H + (size_t)(row + 1) * 1024, lane);
    }
}

template <int Q>
DI void rope_apply(float* v, const float* tab, int rw, int cl) {
#pragma unroll
    for (int f = 0; f < Q; ++f) {
        float cr = tab[rw * Q + f], sr = tab[64 * Q + rw * Q + f], cc = tab[cl * Q + f], sc = tab[64 * Q + cl * Q + f];
        float a1 = v[f], a2 = v[Q + f], b1 = v[2 * Q + f], b2 = v[3 * Q + f];
        v[f] = a1 * cr - a2 * sr; v[Q + f] = a2 * cr + a1 * sr;
        v[2 * Q + f] = b1 * cc - b2 * sc; v[3 * Q + f] = b2 * cc + b1 * sc;
    }
}

DI void phase_inproj0(const Params& p, char* smem_all) {
    const bf16_t* H = (const bf16_t*)(p.ws + OFF_H);
    const bf16_t* W = (const bf16_t*)(p.ws + OFF_WT_IN0);
    const float* TG = (const float*)(p.ws + OFF_TABG);
    for (int id = blockIdx.x; id < 72 * 6; id += gridDim.x) {
        const int nt2 = id / 72, mt2 = id % 72;
        auto epi = [&](const float* Cs, int si, int sj, int tid) {
            const int nt = 2 * nt2 + sj, m0 = (2 * mt2 + si) * 128;
            int b, t0; bool lat; row_info(m0, b, t0, lat);
            const int s0 = lat ? 256 + t0 : t0;
            if (nt < 5) {
                const int row = tid & 127, half = tid >> 7;
                const float4* cp = (const float4*)(Cs + row * CP + half * 64);
                float ss = 0.f;
#pragma unroll
                for (int i = 0; i < 16; ++i) { float4 f = cp[i]; ss += f.x * f.x + f.y * f.y + f.z * f.z + f.w * f.w; }
                const float rstd = rsqrtf(ss * (1.f / 64.f) + EPSF);
                const float* g = nt < 4 ? p.gqa_q_g : p.gqa_k_g;
                const float osc = nt < 4 ? 0.125f * LOG2E : 1.f;
                bf16_t* dst;
                if (nt < 4) dst = (bf16_t*)(p.ws + OFF_QG) + ((size_t)(b * 2304 + s0 + row) * 8 + nt * 2 + half) * 64;
                else dst = (bf16_t*)(p.ws + OFF_KG) + ((size_t)(b * 2304 + s0 + row) * 2 + half) * 64;
                const int t = t0 + row;
#pragma unroll 1
                for (int hh = 0; hh < 2; ++hh) {
                    float v[32];
#pragma unroll
                    for (int i = 0; i < 8; ++i) { float4 f = cp[hh * 8 + i]; const float4 gv = *(const float4*)(g + hh * 32 + 4 * i);
                        v[4 * i] = f.x * rstd * gv.x; v[4 * i + 1] = f.y * rstd * gv.y; v[4 * i + 2] = f.z * rstd * gv.z; v[4 * i + 3] = f.w * rstd * gv.w; }
                    if (lat) {
                        const int pos = hh ? (t & 63) : (t >> 6);
#pragma unroll
                        for (int f = 0; f < 16; ++f) {
                            const float c_ = TG[pos * 16 + f], s_ = TG[1024 + pos * 16 + f];
                            const float x1 = v[f], x2 = v[16 + f];
                            v[f] = x1 * c_ - x2 * s_; v[16 + f] = x2 * c_ + x1 * s_;
                        }
                    }
#pragma unroll
                    for (int i = 0; i < 32; ++i) v[i] *= osc;
#pragma unroll
                    for (int i = 0; i < 4; ++i) *(uint4*)(dst + hh * 32 + i * 8) = pack8(v + i * 8);
                }
            } else if (nt == 5) {
                const int dall = tid & 127, ch0 = (tid >> 7) * 8;
                bf16_t* dst = (bf16_t*)(p.ws + OFF_VGT) + ((size_t)(b * 2 + (dall >> 6)) * 64 + (dall & 63)) * 2304 + s0;
#pragma unroll 2
                for (int ch = 0; ch < 8; ++ch) {
                    float v[8];
#pragma unroll
                    for (int i = 0; i < 8; ++i) v[i] = Cs[((ch0 + ch) * 8 + i) * CP + dall];
                    *(uint4*)(dst + (ch0 + ch) * 8) = pack8(v);
                }
            } else if (nt < 9) {
                epi_store_bf16(Cs, (bf16_t*)(p.ws + OFF_CQ) + (size_t)m0 * 384 + (nt - 6) * 128, 384, tid);
            } else if (nt < 11) {
                epi_store_bf16(Cs, (bf16_t*)(p.ws + OFF_CKV) + (size_t)m0 * 256 + (nt - 9) * 128, 256, tid);
            } else {
                const int row = tid >> 1, half = tid & 1;
                float* dst = (float*)(p.ws + OFF_KR) + (size_t)(m0 + row) * 32 + half * 16;
                const float4* cp = (const float4*)(Cs + row * CP + half * 16);
#pragma unroll
                for (int i = 0; i < 4; ++i) ((float4*)dst)[i] = cp[i];
            }
        };
        const int r0 = g_row(0), r1 = g_row(1), r2 = g_row(2), r3 = g_row(3);
        const bf16_t* Ab = H + (size_t)mt2 * 256 * 1024;
        const bf16_t* Bb = W + (size_t)nt2 * 256 * 1024;
        gemm256(p.ws, Ab + (size_t)r0 * 1024 + g_chunk(r0) * 8, Ab + (size_t)r1 * 1024 + g_chunk(r1) * 8, Ab + (size_t)r2 * 1024 + g_chunk(r2) * 8, Ab + (size_t)r3 * 1024 + g_chunk(r3) * 8,
                Bb + (size_t)b_perm(r0) * 1024 + g_chunk(r0) * 8, Bb + (size_t)b_perm(r1) * 1024 + g_chunk(r1) * 8, Bb + (size_t)b_perm(r2) * 1024 + g_chunk(r2) * 8, Bb + (size_t)b_perm(r3) * 1024 + g_chunk(r3) * 8,
                1024, smem_all, epi);
    }
}

DI void phase_mla_up(const Params& p, char* smem_all) {
    char* smem = smem_all + HBI * HB_SMEM;
    const float* TM = (const float*)(p.ws + OFF_TABM);
    for (int id0 = blockIdx.x * 2; id0 < 144 * 16; id0 += gridDim.x * 2) {
        const int id = id0 + HBI;
        const int nt = (id / 144) & 7, isKV = (id / 144) >> 3, mt = id % 144, m0 = mt * 128;
        int b, t0; bool lat; row_info(m0, b, t0, lat);
        const int s0 = lat ? 256 + t0 : t0;
        if (!isKV) {
            const bf16_t* A = (const bf16_t*)(p.ws + OFF_CQ);
#undef AROW
#define AROW(o_) (A + (size_t)(m0 + (TID >> 3) + (o_)) * 384)
            auto epi = [&](const float* Cs, const float* rowss) {
                const int tid = TID, row = tid >> 1, part = tid & 1;
                const float r1 = rsqrtf(rowss[row] * (1.f / 384.f) + EPSF);
                float v[48];
                const float4* cp = (const float4*)(Cs + row * CP + part * 48);
                float ss = 0.f;
#pragma unroll
                for (int i = 0; i < 12; ++i) { float4 f = cp[i]; v[4 * i] = f.x * r1; v[4 * i + 1] = f.y * r1; v[4 * i + 2] = f.z * r1; v[4 * i + 3] = f.w * r1; }
#pragma unroll
                for (int i = 0; i < 48; ++i) ss += v[i] * v[i];
                ss += __shfl_xor(ss, 1);
                const float r2 = rsqrtf(ss * (1.f / 96.f) + EPSF);
                const float* g = p.mla_q_g + part * 48;
#pragma unroll
                for (int i = 0; i < 48; ++i) v[i] = v[i] * r2 * g[i];
                if (lat && part == 1) { int t = t0 + row; rope_apply<8>(v + 16, TM, t >> 6, t & 63); }
                const float sc = 0.10206207261596575f * LOG2E;
#pragma unroll
                for (int i = 0; i < 48; ++i) v[i] *= sc;
                bf16_t* dst = (bf16_t*)(p.ws + OFF_QM) + ((size_t)(b * 2304 + s0 + row) * 8 + nt) * 96 + part * 48;
#pragma unroll
                for (int i = 0; i < 6; ++i) *(uint4*)(dst + i * 8) = pack8(v + i * 8);
            };
            gemm_tile<true, false>(AROW(0), AROW(32), AROW(64), AROW(96), 0u, 0u, 0u, 0u, (const bf16_t*)(p.ws + OFF_WT_QB) + (size_t)nt * 128 * 384, 384, 384, smem, epi);
        } else {
            const bf16_t* A = (const bf16_t*)(p.ws + OFF_CKV);
#undef AROW
#define AROW(o_) (A + (size_t)(m0 + (TID >> 3) + (o_)) * 256)
            auto epi = [&](const float* Cs, const float* rowss) {
                const int tid = TID;
                {
                    const int row = tid >> 1, part = tid & 1;
                    const float r1 = rsqrtf(rowss[row] * (1.f / 256.f) + EPSF);
                    float v[48];
                    if (part == 0) {
                        const float4* cp = (const float4*)(Cs + row * CP);
#pragma unroll
                        for (int i = 0; i < 12; ++i) { float4 f = cp[i]; v[4 * i] = f.x * r1; v[4 * i + 1] = f.y * r1; v[4 * i + 2] = f.z * r1; v[4 * i + 3] = f.w * r1; }
                    } else {
                        const float4* cp = (const float4*)(Cs + row * CP + 48);
#pragma unroll
                        for (int i = 0; i < 4; ++i) { float4 f = cp[i]; v[4 * i] = f.x * r1; v[4 * i + 1] = f.y * r1; v[4 * i + 2] = f.z * r1; v[4 * i + 3] = f.w * r1; }
                        const float4* kp = (const float4*)((const float*)(p.ws + OFF_KR) + (size_t)(m0 + row) * 32);
#pragma unroll
                        for (int i = 0; i < 8; ++i) { float4 f = kp[i]; v[16 + 4 * i] = f.x; v[16 + 4 * i + 1] = f.y; v[16 + 4 * i + 2] = f.z; v[16 + 4 * i + 3] = f.w; }
                    }
                    float ss = 0.f;
#pragma unroll
                    for (int i = 0; i < 48; ++i) ss += v[i] * v[i];
                    ss += __shfl_xor(ss, 1);
                    const float r2 = rsqrtf(ss * (1.f / 96.f) + EPSF);
                    const float* g = p.mla_k_g + part * 48;
#pragma unroll
                    for (int i = 0; i < 48; ++i) v[i] = v[i] * r2 * g[i];
                    if (lat && part == 1) { int t = t0 + row; rope_apply<8>(v + 16, TM, t >> 6, t & 63); }
                    bf16_t* dst = (bf16_t*)(p.ws + OFF_KM) + ((size_t)(b * 2304 + s0 + row) * 8 + nt) * 96 + part * 48;
#pragma unroll
                    for (int i = 0; i < 6; ++i) *(uint4*)(dst + i * 8) = pack8(v + i * 8);
                }
                {
                    const int d = tid & 63, cg4 = (tid >> 6) * 4;
                    bf16_t* dst = (bf16_t*)(p.ws + OFF_VMT) + ((size_t)(b * 8 + nt) * 64 + d) * 2304 + s0;
#pragma unroll 1
                    for (int ch = 0; ch < 4; ++ch) {
                        float v[8];
#pragma unroll
                        for (int i = 0; i < 8; ++i) { int rr = (cg4 + ch) * 8 + i; v[i] = Cs[rr * CP + 64 + d] * rsqrtf(rowss[rr] * (1.f / 256.f) + EPSF); }
                        *(uint4*)(dst + (cg4 + ch) * 8) = pack8(v);
                    }
                }
            };
            gemm_tile<true, false>(AROW(0), AROW(32), AROW(64), AROW(96), 0u, 0u, 0u, 0u, (const bf16_t*)(p.ws + OFF_WT_KVB) + (size_t)nt * 128 * 256, 256, 256, smem, epi);
        }
    }
}

template <int DK>
DI void attn_body(const bf16_t* __restrict__ Q, int qstride, const bf16_t* __restrict__ Kp, int kstride, const bf16_t* __restrict__ VT,
                  int nkeys, bf16_t* __restrict__ Odst, char* smem, char* smem_os) {
    constexpr int KP = DK + 8, VP = 72, NST = DK / 16, KCH = DK / 8;
    constexpr int NKL = (64 * KCH) / 256;
    constexpr int STAGE = 64 * KP * 2 + 64 * VP * 2;
    const int tid = TID, lane = tid & 63, w = tid >> 6, h = lane >> 5, r = lane & 31;
    bf16x8 qf[NST];
    {
        const bf16_t* qrow = Q + (size_t)(w * 32 + r) * qstride;
#pragma unroll
        for (int st = 0; st < NST; ++st) qf[st] = *(const bf16x8*)(qrow + st * 16 + h * 8);
    }
    f32x16 o[2]; o[0] = zero16(); o[1] = zero16();
    float m = 0.f, l = 0.f;
    uint4 ak0, ak1 = make_uint4(0, 0, 0, 0), av0, bk0, bk1 = make_uint4(0, 0, 0, 0), bv0;
    const int t5 = threadIdx.x;
    const int kr0 = t5 / KCH, kc0 = t5 % KCH, kr1 = (t5 + 512) / KCH, kc1 = (t5 + 512) % KCH;
    const bool k2 = t5 + 512 < 64 * KCH;
    const int vd0 = t5 >> 3, vc0 = t5 & 7;
#define AGLOAD(P_, key0) { P_##k0 = *(const uint4*)(Kp + (size_t)((key0) + kr0) * kstride + kc0 * 8); if (k2) P_##k1 = *(const uint4*)(Kp + (size_t)((key0) + kr1) * kstride + kc1 * 8); \
                       P_##v0 = *(const uint4*)(VT + (size_t)vd0 * 2304 + (key0) + vc0 * 8); }
#define ASWRITE(P_, s_) { bf16_t* Ks_ = (bf16_t*)(smem + (s_) * STAGE); bf16_t* Vs_ = Ks_ + 64 * KP; \
                      *(uint4*)(Ks_ + kr0 * KP + kc0 * 8) = P_##k0; if (k2) *(uint4*)(Ks_ + kr1 * KP + kc1 * 8) = P_##k1; \
                      *(uint4*)(Vs_ + vd0 * VP + vc0 * 8) = P_##v0; }
    const int nkt = nkeys >> 6;
    AGLOAD(a, 0) ASWRITE(a, 0) AGLOAD(a, 64) AGLOAD(b, 128) __syncthreads();
#pragma unroll 1
    for (int kt = 0; kt < nkt; kt += 2) {
        {
            const bf16_t* Ks = (const bf16_t*)(smem);
            const bf16_t* Vs = Ks + 64 * KP;
            f32x16 s[2];
#pragma unroll
            for (int i = 0; i < 16; ++i) { s[0][i] = -m; s[1][i] = -m; }
#pragma unroll
            for (int st = 0; st < NST; ++st)
#pragma unroll
                for (int kk = 0; kk < 2; ++kk) {
                    bf16x8 a = *(const bf16x8*)(Ks + (kk * 32 + r) * KP + st * 16 + h * 8);
                    s[kk] = MFMA(a, qf[st], s[kk]);
                }
            float mx = s[0][0];
#pragma unroll
            for (int i = 0; i < 16; ++i) { mx = fmaxf(mx, s[0][i]); mx = fmaxf(mx, s[1][i]); }
            mx = fmaxf(mx, __shfl_xor(mx, 32));
            if (__any(mx > 8.f)) {
                const float d = fmaxf(mx, 0.f);
                const float alpha = __builtin_amdgcn_exp2f(-d);
                l *= alpha;
#pragma unroll
                for (int i = 0; i < 16; ++i) { o[0][i] *= alpha; o[1][i] *= alpha; s[0][i] -= d; s[1][i] -= d; }
                m += d;
            }
            float ps = 0.f;
#pragma unroll
            for (int kk = 0; kk < 2; ++kk)
#pragma unroll
                for (int i = 0; i < 16; ++i) { float pv = __builtin_amdgcn_exp2f(s[kk][i]); s[kk][i] = pv; ps += pv; }
            l += ps;
#pragma unroll
            for (int kk = 0; kk < 2; ++kk)
#pragma unroll
                for (int s2 = 0; s2 < 2; ++s2) {
                    const bf16x8 pb = pack_frag(s[kk][8 * s2 + 0], s[kk][8 * s2 + 1], s[kk][8 * s2 + 2], s[kk][8 * s2 + 3], s[kk][8 * s2 + 4], s[kk][8 * s2 + 5], s[kk][8 * s2 + 6], s[kk][8 * s2 + 7]);
#pragma unroll
                    for (int dt = 0; dt < 2; ++dt) {
                        const bf16_t* vp = Vs + (dt * 32 + r) * VP + kk * 32 + 16 * s2 + 4 * h;
                        uint2 lo = *(const uint2*)vp, hi = *(const uint2*)(vp + 8);
                        uint4 vu; vu.x = lo.x; vu.y = lo.y; vu.z = hi.x; vu.w = hi.y;
                        o[dt] = MFMA(__builtin_bit_cast(bf16x8, vu), pb, o[dt]);
                    }
                }
        }
        ASWRITE(a, 1)
        if (kt + 3 < nkt) AGLOAD(a, (kt + 3) * 64)
        LDS_BARRIER();
        {
            const bf16_t* Ks = (const bf16_t*)(smem + STAGE);
            const bf16_t* Vs = Ks + 64 * KP;
            f32x16 s[2];
#pragma unroll
            for (int i = 0; i < 16; ++i) { s[0][i] = -m; s[1][i] = -m; }
#pragma unroll
            for (int st = 0; st < NST; ++st)
#pragma unroll
                for (int kk = 0; kk < 2; ++kk) {
                    bf16x8 a = *(const bf16x8*)(Ks + (kk * 32 + r) * KP + st * 16 + h * 8);
                    s[kk] = MFMA(a, qf[st], s[kk]);
                }
            float mx = s[0][0];
#pragma unroll
            for (int i = 0; i < 16; ++i) { mx = fmaxf(mx, s[0][i]); mx = fmaxf(mx, s[1][i]); }
            mx = fmaxf(mx, __shfl_xor(mx, 32));
            if (__any(mx > 8.f)) {
                const float d = fmaxf(mx, 0.f);
                const float alpha = __builtin_amdgcn_exp2f(-d);
                l *= alpha;
#pragma unroll
                for (int i = 0; i < 16; ++i) { o[0][i] *= alpha; o[1][i] *= alpha; s[0][i] -= d; s[1][i] -= d; }
                m += d;
            }
            float ps = 0.f;
#pragma unroll
            for (int kk = 0; kk < 2; ++kk)
#pragma unroll
                for (int i = 0; i < 16; ++i) { float pv = __builtin_amdgcn_exp2f(s[kk][i]); s[kk][i] = pv; ps += pv; }
            l += ps;
#pragma unroll
            for (int kk = 0; kk < 2; ++kk)
#pragma unroll
                for (int s2 = 0; s2 < 2; ++s2) {
                    const bf16x8 pb = pack_frag(s[kk][8 * s2 + 0], s[kk][8 * s2 + 1], s[kk][8 * s2 + 2], s[kk][8 * s2 + 3], s[kk][8 * s2 + 4], s[kk][8 * s2 + 5], s[kk][8 * s2 + 6], s[kk][8 * s2 + 7]);
#pragma unroll
                    for (int dt = 0; dt < 2; ++dt) {
                        const bf16_t* vp = Vs + (dt * 32 + r) * VP + kk * 32 + 16 * s2 + 4 * h;
                        uint2 lo = *(const uint2*)vp, hi = *(const uint2*)(vp + 8);
                        uint4 vu; vu.x = lo.x; vu.y = lo.y; vu.z = hi.x; vu.w = hi.y;
                        o[dt] = MFMA(__builtin_bit_cast(bf16x8, vu), pb, o[dt]);
                    }
                }
        }
        if (kt + 2 < nkt) ASWRITE(b, 0)
        if (kt + 4 < nkt) AGLOAD(b, (kt + 4) * 64)
        LDS_BARRIER();
    }
#undef AGLOAD
#undef ASWRITE
    l += __shfl_xor(l, 32);
    const float inv = 1.f / l;
    bf16_t* Os = (bf16_t*)smem_os + (size_t)w * 32 * 72;
#pragma unroll
    for (int dt = 0; dt < 2; ++dt)
#pragma unroll
        for (int g = 0; g < 4; ++g) {
            uint2 u; u.x = pack2(o[dt][4 * g] * inv, o[dt][4 * g + 1] * inv); u.y = pack2(o[dt][4 * g + 2] * inv, o[dt][4 * g + 3] * inv);
            *(uint2*)(Os + r * 72 + dt * 32 + 8 * g + 4 * h) = u;
        }
    __syncthreads();
#pragma unroll
    for (int j = 0; j < 4; ++j) {
        int c = lane + 64 * j, row = c >> 3, cc = c & 7;
        uint4 u = *(const uint4*)(Os + row * 72 + cc * 8);
        *(uint4*)(Odst + (size_t)(w * 32 + row) * 1024 + cc * 8) = u;
    }
    __syncthreads();
}

DI void phase_attn(const Params& p, char* smem_all) {
    char* smem = smem_all;
    char* smem_os = smem_all + 65536 + HBI * 20480;
    bf16_t* O = (bf16_t*)(p.ws + OFF_H);
    for (int it0 = blockIdx.x * 2; it0 < 2304; it0 += gridDim.x * 2) {
        const int item = it0 + HBI;
        int b, kind, hq, qb, nkeys, sq0, orow;
        if (item < 2048) { qb = item & 15; hq = (item >> 4) & 7; kind = (item >> 7) & 1; b = item >> 8; sq0 = 256 + qb * 128; nkeys = 2304; orow = b * 2048 + qb * 128; }
        else { int it = item - 2048; qb = it & 1; hq = (it >> 1) & 7; kind = (it >> 4) & 1; b = it >> 5; sq0 = qb * 128; nkeys = 256; orow = 16384 + b * 256 + qb * 128; }
        bf16_t* od = O + (size_t)orow * 1024 + kind * 512 + hq * 64;
        if (kind == 0) {
            const bf16_t* Q = (const bf16_t*)(p.ws + OFF_QM) + ((size_t)(b * 2304 + sq0) * 8 + hq) * 96;
            const bf16_t* K = (const bf16_t*)(p.ws + OFF_KM) + ((size_t)(b * 2304) * 8 + hq) * 96;
            const bf16_t* VT = (const bf16_t*)(p.ws + OFF_VMT) + (size_t)(b * 8 + hq) * 64 * 2304;
            attn_body<96>(Q, 768, K, 768, VT, nkeys, od, smem, smem_os);
        } else {
            const int kvh = hq >> 2;
            const bf16_t* Q = (const bf16_t*)(p.ws + OFF_QG) + ((size_t)(b * 2304 + sq0) * 8 + hq) * 64;
            const bf16_t* K = (const bf16_t*)(p.ws + OFF_KG) + ((size_t)(b * 2304) * 2 + kvh) * 64;
            const bf16_t* VT = (const bf16_t*)(p.ws + OFF_VGT) + (size_t)(b * 2 + kvh) * 64 * 2304;
            attn_body<64>(Q, 512, K, 128, VT, nkeys, od, smem, smem_os);
        }
    }
}

DI void phase_proj_resid(const Params& p, const bf16_t* A, int K, const bf16_t* W, const float* mod, int gate_idx,
                         const float* srcLat, const float* srcCtx, float* dstLat, float* dstCtx, int mtiles2, bool ctx_small, bool conv_l1, char* smem_all) {
    for (int id = blockIdx.x; id < mtiles2 * 4; id += gridDim.x) {
        const int nt2 = id / mtiles2, mt2 = id % mtiles2;
        auto epi = [&](const float* Cs, int si, int sj, int tid) {
            const int nt = 2 * nt2 + sj, m0 = (2 * mt2 + si) * 128;
            const float* src; float* dst; int mb;
            if (m0 < 16384) { src = srcLat + (size_t)m0 * 1024; dst = dstLat + (size_t)m0 * 1024; mb = m0 >> 11; }
            else { src = srcCtx + (size_t)(m0 - 16384) * 1024; dst = dstCtx + (size_t)(m0 - 16384) * 1024; mb = 8; }
            epi_resid(Cs, src + nt * 128, dst + nt * 128, mod + (size_t)mb * 6144 + gate_idx * 1024 + nt * 128, tid);
        };
        const int r0 = g_row(0), r1 = g_row(1), r2 = g_row(2), r3 = g_row(3);
        const bf16_t* Ab = A + (size_t)mt2 * 256 * K;
        const bf16_t* Bb = W + (size_t)nt2 * 256 * K;
        gemm256(p.ws, Ab + (size_t)r0 * K + g_chunk(r0) * 8, Ab + (size_t)r1 * K + g_chunk(r1) * 8, Ab + (size_t)r2 * K + g_chunk(r2) * 8, Ab + (size_t)r3 * K + g_chunk(r3) * 8,
                Bb + (size_t)b_perm(r0) * K + g_chunk(r0) * 8, Bb + (size_t)b_perm(r1) * K + g_chunk(r1) * 8, Bb + (size_t)b_perm(r2) * K + g_chunk(r2) * 8, Bb + (size_t)b_perm(r3) * K + g_chunk(r3) * 8,
                K, smem_all, epi);
    }
    if (ctx_small) {
        for (int hq = blockIdx.x; hq < 64; hq += gridDim.x) {
            const int mt2 = 64 + (hq >> 3), nt = hq & 7;
            auto epi = [&](const float* Cs, int si, int, int tid) {
                const int m0 = (2 * mt2 + si) * 128 - 16384;
                epi_resid(Cs, srcCtx + (size_t)m0 * 1024 + nt * 128, dstCtx + (size_t)m0 * 1024 + nt * 128, mod + (size_t)8 * 6144 + gate_idx * 1024 + nt * 128, tid);
            };
            const int r0 = g_row(0), r1 = g_row(1), r2 = g_row(2), r3 = g_row(3);
            const bf16_t* Ab = A + (size_t)mt2 * 256 * K;
            const bf16_t* Bb = W + (size_t)nt * 128 * K;
            gemm256<0>(p.ws, Ab + (size_t)r0 * K + g_chunk(r0) * 8, Ab + (size_t)r1 * K + g_chunk(r1) * 8, Ab + (size_t)r2 * K + g_chunk(r2) * 8, Ab + (size_t)r3 * K + g_chunk(r3) * 8,
                       Bb + (size_t)b_perm(r0) * K + g_chunk(r0) * 8, Bb + (size_t)b_perm(r1) * K + g_chunk(r1) * 8, Bb + (size_t)b_perm(r2) * K + g_chunk(r2) * 8, Bb + (size_t)b_perm(r3) * K + g_chunk(r3) * 8,
                       K, smem_all, epi);
        }
    }
    if (conv_l1) convert_l1_weights(p, smem_all);
}

DI float4 conv4(float4 w0, float4 w1, float4 w2, float4 bb, float4 gm, float4 g0, float4 gp, float4 v) {
    float4 o;
    o.x = siluf_(w0.x * gm.x + w1.x * g0.x + w2.x * gp.x + bb.x) * v.x;
    o.y = siluf_(w0.y * gm.y + w1.y * g0.y + w2.y * gp.y + bb.y) * v.y;
    o.z = siluf_(w0.z * gm.z + w1.z * g0.z + w2.z * gp.z + bb.z) * v.z;
    o.w = siluf_(w0.w * gm.w + w1.w * g0.w + w2.w * gp.w + bb.w) * v.w;
    return o;
}
DI void halo_info(int mt, int& base, int& T, int& tstart) {
    int ti;
    if (mt < 136) { base = (mt / 17) * 2048; T = 2048; ti = mt % 17; }
    else { int q = mt - 136; base = 16384 + (q / 3) * 256; T = 256; ti = q % 3; }
    tstart = 126 * ti - 1;
}
DI const bf16_t* halo_ptr(const bf16_t* H, const bf16_t* Z, int mt2, int row) {
    int base, T, tstart; halo_info(2 * mt2 + (row >> 7), base, T, tstart);
    const int t = tstart + (row & 127);
    return (t >= 0 && t < T) ? H + (size_t)(base + t) * 1024 + g_chunk(row) * 8 : Z;
}
DI void phase_ffn_up(const Params& p, const bf16_t* W, const float* convw, const float* convb, int mtiles2, char* smem_all) {
    const bf16_t* H = (const bf16_t*)(p.ws + OFF_H);
    const bf16_t* Z = (const bf16_t*)(p.ws + OFF_ZROW);
    bf16_t* ACT = (bf16_t*)(p.ws + OFF_ACT);
    for (int id = blockIdx.x; id < mtiles2 * 22; id += gridDim.x) {
        const int nt2 = id / mtiles2, mt2 = id % mtiles2;
        auto epi = [&](const float* Cs, int si, int sj, int tid) {
            const int nt = 2 * nt2 + sj;
            int base, T, tstart; halo_info(2 * mt2 + si, base, T, tstart);
            const int cc = tid & 7;
            const int cg0 = nt * 64 + cc * 8;
            const float4 w0a = *(const float4*)(convw + cg0), w0b = *(const float4*)(convw + cg0 + 4);
            const float4 w1a = *(const float4*)(convw + 2816 + cg0), w1b = *(const float4*)(convw + 2816 + cg0 + 4);
            const float4 w2a = *(const float4*)(convw + 5632 + cg0), w2b = *(const float4*)(convw + 5632 + cg0 + 4);
            const float4 bba = *(const float4*)(convb + cg0), bbb = *(const float4*)(convb + cg0 + 4);
#pragma unroll
            for (int j = 0; j < 4; ++j) {
                const int rr = (tid >> 3) + 32 * j, t = tstart + rr;
                if (rr >= 1 && rr <= 126 && t < T) {
                    const float4* a = (const float4*)(Cs + (rr - 1) * CP + cc * 8);
                    const float4* bq = (const float4*)(Cs + rr * CP + cc * 8);
                    const float4* c = (const float4*)(Cs + (rr + 1) * CP + cc * 8);
                    const float4* d = (const float4*)(Cs + rr * CP + 64 + cc * 8);
                    const float4 oa = conv4(w0a, w1a, w2a, bba, a[0], bq[0], c[0], d[0]);
                    const float4 ob = conv4(w0b, w1b, w2b, bbb, a[1], bq[1], c[1], d[1]);
                    uint4 u; u.x = pack2(oa.x, oa.y); u.y = pack2(oa.z, oa.w); u.z = pack2(ob.x, ob.y); u.w = pack2(ob.z, ob.w);
                    *(uint4*)(ACT + (size_t)(base + t) * 2816 + cg0) = u;
                }
            }
        };
        const int r0 = g_row(0), r1 = g_row(1), r2 = g_row(2), r3 = g_row(3);
        const bf16_t* Bb = W + (size_t)nt2 * 256 * 1024;
        gemm256(p.ws, halo_ptr(H, Z, mt2, r0), halo_ptr(H, Z, mt2, r1), halo_ptr(H, Z, mt2, r2), halo_ptr(H, Z, mt2, r3),
                Bb + (size_t)b_perm(r0) * 1024 + g_chunk(r0) * 8, Bb + (size_t)b_perm(r1) * 1024 + g_chunk(r1) * 8, Bb + (size_t)b_perm(r2) * 1024 + g_chunk(r2) * 8, Bb + (size_t)b_perm(r3) * 1024 + g_chunk(r3) * 8,
                1024, smem_all, epi);
    }
}

DI void inproj1_epi(const Params& p, const float* Cs, int nt, int m0, int tid) {
    if (nt < 8) epi_store_bf16(Cs, (bf16_t*)(p.ws + OFF_QKRAW) + (size_t)m0 * 1024 + nt * 128, 1024, tid);
    else if (nt < 16) epi_store_bf16(Cs, (bf16_t*)(p.ws + OFF_V1) + (size_t)m0 * 1024 + (nt - 8) * 128, 1024, tid);
    else if (nt < 24) epi_store_bf16(Cs, (bf16_t*)(p.ws + OFF_OG) + (size_t)m0 * 1024 + (nt - 16) * 128, 1024, tid);
    else if (nt == 24) {
        const int row = tid >> 1, half = tid & 1;
        float* dst = (float*)(p.ws + OFF_GATES) + (size_t)(m0 + row) * 32 + half * 16;
#pragma unroll 4
        for (int i = 0; i < 16; ++i) {
            int c = half * 16 + i;
            float v = Cs[row * CP + c] + p.ml_gate_b[c];
            if (c & 8) v = logsigmoidf_(v);
            dst[i] = v;
        }
    }
}
DI void inproj1_tile_of(int f, int& nt2, int& mt2) { if (f < 576) { nt2 = f / 72; mt2 = f % 72; } else { const int g = f - 576; nt2 = 8 + g / 64; mt2 = g % 64; } }
DI void phase_inproj1(const Params& p, char* smem_all) {
    const bf16_t* H = (const bf16_t*)(p.ws + OFF_H);
    const bf16_t* W = (const bf16_t*)(p.ws + OFF_WT_IN1);
    const int G = gridDim.x, nfr = 832 / G, rem = 832 - nfr * G, nhalf = 2 * rem + 72;
    const int r0 = g_row(0), r1 = g_row(1), r2 = g_row(2), r3 = g_row(3);
#define IN1_ARGS p.ws, Ab + (size_t)r0 * 1024 + g_chunk(r0) * 8, Ab + (size_t)r1 * 1024 + g_chunk(r1) * 8, Ab + (size_t)r2 * 1024 + g_chunk(r2) * 8, Ab + (size_t)r3 * 1024 + g_chunk(r3) * 8, \
                Bb + (size_t)b_perm(r0) * 1024 + g_chunk(r0) * 8, Bb + (size_t)b_perm(r1) * 1024 + g_chunk(r1) * 8, Bb + (size_t)b_perm(r2) * 1024 + g_chunk(r2) * 8, Bb + (size_t)b_perm(r3) * 1024 + g_chunk(r3) * 8, \
                1024, smem_all, epi
    for (int trip = 0; trip < nfr; ++trip) {
        int nt2, mt2; inproj1_tile_of(trip * G + blockIdx.x, nt2, mt2);
        auto epi = [&](const float* Cs, int si, int sj, int tid) { inproj1_epi(p, Cs, 2 * nt2 + sj, (2 * mt2 + si) * 128, tid); };
        const bf16_t* Ab = H + (size_t)mt2 * 256 * 1024;
        const bf16_t* Bb = W + (size_t)nt2 * 256 * 1024;
        gemm256<-1>(IN1_ARGS);
    }
    for (int hq = blockIdx.x; hq < nhalf; hq += G) {
        int nt2, mt2, nh;
        if (hq < 2 * rem) { inproj1_tile_of(nfr * G + (hq >> 1), nt2, mt2); nh = hq & 1; } else { nt2 = 12; mt2 = hq - 2 * rem; nh = 0; }
        auto epi = [&](const float* Cs, int si, int, int tid) { inproj1_epi(p, Cs, 2 * nt2 + nh, (2 * mt2 + si) * 128, tid); };
        const bf16_t* Ab = H + (size_t)mt2 * 256 * 1024;
        const bf16_t* Bb = W + ((size_t)nt2 * 256 + nh * 128) * 1024;
        gemm256<0>(IN1_ARGS);
    }
#undef IN1_ARGS
}

DI void phase_qkconv(const Params& p) {
    const bf16_t* QK = (const bf16_t*)(p.ws + OFF_QKRAW);
    bf16_t* QC = (bf16_t*)(p.ws + OFF_H);
    {
        const int lane = threadIdx.x & 63, gw = blockIdx.x * 8 + (threadIdx.x >> 6);
        const float* GT = (const float*)(p.ws + OFF_GATES);
        float* SC = (float*)(p.ws + OFF_SCAN);
        for (int seg = gw; seg < 2304; seg += gridDim.x * 8) {
            const int step = seg % 18, dir = (seg / 18) & 1, hd = (seg / 36) & 7, b = seg / 288;
            int base, P0;
            if (step < 2) { base = 16384 + b * 256; P0 = (dir ? 1 - step : step) * 128; } else { base = b * 2048; P0 = (dir ? 17 - step : step - 2) * 128; }
            const int pa = dir ? P0 + 127 - lane : P0 + lane, pb = dir ? pa - 64 : pa + 64;
            const float* ga = GT + (size_t)(base + pa) * 32 + dir * 16 + hd; const float* gb = GT + (size_t)(base + pb) * 32 + dir * 16 + hd;
            const float i0 = ga[0], f0 = ga[8], i1 = gb[0], f1 = gb[8];
            float b0 = f0, b1 = f1;
#pragma unroll
            for (int off = 1; off < 64; off <<= 1) { float t0 = __shfl_up(b0, off), t1 = __shfl_up(b1, off); if (lane >= off) { b0 += t0; b1 += t1; } }
            b1 += __shfl(b0, 63);
            float p0 = i0 - b0, p1 = i1 - b1;
            const float c0 = p0, c1 = p1;
#pragma unroll
            for (int off = 1; off < 64; off <<= 1) { float t0 = __shfl_up(p0, off), t1 = __shfl_up(p1, off); if (lane >= off) { p0 = fmaxf(p0, t0); p1 = fmaxf(p1, t1); } }
            p1 = fmaxf(p1, __shfl(p0, 63));
            float* o = SC + (size_t)seg * 384;
            o[lane] = b0; o[64 + lane] = b1; o[128 + lane] = p0; o[192 + lane] = p1; o[256 + lane] = c0; o[320 + lane] = c1;
        }
    }
    for (int c = blockIdx.x * NTHREADS + threadIdx.x; c < 18432 * 128; c += gridDim.x * NTHREADS) {
        const int row = c >> 7, col = (c & 127) * 8;
        int T, t;
        if (row < 16384) { T = 2048; t = row & 2047; } else { T = 256; t = (row - 16384) & 255; }
        float acc[8];
        { const float4 b0 = *(const float4*)(p.ml_conv_b + col), b1 = *(const float4*)(p.ml_conv_b + col + 4);
          acc[0] = b0.x; acc[1] = b0.y; acc[2] = b0.z; acc[3] = b0.w; acc[4] = b1.x; acc[5] = b1.y; acc[6] = b1.z; acc[7] = b1.w; }
#pragma unroll
        for (int dj = 0; dj < 3; ++dj) {
            const int tt = t + dj - 1;
            const float on = (tt >= 0 && tt < T) ? 1.f : 0.f;
            const int rr = row + min(max(tt, 0), T - 1) - t;
            float f[8]; unpack8(*(const uint4*)(QK + (size_t)rr * 1024 + col), f);
            const float4 w0 = *(const float4*)(p.ml_conv_w + dj * 1024 + col), w1 = *(const float4*)(p.ml_conv_w + dj * 1024 + col + 4);
            acc[0] += w0.x * on * f[0]; acc[1] += w0.y * on * f[1]; acc[2] += w0.z * on * f[2]; acc[3] += w0.w * on * f[3];
            acc[4] += w1.x * on * f[4]; acc[5] += w1.y * on * f[5]; acc[6] += w1.z * on * f[6]; acc[7] += w1.w * on * f[7];
        }
        const float sc = col >= 512 ? 0.125f : 1.f;
#pragma unroll
        for (int i = 0; i < 8; ++i) acc[i] = siluf_(acc[i]) * sc;
        *(uint4*)(QC + (size_t)row * 1024 + col) = pack8(acc);
    }
}

DI void phase_mlstm(const Params& p, char* smem) {
    constexpr int LP = 72, TP = 136, L = 128;
    bf16_t* Qc = (bf16_t*)smem;
    bf16_t* Kc = Qc + L * LP;
    bf16_t* KcT = Kc + L * LP;
    bf16_t* VcT = KcT + 64 * TP;
    bf16_t* VwT = VcT + 64 * TP;
    bf16_t* Pm = VwT + 64 * TP;
    bf16_t* Cb = Pm + L * TP;
    float* fa = (float*)(Cb + 64 * LP);
    float* bcum = fa; float* ig = fa + 128; float* mtv = fa + 256; float* wint = fa + 384; float* denI = fa + 512; float* denX = fa + 640;
    float* wgt = fa + 768; float* nvec = fa + 896; float* scal = fa + 960; float* csv = fa + 1024; float* denP = fa + 1152;
    static_assert((2 * L * LP + 3 * 64 * TP + L * TP + 64 * LP) * 2 + 1408 * 4 <= SMEM_ALL, "mLSTM LDS");
    const int lane0 = threadIdx.x & 63, w = __builtin_amdgcn_readfirstlane(threadIdx.x >> 6);
    const bf16_t* QK = (const bf16_t*)(p.ws + OFF_H);
    const bf16_t* V1 = (const bf16_t*)(p.ws + OFF_V1);
    const float* GT = (const float*)(p.ws + OFF_GATES);
    for (int item = blockIdx.x; item < 256; item += gridDim.x) {
        const int vh = item & 1, dir = (item >> 1) & 1, hd = (item >> 2) & 7, b = item >> 5;
        bf16_t* Hout = (bf16_t*)(p.ws + (dir ? OFF_HB : OFF_HF));
        f32x16 accC = zero16();
        float m_prev = 0.f;
        for (int i = w * 64 + lane0; i < 64 * LP; i += 512) Cb[i] = 0;
        if (w == 0) nvec[lane0] = 0.f;
        int lane = lane0, tid = w * 64 + lane0, h = lane0 >> 5, r = lane0 & 31;
        int u = tid >> 2, part = tid & 3;
        uint4 rq0, rq1, rk0, rk1, rv0, rv1;
        float sc_b = 0.f, sc_p = 0.f, sc_c = 0.f, sc_bl = 0.f, sc_pl = 0.f;
#define ML_STEP_GEOM(st, base_, P0_) { if ((st) < 2) { base_ = 16384 + b * 256; P0_ = (dir ? 1 - (st) : (st)) * L; } else { base_ = b * 2048; P0_ = (dir ? 17 - (st) : (st) - 2) * L; } }
#define ML_PREFETCH(st) { int base_, P0_; ML_STEP_GEOM(st, base_, P0_) \
            const int pos_ = dir ? P0_ + L - 1 - u : P0_ + u; \
            { const bf16_t* rowp = QK + (size_t)(base_ + pos_) * 1024; \
              const int qcol = hd * 64 + part * 16, kcol = 512 + qcol; rq0 = *(const uint4*)(rowp + qcol); rq1 = *(const uint4*)(rowp + qcol + 8); rk0 = *(const uint4*)(rowp + kcol); rk1 = *(const uint4*)(rowp + kcol + 8); } \
            { const bf16_t* vp_ = V1 + (size_t)(base_ + pos_) * 1024 + hd * 128 + vh * 64 + part * 16; rv0 = *(const uint4*)vp_; rv1 = *(const uint4*)(vp_ + 8); } \
            if (w < 2) { const float* sp_ = (const float*)(p.ws + OFF_SCAN) + (size_t)((((b * 8 + hd) * 2 + dir) * 18) + (st)) * 384; \
                sc_b = sp_[tid]; sc_p = sp_[128 + tid]; sc_c = sp_[256 + tid]; sc_bl = sp_[127]; sc_pl = sp_[255]; } }
        ML_PREFETCH(0)
        __syncthreads();
#pragma unroll 1
        for (int step = 0; step < 18; ++step) {
            lane = lane0; asm volatile("" : "+v"(lane));
            tid = w * 64 + lane; h = lane >> 5; r = lane & 31; u = tid >> 2; part = tid & 3;
            int base, P0; ML_STEP_GEOM(step, base, P0)
            const bool full = step >= 2;
            if (w < 2) {
                const float mt = fmaxf(sc_b + m_prev, sc_b + sc_p);
                const float mnew = fmaxf(sc_bl + m_prev, sc_bl + sc_pl);
                bcum[tid] = sc_b; csv[tid] = sc_c; mtv[tid] = mt;
                wint[tid] = __expf(sc_b + m_prev - mt);
                wgt[tid] = __expf(sc_bl + sc_c - mnew);
                if (tid == 0) { scal[0] = mnew; scal[1] = __expf(sc_bl + m_prev - mnew); }
            }
            {
                *(uint4*)(Qc + u * LP + part * 16) = rq0; *(uint4*)(Qc + u * LP + part * 16 + 8) = rq1;
                *(uint4*)(Kc + u * LP + part * 16) = rk0; *(uint4*)(Kc + u * LP + part * 16 + 8) = rk1;
#define ML_T2(dstT, wv, ci) { dstT[(part * 16 + (ci)) * TP + u] = (bf16_t)((wv) & 0xffffu); dstT[(part * 16 + (ci) + 1) * TP + u] = (bf16_t)((wv) >> 16); }
                ML_T2(KcT, rk0.x, 0) ML_T2(KcT, rk0.y, 2) ML_T2(KcT, rk0.z, 4) ML_T2(KcT, rk0.w, 6) ML_T2(KcT, rk1.x, 8) ML_T2(KcT, rk1.y, 10) ML_T2(KcT, rk1.z, 12) ML_T2(KcT, rk1.w, 14)
                ML_T2(VcT, rv0.x, 0) ML_T2(VcT, rv0.y, 2) ML_T2(VcT, rv0.z, 4) ML_T2(VcT, rv0.w, 6) ML_T2(VcT, rv1.x, 8) ML_T2(VcT, rv1.y, 10) ML_T2(VcT, rv1.z, 12) ML_T2(VcT, rv1.w, 14)
#undef ML_T2
            }
            if (step + 1 < 18) ML_PREFETCH(step + 1)
            LDS_BARRIER();
            const float m_new = scal[0], decay = scal[1];
            {
                const int vv = tid >> 3, s0_ = (tid & 7) * 16;
#pragma unroll
                for (int q = 0; q < 2; ++q) {
                    float f[8]; unpack8(*(const uint4*)(VcT + vv * TP + s0_ + q * 8), f);
                    const float4 w0 = *(const float4*)(wgt + s0_ + q * 8), w1 = *(const float4*)(wgt + s0_ + q * 8 + 4);
                    f[0] *= w0.x; f[1] *= w0.y; f[2] *= w0.z; f[3] *= w0.w; f[4] *= w1.x; f[5] *= w1.y; f[6] *= w1.z; f[7] *= w1.w;
                    *(uint4*)(VwT + vv * TP + s0_ + q * 8) = pack8(f);
                }
            }
            if (full) {
                {
                    float sacc_ = 0.f;
#pragma unroll
                    for (int q = 0; q < 2; ++q) {
                        float f[8]; unpack8(*(const uint4*)(Qc + u * LP + part * 16 + q * 8), f);
                        const float4 n0 = *(const float4*)(nvec + part * 16 + q * 8), n1 = *(const float4*)(nvec + part * 16 + q * 8 + 4);
                        sacc_ += f[0] * n0.x + f[1] * n0.y + f[2] * n0.z + f[3] * n0.w + f[4] * n1.x + f[5] * n1.y + f[6] * n1.z + f[7] * n1.w;
                    }
                    sacc_ += __shfl_xor(sacc_, 1); sacc_ += __shfl_xor(sacc_, 2);
                    if (part == 0) denX[u] = sacc_;
                }
                const int ti = w >> 1, t = ti * 32 + r;
                const float bt = bcum[t] - mtv[t];
                float rs = 0.f;
#pragma unroll
                for (int q = 0; q < 2; ++q) {
                    const int si = 2 * (w & 1) + q;
                    if (si <= ti) {
                        f32x16 sacc = zero16();
#pragma unroll
                        for (int ks = 0; ks < 4; ++ks) {
                            bf16x8 a = *(const bf16x8*)(Kc + (si * 32 + r) * LP + ks * 16 + h * 8);
                            bf16x8 bb = *(const bf16x8*)(Qc + (ti * 32 + r) * LP + ks * 16 + h * 8);
                            sacc = MFMA(a, bb, sacc);
                        }
#pragma unroll
                        for (int g4 = 0; g4 < 4; ++g4) {
                            const int s0_ = si * 32 + 8 * g4 + 4 * h;
                            const float4 c4 = *(const float4*)(csv + s0_);
                            float p0 = s0_ + 0 <= t ? sacc[4 * g4 + 0] * __expf(bt + c4.x) : 0.f;
                            float p1 = s0_ + 1 <= t ? sacc[4 * g4 + 1] * __expf(bt + c4.y) : 0.f;
                            float p2 = s0_ + 2 <= t ? sacc[4 * g4 + 2] * __expf(bt + c4.z) : 0.f;
                            float p3 = s0_ + 3 <= t ? sacc[4 * g4 + 3] * __expf(bt + c4.w) : 0.f;
                            rs += (p0 + p1) + (p2 + p3);
                            uint2 pk; pk.x = pack2(p0, p1); pk.y = pack2(p2, p3);
                            *(uint2*)(Pm + t * TP + s0_) = pk;
                        }
                    } else {
#pragma unroll
                        for (int g4 = 0; g4 < 4; ++g4) *(uint2*)(Pm + t * TP + si * 32 + 8 * g4 + 4 * h) = make_uint2(0u, 0u);
                    }
                }
                rs += __shfl_xor(rs, 32);
                if (h == 0) denP[(w & 1) * 128 + t] = rs;
            }
            LDS_BARRIER();
            f32x16 hacc = zero16();
            const int ti = w >> 1, vi = w & 1;
            if (full) {
#pragma unroll
                for (int ks = 0; ks < 4; ++ks) {
                    bf16x8 a = *(const bf16x8*)(Cb + (vi * 32 + r) * LP + ks * 16 + h * 8);
                    bf16x8 bb = *(const bf16x8*)(Qc + (ti * 32 + r) * LP + ks * 16 + h * 8);
                    hacc = MFMA(a, bb, hacc);
                }
                const float wi = wint[ti * 32 + r];
#pragma unroll
                for (int g = 0; g < 16; ++g) hacc[g] *= wi;
#pragma unroll
                for (int ks = 0; ks < 8; ++ks) {
                    if (ks <= 2 * ti + 1) {
                        bf16x8 a = *(const bf16x8*)(VcT + (vi * 32 + r) * TP + ks * 16 + h * 8);
                        bf16x8 bb = *(const bf16x8*)(Pm + (ti * 32 + r) * TP + ks * 16 + h * 8);
                        hacc = MFMA(a, bb, hacc);
                    }
                }
            }
            LDS_BARRIER();
            if (full) {
                const int t = ti * 32 + r;
                const float den = wint[t] * denX[t] + denP[t] + denP[128 + t];
                const float inv = __builtin_amdgcn_rcpf(fmaxf(fabsf(den), __expf(-mtv[t])));
                bf16_t* hp = Pm + t * LP + vi * 32 + 4 * h;
#pragma unroll
                for (int g4 = 0; g4 < 4; ++g4) {
                    uint2 pk; pk.x = pack2(hacc[4 * g4] * inv, hacc[4 * g4 + 1] * inv); pk.y = pack2(hacc[4 * g4 + 2] * inv, hacc[4 * g4 + 3] * inv);
                    *(uint2*)(hp + 8 * g4) = pk;
                }
            }
            if (w < 4) {
                const int vi2 = w >> 1, di = w & 1;
#pragma unroll
                for (int g = 0; g < 16; ++g) accC[g] *= decay;
#pragma unroll
                for (int ks = 0; ks < 8; ++ks) {
                    bf16x8 a = *(const bf16x8*)(VwT + (vi2 * 32 + r) * TP + ks * 16 + h * 8);
                    bf16x8 bb = *(const bf16x8*)(KcT + (di * 32 + r) * TP + ks * 16 + h * 8);
                    accC = MFMA(a, bb, accC);
                }
#pragma unroll
                for (int g = 0; g < 16; ++g) Cb[(vi2 * 32 + crow(g, h)) * LP + di * 32 + r] = f2bf_sw(accC[g]);
            } else {
                const int t2 = tid - 256, d = t2 >> 2, pq = t2 & 3;
                float sacc_ = 0.f;
#pragma unroll
                for (int q = 0; q < 4; ++q) {
                    float f[8]; unpack8(*(const uint4*)(KcT + d * TP + pq * 32 + q * 8), f);
                    const float4 w0 = *(const float4*)(wgt + pq * 32 + q * 8), w1 = *(const float4*)(wgt + pq * 32 + q * 8 + 4);
                    sacc_ += f[0] * w0.x + f[1] * w0.y + f[2] * w0.z + f[3] * w0.w + f[4] * w1.x + f[5] * w1.y + f[6] * w1.z + f[7] * w1.w;
                }
                sacc_ += __shfl_xor(sacc_, 1); sacc_ += __shfl_xor(sacc_, 2);
                if (pq == 0) nvec[d] = decay * nvec[d] + sacc_;
            }
            m_prev = m_new;
            LDS_BARRIER();
            if (full) {
#pragma unroll
                for (int q = 0; q < 2; ++q) {
                    const int c = tid + 512 * q, t = c >> 3, ch = c & 7;
                    const int pos = dir ? P0 + L - 1 - t : P0 + t;
                    *(uint4*)(Hout + (size_t)(base + pos) * 1024 + hd * 128 + vh * 64 + ch * 8) = *(const uint4*)(Pm + t * LP + ch * 8);
                }
            }
        }
#undef ML_STEP_GEOM
#undef ML_PREFETCH
    }
}

DI void phase_mix(const Params& p) {
    const int lane = threadIdx.x & 63, w = threadIdx.x >> 6;
    const bf16_t* HF = (const bf16_t*)(p.ws + OFF_HF);
    const bf16_t* HB = (const bf16_t*)(p.ws + OFF_HB);
    const bf16_t* OG = (const bf16_t*)(p.ws + OFF_OG);
    bf16_t* H = (bf16_t*)(p.ws + OFF_H);
    for (int row = blockIdx.x * 8 + w; row < 16384; row += gridDim.x * 8) {
        const size_t o = (size_t)row * 1024 + lane * 16;
        float a[16], bq[16], og[16];
        unpack8(*(const uint4*)(HF + o), a); unpack8(*(const uint4*)(HF + o + 8), a + 8);
        unpack8(*(const uint4*)(HB + o), bq); unpack8(*(const uint4*)(HB + o + 8), bq + 8);
        unpack8(*(const uint4*)(OG + o), og); unpack8(*(const uint4*)(OG + o + 8), og + 8);
        float ss = 0.f;
#pragma unroll
        for (int i = 0; i < 16; ++i) { a[i] += bq[i]; ss += a[i] * a[i]; }
        ss += __shfl_xor(ss, 1); ss += __shfl_xor(ss, 2); ss += __shfl_xor(ss, 4);
        const float rstd = rsqrtf(ss * (1.f / 128.f) + EPSF);
        const float* g = p.ml_out_g + lane * 16;
#pragma unroll
        for (int i = 0; i < 16; ++i) a[i] = a[i] * rstd * g[i] * sigmoidf_(og[i]);
        *(uint4*)(H + o) = pack8(a); *(uint4*)(H + o + 8) = pack8(a + 8);
    }
}

#define XB_TMO      128
#define XB_XCNT(j)  (256  + 64 * (j))
#define XB_XSUB(j)  (1280 + 64 * (j))
#define XB_XGEN(j)  (2304 + 64 * (j))
#define XB_TOP      3328
#define XB_TOPGEN   3392
#define XCD_BAR_WORDS 3456
#define XB_SPIN_CAP (1u << 18)
#define LAS __attribute__((address_space(3)))

__device__ __forceinline__ unsigned xb_ld(unsigned* p)              { return __hip_atomic_load(p, __ATOMIC_RELAXED, __HIP_MEMORY_SCOPE_AGENT); }
__device__ __forceinline__ unsigned xb_add(unsigned* p, unsigned v) { return __hip_atomic_fetch_add(p, v, __ATOMIC_RELAXED, __HIP_MEMORY_SCOPE_AGENT); }
__device__ __forceinline__ unsigned xb_xcc_id() { return (unsigned)__builtin_amdgcn_s_getreg((3 << 11) | 20) & 0xFu; }
#define XB_SPIN(cond, bar) do { unsigned _sp = 0; while (cond) { __builtin_amdgcn_s_sleep(1); \
    if ((++_sp & 255u) == 0u) { if (xb_ld(&(bar)[XB_TMO])) break; if (_sp > XB_SPIN_CAP) { atomicAdd(&(bar)[XB_TMO], 1u); break; } } } } while (0)

struct XcdBarrier {
    unsigned* bar; unsigned x;
    volatile LAS unsigned* st;
};

__device__ __forceinline__ XcdBarrier xcd_barrier_post(unsigned* bar, volatile LAS unsigned* st) {
    XcdBarrier b; b.bar = bar; b.x = xb_xcc_id(); b.st = st;
    if (threadIdx.x == 0) (void)xb_add(&bar[XB_XCNT(b.x)], 1u);
    return b;
}
__device__ __forceinline__ void xcd_barrier_complete(unsigned* bar, unsigned x, unsigned& nloc, unsigned& nx) {
    const unsigned G = gridDim.x * gridDim.y * gridDim.z;
    unsigned sum, cnt, mine, sp = 0u;
    for (;;) {
        sum = 0u; cnt = 0u; mine = 0u;
#pragma unroll
        for (unsigned j = 0; j < 16; ++j) { const unsigned c = xb_ld(&bar[XB_XCNT(j)]); sum += c; cnt += (c > 0u) ? 1u : 0u; mine = (j == x) ? c : mine; }
        if (sum == G) break;
        __builtin_amdgcn_s_sleep(1);
        if ((++sp & 255u) == 0u) { if (xb_ld(&bar[XB_TMO])) break; if (sp > XB_SPIN_CAP) { atomicAdd(&bar[XB_TMO], 1u); break; } }
    }
    nloc = mine > 0u ? mine : 1u; nx = cnt > 0u ? cnt : 1u;
}

__device__ __forceinline__ void xcd_barrier(const XcdBarrier& b) {
    asm volatile("s_waitcnt vmcnt(0)" ::: "memory");
    __syncthreads();
    if (threadIdx.x == 0) {
        unsigned* bar = b.bar;
        __builtin_amdgcn_s_waitcnt(0);
        unsigned nloc = b.st[0], nx = b.st[1];
        if (nloc == 0u) { xcd_barrier_complete(bar, b.x, nloc, nx); b.st[0] = nloc; b.st[1] = nx; }
        const unsigned old = xb_add(&bar[XB_XSUB(b.x)], 1u);
        const unsigned gen = old / nloc;
        if (old + 1u == (gen + 1u) * nloc) {
            __builtin_amdgcn_fence(__ATOMIC_RELEASE, "agent");
            asm volatile("s_waitcnt vmcnt(0)" ::: "memory");
            const unsigned og = xb_add(&bar[XB_TOP], 1u);
            const unsigned tg = og / nx;
            if (og + 1u == (tg + 1u) * nx) xb_add(&bar[XB_TOPGEN], 1u);
            else XB_SPIN(xb_ld(&bar[XB_TOPGEN]) == tg, bar);
            __builtin_amdgcn_fence(__ATOMIC_ACQUIRE, "agent");
            xb_add(&bar[XB_XGEN(b.x)], 1u);
            asm volatile("s_waitcnt vmcnt(0)" ::: "memory");
        } else {
            XB_SPIN(xb_ld(&bar[XB_XGEN(b.x)]) == gen, bar);
            __builtin_amdgcn_fence(__ATOMIC_ACQUIRE, "agent");
            asm volatile("s_waitcnt vmcnt(0)" ::: "memory");
        }
    }
    __syncthreads();
}


__global__ void __launch_bounds__(NTHREADS, 2) __attribute__((amdgpu_waves_per_eu(2, 2))) fwd_megakernel(Params p) {
    __shared__ __attribute__((aligned(1024))) char smem[SMEM_ALL];
    cg::grid_group grid = cg::this_grid();
    __shared__ uint4 xb_words;
    if (threadIdx.x == 0) xb_words = make_uint4(0u, 0u, 0u, 0u);
    __syncthreads();
    XcdBarrier xb = xcd_barrier_post((unsigned*)(p.ws + OFF_BAR), (volatile LAS unsigned*)&xb_words);
    const float* MOD0 = (const float*)(p.ws + OFF_MOD);
    const float* MOD1 = MOD0 + 9 * 6144;
    float* XRC = (float*)(p.ws + OFF_XRC);
    const bf16_t* Hb = (const bf16_t*)(p.ws + OFF_H);

    phase0(p, smem);
    if (p.ws == nullptr) grid.sync();
    xcd_barrier(xb);
    phase_norm(p, p.x, p.ctx, p.norm1_g, MOD0, 0, 18432);
    xcd_barrier(xb);
    phase_inproj0(p, smem);
    xcd_barrier(xb);
    phase_mla_up(p, smem);
    xcd_barrier(xb);
    phase_attn(p, smem);
    xcd_barrier(xb);
    phase_proj_resid(p, Hb, 1024, (const bf16_t*)(p.ws + OFF_WT_OUT0), MOD0, 2, p.x, p.ctx, p.out, XRC, 64, true, false, smem);
    xcd_barrier(xb);
    phase_norm(p, p.out, XRC, p.norm2_g, MOD0, 3, 18432);
    xcd_barrier(xb);
    phase_ffn_up(p, (const bf16_t*)(p.ws + OFF_WT_UP0), p.ffn_conv_w, p.ffn_conv_b, 80, smem);
    xcd_barrier(xb);
    phase_proj_resid(p, (const bf16_t*)(p.ws + OFF_ACT), 2816, (const bf16_t*)(p.ws + OFF_WT_DOWN0), MOD0, 5, p.out, XRC, p.out, XRC, 64, true, true, smem);
    xcd_barrier(xb);
    phase_norm(p, p.out, XRC, p.norm1_g + 1024, MOD1, 0, 18432);
    xcd_barrier(xb);
    phase_inproj1(p, smem);
    xcd_barrier(xb);
    phase_qkconv(p);
    xcd_barrier(xb);
    phase_mlstm(p, smem);
    xcd_barrier(xb);
    phase_mix(p);
    xcd_barrier(xb);
    phase_proj_resid(p, Hb, 1024, (const bf16_t*)(p.ws + OFF_WT_OUT1), MOD1, 2, p.out, XRC, p.out, XRC, 64, false, false, smem);
    xcd_barrier(xb);
    phase_norm(p, p.out, XRC, p.norm2_g + 1024, MOD1, 3, 16384);
    xcd_barrier(xb);
    phase_ffn_up(p, (const bf16_t*)(p.ws + OFF_WT_UP1), p.ffn_conv_w + 3 * 2816, p.ffn_conv_b + 2816, 68, smem);
    xcd_barrier(xb);
    phase_proj_resid(p, (const bf16_t*)(p.ws + OFF_ACT), 2816, (const bf16_t*)(p.ws + OFF_WT_DOWN1), MOD1, 5, p.out, XRC, p.out, XRC, 64, false, false, smem);
}

extern "C" void kernel_launch(void* const* d_in, const int* in_sizes, int n_in, void* d_out, int out_size, void* d_ws, size_t ws_size,
                              hipStream_t stream) {
    static int grid_blocks = 0;
    if (!grid_blocks) {
        int dev = 0, cus = 0, per_cu = 0;
        hipGetDevice(&dev);
        hipDeviceGetAttribute(&cus, hipDeviceAttributeMultiprocessorCount, dev);
        hipOccupancyMaxActiveBlocksPerMultiprocessor(&per_cu, fwd_megakernel, NTHREADS, 0);
        if (per_cu < 1) per_cu = 1;
        if (per_cu > 1) per_cu = 1;
        grid_blocks = cus * per_cu;
        if (ws_size < WS_END) fprintf(stderr, "kernel_launch: workspace too small: %zu < %zu\n", ws_size, (size_t)WS_END);
    }
    Params p{};
    const float** pf = (const float**)&p;
    for (int i = 0; i < 28; ++i) pf[i] = (const float*)d_in[i];
    p.out = (float*)d_out;
    p.ws = (char*)d_ws;
    hipMemsetAsync((char*)d_ws + OFF_BAR, 0, 16384, stream);
    void* args[] = {&p};
    hipError_t e = hipLaunchCooperativeKernel((void*)fwd_megakernel, dim3(grid_blocks), dim3(NTHREADS), args, 0, stream);
    if (e != hipSuccess) fprintf(stderr, "cooperative launch failed: %s (grid %d)\n", hipGetErrorString(e), grid_blocks);
}
```

```cpp
#include <hip/hip_runtime.h>
#include <hip/hip_cooperative_groups.h>
#include <cstdio>
namespace cg = cooperative_groups;

typedef unsigned short bf16_t;
using bf16x8 = __attribute__((ext_vector_type(8))) short;
using f32x16 = __attribute__((ext_vector_type(16))) float;
using f32x4 = __attribute__((ext_vector_type(4))) float;
#define DI __device__ __forceinline__
#define MFMA(a, b, c) __builtin_amdgcn_mfma_f32_32x32x16_bf16((a), (b), (c), 0, 0, 0)
#define MFMA16(a, b, c) __builtin_amdgcn_mfma_f32_16x16x32_bf16((a), (b), (c), 0, 0, 0)
#define LDS_BARRIER() do { asm volatile("s_waitcnt lgkmcnt(0)" ::: "memory"); __builtin_amdgcn_s_barrier(); asm volatile("" ::: "memory"); } while (0)
#define TID ((int)(threadIdx.x & 255))
#define HBI ((int)(threadIdx.x >> 8))

constexpr float EPSF = 1e-6f;
constexpr float LOG2E = 1.4426950408889634f;
constexpr int NTHREADS = 512;
constexpr int HB_SMEM = 73728;
constexpr int SMEM_ALL = 2 * HB_SMEM;
constexpr int GP = 72;
constexpr int CP = 132;
constexpr int ROWSS_OFF = 67584;

constexpr size_t OFF_WT_UP1 = 0;
constexpr size_t OFF_WT_DOWN1 = OFF_WT_UP1 + 5632ull * 1024 * 2;
constexpr size_t OFF_WT_IN1 = OFF_WT_DOWN1 + 1024ull * 2816 * 2;
constexpr size_t OFF_WT_OUT1 = OFF_WT_IN1 + 3328ull * 1024 * 2;
constexpr size_t OFF_MOD = OFF_WT_OUT1 + 1024ull * 1024 * 2;
constexpr size_t OFF_TABG = OFF_MOD + 2ull * 9 * 6144 * 4;
constexpr size_t OFF_TABM = OFF_TABG + 64 * 16 * 2 * 4;
constexpr size_t OFF_ZROW = OFF_TABM + 64 * 8 * 2 * 4;
constexpr size_t OFF_W0 = OFF_ZROW + 8192;
constexpr size_t OFF_WT_IN0 = OFF_W0;
constexpr size_t OFF_WT_QB = OFF_WT_IN0 + 1536ull * 1024 * 2;
constexpr size_t OFF_WT_KVB = OFF_WT_QB + 1024ull * 384 * 2;
constexpr size_t OFF_WT_OUT0 = OFF_WT_KVB + 1024ull * 256 * 2;
constexpr size_t OFF_WT_UP0 = OFF_WT_OUT0 + 1024ull * 1024 * 2;
constexpr size_t OFF_WT_DOWN0 = OFF_WT_UP0 + 5632ull * 1024 * 2;
constexpr size_t OFF_XRC = OFF_WT_DOWN0 + 1024ull * 2816 * 2;
constexpr size_t OFF_R = OFF_XRC + 2048ull * 1024 * 4;
constexpr size_t OFF_QG = OFF_R;
constexpr size_t OFF_KG = OFF_QG + 18432ull * 512 * 2;
constexpr size_t OFF_VGT = OFF_KG + 18432ull * 128 * 2;
constexpr size_t OFF_CQ = OFF_VGT + 18432ull * 128 * 2;
constexpr size_t OFF_CKV = OFF_CQ + 18432ull * 384 * 2;
constexpr size_t OFF_KR = OFF_CKV + 18432ull * 256 * 2;
constexpr size_t OFF_QM = OFF_KR + 18432ull * 32 * 4;
constexpr size_t OFF_KM = OFF_QM + 18432ull * 768 * 2;
constexpr size_t OFF_VMT = OFF_KM + 18432ull * 768 * 2;
constexpr size_t END_L0 = OFF_VMT + 18432ull * 512 * 2;
constexpr size_t OFF_ACT = OFF_R;
constexpr size_t END_ACT = OFF_ACT + 18432ull * 2816 * 2;
constexpr size_t OFF_QKRAW = OFF_W0;
constexpr size_t OFF_V1 = OFF_QKRAW + 18432ull * 1024 * 2;
constexpr size_t OFF_OG = OFF_V1 + 18432ull * 1024 * 2;
constexpr size_t OFF_GATES = OFF_OG + 16384ull * 1024 * 2;
constexpr size_t OFF_HF = OFF_GATES + 18432ull * 32 * 4;
constexpr size_t OFF_HB = OFF_HF + 16384ull * 1024 * 2;
constexpr size_t END_L1 = OFF_HB + 16384ull * 1024 * 2;
constexpr size_t cmax(size_t a, size_t b) { return a > b ? a : b; }
constexpr size_t OFF_H = cmax(cmax(END_L0, END_ACT), END_L1);
constexpr size_t OFF_BAR = OFF_H + 18432ull * 1024 * 2;
constexpr size_t OFF_SCAN = OFF_BAR + 16384;
constexpr size_t WS_END = OFF_SCAN + 2304ull * 384 * 4;
static_assert(WS_END <= 268435456ull, "workspace too large");
static_assert(OFF_H % 256 == 0 && OFF_R % 256 == 0 && OFF_HF % 256 == 0, "align");

struct Params {
    const float *x, *c, *ctx, *c_ctx, *ada_w, *ada_b, *norm1_g, *norm2_g, *ffn_w_up, *ffn_conv_w, *ffn_conv_b, *ffn_w_down,
        *att_w_in, *mla_qa_g, *mla_w_qb, *mla_kva_g, *mla_w_kvb, *mla_q_g, *mla_k_g, *gqa_q_g, *gqa_k_g, *att_w_out,
        *ml_w_in, *ml_conv_w, *ml_conv_b, *ml_gate_b, *ml_out_g, *ml_w_out;
    float* out;
    char* ws;
};

DI unsigned short f2bf_sw(float x) { unsigned u = __float_as_uint(x); u += 0x7fffu + ((u >> 16) & 1u); return (unsigned short)(u >> 16); }
DI unsigned short f2bf(float x) { unsigned r; asm("v_cvt_pk_bf16_f32 %0, %1, %1" : "=v"(r) : "v"(x)); return (unsigned short)(r & 0xffffu); }
DI unsigned pack2(float a, float b) { unsigned r; asm("v_cvt_pk_bf16_f32 %0, %1, %2" : "=v"(r) : "v"(a), "v"(b)); return r; }
DI bf16x8 pack_frag(float a0, float a1, float a2, float a3, float a4, float a5, float a6, float a7) {
    using u32x4_ = __attribute__((ext_vector_type(4))) unsigned; u32x4_ p;
    asm volatile("v_cvt_pk_bf16_f32 %0, %4, %5\n\tv_cvt_pk_bf16_f32 %1, %6, %7\n\tv_cvt_pk_bf16_f32 %2, %8, %9\n\tv_cvt_pk_bf16_f32 %3, %10, %11\n\ts_nop 1"
                 : "=&v"(p[0]), "=&v"(p[1]), "=&v"(p[2]), "=&v"(p[3]) : "v"(a0), "v"(a1), "v"(a2), "v"(a3), "v"(a4), "v"(a5), "v"(a6), "v"(a7));
    return __builtin_bit_cast(bf16x8, p);
}
DI float bflo(unsigned v) { return __uint_as_float(v << 16); }
DI float bfhi(unsigned v) { return __uint_as_float(v & 0xffff0000u); }
DI float bf2f(unsigned short v) { return __uint_as_float(((unsigned)v) << 16); }
DI uint4 pack8(const float* v) { uint4 o; o.x = pack2(v[0], v[1]); o.y = pack2(v[2], v[3]); o.z = pack2(v[4], v[5]); o.w = pack2(v[6], v[7]); return o; }
DI void unpack8(uint4 u, float* v) { v[0] = bflo(u.x); v[1] = bfhi(u.x); v[2] = bflo(u.y); v[3] = bfhi(u.y); v[4] = bflo(u.z); v[5] = bfhi(u.z); v[6] = bflo(u.w); v[7] = bfhi(u.w); }
DI int crow(int reg, int h) { return (reg & 3) + 8 * (reg >> 2) + 4 * h; }
DI float sigmoidf_(float x) { return __builtin_amdgcn_rcpf(1.f + __expf(-x)); }
DI float siluf_(float x) { return x * __builtin_amdgcn_rcpf(1.f + __expf(-x)); }
DI float logsigmoidf_(float x) { return fminf(x, 0.f) - log1pf(__expf(-fabsf(x))); }
DI f32x16 zero16() { f32x16 z;
#pragma unroll
    for (int i = 0; i < 16; ++i) z[i] = 0.f; return z; }

DI void row_info(int m0, int& b, int& t0, bool& lat) {
    if (m0 < 16384) { b = m0 >> 11; t0 = m0 & 2047; lat = true; }
    else { int q = m0 - 16384; b = q >> 8; t0 = q & 255; lat = false; }
}

template <bool SS, bool HALO, class Epi>
DI void gemm_tile(const bf16_t* ap0, const bf16_t* ap1, const bf16_t* ap2, const bf16_t* ap3, unsigned mk0, unsigned mk1, unsigned mk2, unsigned mk3, const bf16_t* __restrict__ Bt, int ldb, int K, char* smem, Epi epi) {
    const int tid = TID, lane = tid & 63, w = tid >> 6, h = lane >> 5, r = lane & 31;
    const int wm = w >> 1, wn = w & 1;
    const int lr = tid >> 3, kc = tid & 7;
    ap0 += kc * 8; ap1 += kc * 8; ap2 += kc * 8; ap3 += kc * 8;
    const bf16_t* bp0 = Bt + (size_t)lr * ldb + kc * 8;
    const bf16_t* bp1 = bp0 + (size_t)32 * ldb; const bf16_t* bp2 = bp0 + (size_t)64 * ldb; const bf16_t* bp3 = bp0 + (size_t)96 * ldb;
    f32x16 acc00 = zero16(), acc01 = zero16(), acc10 = zero16(), acc11 = zero16();
    float ss0 = 0.f, ss1 = 0.f, ss2 = 0.f, ss3 = 0.f;
    uint4 ra0, ra1, ra2, ra3, rb0, rb1, rb2, rb3;
    const int nk = K >> 6;
#define GLOAD(k0) { ra0 = *(const uint4*)(ap0 + (k0)); ra1 = *(const uint4*)(ap1 + (k0)); ra2 = *(const uint4*)(ap2 + (k0)); ra3 = *(const uint4*)(ap3 + (k0)); \
                    rb0 = *(const uint4*)(bp0 + (k0)); rb1 = *(const uint4*)(bp1 + (k0)); rb2 = *(const uint4*)(bp2 + (k0)); rb3 = *(const uint4*)(bp3 + (k0)); }
#define SSQ(ssv, rv) { if (SS) { float f_[8]; unpack8(rv, f_); ssv += f_[0]*f_[0] + f_[1]*f_[1] + f_[2]*f_[2] + f_[3]*f_[3] + f_[4]*f_[4] + f_[5]*f_[5] + f_[6]*f_[6] + f_[7]*f_[7]; } }
#define MSK(rv, mk) { rv.x &= mk; rv.y &= mk; rv.z &= mk; rv.w &= mk; }
#define SWRITE(s_) { if (HALO) { MSK(ra0, mk0) MSK(ra1, mk1) MSK(ra2, mk2) MSK(ra3, mk3) } bf16_t* As_ = (bf16_t*)(smem + (s_) * 36864) + lr * GP + kc * 8; bf16_t* Bs_ = As_ + 128 * GP; \
                     *(uint4*)(As_) = ra0; *(uint4*)(As_ + 32 * GP) = ra1; *(uint4*)(As_ + 64 * GP) = ra2; *(uint4*)(As_ + 96 * GP) = ra3; \
                     *(uint4*)(Bs_) = rb0; *(uint4*)(Bs_ + 32 * GP) = rb1; *(uint4*)(Bs_ + 64 * GP) = rb2; *(uint4*)(Bs_ + 96 * GP) = rb3; \
                     SSQ(ss0, ra0) SSQ(ss1, ra1) SSQ(ss2, ra2) SSQ(ss3, ra3) }
    GLOAD(0) SWRITE(0) __syncthreads();
#pragma unroll 1
    for (int kt = 0; kt < nk; ++kt) {
        if (kt + 1 < nk) GLOAD((kt + 1) * 64)
        {
            const bf16_t* As = (const bf16_t*)(smem + (kt & 1) * 36864) + (wm * 64 + r) * GP + h * 8;
            const bf16_t* Bs = (const bf16_t*)(smem + (kt & 1) * 36864) + 128 * GP + (wn * 64 + r) * GP + h * 8;
#pragma unroll
            for (int ks = 0; ks < 4; ++ks) {
                const bf16x8 a0 = *(const bf16x8*)(As + ks * 16), a1 = *(const bf16x8*)(As + 32 * GP + ks * 16);
                const bf16x8 b0 = *(const bf16x8*)(Bs + ks * 16), b1 = *(const bf16x8*)(Bs + 32 * GP + ks * 16);
                acc00 = MFMA(a0, b0, acc00); acc01 = MFMA(a0, b1, acc01); acc10 = MFMA(a1, b0, acc10); acc11 = MFMA(a1, b1, acc11);
            }
        }
        if (kt + 1 < nk) SWRITE((kt + 1) & 1)
        __syncthreads();
    }
#undef GLOAD
#undef SWRITE
#undef SSQ
#undef MSK
    float* Cs = (float*)smem;
    {
        float* cb = Cs + (wm * 64 + 4 * h) * CP + wn * 64 + r;
#pragma unroll
        for (int g = 0; g < 16; ++g) {
            const int ro = (g & 3) + 8 * (g >> 2);
            cb[ro * CP] = acc00[g]; cb[ro * CP + 32] = acc01[g]; cb[(ro + 32) * CP] = acc10[g]; cb[(ro + 32) * CP + 32] = acc11[g];
        }
    }
    if (SS) {
        float* rowss = (float*)(smem + ROWSS_OFF);
        ss0 += __shfl_xor(ss0, 1); ss0 += __shfl_xor(ss0, 2); ss0 += __shfl_xor(ss0, 4);
        ss1 += __shfl_xor(ss1, 1); ss1 += __shfl_xor(ss1, 2); ss1 += __shfl_xor(ss1, 4);
        ss2 += __shfl_xor(ss2, 1); ss2 += __shfl_xor(ss2, 2); ss2 += __shfl_xor(ss2, 4);
        ss3 += __shfl_xor(ss3, 1); ss3 += __shfl_xor(ss3, 2); ss3 += __shfl_xor(ss3, 4);
        if (kc == 0) { rowss[lr] = ss0; rowss[lr + 32] = ss1; rowss[lr + 64] = ss2; rowss[lr + 96] = ss3; }
    }
    __syncthreads();
    epi((const float*)smem, (const float*)(smem + ROWSS_OFF));
    __syncthreads();
}


DI int g_row(int i) { return ((i * 8 + (int)(threadIdx.x >> 6)) * 8) + (int)((threadIdx.x & 63) >> 3); }
DI int b_perm(int row) { return ((row >> 5) & 1) * 128 + (row >> 6) * 32 + (row & 31); }
DI int g_chunk(int row) { return (int)(threadIdx.x & 7) ^ ((row >> 1) & 7); }
#define GLDS(g_, l_) __builtin_amdgcn_global_load_lds((const unsigned*)(g_), (unsigned*)(l_), 16, 0, 0)
template <int NH = -1, class Epi>
DI void gemm256(const char* wsb, const bf16_t* a0p, const bf16_t* a1p, const bf16_t* a2p, const bf16_t* a3p,
                const bf16_t* b0p, const bf16_t* b1p, const bf16_t* b2p, const bf16_t* b3p, int K, char* smem_all, Epi epi) {
    const unsigned a0 = (unsigned)((const char*)a0p - wsb), a1 = (unsigned)((const char*)a1p - wsb), a2 = (unsigned)((const char*)a2p - wsb), a3 = (unsigned)((const char*)a3p - wsb);
    const unsigned b0 = (unsigned)((const char*)b0p - wsb), b1 = (unsigned)((const char*)b1p - wsb), b2 = (unsigned)((const char*)b2p - wsb), b3 = (unsigned)((const char*)b3p - wsb);
    const int lane = threadIdx.x & 63, wid = __builtin_amdgcn_readfirstlane(threadIdx.x >> 6), wr = wid >> 2, wc = wid & 3, fr = lane & 15, fq = lane >> 4;
    f32x4 acc[8][4];
#pragma unroll
    for (int m = 0; m < 8; ++m)
#pragma unroll
        for (int n = 0; n < 4; ++n) acc[m][n] = (f32x4){0.f, 0.f, 0.f, 0.f};
#define STAGE256(buf, k0) { char* sa_ = smem_all + (buf) * 65536 + wid * 1024; char* sb_ = sa_ + 32768; const char* wk_ = wsb + (size_t)(k0) * 2; \
        GLDS(wk_ + a0, sa_); GLDS(wk_ + a1, sa_ + 8192); GLDS(wk_ + a2, sa_ + 16384); GLDS(wk_ + a3, sa_ + 24576); \
        if (NH < 0 || (wid >> 2) == NH) { GLDS(wk_ + b0, sb_); GLDS(wk_ + b1, sb_ + 8192); GLDS(wk_ + b2, sb_ + 16384); GLDS(wk_ + b3, sb_ + 24576); } }
    const int sw = (fr >> 1) & 7;
    const unsigned offA = (wr * 128 + fr) * 128, offB = 32768 + (wc * 64 + fr) * 128;
    const unsigned co0 = ((0 + fq) ^ sw) << 4, co1 = ((4 + fq) ^ sw) << 4;
    const unsigned lds0 = (unsigned)(size_t)smem_all;
    const int nt = K >> 6;
    STAGE256(0, 0)
    asm volatile("s_waitcnt vmcnt(0)" ::: "memory");
    __syncthreads();
#pragma unroll 1
    for (int t = 0; t < nt; ++t) {
        const int cur = t & 1;
        if (t + 1 < nt) STAGE256(cur ^ 1, (t + 1) * 64)
        const unsigned lb = lds0 + cur * 65536;
        const unsigned aA0 = lb + offA + co0, aA1 = lb + offA + co1, aB0 = lb + offB + co0, aB1 = lb + offB + co1;
        bf16x8 Bq0[4], Bq1[4], Aq0[2], Aq1[2];
#define DSR(dst, addr, off) asm volatile("ds_read_b128 %0, %1 offset:%2" : "=v"(dst) : "v"(addr), "n"(off) : "memory")
#define LDA2(dst, addr, mo) { DSR(dst[0], addr, (mo) * 2048); DSR(dst[1], addr, ((mo) + 1) * 2048); }
#define LDB4(dst, addr) { DSR(dst[0], addr, 0); DSR(dst[1], addr, 2048); DSR(dst[2], addr, 4096); DSR(dst[3], addr, 6144); }
#define WAIT_A(n, X) asm volatile("s_waitcnt lgkmcnt(" #n ")" : "+v"(X[0]), "+v"(X[1]) :: "memory")
#define WAIT_AB(n, X, Y) asm volatile("s_waitcnt lgkmcnt(" #n ")" : "+v"(X[0]), "+v"(X[1]), "+v"(Y[0]), "+v"(Y[1]), "+v"(Y[2]), "+v"(Y[3]) :: "memory")
#define MM8(Aq, Bq, mo) { _Pragma("unroll") for (int m = 0; m < 2; ++m) _Pragma("unroll") for (int n = 0; n < 4; ++n) if (NH < 0 || (n >> 1) == NH) acc[(mo) + m][n] = MFMA16(Bq[n], Aq[m], acc[(mo) + m][n]); }
        LDB4(Bq0, aB0) LDA2(Aq0, aA0, 0) LDA2(Aq1, aA0, 2)
        WAIT_AB(2, Aq0, Bq0);
        MM8(Aq0, Bq0, 0)
        LDA2(Aq0, aA0, 4)
        WAIT_A(2, Aq1);
        MM8(Aq1, Bq0, 2)
        LDA2(Aq1, aA0, 6) LDB4(Bq1, aB1)
        WAIT_A(6, Aq0);
        MM8(Aq0, Bq0, 4)
        LDA2(Aq0, aA1, 0)
        WAIT_A(6, Aq1);
        MM8(Aq1, Bq0, 6)
        LDA2(Aq1, aA1, 2)
        WAIT_AB(2, Aq0, Bq1);
        MM8(Aq0, Bq1, 0)
        LDA2(Aq0, aA1, 4)
        WAIT_A(2, Aq1);
        MM8(Aq1, Bq1, 2)
        LDA2(Aq1, aA1, 6)
        WAIT_A(2, Aq0);
        MM8(Aq0, Bq1, 4)
        WAIT_A(0, Aq1);
        MM8(Aq1, Bq1, 6)
#undef DSR
#undef LDA2
#undef LDB4
#undef WAIT_A
#undef WAIT_AB
#undef MM8
        asm volatile("s_waitcnt vmcnt(0)" ::: "memory");
        __syncthreads();
    }
#undef STAGE256
    int t_ = threadIdx.x;
    asm volatile("" : "+v"(t_));
    const int lane_ = t_ & 63, wid_ = t_ >> 6, wr_ = wid_ >> 2, wc_ = wid_ & 3, fr_ = lane_ & 15, fq_ = lane_ >> 4, hb_ = t_ >> 8;
#pragma unroll
    for (int p = 0; p < 2; ++p) {
        if (NH >= 0 && p != NH) continue;
        {
            float* Cs = (float*)(smem_all + wr_ * HB_SMEM) + fr_ * CP + wc_ * 32 + 4 * fq_;
#pragma unroll
            for (int m = 0; m < 8; ++m)
#pragma unroll
                for (int n = 0; n < 2; ++n) *(f32x4*)(Cs + (m * 16) * CP + n * 16) = acc[m][2 * p + n];
        }
        __syncthreads();
        epi((const float*)(smem_all + hb_ * HB_SMEM), hb_, p, t_ & 255);
        __syncthreads();
    }
}

DI void epi_store_bf16(const float* Cs, bf16_t* dst, int ld, int tid) {
#pragma unroll 2
    for (int j = 0; j < 8; ++j) {
        int c = tid + 256 * j, row = c >> 4, cc = c & 15;
        const float4* cp = (const float4*)(Cs + row * CP + cc * 8);
        float4 f0 = cp[0], f1 = cp[1];
        float v[8] = {f0.x, f0.y, f0.z, f0.w, f1.x, f1.y, f1.z, f1.w};
        *(uint4*)(dst + (size_t)row * ld + cc * 8) = pack8(v);
    }
}
DI void epi_resid(const float* Cs, const float* src, float* dst, const float* gate, int tid) {
#pragma unroll 4
    for (int j = 0; j < 16; ++j) {
        int c = tid + 256 * j, row = c >> 5, c4 = c & 31;
        float4 cv = *(const float4*)(Cs + row * CP + c4 * 4);
        float4 sv = *(const float4*)(src + (size_t)row * 1024 + c4 * 4);
        float4 gv = *(const float4*)(gate + c4 * 4);
        float4 o; o.x = sv.x + gv.x * cv.x; o.y = sv.y + gv.y * cv.y; o.z = sv.z + gv.z * cv.z; o.w = sv.w + gv.w * cv.w;
        *(float4*)(dst + (size_t)row * 1024 + c4 * 4) = o;
    }
}

DI int wsrc_col(int mode, int tn, int c) {
    if (mode == 0) return tn * 128 + c;
    if (mode == 1) {
        const int np = tn * 128;
        if (np < 512) return 672 + np + c;
        if (np < 640) return 1184 + np - 512 + c;
        if (np < 768) return 1312 + np - 640 + c;
        if (np < 1152) return np - 768 + c;
        if (np < 1408) return 384 + np - 1152 + c;
        return c < 32 ? 640 + c : -1;
    }
    if (mode == 2) return c < 96 ? tn * 96 + c : -1;
    return c < 64 ? 64 * tn + c : 2816 + 64 * tn + c - 64;
}
DI void wtile(const float* __restrict__ src, int Nsrc, const float* __restrict__ g, bf16_t* __restrict__ dst, int K, int k0, int tn, int mode, char* smem) {
    bf16_t* T = (bf16_t*)smem;
    const int tid = TID, lane = tid & 63, w = tid >> 6, rsub = lane >> 5, c4 = (lane & 31) * 4;
    int sc = wsrc_col(mode, tn, c4);
    if (sc >= Nsrc) sc = -1;
#pragma unroll 8
    for (int i = 0; i < 16; ++i) {
        const int rr = w * 32 + 2 * i + rsub;
        float4 v = make_float4(0.f, 0.f, 0.f, 0.f);
        if (sc >= 0) { v = *(const float4*)(src + (size_t)(k0 + rr) * Nsrc + sc); if (g) { const float gg = g[k0 + rr]; v.x *= gg; v.y *= gg; v.z *= gg; v.w *= gg; } }
        T[(c4 + 0) * 130 + rr] = f2bf(v.x);
        T[(c4 + 1) * 130 + rr] = f2bf(v.y);
        T[(c4 + 2) * 130 + rr] = f2bf(v.z);
        T[(c4 + 3) * 130 + rr] = f2bf(v.w);
    }
    __syncthreads();
#pragma unroll
    for (int j = 0; j < 8; ++j) {
        const int c = tid + 256 * j, n = c >> 4, kc = c & 15;
        const unsigned* s32 = (const unsigned*)(T + n * 130 + kc * 8);
        uint4 o; o.x = s32[0]; o.y = s32[1]; o.z = s32[2]; o.w = s32[3];
        *(uint4*)(dst + (size_t)(tn * 128 + n) * K + k0 + kc * 8) = o;
    }
    __syncthreads();
}

DI void mod_item(const Params& p, int item, char* smem) {
    const int tid = TID, lane = tid & 63, w = tid >> 6, hl = lane >> 5, cl = lane & 31;
    const int l = item / 192, n0 = (item % 192) * 32;
    float* sl = (float*)smem;
    for (int i = tid; i < 9216; i += 256) {
        int rr = i >> 10, k = i & 1023;
        float cv = rr < 8 ? p.c[rr * 1024 + k] : p.c_ctx[k];
        sl[i] = cv / (1.f + expf(-cv));
    }
    __syncthreads();
    float acc[9];
#pragma unroll
    for (int q = 0; q < 9; ++q) acc[q] = 0.f;
    const float* wp = p.ada_w + (size_t)l * 1024 * 6144 + n0 + cl;
#pragma unroll 16
    for (int kk = 0; kk < 128; ++kk) {
        const int k = w * 256 + 2 * kk + hl;
        float wv = wp[(size_t)k * 6144];
#pragma unroll
        for (int q = 0; q < 9; ++q) acc[q] += sl[q * 1024 + k] * wv;
    }
    float* red = (float*)(smem + 36864);
#pragma unroll
    for (int q = 0; q < 9; ++q) red[((w * 2 + hl) * 9 + q) * 32 + cl] = acc[q];
    __syncthreads();
    float* MOD = (float*)(p.ws + OFF_MOD);
    for (int i = tid; i < 288; i += 256) {
        int q = i >> 5, ln = i & 31;
        float sacc = 0.f;
#pragma unroll
        for (int u = 0; u < 8; ++u) sacc += red[(u * 9 + q) * 32 + ln];
        sacc += p.ada_b[l * 6144 + n0 + ln];
        MOD[(size_t)(l * 9 + q) * 6144 + n0 + ln] = sacc;
    }
    __syncthreads();
}

DI void sincos_d(double x, float& s, float& c) {
    const double TWO_PI = 6.283185307179586476925;
    double t = x / TWO_PI;
    t -= rint(t);
    double y = t * TWO_PI, y2 = y * y;
    double sv = y, cv = 1.0, ts = y, tc = 1.0;
#pragma unroll 1
    for (int k = 1; k <= 14; ++k) {
        tc *= -y2 / (double)((2 * k - 1) * (2 * k));
        ts *= -y2 / (double)((2 * k) * (2 * k + 1));
        cv += tc; sv += ts;
    }
    s = (float)sv; c = (float)cv;
}

DI void rope_tables(const Params& p) {
    float* TG = (float*)(p.ws + OFF_TABG);
    float* TM = (float*)(p.ws + OFF_TABM);
    for (int i = TID; i < 1024; i += 256) {
        int v = i >> 4, f = i & 15;
        float inv = exp2f(-(float)f / 16.f * 13.287712379549449f);
        float ang = (float)v * inv, s, c;
        sincos_d((double)ang, s, c);
        TG[i] = c; TG[1024 + i] = s;
    }
    for (int i = TID; i < 512; i += 256) {
        int v = i >> 3, f = i & 7;
        float inv = exp2f(-(float)f / 8.f * 13.287712379549449f);
        float ang = (float)v * inv, s, c;
        sincos_d((double)ang, s, c);
        TM[i] = c; TM[512 + i] = s;
    }
}

constexpr int NW = 10;
constexpr int N_WT0 = 8 * 12 + 3 * 8 + 2 * 8 + 8 * 8 + 8 * 44 + 22 * 8;
constexpr int N_WT1 = 8 * 44 + 22 * 8 + 8 * 26 + 8 * 8;
constexpr int N_MOD = 384;
constexpr int N_P0 = N_MOD + 96;
static_assert(N_P0 % 2 == 0 && N_MOD % 2 == 0 && N_WT1 % 2 == 0, "items are dealt to half-block pairs");

DI void wtile_item(const Params& p, int t, char* smem) {
    int wi = 0;
    int cnt[NW] = {8 * 12, 3 * 8, 2 * 8, 8 * 8, 8 * 44, 22 * 8, 8 * 44, 22 * 8, 8 * 26, 8 * 8};
#pragma unroll
    for (int i = 0; i < NW - 1; ++i) { if (wi == i && t >= cnt[i]) { t -= cnt[i]; wi = i + 1; } }
    const float* src; const float* g = nullptr; bf16_t* dst; int K, Nsrc, ntn, mode;
    switch (wi) {
        case 0: src = p.att_w_in; dst = (bf16_t*)(p.ws + OFF_WT_IN0); K = 1024; Nsrc = 1440; ntn = 12; mode = 1; break;
        case 1: src = p.mla_w_qb; g = p.mla_qa_g; dst = (bf16_t*)(p.ws + OFF_WT_QB); K = 384; Nsrc = 768; ntn = 8; mode = 2; break;
        case 2: src = p.mla_w_kvb; g = p.mla_kva_g; dst = (bf16_t*)(p.ws + OFF_WT_KVB); K = 256; Nsrc = 1024; ntn = 8; mode = 0; break;
        case 3: src = p.att_w_out; dst = (bf16_t*)(p.ws + OFF_WT_OUT0); K = 1024; Nsrc = 1024; ntn = 8; mode = 0; break;
        case 4: src = p.ffn_w_up; dst = (bf16_t*)(p.ws + OFF_WT_UP0); K = 1024; Nsrc = 5632; ntn = 44; mode = 3; break;
        case 5: src = p.ffn_w_down; dst = (bf16_t*)(p.ws + OFF_WT_DOWN0); K = 2816; Nsrc = 1024; ntn = 8; mode = 0; break;
        case 6: src = p.ffn_w_up + 1024ull * 5632; dst = (bf16_t*)(p.ws + OFF_WT_UP1); K = 1024; Nsrc = 5632; ntn = 44; mode = 3; break;
        case 7: src = p.ffn_w_down + 2816ull * 1024; dst = (bf16_t*)(p.ws + OFF_WT_DOWN1); K = 2816; Nsrc = 1024; ntn = 8; mode = 0; break;
        case 8: src = p.ml_w_in; dst = (bf16_t*)(p.ws + OFF_WT_IN1); K = 1024; Nsrc = 3104; ntn = 26; mode = 0; break;
        default: src = p.ml_w_out; dst = (bf16_t*)(p.ws + OFF_WT_OUT1); K = 1024; Nsrc = 1024; ntn = 8; mode = 0; break;
    }
    const int tn = t % ntn, tk = t / ntn;
    wtile(src, Nsrc, g, dst, K, tk * 128, tn, mode, smem);
}

DI void phase0(const Params& p, char* smem_all) {
    char* smem = smem_all + HBI * HB_SMEM;
    if (blockIdx.x == gridDim.x - 1) {
        if (HBI == 0) rope_tables(p);
        else { for (int i = TID; i < 512; i += 256) ((uint4*)(p.ws + OFF_ZROW))[i] = make_uint4(0, 0, 0, 0); }
    }
    for (int it0 = blockIdx.x * 2; it0 < N_P0; it0 += gridDim.x * 2) {
        const int item = it0 + HBI;
        if (item < N_MOD) mod_item(p, item, smem);
        else wtile_item(p, item - N_MOD, smem);
    }
}
DI void convert_weights(const Params& p, char* smem_all, int t0, int cnt, int first) {
    char* smem = smem_all + HBI * HB_SMEM;
    const int G = gridDim.x;
    if (first >= G) first = 0;
    if ((int)blockIdx.x < first) return;
    for (int it0 = ((int)blockIdx.x - first) * 2; it0 < cnt; it0 += (G - first) * 2) wtile_item(p, t0 + it0 + HBI, smem);
}
constexpr int WT_IN0_0 = 0, WT_IN0_N = 96, WT_MLA_0 = 96, WT_MLA_N = 40, WT_OUT0_0 = 136, WT_OUT0_N = 64, WT_UP0_0 = 200, WT_UP0_N = 352, WT_DOWN0_0 = 552, WT_DOWN0_N = 176, WT_L1_0 = 728, WT_L1_N = 800;
static_assert(WT_L1_0 == N_WT0 && WT_L1_N == N_WT1, "tile ranges");

DI void norm_row_ptrs(int row, const float* srcLat, const float* srcCtx, const float* mod, int shift_idx, const float*& src, const float*& sh) {
    int mb;
    if (row < 16384) { src = srcLat + (size_t)row * 1024; mb = row >> 11; }
    else { src = srcCtx + (size_t)(row - 16384) * 1024; mb = 8; }
    sh = mod + (size_t)mb * 6144 + shift_idx * 1024;
}
DI void norm_row_finish(const float4 (&v)[4], float ss, const float* g, const float* sh, bf16_t* dst, int lane) {
#pragma unroll
    for (int o = 32; o >= 1; o >>= 1) ss += __shfl_xor(ss, o);
    const float rstd = rsqrtf(ss * (1.f / 1024.f) + EPSF);
    const float* sc = sh + 1024;
#pragma unroll
    for (int j = 0; j < 4; ++j) {
        const int c = j * 256 + lane * 4;
        const float4 gv = *(const float4*)(g + c), shv = *(const float4*)(sh + c), scv = *(const float4*)(sc + c);
        const float o0 = v[j].x * rstd * gv.x * (1.f + scv.x) + shv.x;
        const float o1 = v[j].y * rstd * gv.y * (1.f + scv.y) + shv.y;
        const float o2 = v[j].z * rstd * gv.z * (1.f + scv.z) + shv.z;
        const float o3 = v[j].w * rstd * gv.w * (1.f + scv.w) + shv.w;
        uint2 o; o.x = pack2(o0, o1); o.y = pack2(o2, o3);
        *(uint2*)(dst + c) = o;
    }
}
DI void phase_norm(const Params& p, const float* srcLat, const float* srcCtx, const float* g, const float* mod, int shift_idx, int nrows) {
    const int lane = threadIdx.x & 63, w = threadIdx.x >> 6;
    bf16_t* H = (bf16_t*)(p.ws + OFF_H);
    for (int row = (blockIdx.x * 8 + w) * 2; row < nrows; row += gridDim.x * 16) {
        const float *srcA, *shA, *srcB, *shB;
        norm_row_ptrs(row, srcLat, srcCtx, mod, shift_idx, srcA, shA);
        norm_row_ptrs(row + 1, srcLat, srcCtx, mod, shift_idx, srcB, shB);
        float4 va[4], vb[4];
        float sa = 0.f, sb = 0.f;
#pragma unroll
        for (int j = 0; j < 4; ++j) { va[j] = *(const float4*)(srcA + j * 256 + lane * 4); vb[j] = *(const float4*)(srcB + j * 256 + lane * 4); }
#pragma unroll
        for (int j = 0; j < 4; ++j) { sa += va[j].x * va[j].x + va[j].y * va[j].y + va[j].z * va[j].z + va[j].w * va[j].w; sb += vb[j].x * vb[j].x + vb[j].y * vb[j].y + vb[j].z * vb[j].z + vb[j].w * vb[j].w; }
        norm_row_finish(va, sa, g, shA, H + (size_t)row * 1024, lane);
        norm_row_finish(vb, sb, g, shB, H + (size_t)(row + 1) * 1024, lane);
    }
}

template <int Q>
DI void rope_apply(float* v, const float* tab, int rw, int cl) {
#pragma unroll
    for (int f = 0; f < Q; ++f) {
        float cr = tab[rw * Q + f], sr = tab[64 * Q + rw * Q + f], cc = tab[cl * Q + f], sc = tab[64 * Q + cl * Q + f];
        float a1 = v[f], a2 = v[Q + f], b1 = v[2 * Q + f], b2 = v[3 * Q + f];
        v[f] = a1 * cr - a2 * sr; v[Q + f] = a2 * cr + a1 * sr;
        v[2 * Q + f] = b1 * cc - b2 * sc; v[3 * Q + f] = b2 * cc + b1 * sc;
    }
}

DI void phase_inproj0(const Params& p, char* smem_all) {
    const bf16_t* H = (const bf16_t*)(p.ws + OFF_H);
    const bf16_t* W = (const bf16_t*)(p.ws + OFF_WT_IN0);
    const float* TG = (const float*)(p.ws + OFF_TABG);
    for (int id = blockIdx.x; id < 72 * 6; id += gridDim.x) {
        const int nt2 = id / 72, mt2 = id % 72;
        auto epi = [&](const float* Cs, int si, int sj, int tid) {
            const int nt = 2 * nt2 + sj, m0 = (2 * mt2 + si) * 128;
            int b, t0; bool lat; row_info(m0, b, t0, lat);
            const int s0 = lat ? 256 + t0 : t0;
            if (nt < 5) {
                const int row = tid & 127, half = tid >> 7;
                const float4* cp = (const float4*)(Cs + row * CP + half * 64);
                float ss = 0.f;
#pragma unroll
                for (int i = 0; i < 16; ++i) { float4 f = cp[i]; ss += f.x * f.x + f.y * f.y + f.z * f.z + f.w * f.w; }
                const float rstd = rsqrtf(ss * (1.f / 64.f) + EPSF);
                const float* g = nt < 4 ? p.gqa_q_g : p.gqa_k_g;
                const float osc = nt < 4 ? 0.125f * LOG2E : 1.f;
                bf16_t* dst;
                if (nt < 4) dst = (bf16_t*)(p.ws + OFF_QG) + ((size_t)(b * 2304 + s0 + row) * 8 + nt * 2 + half) * 64;
                else dst = (bf16_t*)(p.ws + OFF_KG) + ((size_t)(b * 2304 + s0 + row) * 2 + half) * 64;
                const int t = t0 + row;
#pragma unroll 1
                for (int hh = 0; hh < 2; ++hh) {
                    float v[32];
#pragma unroll
                    for (int i = 0; i < 8; ++i) { float4 f = cp[hh * 8 + i]; const float4 gv = *(const float4*)(g + hh * 32 + 4 * i);
                        v[4 * i] = f.x * rstd * gv.x; v[4 * i + 1] = f.y * rstd * gv.y; v[4 * i + 2] = f.z * rstd * gv.z; v[4 * i + 3] = f.w * rstd * gv.w; }
                    if (lat) {
                        const int pos = hh ? (t & 63) : (t >> 6);
#pragma unroll
                        for (int f = 0; f < 16; ++f) {
                            const float c_ = TG[pos * 16 + f], s_ = TG[1024 + pos * 16 + f];
                            const float x1 = v[f], x2 = v[16 + f];
                            v[f] = x1 * c_ - x2 * s_; v[16 + f] = x2 * c_ + x1 * s_;
                        }
                    }
#pragma unroll
                    for (int i = 0; i < 32; ++i) v[i] *= osc;
#pragma unroll
                    for (int i = 0; i < 4; ++i) *(uint4*)(dst + hh * 32 + i * 8) = pack8(v + i * 8);
                }
            } else if (nt == 5) {
                const int dall = tid & 127, ch0 = (tid >> 7) * 8;
                bf16_t* dst = (bf16_t*)(p.ws + OFF_VGT) + ((size_t)(b * 2 + (dall >> 6)) * 64 + (dall & 63)) * 2304 + s0;
#pragma unroll 2
                for (int ch = 0; ch < 8; ++ch) {
                    float v[8];
#pragma unroll
                    for (int i = 0; i < 8; ++i) v[i] = Cs[((ch0 + ch) * 8 + i) * CP + dall];
                    *(uint4*)(dst + (ch0 + ch) * 8) = pack8(v);
                }
            } else if (nt < 9) {
                epi_store_bf16(Cs, (bf16_t*)(p.ws + OFF_CQ) + (size_t)m0 * 384 + (nt - 6) * 128, 384, tid);
            } else if (nt < 11) {
                epi_store_bf16(Cs, (bf16_t*)(p.ws + OFF_CKV) + (size_t)m0 * 256 + (nt - 9) * 128, 256, tid);
            } else {
                const int row = tid >> 1, half = tid & 1;
                float* dst = (float*)(p.ws + OFF_KR) + (size_t)(m0 + row) * 32 + half * 16;
                const float4* cp = (const float4*)(Cs + row * CP + half * 16);
#pragma unroll
                for (int i = 0; i < 4; ++i) ((float4*)dst)[i] = cp[i];
            }
        };
        const int r0 = g_row(0), r1 = g_row(1), r2 = g_row(2), r3 = g_row(3);
        const bf16_t* Ab = H + (size_t)mt2 * 256 * 1024;
        const bf16_t* Bb = W + (size_t)nt2 * 256 * 1024;
        gemm256(p.ws, Ab + (size_t)r0 * 1024 + g_chunk(r0) * 8, Ab + (size_t)r1 * 1024 + g_chunk(r1) * 8, Ab + (size_t)r2 * 1024 + g_chunk(r2) * 8, Ab + (size_t)r3 * 1024 + g_chunk(r3) * 8,
                Bb + (size_t)b_perm(r0) * 1024 + g_chunk(r0) * 8, Bb + (size_t)b_perm(r1) * 1024 + g_chunk(r1) * 8, Bb + (size_t)b_perm(r2) * 1024 + g_chunk(r2) * 8, Bb + (size_t)b_perm(r3) * 1024 + g_chunk(r3) * 8,
                1024, smem_all, epi);
    }
    convert_weights(p, smem_all, WT_MLA_0, WT_MLA_N, (72 * 6) % (int)gridDim.x);
}

DI void phase_mla_up(const Params& p, char* smem_all) {
    char* smem = smem_all + HBI * HB_SMEM;
    const float* TM = (const float*)(p.ws + OFF_TABM);
    for (int id0 = blockIdx.x * 2; id0 < 144 * 16; id0 += gridDim.x * 2) {
        const int id = id0 + HBI;
        const int nt = (id / 144) & 7, isKV = (id / 144) >> 3, mt = id % 144, m0 = mt * 128;
        int b, t0; bool lat; row_info(m0, b, t0, lat);
        const int s0 = lat ? 256 + t0 : t0;
        if (!isKV) {
            const bf16_t* A = (const bf16_t*)(p.ws + OFF_CQ);
#undef AROW
#define AROW(o_) (A + (size_t)(m0 + (TID >> 3) + (o_)) * 384)
            auto epi = [&](const float* Cs, const float* rowss) {
                const int tid = TID, row = tid >> 1, part = tid & 1;
                const float r1 = rsqrtf(rowss[row] * (1.f / 384.f) + EPSF);
                float v[48];
                const float4* cp = (const float4*)(Cs + row * CP + part * 48);
                float ss = 0.f;
#pragma unroll
                for (int i = 0; i < 12; ++i) { float4 f = cp[i]; v[4 * i] = f.x * r1; v[4 * i + 1] = f.y * r1; v[4 * i + 2] = f.z * r1; v[4 * i + 3] = f.w * r1; }
#pragma unroll
                for (int i = 0; i < 48; ++i) ss += v[i] * v[i];
                ss += __shfl_xor(ss, 1);
                const float r2 = rsqrtf(ss * (1.f / 96.f) + EPSF);
                const float* g = p.mla_q_g + part * 48;
#pragma unroll
                for (int i = 0; i < 48; ++i) v[i] = v[i] * r2 * g[i];
                if (lat && part == 1) { int t = t0 + row; rope_apply<8>(v + 16, TM, t >> 6, t & 63); }
                const float sc = 0.10206207261596575f * LOG2E;
#pragma unroll
                for (int i = 0; i < 48; ++i) v[i] *= sc;
                bf16_t* dst = (bf16_t*)(p.ws + OFF_QM) + ((size_t)(b * 2304 + s0 + row) * 8 + nt) * 96 + part * 48;
#pragma unroll
                for (int i = 0; i < 6; ++i) *(uint4*)(dst + i * 8) = pack8(v + i * 8);
            };
            gemm_tile<true, false>(AROW(0), AROW(32), AROW(64), AROW(96), 0u, 0u, 0u, 0u, (const bf16_t*)(p.ws + OFF_WT_QB) + (size_t)nt * 128 * 384, 384, 384, smem, epi);
        } else {
            const bf16_t* A = (const bf16_t*)(p.ws + OFF_CKV);
#undef AROW
#define AROW(o_) (A + (size_t)(m0 + (TID >> 3) + (o_)) * 256)
            auto epi = [&](const float* Cs, const float* rowss) {
                const int tid = TID;
                {
                    const int row = tid >> 1, part = tid & 1;
                    const float r1 = rsqrtf(rowss[row] * (1.f / 256.f) + EPSF);
                    float v[48];
                    if (part == 0) {
                        const float4* cp = (const float4*)(Cs + row * CP);
#pragma unroll
                        for (int i = 0; i < 12; ++i) { float4 f = cp[i]; v[4 * i] = f.x * r1; v[4 * i + 1] = f.y * r1; v[4 * i + 2] = f.z * r1; v[4 * i + 3] = f.w * r1; }
                    } else {
                        const float4* cp = (const float4*)(Cs + row * CP + 48);
#pragma unroll
                        for (int i = 0; i < 4; ++i) { float4 f = cp[i]; v[4 * i] = f.x * r1; v[4 * i + 1] = f.y * r1; v[4 * i + 2] = f.z * r1; v[4 * i + 3] = f.w * r1; }
                        const float4* kp = (const float4*)((const float*)(p.ws + OFF_KR) + (size_t)(m0 + row) * 32);
#pragma unroll
                        for (int i = 0; i < 8; ++i) { float4 f = kp[i]; v[16 + 4 * i] = f.x; v[16 + 4 * i + 1] = f.y; v[16 + 4 * i + 2] = f.z; v[16 + 4 * i + 3] = f.w; }
                    }
                    float ss = 0.f;
#pragma unroll
                    for (int i = 0; i < 48; ++i) ss += v[i] * v[i];
                    ss += __shfl_xor(ss, 1);
                    const float r2 = rsqrtf(ss * (1.f / 96.f) + EPSF);
                    const float* g = p.mla_k_g + part * 48;
#pragma unroll
                    for (int i = 0; i < 48; ++i) v[i] = v[i] * r2 * g[i];
                    if (lat && part == 1) { int t = t0 + row; rope_apply<8>(v + 16, TM, t >> 6, t & 63); }
                    bf16_t* dst = (bf16_t*)(p.ws + OFF_KM) + ((size_t)(b * 2304 + s0 + row) * 8 + nt) * 96 + part * 48;
#pragma unroll
                    for (int i = 0; i < 6; ++i) *(uint4*)(dst + i * 8) = pack8(v + i * 8);
                }
                {
                    const int d = tid & 63, cg4 = (tid >> 6) * 4;
                    bf16_t* dst = (bf16_t*)(p.ws + OFF_VMT) + ((size_t)(b * 8 + nt) * 64 + d) * 2304 + s0;
#pragma unroll 1
                    for (int ch = 0; ch < 4; ++ch) {
                        float v[8];
#pragma unroll
                        for (int i = 0; i < 8; ++i) { int rr = (cg4 + ch) * 8 + i; v[i] = Cs[rr * CP + 64 + d] * rsqrtf(rowss[rr] * (1.f / 256.f) + EPSF); }
                        *(uint4*)(dst + (cg4 + ch) * 8) = pack8(v);
                    }
                }
            };
            gemm_tile<true, false>(AROW(0), AROW(32), AROW(64), AROW(96), 0u, 0u, 0u, 0u, (const bf16_t*)(p.ws + OFF_WT_KVB) + (size_t)nt * 128 * 256, 256, 256, smem, epi);
        }
    }
}

template <int DK>
DI void attn_body(const bf16_t* __restrict__ Q, int qstride, const bf16_t* __restrict__ Kp, int kstride, const bf16_t* __restrict__ VT,
                  int nkeys, bf16_t* __restrict__ Odst, char* smem, char* smem_os) {
    constexpr int KP = DK + 8, VP = 72, NST = DK / 16, KCH = DK / 8;
    constexpr int NKL = (64 * KCH) / 256;
    constexpr int STAGE = 64 * KP * 2 + 64 * VP * 2;
    const int tid = TID, lane = tid & 63, w = tid >> 6, h = lane >> 5, r = lane & 31;
    bf16x8 qf[NST];
    {
        const bf16_t* qrow = Q + (size_t)(w * 32 + r) * qstride;
#pragma unroll
        for (int st = 0; st < NST; ++st) qf[st] = *(const bf16x8*)(qrow + st * 16 + h * 8);
    }
    f32x16 o[2]; o[0] = zero16(); o[1] = zero16();
    float m = 0.f, l = 0.f;
    uint4 ak0, ak1 = make_uint4(0, 0, 0, 0), av0, bk0, bk1 = make_uint4(0, 0, 0, 0), bv0;
    const int t5 = threadIdx.x;
    const int kr0 = t5 / KCH, kc0 = t5 % KCH, kr1 = (t5 + 512) / KCH, kc1 = (t5 + 512) % KCH;
    const bool k2 = t5 + 512 < 64 * KCH;
    const int vd0 = t5 >> 3, vc0 = t5 & 7;
#define AGLOAD(P_, key0) { P_##k0 = *(const uint4*)(Kp + (size_t)((key0) + kr0) * kstride + kc0 * 8); if (k2) P_##k1 = *(const uint4*)(Kp + (size_t)((key0) + kr1) * kstride + kc1 * 8); \
                       P_##v0 = *(const uint4*)(VT + (size_t)vd0 * 2304 + (key0) + vc0 * 8); }
#define ASWRITE(P_, s_) { bf16_t* Ks_ = (bf16_t*)(smem + (s_) * STAGE); bf16_t* Vs_ = Ks_ + 64 * KP; \
                      *(uint4*)(Ks_ + kr0 * KP + kc0 * 8) = P_##k0; if (k2) *(uint4*)(Ks_ + kr1 * KP + kc1 * 8) = P_##k1; \
                      *(uint4*)(Vs_ + vd0 * VP + vc0 * 8) = P_##v0; }
    const int nkt = nkeys >> 6;
    AGLOAD(a, 0) ASWRITE(a, 0) AGLOAD(a, 64) AGLOAD(b, 128) __syncthreads();
#pragma unroll 1
    for (int kt = 0; kt < nkt; kt += 2) {
        {
            const bf16_t* Ks = (const bf16_t*)(smem);
            const bf16_t* Vs = Ks + 64 * KP;
            f32x16 s[2];
#pragma unroll
            for (int i = 0; i < 16; ++i) { s[0][i] = -m; s[1][i] = -m; }
#pragma unroll
            for (int st = 0; st < NST; ++st)
#pragma unroll
                for (int kk = 0; kk < 2; ++kk) {
                    bf16x8 a = *(const bf16x8*)(Ks + (kk * 32 + r) * KP + st * 16 + h * 8);
                    s[kk] = MFMA(a, qf[st], s[kk]);
                }
            float mx = s[0][0];
#pragma unroll
            for (int i = 0; i < 16; ++i) { mx = fmaxf(mx, s[0][i]); mx = fmaxf(mx, s[1][i]); }
            mx = fmaxf(mx, __shfl_xor(mx, 32));
            if (__any(mx > 8.f)) {
                const float d = fmaxf(mx, 0.f);
                const float alpha = __builtin_amdgcn_exp2f(-d);
                l *= alpha;
#pragma unroll
                for (int i = 0; i < 16; ++i) { o[0][i] *= alpha; o[1][i] *= alpha; s[0][i] -= d; s[1][i] -= d; }
                m += d;
            }
            float ps = 0.f;
#pragma unroll
            for (int kk = 0; kk < 2; ++kk)
#pragma unroll
                for (int i = 0; i < 16; ++i) { float pv = __builtin_amdgcn_exp2f(s[kk][i]); s[kk][i] = pv; ps += pv; }
            l += ps;
#pragma unroll
            for (int kk = 0; kk < 2; ++kk)
#pragma unroll
                for (int s2 = 0; s2 < 2; ++s2) {
                    const bf16x8 pb = pack_frag(s[kk][8 * s2 + 0], s[kk][8 * s2 + 1], s[kk][8 * s2 + 2], s[kk][8 * s2 + 3], s[kk][8 * s2 + 4], s[kk][8 * s2 + 5], s[kk][8 * s2 + 6], s[kk][8 * s2 + 7]);
#pragma unroll
                    for (int dt = 0; dt < 2; ++dt) {
                        const bf16_t* vp = Vs + (dt * 32 + r) * VP + kk * 32 + 16 * s2 + 4 * h;
                        uint2 lo = *(const uint2*)vp, hi = *(const uint2*)(vp + 8);
                        uint4 vu; vu.x = lo.x; vu.y = lo.y; vu.z = hi.x; vu.w = hi.y;
                        o[dt] = MFMA(__builtin_bit_cast(bf16x8, vu), pb, o[dt]);
                    }
                }
        }
        ASWRITE(a, 1)
        if (kt + 3 < nkt) AGLOAD(a, (kt + 3) * 64)
        LDS_BARRIER();
        {
            const bf16_t* Ks = (const bf16_t*)(smem + STAGE);
            const bf16_t* Vs = Ks + 64 * KP;
            f32x16 s[2];
#pragma unroll
            for (int i = 0; i < 16; ++i) { s[0][i] = -m; s[1][i] = -m; }
#pragma unroll
            for (int st = 0; st < NST; ++st)
#pragma unroll
                for (int kk = 0; kk < 2; ++kk) {
                    bf16x8 a = *(const bf16x8*)(Ks + (kk * 32 + r) * KP + st * 16 + h * 8);
                    s[kk] = MFMA(a, qf[st], s[kk]);
                }
            float mx = s[0][0];
#pragma unroll
            for (int i = 0; i < 16; ++i) { mx = fmaxf(mx, s[0][i]); mx = fmaxf(mx, s[1][i]); }
            mx = fmaxf(mx, __shfl_xor(mx, 32));
            if (__any(mx > 8.f)) {
                const float d = fmaxf(mx, 0.f);
                const float alpha = __builtin_amdgcn_exp2f(-d);
                l *= alpha;
#pragma unroll
                for (int i = 0; i < 16; ++i) { o[0][i] *= alpha; o[1][i] *= alpha; s[0][i] -= d; s[1][i] -= d; }
                m += d;
            }
            float ps = 0.f;
#pragma unroll
            for (int kk = 0; kk < 2; ++kk)
#pragma unroll
                for (int i = 0; i < 16; ++i) { float pv = __builtin_amdgcn_exp2f(s[kk][i]); s[kk][i] = pv; ps += pv; }
            l += ps;
#pragma unroll
            for (int kk = 0; kk < 2; ++kk)
#pragma unroll
                for (int s2 = 0; s2 < 2; ++s2) {
                    const bf16x8 pb = pack_frag(s[kk][8 * s2 + 0], s[kk][8 * s2 + 1], s[kk][8 * s2 + 2], s[kk][8 * s2 + 3], s[kk][8 * s2 + 4], s[kk][8 * s2 + 5], s[kk][8 * s2 + 6], s[kk][8 * s2 + 7]);
#pragma unroll
                    for (int dt = 0; dt < 2; ++dt) {
                        const bf16_t* vp = Vs + (dt * 32 + r) * VP + kk * 32 + 16 * s2 + 4 * h;
                        uint2 lo = *(const uint2*)vp, hi = *(const uint2*)(vp + 8);
                        uint4 vu; vu.x = lo.x; vu.y = lo.y; vu.z = hi.x; vu.w = hi.y;
                        o[dt] = MFMA(__builtin_bit_cast(bf16x8, vu), pb, o[dt]);
                    }
                }
        }
        if (kt + 2 < nkt) ASWRITE(b, 0)
        if (kt + 4 < nkt) AGLOAD(b, (kt + 4) * 64)
        LDS_BARRIER();
    }
#undef AGLOAD
#undef ASWRITE
    l += __shfl_xor(l, 32);
    const float inv = 1.f / l;
    bf16_t* Os = (bf16_t*)smem_os + (size_t)w * 32 * 72;
#pragma unroll
    for (int dt = 0; dt < 2; ++dt)
#pragma unroll
        for (int g = 0; g < 4; ++g) {
            uint2 u; u.x = pack2(o[dt][4 * g] * inv, o[dt][4 * g + 1] * inv); u.y = pack2(o[dt][4 * g + 2] * inv, o[dt][4 * g + 3] * inv);
            *(uint2*)(Os + r * 72 + dt * 32 + 8 * g + 4 * h) = u;
        }
    __syncthreads();
#pragma unroll
    for (int j = 0; j < 4; ++j) {
        int c = lane + 64 * j, row = c >> 3, cc = c & 7;
        uint4 u = *(const uint4*)(Os + row * 72 + cc * 8);
        *(uint4*)(Odst + (size_t)(w * 32 + row) * 1024 + cc * 8) = u;
    }
    __syncthreads();
}

DI void phase_attn(const Params& p, char* smem_all) {
    char* smem = smem_all;
    char* smem_os = smem_all + 65536 + HBI * 20480;
    bf16_t* O = (bf16_t*)(p.ws + OFF_H);
    for (int it0 = blockIdx.x * 2; it0 < 2304; it0 += gridDim.x * 2) {
        const int item = it0 + HBI;
        int b, kind, hq, qb, nkeys, sq0, orow;
        if (item < 2048) { qb = item & 15; hq = (item >> 4) & 7; kind = (item >> 7) & 1; b = item >> 8; sq0 = 256 + qb * 128; nkeys = 2304; orow = b * 2048 + qb * 128; }
        else { int it = item - 2048; qb = it & 1; hq = (it >> 1) & 7; kind = (it >> 4) & 1; b = it >> 5; sq0 = qb * 128; nkeys = 256; orow = 16384 + b * 256 + qb * 128; }
        bf16_t* od = O + (size_t)orow * 1024 + kind * 512 + hq * 64;
        if (kind == 0) {
            const bf16_t* Q = (const bf16_t*)(p.ws + OFF_QM) + ((size_t)(b * 2304 + sq0) * 8 + hq) * 96;
            const bf16_t* K = (const bf16_t*)(p.ws + OFF_KM) + ((size_t)(b * 2304) * 8 + hq) * 96;
            const bf16_t* VT = (const bf16_t*)(p.ws + OFF_VMT) + (size_t)(b * 8 + hq) * 64 * 2304;
            attn_body<96>(Q, 768, K, 768, VT, nkeys, od, smem, smem_os);
        } else {
            const int kvh = hq >> 2;
            const bf16_t* Q = (const bf16_t*)(p.ws + OFF_QG) + ((size_t)(b * 2304 + sq0) * 8 + hq) * 64;
            const bf16_t* K = (const bf16_t*)(p.ws + OFF_KG) + ((size_t)(b * 2304) * 2 + kvh) * 64;
            const bf16_t* VT = (const bf16_t*)(p.ws + OFF_VGT) + (size_t)(b * 2 + kvh) * 64 * 2304;
            attn_body<64>(Q, 512, K, 128, VT, nkeys, od, smem, smem_os);
        }
    }
    convert_weights(p, smem_all, WT_OUT0_0, WT_OUT0_N, 1152 % (int)gridDim.x);
}

DI void phase_proj_resid(const Params& p, const bf16_t* A, int K, const bf16_t* W, const float* mod, int gate_idx,
                         const float* srcLat, const float* srcCtx, float* dstLat, float* dstCtx, int mtiles2, bool ctx_small, int conv_t0, int conv_cnt, char* smem_all) {
    for (int id = blockIdx.x; id < mtiles2 * 4; id += gridDim.x) {
        const int nt2 = id / mtiles2, mt2 = id % mtiles2;
        auto epi = [&](const float* Cs, int si, int sj, int tid) {
            const int nt = 2 * nt2 + sj, m0 = (2 * mt2 + si) * 128;
            const float* src; float* dst; int mb;
            if (m0 < 16384) { src = srcLat + (size_t)m0 * 1024; dst = dstLat + (size_t)m0 * 1024; mb = m0 >> 11; }
            else { src = srcCtx + (size_t)(m0 - 16384) * 1024; dst = dstCtx + (size_t)(m0 - 16384) * 1024; mb = 8; }
            epi_resid(Cs, src + nt * 128, dst + nt * 128, mod + (size_t)mb * 6144 + gate_idx * 1024 + nt * 128, tid);
        };
        const int r0 = g_row(0), r1 = g_row(1), r2 = g_row(2), r3 = g_row(3);
        const bf16_t* Ab = A + (size_t)mt2 * 256 * K;
        const bf16_t* Bb = W + (size_t)nt2 * 256 * K;
        gemm256(p.ws, Ab + (size_t)r0 * K + g_chunk(r0) * 8, Ab + (size_t)r1 * K + g_chunk(r1) * 8, Ab + (size_t)r2 * K + g_chunk(r2) * 8, Ab + (size_t)r3 * K + g_chunk(r3) * 8,
                Bb + (size_t)b_perm(r0) * K + g_chunk(r0) * 8, Bb + (size_t)b_perm(r1) * K + g_chunk(r1) * 8, Bb + (size_t)b_perm(r2) * K + g_chunk(r2) * 8, Bb + (size_t)b_perm(r3) * K + g_chunk(r3) * 8,
                K, smem_all, epi);
    }
    if (ctx_small) {
        for (int hq = blockIdx.x; hq < 64; hq += gridDim.x) {
            const int mt2 = 64 + (hq >> 3), nt = hq & 7;
            auto epi = [&](const float* Cs, int si, int, int tid) {
                const int m0 = (2 * mt2 + si) * 128 - 16384;
                epi_resid(Cs, srcCtx + (size_t)m0 * 1024 + nt * 128, dstCtx + (size_t)m0 * 1024 + nt * 128, mod + (size_t)8 * 6144 + gate_idx * 1024 + nt * 128, tid);
            };
            const int r0 = g_row(0), r1 = g_row(1), r2 = g_row(2), r3 = g_row(3);
            const bf16_t* Ab = A + (size_t)mt2 * 256 * K;
            const bf16_t* Bb = W + (size_t)nt * 128 * K;
            gemm256<0>(p.ws, Ab + (size_t)r0 * K + g_chunk(r0) * 8, Ab + (size_t)r1 * K + g_chunk(r1) * 8, Ab + (size_t)r2 * K + g_chunk(r2) * 8, Ab + (size_t)r3 * K + g_chunk(r3) * 8,
                       Bb + (size_t)b_perm(r0) * K + g_chunk(r0) * 8, Bb + (size_t)b_perm(r1) * K + g_chunk(r1) * 8, Bb + (size_t)b_perm(r2) * K + g_chunk(r2) * 8, Bb + (size_t)b_perm(r3) * K + g_chunk(r3) * 8,
                       K, smem_all, epi);
        }
    }
    if (conv_cnt) convert_weights(p, smem_all, conv_t0, conv_cnt, 64);
}

DI float4 conv4(float4 w0, float4 w1, float4 w2, float4 bb, float4 gm, float4 g0, float4 gp, float4 v) {
    float4 o;
    o.x = siluf_(w0.x * gm.x + w1.x * g0.x + w2.x * gp.x + bb.x) * v.x;
    o.y = siluf_(w0.y * gm.y + w1.y * g0.y + w2.y * gp.y + bb.y) * v.y;
    o.z = siluf_(w0.z * gm.z + w1.z * g0.z + w2.z * gp.z + bb.z) * v.z;
    o.w = siluf_(w0.w * gm.w + w1.w * g0.w + w2.w * gp.w + bb.w) * v.w;
    return o;
}
DI void halo_info(int mt, int& base, int& T, int& tstart) {
    int ti;
    if (mt < 136) { base = (mt / 17) * 2048; T = 2048; ti = mt % 17; }
    else { int q = mt - 136; base = 16384 + (q / 3) * 256; T = 256; ti = q % 3; }
    tstart = 126 * ti - 1;
}
DI const bf16_t* halo_ptr(const bf16_t* H, const bf16_t* Z, int mt2, int row) {
    int base, T, tstart; halo_info(2 * mt2 + (row >> 7), base, T, tstart);
    const int t = tstart + (row & 127);
    return (t >= 0 && t < T) ? H + (size_t)(base + t) * 1024 + g_chunk(row) * 8 : Z;
}
DI void phase_ffn_up(const Params& p, const bf16_t* W, const float* convw, const float* convb, int mtiles2, int conv_t0, int conv_cnt, char* smem_all) {
    const bf16_t* H = (const bf16_t*)(p.ws + OFF_H);
    const bf16_t* Z = (const bf16_t*)(p.ws + OFF_ZROW);
    bf16_t* ACT = (bf16_t*)(p.ws + OFF_ACT);
    for (int id = blockIdx.x; id < mtiles2 * 22; id += gridDim.x) {
        const int nt2 = id / mtiles2, mt2 = id % mtiles2;
        auto epi = [&](const float* Cs, int si, int sj, int tid) {
            const int nt = 2 * nt2 + sj;
            int base, T, tstart; halo_info(2 * mt2 + si, base, T, tstart);
            const int cc = tid & 7;
            const int cg0 = nt * 64 + cc * 8;
            const float4 w0a = *(const float4*)(convw + cg0), w0b = *(const float4*)(convw + cg0 + 4);
            const float4 w1a = *(const float4*)(convw + 2816 + cg0), w1b = *(const float4*)(convw + 2816 + cg0 + 4);
            const float4 w2a = *(const float4*)(convw + 5632 + cg0), w2b = *(const float4*)(convw + 5632 + cg0 + 4);
            const float4 bba = *(const float4*)(convb + cg0), bbb = *(const float4*)(convb + cg0 + 4);
#pragma unroll
            for (int j = 0; j < 4; ++j) {
                const int rr = (tid >> 3) + 32 * j, t = tstart + rr;
                if (rr >= 1 && rr <= 126 && t < T) {
                    const float4* a = (const float4*)(Cs + (rr - 1) * CP + cc * 8);
                    const float4* bq = (const float4*)(Cs + rr * CP + cc * 8);
                    const float4* c = (const float4*)(Cs + (rr + 1) * CP + cc * 8);
                    const float4* d = (const float4*)(Cs + rr * CP + 64 + cc * 8);
                    const float4 oa = conv4(w0a, w1a, w2a, bba, a[0], bq[0], c[0], d[0]);
                    const float4 ob = conv4(w0b, w1b, w2b, bbb, a[1], bq[1], c[1], d[1]);
                    uint4 u; u.x = pack2(oa.x, oa.y); u.y = pack2(oa.z, oa.w); u.z = pack2(ob.x, ob.y); u.w = pack2(ob.z, ob.w);
                    *(uint4*)(ACT + (size_t)(base + t) * 2816 + cg0) = u;
                }
            }
        };
        const int r0 = g_row(0), r1 = g_row(1), r2 = g_row(2), r3 = g_row(3);
        const bf16_t* Bb = W + (size_t)nt2 * 256 * 1024;
        gemm256(p.ws, halo_ptr(H, Z, mt2, r0), halo_ptr(H, Z, mt2, r1), halo_ptr(H, Z, mt2, r2), halo_ptr(H, Z, mt2, r3),
                Bb + (size_t)b_perm(r0) * 1024 + g_chunk(r0) * 8, Bb + (size_t)b_perm(r1) * 1024 + g_chunk(r1) * 8, Bb + (size_t)b_perm(r2) * 1024 + g_chunk(r2) * 8, Bb + (size_t)b_perm(r3) * 1024 + g_chunk(r3) * 8,
                1024, smem_all, epi);
    }
    if (conv_cnt) convert_weights(p, smem_all, conv_t0, conv_cnt, (mtiles2 * 22) % (int)gridDim.x);
}

DI void inproj1_epi(const Params& p, const float* Cs, int nt, int m0, int tid) {
    if (nt < 8) epi_store_bf16(Cs, (bf16_t*)(p.ws + OFF_QKRAW) + (size_t)m0 * 1024 + nt * 128, 1024, tid);
    else if (nt < 16) epi_store_bf16(Cs, (bf16_t*)(p.ws + OFF_V1) + (size_t)m0 * 1024 + (nt - 8) * 128, 1024, tid);
    else if (nt < 24) epi_store_bf16(Cs, (bf16_t*)(p.ws + OFF_OG) + (size_t)m0 * 1024 + (nt - 16) * 128, 1024, tid);
    else if (nt == 24) {
        const int row = tid >> 1, half = tid & 1;
        float* dst = (float*)(p.ws + OFF_GATES) + (size_t)(m0 + row) * 32 + half * 16;
#pragma unroll 4
        for (int i = 0; i < 16; ++i) {
            int c = half * 16 + i;
            float v = Cs[row * CP + c] + p.ml_gate_b[c];
            if (c & 8) v = logsigmoidf_(v);
            dst[i] = v;
        }
    }
}
DI void inproj1_tile_of(int f, int& nt2, int& mt2) { if (f < 576) { nt2 = f / 72; mt2 = f % 72; } else { const int g = f - 576; nt2 = 8 + g / 64; mt2 = g % 64; } }
DI void phase_inproj1(const Params& p, char* smem_all) {
    const bf16_t* H = (const bf16_t*)(p.ws + OFF_H);
    const bf16_t* W = (const bf16_t*)(p.ws + OFF_WT_IN1);
    const int G = gridDim.x, nfr = 832 / G, rem = 832 - nfr * G, nhalf = 2 * rem + 72;
    const int r0 = g_row(0), r1 = g_row(1), r2 = g_row(2), r3 = g_row(3);
#define IN1_ARGS p.ws, Ab + (size_t)r0 * 1024 + g_chunk(r0) * 8, Ab + (size_t)r1 * 1024 + g_chunk(r1) * 8, Ab + (size_t)r2 * 1024 + g_chunk(r2) * 8, Ab + (size_t)r3 * 1024 + g_chunk(r3) * 8, \
                Bb + (size_t)b_perm(r0) * 1024 + g_chunk(r0) * 8, Bb + (size_t)b_perm(r1) * 1024 + g_chunk(r1) * 8, Bb + (size_t)b_perm(r2) * 1024 + g_chunk(r2) * 8, Bb + (size_t)b_perm(r3) * 1024 + g_chunk(r3) * 8, \
                1024, smem_all, epi
    for (int trip = 0; trip < nfr; ++trip) {
        int nt2, mt2; inproj1_tile_of(trip * G + blockIdx.x, nt2, mt2);
        auto epi = [&](const float* Cs, int si, int sj, int tid) { inproj1_epi(p, Cs, 2 * nt2 + sj, (2 * mt2 + si) * 128, tid); };
        const bf16_t* Ab = H + (size_t)mt2 * 256 * 1024;
        const bf16_t* Bb = W + (size_t)nt2 * 256 * 1024;
        gemm256<-1>(IN1_ARGS);
    }
    for (int hq = blockIdx.x; hq < nhalf; hq += G) {
        int nt2, mt2, nh;
        if (hq < 2 * rem) { inproj1_tile_of(nfr * G + (hq >> 1), nt2, mt2); nh = hq & 1; } else { nt2 = 12; mt2 = hq - 2 * rem; nh = 0; }
        auto epi = [&](const float* Cs, int si, int, int tid) { inproj1_epi(p, Cs, 2 * nt2 + nh, (2 * mt2 + si) * 128, tid); };
        const bf16_t* Ab = H + (size_t)mt2 * 256 * 1024;
        const bf16_t* Bb = W + ((size_t)nt2 * 256 + nh * 128) * 1024;
        gemm256<0>(IN1_ARGS);
    }
#undef IN1_ARGS
}

DI void phase_qkconv(const Params& p) {
    const bf16_t* QK = (const bf16_t*)(p.ws + OFF_QKRAW);
    bf16_t* QC = (bf16_t*)(p.ws + OFF_H);
    {
        const int lane = threadIdx.x & 63, gw = blockIdx.x * 8 + (threadIdx.x >> 6);
        const float* GT = (const float*)(p.ws + OFF_GATES);
        float* SC = (float*)(p.ws + OFF_SCAN);
        for (int seg = gw; seg < 2304; seg += gridDim.x * 8) {
            const int step = seg % 18, dir = (seg / 18) & 1, hd = (seg / 36) & 7, b = seg / 288;
            int base, P0;
            if (step < 2) { base = 16384 + b * 256; P0 = (dir ? 1 - step : step) * 128; } else { base = b * 2048; P0 = (dir ? 17 - step : step - 2) * 128; }
            const int pa = dir ? P0 + 127 - lane : P0 + lane, pb = dir ? pa - 64 : pa + 64;
            const float* ga = GT + (size_t)(base + pa) * 32 + dir * 16 + hd; const float* gb = GT + (size_t)(base + pb) * 32 + dir * 16 + hd;
            const float i0 = ga[0], f0 = ga[8], i1 = gb[0], f1 = gb[8];
            float b0 = f0, b1 = f1;
#pragma unroll
            for (int off = 1; off < 64; off <<= 1) { float t0 = __shfl_up(b0, off), t1 = __shfl_up(b1, off); if (lane >= off) { b0 += t0; b1 += t1; } }
            b1 += __shfl(b0, 63);
            float p0 = i0 - b0, p1 = i1 - b1;
            const float c0 = p0, c1 = p1;
#pragma unroll
            for (int off = 1; off < 64; off <<= 1) { float t0 = __shfl_up(p0, off), t1 = __shfl_up(p1, off); if (lane >= off) { p0 = fmaxf(p0, t0); p1 = fmaxf(p1, t1); } }
            p1 = fmaxf(p1, __shfl(p0, 63));
            float* o = SC + (size_t)seg * 384;
            o[lane] = b0; o[64 + lane] = b1; o[128 + lane] = p0; o[192 + lane] = p1; o[256 + lane] = c0; o[320 + lane] = c1;
        }
    }
    for (int c = blockIdx.x * NTHREADS + threadIdx.x; c < 18432 * 128; c += gridDim.x * NTHREADS) {
        const int row = c >> 7, col = (c & 127) * 8;
        int T, t;
        if (row < 16384) { T = 2048; t = row & 2047; } else { T = 256; t = (row - 16384) & 255; }
        float acc[8];
        { const float4 b0 = *(const float4*)(p.ml_conv_b + col), b1 = *(const float4*)(p.ml_conv_b + col + 4);
          acc[0] = b0.x; acc[1] = b0.y; acc[2] = b0.z; acc[3] = b0.w; acc[4] = b1.x; acc[5] = b1.y; acc[6] = b1.z; acc[7] = b1.w; }
#pragma unroll
        for (int dj = 0; dj < 3; ++dj) {
            const int tt = t + dj - 1;
            const float on = (tt >= 0 && tt < T) ? 1.f : 0.f;
            const int rr = row + min(max(tt, 0), T - 1) - t;
            float f[8]; unpack8(*(const uint4*)(QK + (size_t)rr * 1024 + col), f);
            const float4 w0 = *(const float4*)(p.ml_conv_w + dj * 1024 + col), w1 = *(const float4*)(p.ml_conv_w + dj * 1024 + col + 4);
            acc[0] += w0.x * on * f[0]; acc[1] += w0.y * on * f[1]; acc[2] += w0.z * on * f[2]; acc[3] += w0.w * on * f[3];
            acc[4] += w1.x * on * f[4]; acc[5] += w1.y * on * f[5]; acc[6] += w1.z * on * f[6]; acc[7] += w1.w * on * f[7];
        }
        const float sc = col >= 512 ? 0.125f : 1.f;
#pragma unroll
        for (int i = 0; i < 8; ++i) acc[i] = siluf_(acc[i]) * sc;
        *(uint4*)(QC + (size_t)row * 1024 + col) = pack8(acc);
    }
}

DI void phase_mlstm(const Params& p, char* smem) {
    constexpr int LP = 72, TP = 136, L = 128;
    bf16_t* Qc = (bf16_t*)smem;
    bf16_t* Kc = Qc + L * LP;
    bf16_t* KcT = Kc + L * LP;
    bf16_t* VcT = KcT + 64 * TP;
    bf16_t* VwT = VcT + 64 * TP;
    bf16_t* Pm = VwT + 64 * TP;
    bf16_t* Cb = Pm + L * TP;
    float* fa = (float*)(Cb + 64 * LP);
    float* bcum = fa; float* ig = fa + 128; float* mtv = fa + 256; float* wint = fa + 384; float* denI = fa + 512; float* denX = fa + 640;
    float* wgt = fa + 768; float* nvec = fa + 896; float* scal = fa + 960; float* csv = fa + 1024; float* denP = fa + 1152;
    static_assert((2 * L * LP + 3 * 64 * TP + L * TP + 64 * LP) * 2 + 1408 * 4 <= SMEM_ALL, "mLSTM LDS");
    const int lane0 = threadIdx.x & 63, w = __builtin_amdgcn_readfirstlane(threadIdx.x >> 6);
    const bf16_t* QK = (const bf16_t*)(p.ws + OFF_H);
    const bf16_t* V1 = (const bf16_t*)(p.ws + OFF_V1);
    const float* GT = (const float*)(p.ws + OFF_GATES);
    for (int item = blockIdx.x; item < 256; item += gridDim.x) {
        const int vh = item & 1, dir = (item >> 1) & 1, hd = (item >> 2) & 7, b = item >> 5;
        bf16_t* Hout = (bf16_t*)(p.ws + (dir ? OFF_HB : OFF_HF));
        f32x16 accC = zero16();
        float m_prev = 0.f;
        for (int i = w * 64 + lane0; i < 64 * LP; i += 512) Cb[i] = 0;
        if (w == 0) nvec[lane0] = 0.f;
        int lane = lane0, tid = w * 64 + lane0, h = lane0 >> 5, r = lane0 & 31;
        int u = tid >> 2, part = tid & 3;
        uint4 rq0, rq1, rk0, rk1, rv0, rv1;
        float sc_b = 0.f, sc_p = 0.f, sc_c = 0.f, sc_bl = 0.f, sc_pl = 0.f;
#define ML_STEP_GEOM(st, base_, P0_) { if ((st) < 2) { base_ = 16384 + b * 256; P0_ = (dir ? 1 - (st) : (st)) * L; } else { base_ = b * 2048; P0_ = (dir ? 17 - (st) : (st) - 2) * L; } }
#define ML_PREFETCH(st) { int base_, P0_; ML_STEP_GEOM(st, base_, P0_) \
            const int pos_ = dir ? P0_ + L - 1 - u : P0_ + u; \
            { const bf16_t* rowp = QK + (size_t)(base_ + pos_) * 1024; \
              const int qcol = hd * 64 + part * 16, kcol = 512 + qcol; rq0 = *(const uint4*)(rowp + qcol); rq1 = *(const uint4*)(rowp + qcol + 8); rk0 = *(const uint4*)(rowp + kcol); rk1 = *(const uint4*)(rowp + kcol + 8); } \
            { const bf16_t* vp_ = V1 + (size_t)(base_ + pos_) * 1024 + hd * 128 + vh * 64 + part * 16; rv0 = *(const uint4*)vp_; rv1 = *(const uint4*)(vp_ + 8); } \
            if (w < 2) { const float* sp_ = (const float*)(p.ws + OFF_SCAN) + (size_t)((((b * 8 + hd) * 2 + dir) * 18) + (st)) * 384; \
                sc_b = sp_[tid]; sc_p = sp_[128 + tid]; sc_c = sp_[256 + tid]; sc_bl = sp_[127]; sc_pl = sp_[255]; } }
        ML_PREFETCH(0)
        __syncthreads();
#pragma unroll 1
        for (int step = 0; step < 18; ++step) {
            lane = lane0; asm volatile("" : "+v"(lane));
            tid = w * 64 + lane; h = lane >> 5; r = lane & 31; u = tid >> 2; part = tid & 3;
            int base, P0; ML_STEP_GEOM(step, base, P0)
            const bool full = step >= 2;
            if (w < 2) {
                const float mt = fmaxf(sc_b + m_prev, sc_b + sc_p);
                const float mnew = fmaxf(sc_bl + m_prev, sc_bl + sc_pl);
                bcum[tid] = sc_b; csv[tid] = sc_c; mtv[tid] = mt;
                wint[tid] = __expf(sc_b + m_prev - mt);
                wgt[tid] = __expf(sc_bl + sc_c - mnew);
                if (tid == 0) { scal[0] = mnew; scal[1] = __expf(sc_bl + m_prev - mnew); }
            }
            {
                *(uint4*)(Qc + u * LP + part * 16) = rq0; *(uint4*)(Qc + u * LP + part * 16 + 8) = rq1;
                *(uint4*)(Kc + u * LP + part * 16) = rk0; *(uint4*)(Kc + u * LP + part * 16 + 8) = rk1;
#define ML_T2(dstT, wv, ci) { dstT[(part * 16 + (ci)) * TP + u] = (bf16_t)((wv) & 0xffffu); dstT[(part * 16 + (ci) + 1) * TP + u] = (bf16_t)((wv) >> 16); }
                ML_T2(KcT, rk0.x, 0) ML_T2(KcT, rk0.y, 2) ML_T2(KcT, rk0.z, 4) ML_T2(KcT, rk0.w, 6) ML_T2(KcT, rk1.x, 8) ML_T2(KcT, rk1.y, 10) ML_T2(KcT, rk1.z, 12) ML_T2(KcT, rk1.w, 14)
                ML_T2(VcT, rv0.x, 0) ML_T2(VcT, rv0.y, 2) ML_T2(VcT, rv0.z, 4) ML_T2(VcT, rv0.w, 6) ML_T2(VcT, rv1.x, 8) ML_T2(VcT, rv1.y, 10) ML_T2(VcT, rv1.z, 12) ML_T2(VcT, rv1.w, 14)
#undef ML_T2
            }
            if (step + 1 < 18) ML_PREFETCH(step + 1)
            LDS_BARRIER();
            const float m_new = scal[0], decay = scal[1];
            {
                const int vv = tid >> 3, s0_ = (tid & 7) * 16;
#pragma unroll
                for (int q = 0; q < 2; ++q) {
                    float f[8]; unpack8(*(const uint4*)(VcT + vv * TP + s0_ + q * 8), f);
                    const float4 w0 = *(const float4*)(wgt + s0_ + q * 8), w1 = *(const float4*)(wgt + s0_ + q * 8 + 4);
                    f[0] *= w0.x; f[1] *= w0.y; f[2] *= w0.z; f[3] *= w0.w; f[4] *= w1.x; f[5] *= w1.y; f[6] *= w1.z; f[7] *= w1.w;
                    *(uint4*)(VwT + vv * TP + s0_ + q * 8) = pack8(f);
                }
            }
            if (full) {
                {
                    float sacc_ = 0.f;
#pragma unroll
                    for (int q = 0; q < 2; ++q) {
                        float f[8]; unpack8(*(const uint4*)(Qc + u * LP + part * 16 + q * 8), f);
                        const float4 n0 = *(const float4*)(nvec + part * 16 + q * 8), n1 = *(const float4*)(nvec + part * 16 + q * 8 + 4);
                        sacc_ += f[0] * n0.x + f[1] * n0.y + f[2] * n0.z + f[3] * n0.w + f[4] * n1.x + f[5] * n1.y + f[6] * n1.z + f[7] * n1.w;
                    }
                    sacc_ += __shfl_xor(sacc_, 1); sacc_ += __shfl_xor(sacc_, 2);
                    if (part == 0) denX[u] = sacc_;
                }
                const int ti = w >> 1, t = ti * 32 + r;
                const float bt = bcum[t] - mtv[t];
                float rs = 0.f;
#pragma unroll
                for (int q = 0; q < 2; ++q) {
                    const int si = 2 * (w & 1) + q;
                    if (si <= ti) {
                        f32x16 sacc = zero16();
#pragma unroll
                        for (int ks = 0; ks < 4; ++ks) {
                            bf16x8 a = *(const bf16x8*)(Kc + (si * 32 + r) * LP + ks * 16 + h * 8);
                            bf16x8 bb = *(const bf16x8*)(Qc + (ti * 32 + r) * LP + ks * 16 + h * 8);
                            sacc = MFMA(a, bb, sacc);
                        }
#pragma unroll
                        for (int g4 = 0; g4 < 4; ++g4) {
                            const int s0_ = si * 32 + 8 * g4 + 4 * h;
                            const float4 c4 = *(const float4*)(csv + s0_);
                            float p0 = s0_ + 0 <= t ? sacc[4 * g4 + 0] * __expf(bt + c4.x) : 0.f;
                            float p1 = s0_ + 1 <= t ? sacc[4 * g4 + 1] * __expf(bt + c4.y) : 0.f;
                            float p2 = s0_ + 2 <= t ? sacc[4 * g4 + 2] * __expf(bt + c4.z) : 0.f;
                            float p3 = s0_ + 3 <= t ? sacc[4 * g4 + 3] * __expf(bt + c4.w) : 0.f;
                            rs += (p0 + p1) + (p2 + p3);
                            uint2 pk; pk.x = pack2(p0, p1); pk.y = pack2(p2, p3);
                            *(uint2*)(Pm + t * TP + s0_) = pk;
                        }
                    } else {
#pragma unroll
                        for (int g4 = 0; g4 < 4; ++g4) *(uint2*)(Pm + t * TP + si * 32 + 8 * g4 + 4 * h) = make_uint2(0u, 0u);
                    }
                }
                rs += __shfl_xor(rs, 32);
                if (h == 0) denP[(w & 1) * 128 + t] = rs;
            }
            LDS_BARRIER();
            f32x16 hacc = zero16();
            const int ti = w >> 1, vi = w & 1;
            if (full) {
#pragma unroll
                for (int ks = 0; ks < 4; ++ks) {
                    bf16x8 a = *(const bf16x8*)(Cb + (vi * 32 + r) * LP + ks * 16 + h * 8);
                    bf16x8 bb = *(const bf16x8*)(Qc + (ti * 32 + r) * LP + ks * 16 + h * 8);
                    hacc = MFMA(a, bb, hacc);
                }
                const float wi = wint[ti * 32 + r];
#pragma unroll
                for (int g = 0; g < 16; ++g) hacc[g] *= wi;
#pragma unroll
                for (int ks = 0; ks < 8; ++ks) {
                    if (ks <= 2 * ti + 1) {
                        bf16x8 a = *(const bf16x8*)(VcT + (vi * 32 + r) * TP + ks * 16 + h * 8);
                        bf16x8 bb = *(const bf16x8*)(Pm + (ti * 32 + r) * TP + ks * 16 + h * 8);
                        hacc = MFMA(a, bb, hacc);
                    }
                }
            }
            LDS_BARRIER();
            if (full) {
                const int t = ti * 32 + r;
                const float den = wint[t] * denX[t] + denP[t] + denP[128 + t];
                const float inv = __builtin_amdgcn_rcpf(fmaxf(fabsf(den), __expf(-mtv[t])));
                bf16_t* hp = Pm + t * LP + vi * 32 + 4 * h;
#pragma unroll
                for (int g4 = 0; g4 < 4; ++g4) {
                    uint2 pk; pk.x = pack2(hacc[4 * g4] * inv, hacc[4 * g4 + 1] * inv); pk.y = pack2(hacc[4 * g4 + 2] * inv, hacc[4 * g4 + 3] * inv);
                    *(uint2*)(hp + 8 * g4) = pk;
                }
            }
            if (w < 4) {
                const int vi2 = w >> 1, di = w & 1;
#pragma unroll
                for (int g = 0; g < 16; ++g) accC[g] *= decay;
#pragma unroll
                for (int ks = 0; ks < 8; ++ks) {
                    bf16x8 a = *(const bf16x8*)(VwT + (vi2 * 32 + r) * TP + ks * 16 + h * 8);
                    bf16x8 bb = *(const bf16x8*)(KcT + (di * 32 + r) * TP + ks * 16 + h * 8);
                    accC = MFMA(a, bb, accC);
                }
#pragma unroll
                for (int g = 0; g < 16; ++g) Cb[(vi2 * 32 + crow(g, h)) * LP + di * 32 + r] = f2bf_sw(accC[g]);
            } else {
                const int t2 = tid - 256, d = t2 >> 2, pq = t2 & 3;
                float sacc_ = 0.f;
#pragma unroll
                for (int q = 0; q < 4; ++q) {
                    float f[8]; unpack8(*(const uint4*)(KcT + d * TP + pq * 32 + q * 8), f);
                    const float4 w0 = *(const float4*)(wgt + pq * 32 + q * 8), w1 = *(const float4*)(wgt + pq * 32 + q * 8 + 4);
                    sacc_ += f[0] * w0.x + f[1] * w0.y + f[2] * w0.z + f[3] * w0.w + f[4] * w1.x + f[5] * w1.y + f[6] * w1.z + f[7] * w1.w;
                }
                sacc_ += __shfl_xor(sacc_, 1); sacc_ += __shfl_xor(sacc_, 2);
                if (pq == 0) nvec[d] = decay * nvec[d] + sacc_;
            }
            m_prev = m_new;
            LDS_BARRIER();
            if (full) {
#pragma unroll
                for (int q = 0; q < 2; ++q) {
                    const int c = tid + 512 * q, t = c >> 3, ch = c & 7;
                    const int pos = dir ? P0 + L - 1 - t : P0 + t;
                    *(uint4*)(Hout + (size_t)(base + pos) * 1024 + hd * 128 + vh * 64 + ch * 8) = *(const uint4*)(Pm + t * LP + ch * 8);
                }
            }
        }
#undef ML_STEP_GEOM
#undef ML_PREFETCH
    }
}

DI void phase_mix(const Params& p) {
    const int lane = threadIdx.x & 63, w = threadIdx.x >> 6;
    const bf16_t* HF = (const bf16_t*)(p.ws + OFF_HF);
    const bf16_t* HB = (const bf16_t*)(p.ws + OFF_HB);
    const bf16_t* OG = (const bf16_t*)(p.ws + OFF_OG);
    bf16_t* H = (bf16_t*)(p.ws + OFF_H);
    for (int row = blockIdx.x * 8 + w; row < 16384; row += gridDim.x * 8) {
        const size_t o = (size_t)row * 1024 + lane * 16;
        float a[16], bq[16], og[16];
        unpack8(*(const uint4*)(HF + o), a); unpack8(*(const uint4*)(HF + o + 8), a + 8);
        unpack8(*(const uint4*)(HB + o), bq); unpack8(*(const uint4*)(HB + o + 8), bq + 8);
        unpack8(*(const uint4*)(OG + o), og); unpack8(*(const uint4*)(OG + o + 8), og + 8);
        float ss = 0.f;
#pragma unroll
        for (int i = 0; i < 16; ++i) { a[i] += bq[i]; ss += a[i] * a[i]; }
        ss += __shfl_xor(ss, 1); ss += __shfl_xor(ss, 2); ss += __shfl_xor(ss, 4);
        const float rstd = rsqrtf(ss * (1.f / 128.f) + EPSF);
        const float* g = p.ml_out_g + lane * 16;
#pragma unroll
        for (int i = 0; i < 16; ++i) a[i] = a[i] * rstd * g[i] * sigmoidf_(og[i]);
        *(uint4*)(H + o) = pack8(a); *(uint4*)(H + o + 8) = pack8(a + 8);
    }
}

#define XB_TMO      128
#define XB_XCNT(j)  (256  + 64 * (j))
#define XB_XSUB(j)  (1280 + 64 * (j))
#define XB_XGEN(j)  (2304 + 64 * (j))
#define XB_TOP      3328
#define XB_TOPGEN   3392
#define XCD_BAR_WORDS 3456
#define XB_SPIN_CAP (1u << 18)
#define LAS __attribute__((address_space(3)))

__device__ __forceinline__ unsigned xb_ld(unsigned* p)              { return __hip_atomic_load(p, __ATOMIC_RELAXED, __HIP_MEMORY_SCOPE_AGENT); }
__device__ __forceinline__ unsigned xb_add(unsigned* p, unsigned v) { return __hip_atomic_fetch_add(p, v, __ATOMIC_RELAXED, __HIP_MEMORY_SCOPE_AGENT); }
__device__ __forceinline__ unsigned xb_xcc_id() { return (unsigned)__builtin_amdgcn_s_getreg((3 << 11) | 20) & 0xFu; }
#define XB_SPIN(cond, bar) do { unsigned _sp = 0; while (cond) { __builtin_amdgcn_s_sleep(1); \
    if ((++_sp & 255u) == 0u) { if (xb_ld(&(bar)[XB_TMO])) break; if (_sp > XB_SPIN_CAP) { atomicAdd(&(bar)[XB_TMO], 1u); break; } } } } while (0)

struct XcdBarrier {
    unsigned* bar; unsigned x;
    volatile LAS unsigned* st;
};

__device__ __forceinline__ XcdBarrier xcd_barrier_post(unsigned* bar, volatile LAS unsigned* st) {
    XcdBarrier b; b.bar = bar; b.x = xb_xcc_id(); b.st = st;
    if (threadIdx.x == 0) (void)xb_add(&bar[XB_XCNT(b.x)], 1u);
    return b;
}
__device__ __forceinline__ void xcd_barrier_complete(unsigned* bar, unsigned x, unsigned& nloc, unsigned& nx) {
    const unsigned G = gridDim.x * gridDim.y * gridDim.z;
    unsigned sum, cnt, mine, sp = 0u;
    for (;;) {
        sum = 0u; cnt = 0u; mine = 0u;
#pragma unroll
        for (unsigned j = 0; j < 16; ++j) { const unsigned c = xb_ld(&bar[XB_XCNT(j)]); sum += c; cnt += (c > 0u) ? 1u : 0u; mine = (j == x) ? c : mine; }
        if (sum == G) break;
        __builtin_amdgcn_s_sleep(1);
        if ((++sp & 255u) == 0u) { if (xb_ld(&bar[XB_TMO])) break; if (sp > XB_SPIN_CAP) { atomicAdd(&bar[XB_TMO], 1u); break; } }
    }
    nloc = mine > 0u ? mine : 1u; nx = cnt > 0u ? cnt : 1u;
}

__device__ __forceinline__ void xcd_barrier(const XcdBarrier& b) {
    asm volatile("s_waitcnt vmcnt(0)" ::: "memory");
    __syncthreads();
    if (threadIdx.x == 0) {
        unsigned* bar = b.bar;
        __builtin_amdgcn_s_waitcnt(0);
        unsigned nloc = b.st[0], nx = b.st[1];
        if (nloc == 0u) { xcd_barrier_complete(bar, b.x, nloc, nx); b.st[0] = nloc; b.st[1] = nx; }
        const unsigned old = xb_add(&bar[XB_XSUB(b.x)], 1u);
        const unsigned gen = old / nloc;
        if (old + 1u == (gen + 1u) * nloc) {
            __builtin_amdgcn_fence(__ATOMIC_RELEASE, "agent");
            asm volatile("s_waitcnt vmcnt(0)" ::: "memory");
            const unsigned og = xb_add(&bar[XB_TOP], 1u);
            const unsigned tg = og / nx;
            if (og + 1u == (tg + 1u) * nx) xb_add(&bar[XB_TOPGEN], 1u);
            else XB_SPIN(xb_ld(&bar[XB_TOPGEN]) == tg, bar);
            __builtin_amdgcn_fence(__ATOMIC_ACQUIRE, "agent");
            xb_add(&bar[XB_XGEN(b.x)], 1u);
            asm volatile("s_waitcnt vmcnt(0)" ::: "memory");
        } else {
            XB_SPIN(xb_ld(&bar[XB_XGEN(b.x)]) == gen, bar);
            __builtin_amdgcn_fence(__ATOMIC_ACQUIRE, "agent");
            asm volatile("s_waitcnt vmcnt(0)" ::: "memory");
        }
    }
    __syncthreads();
}


__global__ void __launch_bounds__(NTHREADS, 2) __attribute__((amdgpu_waves_per_eu(2, 2))) fwd_megakernel(Params p) {
    __shared__ __attribute__((aligned(1024))) char smem[SMEM_ALL];
    cg::grid_group grid = cg::this_grid();
    __shared__ uint4 xb_words;
    if (threadIdx.x == 0) xb_words = make_uint4(0u, 0u, 0u, 0u);
    __syncthreads();
    XcdBarrier xb = xcd_barrier_post((unsigned*)(p.ws + OFF_BAR), (volatile LAS unsigned*)&xb_words);
    const float* MOD0 = (const float*)(p.ws + OFF_MOD);
    const float* MOD1 = MOD0 + 9 * 6144;
    float* XRC = (float*)(p.ws + OFF_XRC);
    const bf16_t* Hb = (const bf16_t*)(p.ws + OFF_H);

    phase0(p, smem);
    if (p.ws == nullptr) grid.sync();
    xcd_barrier(xb);
    phase_norm(p, p.x, p.ctx, p.norm1_g, MOD0, 0, 18432);
    xcd_barrier(xb);
    phase_inproj0(p, smem);
    xcd_barrier(xb);
    phase_mla_up(p, smem);
    xcd_barrier(xb);
    phase_attn(p, smem);
    xcd_barrier(xb);
    phase_proj_resid(p, Hb, 1024, (const bf16_t*)(p.ws + OFF_WT_OUT0), MOD0, 2, p.x, p.ctx, p.out, XRC, 64, true, WT_UP0_0, WT_UP0_N, smem);
    xcd_barrier(xb);
    phase_norm(p, p.out, XRC, p.norm2_g, MOD0, 3, 18432);
    xcd_barrier(xb);
    phase_ffn_up(p, (const bf16_t*)(p.ws + OFF_WT_UP0), p.ffn_conv_w, p.ffn_conv_b, 80, WT_DOWN0_0, WT_DOWN0_N, smem);
    xcd_barrier(xb);
    phase_proj_resid(p, (const bf16_t*)(p.ws + OFF_ACT), 2816, (const bf16_t*)(p.ws + OFF_WT_DOWN0), MOD0, 5, p.out, XRC, p.out, XRC, 64, true, WT_L1_0, WT_L1_N, smem);
    xcd_barrier(xb);
    phase_norm(p, p.out, XRC, p.norm1_g + 1024, MOD1, 0, 18432);
    xcd_barrier(xb);
    phase_inproj1(p, smem);
    xcd_barrier(xb);
    phase_qkconv(p);
    xcd_barrier(xb);
    phase_mlstm(p, smem);
    xcd_barrier(xb);
    phase_mix(p);
    xcd_barrier(xb);
    phase_proj_resid(p, Hb, 1024, (const bf16_t*)(p.ws + OFF_WT_OUT1), MOD1, 2, p.out, XRC, p.out, XRC, 64, false, 0, 0, smem);
    xcd_barrier(xb);
    phase_norm(p, p.out, XRC, p.norm2_g + 1024, MOD1, 3, 16384);
    xcd_barrier(xb);
    phase_ffn_up(p, (const bf16_t*)(p.ws + OFF_WT_UP1), p.ffn_conv_w + 3 * 2816, p.ffn_conv_b + 2816, 68, 0, 0, smem);
    xcd_barrier(xb);
    phase_proj_resid(p, (const bf16_t*)(p.ws + OFF_ACT), 2816, (const bf16_t*)(p.ws + OFF_WT_DOWN1), MOD1, 5, p.out, XRC, p.out, XRC, 64, false, 0, 0, smem);
}

extern "C" void kernel_launch(void* const* d_in, const int* in_sizes, int n_in, void* d_out, int out_size, void* d_ws, size_t ws_size,
                              hipStream_t stream) {
    static int grid_blocks = 0;
    if (!grid_blocks) {
        int dev = 0, cus = 0, per_cu = 0;
        hipGetDevice(&dev);
        hipDeviceGetAttribute(&cus, hipDeviceAttributeMultiprocessorCount, dev);
        hipOccupancyMaxActiveBlocksPerMultiprocessor(&per_cu, fwd_megakernel, NTHREADS, 0);
        if (per_cu < 1) per_cu = 1;
        if (per_cu > 1) per_cu = 1;
        grid_blocks = cus * per_cu;
        if (ws_size < WS_END) fprintf(stderr, "kernel_launch: workspace too small: %zu < %zu\n", ws_size, (size_t)WS_END);
    }
    Params p{};
    const float** pf = (const float**)&p;
    for (int i = 0; i < 28; ++i) pf[i] = (const float*)d_in[i];
    p.out = (float*)d_out;
    p.ws = (char*)d_ws;
    hipMemsetAsync((char*)d_ws + OFF_BAR, 0, 16384, stream);
    void* args[] = {&p};
    hipError_t e = hipLaunchCooperativeKernel((void*)fwd_megakernel, dim3(grid_blocks), dim3(NTHREADS), args, 0, stream);
    if (e != hipSuccess) fprintf(stderr, "cooperative launch failed: %s (grid %d)\n", hipGetErrorString(e), grid_blocks);
}
```

```cpp
#include <hip/hip_runtime.h>
#include <hip/hip_cooperative_groups.h>
#include <cstdio>
namespace cg = cooperative_groups;

typedef unsigned short bf16_t;
using bf16x8 = __attribute__((ext_vector_type(8))) short;
using f32x16 = __attribute__((ext_vector_type(16))) float;
using f32x4 = __attribute__((ext_vector_type(4))) float;
#define DI __device__ __forceinline__
#define MFMA(a, b, c) __builtin_amdgcn_mfma_f32_32x32x16_bf16((a), (b), (c), 0, 0, 0)
#define MFMA16(a, b, c) __builtin_amdgcn_mfma_f32_16x16x32_bf16((a), (b), (c), 0, 0, 0)
#define LDS_BARRIER() do { asm volatile("s_waitcnt lgkmcnt(0)" ::: "memory"); __builtin_amdgcn_s_barrier(); asm volatile("" ::: "memory"); } while (0)
#define TID ((int)(threadIdx.x & 255))
#define HBI ((int)(threadIdx.x >> 8))

constexpr float EPSF = 1e-6f;
constexpr float LOG2E = 1.4426950408889634f;
constexpr int NTHREADS = 512;
constexpr int HB_SMEM = 73728;
constexpr int SMEM_ALL = 2 * HB_SMEM;
constexpr int GP = 72;
constexpr int CP = 132;
constexpr int ROWSS_OFF = 67584;

constexpr size_t OFF_WT_UP1 = 0;
constexpr size_t OFF_WT_DOWN1 = OFF_WT_UP1 + 5632ull * 1024 * 2;
constexpr size_t OFF_WT_IN1 = OFF_WT_DOWN1 + 1024ull * 2816 * 2;
constexpr size_t OFF_WT_OUT1 = OFF_WT_IN1 + 3328ull * 1024 * 2;
constexpr size_t OFF_MOD = OFF_WT_OUT1 + 1024ull * 1024 * 2;
constexpr size_t OFF_TABG = OFF_MOD + 2ull * 9 * 6144 * 4;
constexpr size_t OFF_TABM = OFF_TABG + 64 * 16 * 2 * 4;
constexpr size_t OFF_ZROW = OFF_TABM + 64 * 8 * 2 * 4;
constexpr size_t OFF_W0 = OFF_ZROW + 8192;
constexpr size_t OFF_WT_IN0 = OFF_W0;
constexpr size_t OFF_WT_QB = OFF_WT_IN0 + 1536ull * 1024 * 2;
constexpr size_t OFF_WT_KVB = OFF_WT_QB + 1024ull * 384 * 2;
constexpr size_t OFF_WT_OUT0 = OFF_WT_KVB + 1024ull * 256 * 2;
constexpr size_t OFF_WT_UP0 = OFF_WT_OUT0 + 1024ull * 1024 * 2;
constexpr size_t OFF_WT_DOWN0 = OFF_WT_UP0 + 5632ull * 1024 * 2;
constexpr size_t OFF_XRC = OFF_WT_DOWN0 + 1024ull * 2816 * 2;
constexpr size_t OFF_R = OFF_XRC + 2048ull * 1024 * 4;
constexpr size_t OFF_QG = OFF_R;
constexpr size_t OFF_KG = OFF_QG + 18432ull * 512 * 2;
constexpr size_t OFF_VGT = OFF_KG + 18432ull * 128 * 2;
constexpr size_t OFF_CQ = OFF_VGT + 18432ull * 128 * 2;
constexpr size_t OFF_CKV = OFF_CQ + 18432ull * 384 * 2;
constexpr size_t OFF_KR = OFF_CKV + 18432ull * 256 * 2;
constexpr size_t OFF_QM = OFF_KR + 18432ull * 32 * 4;
constexpr size_t OFF_KM = OFF_QM + 18432ull * 768 * 2;
constexpr size_t OFF_VMT = OFF_KM + 18432ull * 768 * 2;
constexpr size_t END_L0 = OFF_VMT + 18432ull * 512 * 2;
constexpr size_t OFF_ACT = OFF_R;
constexpr size_t END_ACT = OFF_ACT + 18432ull * 2816 * 2;
constexpr size_t OFF_QKRAW = OFF_W0;
constexpr size_t OFF_V1 = OFF_QKRAW + 18432ull * 1024 * 2;
constexpr size_t OFF_OG = OFF_V1 + 18432ull * 1024 * 2;
constexpr size_t OFF_GATES = OFF_OG + 16384ull * 1024 * 2;
constexpr size_t OFF_HF = OFF_GATES + 18432ull * 32 * 4;
constexpr size_t OFF_HB = OFF_HF + 16384ull * 1024 * 2;
constexpr size_t END_L1 = OFF_HB + 16384ull * 1024 * 2;
constexpr size_t cmax(size_t a, size_t b) { return a > b ? a : b; }
constexpr size_t OFF_H = cmax(cmax(END_L0, END_ACT), END_L1);
constexpr size_t OFF_BAR = OFF_H + 18432ull * 1024 * 2;
constexpr size_t OFF_SCAN = OFF_BAR + 16384;
constexpr size_t WS_END = OFF_SCAN + 2304ull * 384 * 4;
static_assert(WS_END <= 268435456ull, "workspace too large");
static_assert(OFF_H % 256 == 0 && OFF_R % 256 == 0 && OFF_HF % 256 == 0, "align");

struct Params {
    const float *x, *c, *ctx, *c_ctx, *ada_w, *ada_b, *norm1_g, *norm2_g, *ffn_w_up, *ffn_conv_w, *ffn_conv_b, *ffn_w_down,
        *att_w_in, *mla_qa_g, *mla_w_qb, *mla_kva_g, *mla_w_kvb, *mla_q_g, *mla_k_g, *gqa_q_g, *gqa_k_g, *att_w_out,
        *ml_w_in, *ml_conv_w, *ml_conv_b, *ml_gate_b, *ml_out_g, *ml_w_out;
    float* out;
    char* ws;
};

DI unsigned short f2bf_sw(float x) { unsigned u = __float_as_uint(x); u += 0x7fffu + ((u >> 16) & 1u); return (unsigned short)(u >> 16); }
DI unsigned short f2bf(float x) { unsigned r; asm("v_cvt_pk_bf16_f32 %0, %1, %1" : "=v"(r) : "v"(x)); return (unsigned short)(r & 0xffffu); }
DI unsigned pack2(float a, float b) { unsigned r; asm("v_cvt_pk_bf16_f32 %0, %1, %2" : "=v"(r) : "v"(a), "v"(b)); return r; }
DI bf16x8 pack_frag(float a0, float a1, float a2, float a3, float a4, float a5, float a6, float a7) {
    using u32x4_ = __attribute__((ext_vector_type(4))) unsigned; u32x4_ p;
    asm volatile("v_cvt_pk_bf16_f32 %0, %4, %5\n\tv_cvt_pk_bf16_f32 %1, %6, %7\n\tv_cvt_pk_bf16_f32 %2, %8, %9\n\tv_cvt_pk_bf16_f32 %3, %10, %11\n\ts_nop 1"
                 : "=&v"(p[0]), "=&v"(p[1]), "=&v"(p[2]), "=&v"(p[3]) : "v"(a0), "v"(a1), "v"(a2), "v"(a3), "v"(a4), "v"(a5), "v"(a6), "v"(a7));
    return __builtin_bit_cast(bf16x8, p);
}
DI float bflo(unsigned v) { return __uint_as_float(v << 16); }
DI float bfhi(unsigned v) { return __uint_as_float(v & 0xffff0000u); }
DI float bf2f(unsigned short v) { return __uint_as_float(((unsigned)v) << 16); }
DI uint4 pack8(const float* v) { uint4 o; o.x = pack2(v[0], v[1]); o.y = pack2(v[2], v[3]); o.z = pack2(v[4], v[5]); o.w = pack2(v[6], v[7]); return o; }
DI void unpack8(uint4 u, float* v) { v[0] = bflo(u.x); v[1] = bfhi(u.x); v[2] = bflo(u.y); v[3] = bfhi(u.y); v[4] = bflo(u.z); v[5] = bfhi(u.z); v[6] = bflo(u.w); v[7] = bfhi(u.w); }
DI int crow(int reg, int h) { return (reg & 3) + 8 * (reg >> 2) + 4 * h; }
DI float sigmoidf_(float x) { return __builtin_amdgcn_rcpf(1.f + __expf(-x)); }
DI float siluf_(float x) { return x * __builtin_amdgcn_rcpf(1.f + __expf(-x)); }
DI float logsigmoidf_(float x) { return fminf(x, 0.f) - log1pf(__expf(-fabsf(x))); }
DI f32x16 zero16() { f32x16 z;
#pragma unroll
    for (int i = 0; i < 16; ++i) z[i] = 0.f; return z; }

DI void row_info(int m0, int& b, int& t0, bool& lat) {
    if (m0 < 16384) { b = m0 >> 11; t0 = m0 & 2047; lat = true; }
    else { int q = m0 - 16384; b = q >> 8; t0 = q & 255; lat = false; }
}

template <bool SS, bool HALO, class Epi>
DI void gemm_tile(const bf16_t* ap0, const bf16_t* ap1, const bf16_t* ap2, const bf16_t* ap3, unsigned mk0, unsigned mk1, unsigned mk2, unsigned mk3, const bf16_t* __restrict__ Bt, int ldb, int K, char* smem, Epi epi) {
    const int tid = TID, lane = tid & 63, w = tid >> 6, h = lane >> 5, r = lane & 31;
    const int wm = w >> 1, wn = w & 1;
    const int lr = tid >> 3, kc = tid & 7;
    ap0 += kc * 8; ap1 += kc * 8; ap2 += kc * 8; ap3 += kc * 8;
    const bf16_t* bp0 = Bt + (size_t)lr * ldb + kc * 8;
    const bf16_t* bp1 = bp0 + (size_t)32 * ldb; const bf16_t* bp2 = bp0 + (size_t)64 * ldb; const bf16_t* bp3 = bp0 + (size_t)96 * ldb;
    f32x16 acc00 = zero16(), acc01 = zero16(), acc10 = zero16(), acc11 = zero16();
    float ss0 = 0.f, ss1 = 0.f, ss2 = 0.f, ss3 = 0.f;
    uint4 ra0, ra1, ra2, ra3, rb0, rb1, rb2, rb3;
    const int nk = K >> 6;
#define GLOAD(k0) { ra0 = *(const uint4*)(ap0 + (k0)); ra1 = *(const uint4*)(ap1 + (k0)); ra2 = *(const uint4*)(ap2 + (k0)); ra3 = *(const uint4*)(ap3 + (k0)); \
                    rb0 = *(const uint4*)(bp0 + (k0)); rb1 = *(const uint4*)(bp1 + (k0)); rb2 = *(const uint4*)(bp2 + (k0)); rb3 = *(const uint4*)(bp3 + (k0)); }
#define SSQ(ssv, rv) { if (SS) { float f_[8]; unpack8(rv, f_); ssv += f_[0]*f_[0] + f_[1]*f_[1] + f_[2]*f_[2] + f_[3]*f_[3] + f_[4]*f_[4] + f_[5]*f_[5] + f_[6]*f_[6] + f_[7]*f_[7]; } }
#define MSK(rv, mk) { rv.x &= mk; rv.y &= mk; rv.z &= mk; rv.w &= mk; }
#define SWRITE(s_) { if (HALO) { MSK(ra0, mk0) MSK(ra1, mk1) MSK(ra2, mk2) MSK(ra3, mk3) } bf16_t* As_ = (bf16_t*)(smem + (s_) * 36864) + lr * GP + kc * 8; bf16_t* Bs_ = As_ + 128 * GP; \
                     *(uint4*)(As_) = ra0; *(uint4*)(As_ + 32 * GP) = ra1; *(uint4*)(As_ + 64 * GP) = ra2; *(uint4*)(As_ + 96 * GP) = ra3; \
                     *(uint4*)(Bs_) = rb0; *(uint4*)(Bs_ + 32 * GP) = rb1; *(uint4*)(Bs_ + 64 * GP) = rb2; *(uint4*)(Bs_ + 96 * GP) = rb3; \
                     SSQ(ss0, ra0) SSQ(ss1, ra1) SSQ(ss2, ra2) SSQ(ss3, ra3) }
    GLOAD(0) SWRITE(0) __syncthreads();
#pragma unroll 1
    for (int kt = 0; kt < nk; ++kt) {
        if (kt + 1 < nk) GLOAD((kt + 1) * 64)
        {
            const bf16_t* As = (const bf16_t*)(smem + (kt & 1) * 36864) + (wm * 64 + r) * GP + h * 8;
            const bf16_t* Bs = (const bf16_t*)(smem + (kt & 1) * 36864) + 128 * GP + (wn * 64 + r) * GP + h * 8;
#pragma unroll
            for (int ks = 0; ks < 4; ++ks) {
                const bf16x8 a0 = *(const bf16x8*)(As + ks * 16), a1 = *(const bf16x8*)(As + 32 * GP + ks * 16);
                const bf16x8 b0 = *(const bf16x8*)(Bs + ks * 16), b1 = *(const bf16x8*)(Bs + 32 * GP + ks * 16);
                acc00 = MFMA(a0, b0, acc00); acc01 = MFMA(a0, b1, acc01); acc10 = MFMA(a1, b0, acc10); acc11 = MFMA(a1, b1, acc11);
            }
        }
        if (kt + 1 < nk) SWRITE((kt + 1) & 1)
        __syncthreads();
    }
#undef GLOAD
#undef SWRITE
#undef SSQ
#undef MSK
    float* Cs = (float*)smem;
    {
        float* cb = Cs + (wm * 64 + 4 * h) * CP + wn * 64 + r;
#pragma unroll
        for (int g = 0; g < 16; ++g) {
            const int ro = (g & 3) + 8 * (g >> 2);
            cb[ro * CP] = acc00[g]; cb[ro * CP + 32] = acc01[g]; cb[(ro + 32) * CP] = acc10[g]; cb[(ro + 32) * CP + 32] = acc11[g];
        }
    }
    if (SS) {
        float* rowss = (float*)(smem + ROWSS_OFF);
        ss0 += __shfl_xor(ss0, 1); ss0 += __shfl_xor(ss0, 2); ss0 += __shfl_xor(ss0, 4);
        ss1 += __shfl_xor(ss1, 1); ss1 += __shfl_xor(ss1, 2); ss1 += __shfl_xor(ss1, 4);
        ss2 += __shfl_xor(ss2, 1); ss2 += __shfl_xor(ss2, 2); ss2 += __shfl_xor(ss2, 4);
        ss3 += __shfl_xor(ss3, 1); ss3 += __shfl_xor(ss3, 2); ss3 += __shfl_xor(ss3, 4);
        if (kc == 0) { rowss[lr] = ss0; rowss[lr + 32] = ss1; rowss[lr + 64] = ss2; rowss[lr + 96] = ss3; }
    }
    __syncthreads();
    epi((const float*)smem, (const float*)(smem + ROWSS_OFF));
    __syncthreads();
}


DI int g_row(int i) { return ((i * 8 + (int)(threadIdx.x >> 6)) * 8) + (int)((threadIdx.x & 63) >> 3); }
DI int b_perm(int row) { return ((row >> 5) & 1) * 128 + (row >> 6) * 32 + (row & 31); }
DI int g_chunk(int row) { return (int)(threadIdx.x & 7) ^ ((row >> 1) & 7); }
#define GLDS(g_, l_) __builtin_amdgcn_global_load_lds((const unsigned*)(g_), (unsigned*)(l_), 16, 0, 0)
template <int NH = -1, class Epi>
DI void gemm256(const char* wsb, const bf16_t* a0p, const bf16_t* a1p, const bf16_t* a2p, const bf16_t* a3p,
                const bf16_t* b0p, const bf16_t* b1p, const bf16_t* b2p, const bf16_t* b3p, int K, char* smem_all, Epi epi) {
    const unsigned a0 = (unsigned)((const char*)a0p - wsb), a1 = (unsigned)((const char*)a1p - wsb), a2 = (unsigned)((const char*)a2p - wsb), a3 = (unsigned)((const char*)a3p - wsb);
    const unsigned b0 = (unsigned)((const char*)b0p - wsb), b1 = (unsigned)((const char*)b1p - wsb), b2 = (unsigned)((const char*)b2p - wsb), b3 = (unsigned)((const char*)b3p - wsb);
    const int lane = threadIdx.x & 63, wid = __builtin_amdgcn_readfirstlane(threadIdx.x >> 6), wr = wid >> 2, wc = wid & 3, fr = lane & 15, fq = lane >> 4;
    f32x4 acc[8][4];
#pragma unroll
    for (int m = 0; m < 8; ++m)
#pragma unroll
        for (int n = 0; n < 4; ++n) acc[m][n] = (f32x4){0.f, 0.f, 0.f, 0.f};
#define STAGE256(buf, k0) { char* sa_ = smem_all + (buf) * 65536 + wid * 1024; char* sb_ = sa_ + 32768; const char* wk_ = wsb + (size_t)(k0) * 2; \
        GLDS(wk_ + a0, sa_); GLDS(wk_ + a1, sa_ + 8192); GLDS(wk_ + a2, sa_ + 16384); GLDS(wk_ + a3, sa_ + 24576); \
        if (NH < 0 || (wid >> 2) == NH) { GLDS(wk_ + b0, sb_); GLDS(wk_ + b1, sb_ + 8192); GLDS(wk_ + b2, sb_ + 16384); GLDS(wk_ + b3, sb_ + 24576); } }
    const int sw = (fr >> 1) & 7;
    const unsigned offA = (wr * 128 + fr) * 128, offB = 32768 + (wc * 64 + fr) * 128;
    const unsigned co0 = ((0 + fq) ^ sw) << 4, co1 = ((4 + fq) ^ sw) << 4;
    const unsigned lds0 = (unsigned)(size_t)smem_all;
    const int nt = K >> 6;
    STAGE256(0, 0)
    asm volatile("s_waitcnt vmcnt(0)" ::: "memory");
    __syncthreads();
#pragma unroll 1
    for (int t = 0; t < nt; ++t) {
        const int cur = t & 1;
        if (t + 1 < nt) STAGE256(cur ^ 1, (t + 1) * 64)
        const unsigned lb = lds0 + cur * 65536;
        const unsigned aA0 = lb + offA + co0, aA1 = lb + offA + co1, aB0 = lb + offB + co0, aB1 = lb + offB + co1;
        bf16x8 Bq0[4], Bq1[4], Aq0[2], Aq1[2];
#define DSR(dst, addr, off) asm volatile("ds_read_b128 %0, %1 offset:%2" : "=v"(dst) : "v"(addr), "n"(off) : "memory")
#define LDA2(dst, addr, mo) { DSR(dst[0], addr, (mo) * 2048); DSR(dst[1], addr, ((mo) + 1) * 2048); }
#define LDB4(dst, addr) { DSR(dst[0], addr, 0); DSR(dst[1], addr, 2048); DSR(dst[2], addr, 4096); DSR(dst[3], addr, 6144); }
#define WAIT_A(n, X) asm volatile("s_waitcnt lgkmcnt(" #n ")" : "+v"(X[0]), "+v"(X[1]) :: "memory")
#define WAIT_AB(n, X, Y) asm volatile("s_waitcnt lgkmcnt(" #n ")" : "+v"(X[0]), "+v"(X[1]), "+v"(Y[0]), "+v"(Y[1]), "+v"(Y[2]), "+v"(Y[3]) :: "memory")
#define MM8(Aq, Bq, mo) { _Pragma("unroll") for (int m = 0; m < 2; ++m) _Pragma("unroll") for (int n = 0; n < 4; ++n) if (NH < 0 || (n >> 1) == NH) acc[(mo) + m][n] = MFMA16(Bq[n], Aq[m], acc[(mo) + m][n]); }
        LDB4(Bq0, aB0) LDA2(Aq0, aA0, 0) LDA2(Aq1, aA0, 2)
        WAIT_AB(2, Aq0, Bq0);
        MM8(Aq0, Bq0, 0)
        LDA2(Aq0, aA0, 4)
        WAIT_A(2, Aq1);
        MM8(Aq1, Bq0, 2)
        LDA2(Aq1, aA0, 6) LDB4(Bq1, aB1)
        WAIT_A(6, Aq0);
        MM8(Aq0, Bq0, 4)
        LDA2(Aq0, aA1, 0)
        WAIT_A(6, Aq1);
        MM8(Aq1, Bq0, 6)
        LDA2(Aq1, aA1, 2)
        WAIT_AB(2, Aq0, Bq1);
        MM8(Aq0, Bq1, 0)
        LDA2(Aq0, aA1, 4)
        WAIT_A(2, Aq1);
        MM8(Aq1, Bq1, 2)
        LDA2(Aq1, aA1, 6)
        WAIT_A(2, Aq0);
        MM8(Aq0, Bq1, 4)
        WAIT_A(0, Aq1);
        MM8(Aq1, Bq1, 6)
#undef DSR
#undef LDA2
#undef LDB4
#undef WAIT_A
#undef WAIT_AB
#undef MM8
        asm volatile("s_waitcnt vmcnt(0)" ::: "memory");
        __syncthreads();
    }
#undef STAGE256
    int t_ = threadIdx.x;
    asm volatile("" : "+v"(t_));
    const int lane_ = t_ & 63, wid_ = t_ >> 6, wr_ = wid_ >> 2, wc_ = wid_ & 3, fr_ = lane_ & 15, fq_ = lane_ >> 4, hb_ = t_ >> 8;
#pragma unroll
    for (int p = 0; p < 2; ++p) {
        if (NH >= 0 && p != NH) continue;
        {
            float* Cs = (float*)(smem_all + wr_ * HB_SMEM) + fr_ * CP + wc_ * 32 + 4 * fq_;
#pragma unroll
            for (int m = 0; m < 8; ++m)
#pragma unroll
                for (int n = 0; n < 2; ++n) *(f32x4*)(Cs + (m * 16) * CP + n * 16) = acc[m][2 * p + n];
        }
        __syncthreads();
        epi((const float*)(smem_all + hb_ * HB_SMEM), hb_, p, t_ & 255);
        __syncthreads();
    }
}

DI void epi_store_bf16(const float* Cs, bf16_t* dst, int ld, int tid) {
#pragma unroll 2
    for (int j = 0; j < 8; ++j) {
        int c = tid + 256 * j, row = c >> 4, cc = c & 15;
        const float4* cp = (const float4*)(Cs + row * CP + cc * 8);
        float4 f0 = cp[0], f1 = cp[1];
        float v[8] = {f0.x, f0.y, f0.z, f0.w, f1.x, f1.y, f1.z, f1.w};
        *(uint4*)(dst + (size_t)row * ld + cc * 8) = pack8(v);
    }
}
DI void epi_resid(const float* Cs, const float* src, float* dst, const float* gate, int tid) {
#pragma unroll 4
    for (int j = 0; j < 16; ++j) {
        int c = tid + 256 * j, row = c >> 5, c4 = c & 31;
        float4 cv = *(const float4*)(Cs + row * CP + c4 * 4);
        float4 sv = *(const float4*)(src + (size_t)row * 1024 + c4 * 4);
        float4 gv = *(const float4*)(gate + c4 * 4);
        float4 o; o.x = sv.x + gv.x * cv.x; o.y = sv.y + gv.y * cv.y; o.z = sv.z + gv.z * cv.z; o.w = sv.w + gv.w * cv.w;
        *(float4*)(dst + (size_t)row * 1024 + c4 * 4) = o;
    }
}

DI int wsrc_col(int mode, int tn, int c) {
    if (mode == 0) return tn * 128 + c;
    if (mode == 1) {
        const int np = tn * 128;
        if (np < 512) return 672 + np + c;
        if (np < 640) return 1184 + np - 512 + c;
        if (np < 768) return 1312 + np - 640 + c;
        if (np < 1152) return np - 768 + c;
        if (np < 1408) return 384 + np - 1152 + c;
        return c < 32 ? 640 + c : -1;
    }
    if (mode == 2) return c < 96 ? tn * 96 + c : -1;
    return c < 64 ? 64 * tn + c : 2816 + 64 * tn + c - 64;
}
DI void wtile(const float* __restrict__ src, int Nsrc, const float* __restrict__ g, bf16_t* __restrict__ dst, int K, int k0, int tn, int mode, char* smem) {
    bf16_t* T = (bf16_t*)smem;
    const int tid = TID, lane = tid & 63, w = tid >> 6, rsub = lane >> 5, c4 = (lane & 31) * 4;
    int sc = wsrc_col(mode, tn, c4);
    if (sc >= Nsrc) sc = -1;
#pragma unroll 8
    for (int i = 0; i < 16; ++i) {
        const int rr = w * 32 + 2 * i + rsub;
        float4 v = make_float4(0.f, 0.f, 0.f, 0.f);
        if (sc >= 0) { v = *(const float4*)(src + (size_t)(k0 + rr) * Nsrc + sc); if (g) { const float gg = g[k0 + rr]; v.x *= gg; v.y *= gg; v.z *= gg; v.w *= gg; } }
        T[(c4 + 0) * 130 + rr] = f2bf(v.x);
        T[(c4 + 1) * 130 + rr] = f2bf(v.y);
        T[(c4 + 2) * 130 + rr] = f2bf(v.z);
        T[(c4 + 3) * 130 + rr] = f2bf(v.w);
    }
    __syncthreads();
#pragma unroll
    for (int j = 0; j < 8; ++j) {
        const int c = tid + 256 * j, n = c >> 4, kc = c & 15;
        const unsigned* s32 = (const unsigned*)(T + n * 130 + kc * 8);
        uint4 o; o.x = s32[0]; o.y = s32[1]; o.z = s32[2]; o.w = s32[3];
        *(uint4*)(dst + (size_t)(tn * 128 + n) * K + k0 + kc * 8) = o;
    }
    __syncthreads();
}

DI void mod_item(const Params& p, int item, char* smem) {
    const int tid = TID, lane = tid & 63, w = tid >> 6, hl = lane >> 5, cl = lane & 31;
    const int l = item / 192, n0 = (item % 192) * 32;
    float* sl = (float*)smem;
    for (int i = tid; i < 9216; i += 256) {
        int rr = i >> 10, k = i & 1023;
        float cv = rr < 8 ? p.c[rr * 1024 + k] : p.c_ctx[k];
        sl[i] = cv / (1.f + expf(-cv));
    }
    __syncthreads();
    float acc[9];
#pragma unroll
    for (int q = 0; q < 9; ++q) acc[q] = 0.f;
    const float* wp = p.ada_w + (size_t)l * 1024 * 6144 + n0 + cl;
#pragma unroll 32
    for (int kk = 0; kk < 128; ++kk) {
        const int k = w * 256 + 2 * kk + hl;
        float wv = wp[(size_t)k * 6144];
#pragma unroll
        for (int q = 0; q < 9; ++q) acc[q] += sl[q * 1024 + k] * wv;
    }
    float* red = (float*)(smem + 36864);
#pragma unroll
    for (int q = 0; q < 9; ++q) red[((w * 2 + hl) * 9 + q) * 32 + cl] = acc[q];
    __syncthreads();
    float* MOD = (float*)(p.ws + OFF_MOD);
    for (int i = tid; i < 288; i += 256) {
        int q = i >> 5, ln = i & 31;
        float sacc = 0.f;
#pragma unroll
        for (int u = 0; u < 8; ++u) sacc += red[(u * 9 + q) * 32 + ln];
        sacc += p.ada_b[l * 6144 + n0 + ln];
        MOD[(size_t)(l * 9 + q) * 6144 + n0 + ln] = sacc;
    }
    __syncthreads();
}

DI void sincos_d(double x, float& s, float& c) {
    const double TWO_PI = 6.283185307179586476925;
    double t = x / TWO_PI;
    t -= rint(t);
    double y = t * TWO_PI, y2 = y * y;
    double sv = y, cv = 1.0, ts = y, tc = 1.0;
#pragma unroll 1
    for (int k = 1; k <= 14; ++k) {
        tc *= -y2 / (double)((2 * k - 1) * (2 * k));
        ts *= -y2 / (double)((2 * k) * (2 * k + 1));
        cv += tc; sv += ts;
    }
    s = (float)sv; c = (float)cv;
}

DI void rope_tables(const Params& p) {
    float* TG = (float*)(p.ws + OFF_TABG);
    float* TM = (float*)(p.ws + OFF_TABM);
    for (int i = TID; i < 1024; i += 256) {
        int v = i >> 4, f = i & 15;
        float inv = exp2f(-(float)f / 16.f * 13.287712379549449f);
        float ang = (float)v * inv, s, c;
        sincos_d((double)ang, s, c);
        TG[i] = c; TG[1024 + i] = s;
    }
    for (int i = TID; i < 512; i += 256) {
        int v = i >> 3, f = i & 7;
        float inv = exp2f(-(float)f / 8.f * 13.287712379549449f);
        float ang = (float)v * inv, s, c;
        sincos_d((double)ang, s, c);
        TM[i] = c; TM[512 + i] = s;
    }
}

constexpr int NW = 10;
constexpr int N_WT0 = 8 * 12 + 3 * 8 + 2 * 8 + 8 * 8 + 8 * 44 + 22 * 8;
constexpr int N_WT1 = 8 * 44 + 22 * 8 + 8 * 26 + 8 * 8;
constexpr int N_MOD = 384;
constexpr int N_P0 = N_MOD + 96;
static_assert(N_P0 % 2 == 0 && N_MOD % 2 == 0 && N_WT1 % 2 == 0, "items are dealt to half-block pairs");

DI void wtile_item(const Params& p, int t, char* smem) {
    int wi = 0;
    int cnt[NW] = {8 * 12, 3 * 8, 2 * 8, 8 * 8, 8 * 44, 22 * 8, 8 * 44, 22 * 8, 8 * 26, 8 * 8};
#pragma unroll
    for (int i = 0; i < NW - 1; ++i) { if (wi == i && t >= cnt[i]) { t -= cnt[i]; wi = i + 1; } }
    const float* src; const float* g = nullptr; bf16_t* dst; int K, Nsrc, ntn, mode;
    switch (wi) {
        case 0: src = p.att_w_in; dst = (bf16_t*)(p.ws + OFF_WT_IN0); K = 1024; Nsrc = 1440; ntn = 12; mode = 1; break;
        case 1: src = p.mla_w_qb; g = p.mla_qa_g; dst = (bf16_t*)(p.ws + OFF_WT_QB); K = 384; Nsrc = 768; ntn = 8; mode = 2; break;
        case 2: src = p.mla_w_kvb; g = p.mla_kva_g; dst = (bf16_t*)(p.ws + OFF_WT_KVB); K = 256; Nsrc = 1024; ntn = 8; mode = 0; break;
        case 3: src = p.att_w_out; dst = (bf16_t*)(p.ws + OFF_WT_OUT0); K = 1024; Nsrc = 1024; ntn = 8; mode = 0; break;
        case 4: src = p.ffn_w_up; dst = (bf16_t*)(p.ws + OFF_WT_UP0); K = 1024; Nsrc = 5632; ntn = 44; mode = 3; break;
        case 5: src = p.ffn_w_down; dst = (bf16_t*)(p.ws + OFF_WT_DOWN0); K = 2816; Nsrc = 1024; ntn = 8; mode = 0; break;
        case 6: src = p.ffn_w_up + 1024ull * 5632; dst = (bf16_t*)(p.ws + OFF_WT_UP1); K = 1024; Nsrc = 5632; ntn = 44; mode = 3; break;
        case 7: src = p.ffn_w_down + 2816ull * 1024; dst = (bf16_t*)(p.ws + OFF_WT_DOWN1); K = 2816; Nsrc = 1024; ntn = 8; mode = 0; break;
        case 8: src = p.ml_w_in; dst = (bf16_t*)(p.ws + OFF_WT_IN1); K = 1024; Nsrc = 3104; ntn = 26; mode = 0; break;
        default: src = p.ml_w_out; dst = (bf16_t*)(p.ws + OFF_WT_OUT1); K = 1024; Nsrc = 1024; ntn = 8; mode = 0; break;
    }
    const int tn = t % ntn, tk = t / ntn;
    wtile(src, Nsrc, g, dst, K, tk * 128, tn, mode, smem);
}

DI void phase0(const Params& p, char* smem_all) {
    char* smem = smem_all + HBI * HB_SMEM;
    if (blockIdx.x == gridDim.x - 1) {
        if (HBI == 0) rope_tables(p);
        else { for (int i = TID; i < 512; i += 256) ((uint4*)(p.ws + OFF_ZROW))[i] = make_uint4(0, 0, 0, 0); }
    }
    for (int it0 = blockIdx.x * 2; it0 < N_P0; it0 += gridDim.x * 2) {
        const int item = it0 + HBI;
        if (item < N_MOD) mod_item(p, item, smem);
        else wtile_item(p, item - N_MOD, smem);
    }
}
DI void convert_weights(const Params& p, char* smem_all, int t0, int cnt, int first) {
    char* smem = smem_all + HBI * HB_SMEM;
    const int G = gridDim.x;
    if (first >= G) first = 0;
    if ((int)blockIdx.x < first) return;
    for (int it0 = ((int)blockIdx.x - first) * 2; it0 < cnt; it0 += (G - first) * 2) wtile_item(p, t0 + it0 + HBI, smem);
}
constexpr int WT_IN0_0 = 0, WT_IN0_N = 96, WT_MLA_0 = 96, WT_MLA_N = 40, WT_OUT0_0 = 136, WT_OUT0_N = 64, WT_UP0_0 = 200, WT_UP0_N = 352, WT_DOWN0_0 = 552, WT_DOWN0_N = 176, WT_L1_0 = 728, WT_L1_N = 800;
static_assert(WT_L1_0 == N_WT0 && WT_L1_N == N_WT1, "tile ranges");

DI void norm_row_ptrs(int row, const float* srcLat, const float* srcCtx, const float* mod, int shift_idx, const float*& src, const float*& sh) {
    int mb;
    if (row < 16384) { src = srcLat + (size_t)row * 1024; mb = row >> 11; }
    else { src = srcCtx + (size_t)(row - 16384) * 1024; mb = 8; }
    sh = mod + (size_t)mb * 6144 + shift_idx * 1024;
}
DI void norm_row_finish(const float4 (&v)[4], float ss, const float* g, const float* sh, bf16_t* dst, int lane) {
#pragma unroll
    for (int o = 32; o >= 1; o >>= 1) ss += __shfl_xor(ss, o);
    const float rstd = rsqrtf(ss * (1.f / 1024.f) + EPSF);
    const float* sc = sh + 1024;
#pragma unroll
    for (int j = 0; j < 4; ++j) {
        const int c = j * 256 + lane * 4;
        const float4 gv = *(const float4*)(g + c), shv = *(const float4*)(sh + c), scv = *(const float4*)(sc + c);
        const float o0 = v[j].x * rstd * gv.x * (1.f + scv.x) + shv.x;
        const float o1 = v[j].y * rstd * gv.y * (1.f + scv.y) + shv.y;
        const float o2 = v[j].z * rstd * gv.z * (1.f + scv.z) + shv.z;
        const float o3 = v[j].w * rstd * gv.w * (1.f + scv.w) + shv.w;
        uint2 o; o.x = pack2(o0, o1); o.y = pack2(o2, o3);
        *(uint2*)(dst + c) = o;
    }
}
DI void phase_norm(const Params& p, const float* srcLat, const float* srcCtx, const float* g, const float* mod, int shift_idx, int nrows) {
    const int lane = threadIdx.x & 63, w = threadIdx.x >> 6;
    bf16_t* H = (bf16_t*)(p.ws + OFF_H);
    for (int row = (blockIdx.x * 8 + w) * 2; row < nrows; row += gridDim.x * 16) {
        const float *srcA, *shA, *srcB, *shB;
        norm_row_ptrs(row, srcLat, srcCtx, mod, shift_idx, srcA, shA);
        norm_row_ptrs(row + 1, srcLat, srcCtx, mod, shift_idx, srcB, shB);
        float4 va[4], vb[4];
        float sa = 0.f, sb = 0.f;
#pragma unroll
        for (int j = 0; j < 4; ++j) { va[j] = *(const float4*)(srcA + j * 256 + lane * 4); vb[j] = *(const float4*)(srcB + j * 256 + lane * 4); }
#pragma unroll
        for (int j = 0; j < 4; ++j) { sa += va[j].x * va[j].x + va[j].y * va[j].y + va[j].z * va[j].z + va[j].w * va[j].w; sb += vb[j].x * vb[j].x + vb[j].y * vb[j].y + vb[j].z * vb[j].z + vb[j].w * vb[j].w; }
        norm_row_finish(va, sa, g, shA, H + (size_t)row * 1024, lane);
        norm_row_finish(vb, sb, g, shB, H + (size_t)(row + 1) * 1024, lane);
    }
}

template <int Q>
DI void rope_apply(float* v, const float* tab, int rw, int cl) {
#pragma unroll
    for (int f = 0; f < Q; ++f) {
        float cr = tab[rw * Q + f], sr = tab[64 * Q + rw * Q + f], cc = tab[cl * Q + f], sc = tab[64 * Q + cl * Q + f];
        float a1 = v[f], a2 = v[Q + f], b1 = v[2 * Q + f], b2 = v[3 * Q + f];
        v[f] = a1 * cr - a2 * sr; v[Q + f] = a2 * cr + a1 * sr;
        v[2 * Q + f] = b1 * cc - b2 * sc; v[3 * Q + f] = b2 * cc + b1 * sc;
    }
}

DI void phase_inproj0(const Params& p, char* smem_all) {
    const bf16_t* H = (const bf16_t*)(p.ws + OFF_H);
    const bf16_t* W = (const bf16_t*)(p.ws + OFF_WT_IN0);
    const float* TG = (const float*)(p.ws + OFF_TABG);
    for (int id = blockIdx.x; id < 72 * 6; id += gridDim.x) {
        const int nt2 = id / 72, mt2 = id % 72;
        auto epi = [&](const float* Cs, int si, int sj, int tid) {
            const int nt = 2 * nt2 + sj, m0 = (2 * mt2 + si) * 128;
            int b, t0; bool lat; row_info(m0, b, t0, lat);
            const int s0 = lat ? 256 + t0 : t0;
            if (nt < 5) {
                const int row = tid & 127, half = tid >> 7;
                const float4* cp = (const float4*)(Cs + row * CP + half * 64);
                float ss = 0.f;
#pragma unroll
                for (int i = 0; i < 16; ++i) { float4 f = cp[i]; ss += f.x * f.x + f.y * f.y + f.z * f.z + f.w * f.w; }
                const float rstd = rsqrtf(ss * (1.f / 64.f) + EPSF);
                const float* g = nt < 4 ? p.gqa_q_g : p.gqa_k_g;
                const float osc = nt < 4 ? 0.125f * LOG2E : 1.f;
                bf16_t* dst;
                if (nt < 4) dst = (bf16_t*)(p.ws + OFF_QG) + ((size_t)(b * 2304 + s0 + row) * 8 + nt * 2 + half) * 64;
                else dst = (bf16_t*)(p.ws + OFF_KG) + ((size_t)(b * 2304 + s0 + row) * 2 + half) * 64;
                const int t = t0 + row;
#pragma unroll 1
                for (int hh = 0; hh < 2; ++hh) {
                    float v[32];
#pragma unroll
                    for (int i = 0; i < 8; ++i) { float4 f = cp[hh * 8 + i]; const float4 gv = *(const float4*)(g + hh * 32 + 4 * i);
                        v[4 * i] = f.x * rstd * gv.x; v[4 * i + 1] = f.y * rstd * gv.y; v[4 * i + 2] = f.z * rstd * gv.z; v[4 * i + 3] = f.w * rstd * gv.w; }
                    if (lat) {
                        const int pos = hh ? (t & 63) : (t >> 6);
#pragma unroll
                        for (int f = 0; f < 16; ++f) {
                            const float c_ = TG[pos * 16 + f], s_ = TG[1024 + pos * 16 + f];
                            const float x1 = v[f], x2 = v[16 + f];
                            v[f] = x1 * c_ - x2 * s_; v[16 + f] = x2 * c_ + x1 * s_;
                        }
                    }
#pragma unroll
                    for (int i = 0; i < 32; ++i) v[i] *= osc;
#pragma unroll
                    for (int i = 0; i < 4; ++i) *(uint4*)(dst + hh * 32 + i * 8) = pack8(v + i * 8);
                }
            } else if (nt == 5) {
                const int dall = tid & 127, ch0 = (tid >> 7) * 8;
                bf16_t* dst = (bf16_t*)(p.ws + OFF_VGT) + ((size_t)(b * 2 + (dall >> 6)) * 64 + (dall & 63)) * 2304 + s0;
#pragma unroll 2
                for (int ch = 0; ch < 8; ++ch) {
                    float v[8];
#pragma unroll
                    for (int i = 0; i < 8; ++i) v[i] = Cs[((ch0 + ch) * 8 + i) * CP + dall];
                    *(uint4*)(dst + (ch0 + ch) * 8) = pack8(v);
                }
            } else if (nt < 9) {
                epi_store_bf16(Cs, (bf16_t*)(p.ws + OFF_CQ) + (size_t)m0 * 384 + (nt - 6) * 128, 384, tid);
            } else if (nt < 11) {
                epi_store_bf16(Cs, (bf16_t*)(p.ws + OFF_CKV) + (size_t)m0 * 256 + (nt - 9) * 128, 256, tid);
            } else {
                const int row = tid >> 1, half = tid & 1;
                float* dst = (float*)(p.ws + OFF_KR) + (size_t)(m0 + row) * 32 + half * 16;
                const float4* cp = (const float4*)(Cs + row * CP + half * 16);
#pragma unroll
                for (int i = 0; i < 4; ++i) ((float4*)dst)[i] = cp[i];
            }
        };
        const int r0 = g_row(0), r1 = g_row(1), r2 = g_row(2), r3 = g_row(3);
        const bf16_t* Ab = H + (size_t)mt2 * 256 * 1024;
        const bf16_t* Bb = W + (size_t)nt2 * 256 * 1024;
        gemm256(p.ws, Ab + (size_t)r0 * 1024 + g_chunk(r0) * 8, Ab + (size_t)r1 * 1024 + g_chunk(r1) * 8, Ab + (size_t)r2 * 1024 + g_chunk(r2) * 8, Ab + (size_t)r3 * 1024 + g_chunk(r3) * 8,
                Bb + (size_t)b_perm(r0) * 1024 + g_chunk(r0) * 8, Bb + (size_t)b_perm(r1) * 1024 + g_chunk(r1) * 8, Bb + (size_t)b_perm(r2) * 1024 + g_chunk(r2) * 8, Bb + (size_t)b_perm(r3) * 1024 + g_chunk(r3) * 8,
                1024, smem_all, epi);
    }
    convert_weights(p, smem_all, WT_MLA_0, WT_MLA_N, (72 * 6) % (int)gridDim.x);
}

DI void phase_mla_up(const Params& p, char* smem_all) {
    char* smem = smem_all + HBI * HB_SMEM;
    const float* TM = (const float*)(p.ws + OFF_TABM);
    for (int id0 = blockIdx.x * 2; id0 < 144 * 16; id0 += gridDim.x * 2) {
        const int id = id0 + HBI;
        const int nt = (id / 144) & 7, isKV = (id / 144) >> 3, mt = id % 144, m0 = mt * 128;
        int b, t0; bool lat; row_info(m0, b, t0, lat);
        const int s0 = lat ? 256 + t0 : t0;
        if (!isKV) {
            const bf16_t* A = (const bf16_t*)(p.ws + OFF_CQ);
#undef AROW
#define AROW(o_) (A + (size_t)(m0 + (TID >> 3) + (o_)) * 384)
            auto epi = [&](const float* Cs, const float* rowss) {
                const int tid = TID, row = tid >> 1, part = tid & 1;
                const float r1 = rsqrtf(rowss[row] * (1.f / 384.f) + EPSF);
                float v[48];
                const float4* cp = (const float4*)(Cs + row * CP + part * 48);
                float ss = 0.f;
#pragma unroll
                for (int i = 0; i < 12; ++i) { float4 f = cp[i]; v[4 * i] = f.x * r1; v[4 * i + 1] = f.y * r1; v[4 * i + 2] = f.z * r1; v[4 * i + 3] = f.w * r1; }
#pragma unroll
                for (int i = 0; i < 48; ++i) ss += v[i] * v[i];
                ss += __shfl_xor(ss, 1);
                const float r2 = rsqrtf(ss * (1.f / 96.f) + EPSF);
                const float* g = p.mla_q_g + part * 48;
#pragma unroll
                for (int i = 0; i < 48; ++i) v[i] = v[i] * r2 * g[i];
                if (lat && part == 1) { int t = t0 + row; rope_apply<8>(v + 16, TM, t >> 6, t & 63); }
                const float sc = 0.10206207261596575f * LOG2E;
#pragma unroll
                for (int i = 0; i < 48; ++i) v[i] *= sc;
                bf16_t* dst = (bf16_t*)(p.ws + OFF_QM) + ((size_t)(b * 2304 + s0 + row) * 8 + nt) * 96 + part * 48;
#pragma unroll
                for (int i = 0; i < 6; ++i) *(uint4*)(dst + i * 8) = pack8(v + i * 8);
            };
            gemm_tile<true, false>(AROW(0), AROW(32), AROW(64), AROW(96), 0u, 0u, 0u, 0u, (const bf16_t*)(p.ws + OFF_WT_QB) + (size_t)nt * 128 * 384, 384, 384, smem, epi);
        } else {
            const bf16_t* A = (const bf16_t*)(p.ws + OFF_CKV);
#undef AROW
#define AROW(o_) (A + (size_t)(m0 + (TID >> 3) + (o_)) * 256)
            auto epi = [&](const float* Cs, const float* rowss) {
                const int tid = TID;
                {
                    const int row = tid >> 1, part = tid & 1;
                    const float r1 = rsqrtf(rowss[row] * (1.f / 256.f) + EPSF);
                    float v[48];
                    if (part == 0) {
                        const float4* cp = (const float4*)(Cs + row * CP);
#pragma unroll
                        for (int i = 0; i < 12; ++i) { float4 f = cp[i]; v[4 * i] = f.x * r1; v[4 * i + 1] = f.y * r1; v[4 * i + 2] = f.z * r1; v[4 * i + 3] = f.w * r1; }
                    } else {
                        const float4* cp = (const float4*)(Cs + row * CP + 48);
#pragma unroll
                        for (int i = 0; i < 4; ++i) { float4 f = cp[i]; v[4 * i] = f.x * r1; v[4 * i + 1] = f.y * r1; v[4 * i + 2] = f.z * r1; v[4 * i + 3] = f.w * r1; }
                        const float4* kp = (const float4*)((const float*)(p.ws + OFF_KR) + (size_t)(m0 + row) * 32);
#pragma unroll
                        for (int i = 0; i < 8; ++i) { float4 f = kp[i]; v[16 + 4 * i] = f.x; v[16 + 4 * i + 1] = f.y; v[16 + 4 * i + 2] = f.z; v[16 + 4 * i + 3] = f.w; }
                    }
                    float ss = 0.f;
#pragma unroll
                    for (int i = 0; i < 48; ++i) ss += v[i] * v[i];
                    ss += __shfl_xor(ss, 1);
                    const float r2 = rsqrtf(ss * (1.f / 96.f) + EPSF);
                    const float* g = p.mla_k_g + part * 48;
#pragma unroll
                    for (int i = 0; i < 48; ++i) v[i] = v[i] * r2 * g[i];
                    if (lat && part == 1) { int t = t0 + row; rope_apply<8>(v + 16, TM, t >> 6, t & 63); }
                    bf16_t* dst = (bf16_t*)(p.ws + OFF_KM) + ((size_t)(b * 2304 + s0 + row) * 8 + nt) * 96 + part * 48;
#pragma unroll
                    for (int i = 0; i < 6; ++i) *(uint4*)(dst + i * 8) = pack8(v + i * 8);
                }
                {
                    const int d = tid & 63, cg4 = (tid >> 6) * 4;
                    bf16_t* dst = (bf16_t*)(p.ws + OFF_VMT) + ((size_t)(b * 8 + nt) * 64 + d) * 2304 + s0;
#pragma unroll 1
                    for (int ch = 0; ch < 4; ++ch) {
                        float v[8];
#pragma unroll
                        for (int i = 0; i < 8; ++i) { int rr = (cg4 + ch) * 8 + i; v[i] = Cs[rr * CP + 64 + d] * rsqrtf(rowss[rr] * (1.f / 256.f) + EPSF); }
                        *(uint4*)(dst + (cg4 + ch) * 8) = pack8(v);
                    }
                }
            };
            gemm_tile<true, false>(AROW(0), AROW(32), AROW(64), AROW(96), 0u, 0u, 0u, 0u, (const bf16_t*)(p.ws + OFF_WT_KVB) + (size_t)nt * 128 * 256, 256, 256, smem, epi);
        }
    }
}

template <int DK>
DI void attn_body(const bf16_t* __restrict__ Q, int qstride, const bf16_t* __restrict__ Kp, int kstride, const bf16_t* __restrict__ VT,
                  int nkeys, bf16_t* __restrict__ Odst, char* smem, char* smem_os) {
    constexpr int KP = DK + 8, VP = 72, NST = DK / 16, KCH = DK / 8;
    constexpr int NKL = (64 * KCH) / 256;
    constexpr int STAGE = 64 * KP * 2 + 64 * VP * 2;
    const int tid = TID, lane = tid & 63, w = tid >> 6, h = lane >> 5, r = lane & 31;
    bf16x8 qf[NST];
    {
        const bf16_t* qrow = Q + (size_t)(w * 32 + r) * qstride;
#pragma unroll
        for (int st = 0; st < NST; ++st) qf[st] = *(const bf16x8*)(qrow + st * 16 + h * 8);
    }
    f32x16 o[2]; o[0] = zero16(); o[1] = zero16();
    float m = 0.f, l = 0.f;
    uint4 ak0, ak1 = make_uint4(0, 0, 0, 0), av0, bk0, bk1 = make_uint4(0, 0, 0, 0), bv0;
    const int t5 = threadIdx.x;
    const int kr0 = t5 / KCH, kc0 = t5 % KCH, kr1 = (t5 + 512) / KCH, kc1 = (t5 + 512) % KCH;
    const bool k2 = t5 + 512 < 64 * KCH;
    const int vd0 = t5 >> 3, vc0 = t5 & 7;
#define AGLOAD(P_, key0) { P_##k0 = *(const uint4*)(Kp + (size_t)((key0) + kr0) * kstride + kc0 * 8); if (k2) P_##k1 = *(const uint4*)(Kp + (size_t)((key0) + kr1) * kstride + kc1 * 8); \
                       P_##v0 = *(const uint4*)(VT + (size_t)vd0 * 2304 + (key0) + vc0 * 8); }
#define ASWRITE(P_, s_) { bf16_t* Ks_ = (bf16_t*)(smem + (s_) * STAGE); bf16_t* Vs_ = Ks_ + 64 * KP; \
                      *(uint4*)(Ks_ + kr0 * KP + kc0 * 8) = P_##k0; if (k2) *(uint4*)(Ks_ + kr1 * KP + kc1 * 8) = P_##k1; \
                      *(uint4*)(Vs_ + vd0 * VP + vc0 * 8) = P_##v0; }
    const int nkt = nkeys >> 6;
    AGLOAD(a, 0) ASWRITE(a, 0) AGLOAD(a, 64) AGLOAD(b, 128) __syncthreads();
#pragma unroll 1
    for (int kt = 0; kt < nkt; kt += 2) {
        {
            const bf16_t* Ks = (const bf16_t*)(smem);
            const bf16_t* Vs = Ks + 64 * KP;
            f32x16 s[2];
#pragma unroll
            for (int i = 0; i < 16; ++i) { s[0][i] = -m; s[1][i] = -m; }
#pragma unroll
            for (int st = 0; st < NST; ++st)
#pragma unroll
                for (int kk = 0; kk < 2; ++kk) {
                    bf16x8 a = *(const bf16x8*)(Ks + (kk * 32 + r) * KP + st * 16 + h * 8);
                    s[kk] = MFMA(a, qf[st], s[kk]);
                }
            float mx = s[0][0];
#pragma unroll
            for (int i = 0; i < 16; ++i) { mx = fmaxf(mx, s[0][i]); mx = fmaxf(mx, s[1][i]); }
            mx = fmaxf(mx, __shfl_xor(mx, 32));
            if (__any(mx > 8.f)) {
                const float d = fmaxf(mx, 0.f);
                const float alpha = __builtin_amdgcn_exp2f(-d);
                l *= alpha;
#pragma unroll
                for (int i = 0; i < 16; ++i) { o[0][i] *= alpha; o[1][i] *= alpha; s[0][i] -= d; s[1][i] -= d; }
                m += d;
            }
            float ps = 0.f;
#pragma unroll
            for (int kk = 0; kk < 2; ++kk)
#pragma unroll
                for (int i = 0; i < 16; ++i) { float pv = __builtin_amdgcn_exp2f(s[kk][i]); s[kk][i] = pv; ps += pv; }
            l += ps;
#pragma unroll
            for (int kk = 0; kk < 2; ++kk)
#pragma unroll
                for (int s2 = 0; s2 < 2; ++s2) {
                    const bf16x8 pb = pack_frag(s[kk][8 * s2 + 0], s[kk][8 * s2 + 1], s[kk][8 * s2 + 2], s[kk][8 * s2 + 3], s[kk][8 * s2 + 4], s[kk][8 * s2 + 5], s[kk][8 * s2 + 6], s[kk][8 * s2 + 7]);
#pragma unroll
                    for (int dt = 0; dt < 2; ++dt) {
                        const bf16_t* vp = Vs + (dt * 32 + r) * VP + kk * 32 + 16 * s2 + 4 * h;
                        uint2 lo = *(const uint2*)vp, hi = *(const uint2*)(vp + 8);
                        uint4 vu; vu.x = lo.x; vu.y = lo.y; vu.z = hi.x; vu.w = hi.y;
                        o[dt] = MFMA(__builtin_bit_cast(bf16x8, vu), pb, o[dt]);
                    }
                }
        }
        ASWRITE(a, 1)
        if (kt + 3 < nkt) AGLOAD(a, (kt + 3) * 64)
        LDS_BARRIER();
        {
            const bf16_t* Ks = (const bf16_t*)(smem + STAGE);
            const bf16_t* Vs = Ks + 64 * KP;
            f32x16 s[2];
#pragma unroll
            for (int i = 0; i < 16; ++i) { s[0][i] = -m; s[1][i] = -m; }
#pragma unroll
            for (int st = 0; st < NST; ++st)
#pragma unroll
                for (int kk = 0; kk < 2; ++kk) {
                    bf16x8 a = *(const bf16x8*)(Ks + (kk * 32 + r) * KP + st * 16 + h * 8);
                    s[kk] = MFMA(a, qf[st], s[kk]);
                }
            float mx = s[0][0];
#pragma unroll
            for (int i = 0; i < 16; ++i) { mx = fmaxf(mx, s[0][i]); mx = fmaxf(mx, s[1][i]); }
            mx = fmaxf(mx, __shfl_xor(mx, 32));
            if (__any(mx > 8.f)) {
                const float d = fmaxf(mx, 0.f);
                const float alpha = __builtin_amdgcn_exp2f(-d);
                l *= alpha;
#pragma unroll
                for (int i = 0; i < 16; ++i) { o[0][i] *= alpha; o[1][i] *= alpha; s[0][i] -= d; s[1][i] -= d; }
                m += d;
            }
            float ps = 0.f;
#pragma unroll
            for (int kk = 0; kk < 2; ++kk)
#pragma unroll
                for (int i = 0; i < 16; ++i) { float pv = __builtin_amdgcn_exp2f(s[kk][i]); s[kk][i] = pv; ps += pv; }
            l += ps;
#pragma unroll
            for (int kk = 0; kk < 2; ++kk)
#pragma unroll
                for (int s2 = 0; s2 < 2; ++s2) {
                    const bf16x8 pb = pack_frag(s[kk][8 * s2 + 0], s[kk][8 * s2 + 1], s[kk][8 * s2 + 2], s[kk][8 * s2 + 3], s[kk][8 * s2 + 4], s[kk][8 * s2 + 5], s[kk][8 * s2 + 6], s[kk][8 * s2 + 7]);
#pragma unroll
                    for (int dt = 0; dt < 2; ++dt) {
                        const bf16_t* vp = Vs + (dt * 32 + r) * VP + kk * 32 + 16 * s2 + 4 * h;
                        uint2 lo = *(const uint2*)vp, hi = *(const uint2*)(vp + 8);
                        uint4 vu; vu.x = lo.x; vu.y = lo.y; vu.z = hi.x; vu.w = hi.y;
                        o[dt] = MFMA(__builtin_bit_cast(bf16x8, vu), pb, o[dt]);
                    }
                }
        }
        if (kt + 2 < nkt) ASWRITE(b, 0)
        if (kt + 4 < nkt) AGLOAD(b, (kt + 4) * 64)
        LDS_BARRIER();
    }
#undef AGLOAD
#undef ASWRITE
    l += __shfl_xor(l, 32);
    const float inv = 1.f / l;
    bf16_t* Os = (bf16_t*)smem_os + (size_t)w * 32 * 72;
#pragma unroll
    for (int dt = 0; dt < 2; ++dt)
#pragma unroll
        for (int g = 0; g < 4; ++g) {
            uint2 u; u.x = pack2(o[dt][4 * g] * inv, o[dt][4 * g + 1] * inv); u.y = pack2(o[dt][4 * g + 2] * inv, o[dt][4 * g + 3] * inv);
            *(uint2*)(Os + r * 72 + dt * 32 + 8 * g + 4 * h) = u;
        }
    __syncthreads();
#pragma unroll
    for (int j = 0; j < 4; ++j) {
        int c = lane + 64 * j, row = c >> 3, cc = c & 7;
        uint4 u = *(const uint4*)(Os + row * 72 + cc * 8);
        *(uint4*)(Odst + (size_t)(w * 32 + row) * 1024 + cc * 8) = u;
    }
    __syncthreads();
}

DI void phase_attn(const Params& p, char* smem_all) {
    char* smem = smem_all;
    char* smem_os = smem_all + 65536 + HBI * 20480;
    bf16_t* O = (bf16_t*)(p.ws + OFF_H);
    for (int it0 = blockIdx.x * 2; it0 < 2304; it0 += gridDim.x * 2) {
        const int item = it0 + HBI;
        int b, kind, hq, qb, nkeys, sq0, orow;
        if (item < 2048) { qb = item & 15; hq = (item >> 4) & 7; kind = (item >> 7) & 1; b = item >> 8; sq0 = 256 + qb * 128; nkeys = 2304; orow = b * 2048 + qb * 128; }
        else { int it = item - 2048; qb = it & 1; hq = (it >> 1) & 7; kind = (it >> 4) & 1; b = it >> 5; sq0 = qb * 128; nkeys = 256; orow = 16384 + b * 256 + qb * 128; }
        bf16_t* od = O + (size_t)orow * 1024 + kind * 512 + hq * 64;
        if (kind == 0) {
            const bf16_t* Q = (const bf16_t*)(p.ws + OFF_QM) + ((size_t)(b * 2304 + sq0) * 8 + hq) * 96;
            const bf16_t* K = (const bf16_t*)(p.ws + OFF_KM) + ((size_t)(b * 2304) * 8 + hq) * 96;
            const bf16_t* VT = (const bf16_t*)(p.ws + OFF_VMT) + (size_t)(b * 8 + hq) * 64 * 2304;
            attn_body<96>(Q, 768, K, 768, VT, nkeys, od, smem, smem_os);
        } else {
            const int kvh = hq >> 2;
            const bf16_t* Q = (const bf16_t*)(p.ws + OFF_QG) + ((size_t)(b * 2304 + sq0) * 8 + hq) * 64;
            const bf16_t* K = (const bf16_t*)(p.ws + OFF_KG) + ((size_t)(b * 2304) * 2 + kvh) * 64;
            const bf16_t* VT = (const bf16_t*)(p.ws + OFF_VGT) + (size_t)(b * 2 + kvh) * 64 * 2304;
            attn_body<64>(Q, 512, K, 128, VT, nkeys, od, smem, smem_os);
        }
    }
    convert_weights(p, smem_all, WT_OUT0_0, WT_OUT0_N, 1152 % (int)gridDim.x);
}

DI void phase_proj_resid(const Params& p, const bf16_t* A, int K, const bf16_t* W, const float* mod, int gate_idx,
                         const float* srcLat, const float* srcCtx, float* dstLat, float* dstCtx, int mtiles2, bool ctx_small, int conv_t0, int conv_cnt, char* smem_all) {
    for (int id = blockIdx.x; id < mtiles2 * 4; id += gridDim.x) {
        const int nt2 = id / mtiles2, mt2 = id % mtiles2;
        auto epi = [&](const float* Cs, int si, int sj, int tid) {
            const int nt = 2 * nt2 + sj, m0 = (2 * mt2 + si) * 128;
            const float* src; float* dst; int mb;
            if (m0 < 16384) { src = srcLat + (size_t)m0 * 1024; dst = dstLat + (size_t)m0 * 1024; mb = m0 >> 11; }
            else { src = srcCtx + (size_t)(m0 - 16384) * 1024; dst = dstCtx + (size_t)(m0 - 16384) * 1024; mb = 8; }
            epi_resid(Cs, src + nt * 128, dst + nt * 128, mod + (size_t)mb * 6144 + gate_idx * 1024 + nt * 128, tid);
        };
        const int r0 = g_row(0), r1 = g_row(1), r2 = g_row(2), r3 = g_row(3);
        const bf16_t* Ab = A + (size_t)mt2 * 256 * K;
        const bf16_t* Bb = W + (size_t)nt2 * 256 * K;
        gemm256(p.ws, Ab + (size_t)r0 * K + g_chunk(r0) * 8, Ab + (size_t)r1 * K + g_chunk(r1) * 8, Ab + (size_t)r2 * K + g_chunk(r2) * 8, Ab + (size_t)r3 * K + g_chunk(r3) * 8,
                Bb + (size_t)b_perm(r0) * K + g_chunk(r0) * 8, Bb + (size_t)b_perm(r1) * K + g_chunk(r1) * 8, Bb + (size_t)b_perm(r2) * K + g_chunk(r2) * 8, Bb + (size_t)b_perm(r3) * K + g_chunk(r3) * 8,
                K, smem_all, epi);
    }
    if (ctx_small) {
        for (int hq = blockIdx.x; hq < 64; hq += gridDim.x) {
            const int mt2 = 64 + (hq >> 3), nt = hq & 7;
            auto epi = [&](const float* Cs, int si, int, int tid) {
                const int m0 = (2 * mt2 + si) * 128 - 16384;
                epi_resid(Cs, srcCtx + (size_t)m0 * 1024 + nt * 128, dstCtx + (size_t)m0 * 1024 + nt * 128, mod + (size_t)8 * 6144 + gate_idx * 1024 + nt * 128, tid);
            };
            const int r0 = g_row(0), r1 = g_row(1), r2 = g_row(2), r3 = g_row(3);
            const bf16_t* Ab = A + (size_t)mt2 * 256 * K;
            const bf16_t* Bb = W + (size_t)nt * 128 * K;
            gemm256<0>(p.ws, Ab + (size_t)r0 * K + g_chunk(r0) * 8, Ab + (size_t)r1 * K + g_chunk(r1) * 8, Ab + (size_t)r2 * K + g_chunk(r2) * 8, Ab + (size_t)r3 * K + g_chunk(r3) * 8,
                       Bb + (size_t)b_perm(r0) * K + g_chunk(r0) * 8, Bb + (size_t)b_perm(r1) * K + g_chunk(r1) * 8, Bb + (size_t)b_perm(r2) * K + g_chunk(r2) * 8, Bb + (size_t)b_perm(r3) * K + g_chunk(r3) * 8,
                       K, smem_all, epi);
        }
    }
    if (conv_cnt) convert_weights(p, smem_all, conv_t0, conv_cnt, 64);
}

DI float4 conv4(float4 w0, float4 w1, float4 w2, float4 bb, float4 gm, float4 g0, float4 gp, float4 v) {
    float4 o;
    o.x = siluf_(w0.x * gm.x + w1.x * g0.x + w2.x * gp.x + bb.x) * v.x;
    o.y = siluf_(w0.y * gm.y + w1.y * g0.y + w2.y * gp.y + bb.y) * v.y;
    o.z = siluf_(w0.z * gm.z + w1.z * g0.z + w2.z * gp.z + bb.z) * v.z;
    o.w = siluf_(w0.w * gm.w + w1.w * g0.w + w2.w * gp.w + bb.w) * v.w;
    return o;
}
DI void halo_info(int mt, int& base, int& T, int& tstart) {
    int ti;
    if (mt < 136) { base = (mt / 17) * 2048; T = 2048; ti = mt % 17; }
    else { int q = mt - 136; base = 16384 + (q / 3) * 256; T = 256; ti = q % 3; }
    tstart = 126 * ti - 1;
}
DI const bf16_t* halo_ptr(const bf16_t* H, const bf16_t* Z, int mt2, int row) {
    int base, T, tstart; halo_info(2 * mt2 + (row >> 7), base, T, tstart);
    const int t = tstart + (row & 127);
    return (t >= 0 && t < T) ? H + (size_t)(base + t) * 1024 + g_chunk(row) * 8 : Z;
}
DI void phase_ffn_up(const Params& p, const bf16_t* W, const float* convw, const float* convb, int mtiles2, int conv_t0, int conv_cnt, char* smem_all) {
    const bf16_t* H = (const bf16_t*)(p.ws + OFF_H);
    const bf16_t* Z = (const bf16_t*)(p.ws + OFF_ZROW);
    bf16_t* ACT = (bf16_t*)(p.ws + OFF_ACT);
    for (int id = blockIdx.x; id < mtiles2 * 22; id += gridDim.x) {
        const int nt2 = id / mtiles2, mt2 = id % mtiles2;
        auto epi = [&](const float* Cs, int si, int sj, int tid) {
            const int nt = 2 * nt2 + sj;
            int base, T, tstart; halo_info(2 * mt2 + si, base, T, tstart);
            const int cc = tid & 7;
            const int cg0 = nt * 64 + cc * 8;
            const float4 w0a = *(const float4*)(convw + cg0), w0b = *(const float4*)(convw + cg0 + 4);
            const float4 w1a = *(const float4*)(convw + 2816 + cg0), w1b = *(const float4*)(convw + 2816 + cg0 + 4);
            const float4 w2a = *(const float4*)(convw + 5632 + cg0), w2b = *(const float4*)(convw + 5632 + cg0 + 4);
            const float4 bba = *(const float4*)(convb + cg0), bbb = *(const float4*)(convb + cg0 + 4);
#pragma unroll
            for (int j = 0; j < 4; ++j) {
                const int rr = (tid >> 3) + 32 * j, t = tstart + rr;
                if (rr >= 1 && rr <= 126 && t < T) {
                    const float4* a = (const float4*)(Cs + (rr - 1) * CP + cc * 8);
                    const float4* bq = (const float4*)(Cs + rr * CP + cc * 8);
                    const float4* c = (const float4*)(Cs + (rr + 1) * CP + cc * 8);
                    const float4* d = (const float4*)(Cs + rr * CP + 64 + cc * 8);
                    const float4 oa = conv4(w0a, w1a, w2a, bba, a[0], bq[0], c[0], d[0]);
                    const float4 ob = conv4(w0b, w1b, w2b, bbb, a[1], bq[1], c[1], d[1]);
                    uint4 u; u.x = pack2(oa.x, oa.y); u.y = pack2(oa.z, oa.w); u.z = pack2(ob.x, ob.y); u.w = pack2(ob.z, ob.w);
                    *(uint4*)(ACT + (size_t)(base + t) * 2816 + cg0) = u;
                }
            }
        };
        const int r0 = g_row(0), r1 = g_row(1), r2 = g_row(2), r3 = g_row(3);
        const bf16_t* Bb = W + (size_t)nt2 * 256 * 1024;
        gemm256(p.ws, halo_ptr(H, Z, mt2, r0), halo_ptr(H, Z, mt2, r1), halo_ptr(H, Z, mt2, r2), halo_ptr(H, Z, mt2, r3),
                Bb + (size_t)b_perm(r0) * 1024 + g_chunk(r0) * 8, Bb + (size_t)b_perm(r1) * 1024 + g_chunk(r1) * 8, Bb + (size_t)b_perm(r2) * 1024 + g_chunk(r2) * 8, Bb + (size_t)b_perm(r3) * 1024 + g_chunk(r3) * 8,
                1024, smem_all, epi);
    }
    if (conv_cnt) convert_weights(p, smem_all, conv_t0, conv_cnt, (mtiles2 * 22) % (int)gridDim.x);
}

DI void inproj1_epi(const Params& p, const float* Cs, int nt, int m0, int tid) {
    if (nt < 8) epi_store_bf16(Cs, (bf16_t*)(p.ws + OFF_QKRAW) + (size_t)m0 * 1024 + nt * 128, 1024, tid);
    else if (nt < 16) epi_store_bf16(Cs, (bf16_t*)(p.ws + OFF_V1) + (size_t)m0 * 1024 + (nt - 8) * 128, 1024, tid);
    else if (nt < 24) epi_store_bf16(Cs, (bf16_t*)(p.ws + OFF_OG) + (size_t)m0 * 1024 + (nt - 16) * 128, 1024, tid);
    else if (nt == 24) {
        const int row = tid >> 1, half = tid & 1;
        float* dst = (float*)(p.ws + OFF_GATES) + (size_t)(m0 + row) * 32 + half * 16;
#pragma unroll 4
        for (int i = 0; i < 16; ++i) {
            int c = half * 16 + i;
            float v = Cs[row * CP + c] + p.ml_gate_b[c];
            if (c & 8) v = logsigmoidf_(v);
            dst[i] = v;
        }
    }
}
DI void inproj1_tile_of(int f, int& nt2, int& mt2) { if (f < 576) { nt2 = f / 72; mt2 = f % 72; } else { const int g = f - 576; nt2 = 8 + g / 64; mt2 = g % 64; } }
DI void phase_inproj1(const Params& p, char* smem_all) {
    const bf16_t* H = (const bf16_t*)(p.ws + OFF_H);
    const bf16_t* W = (const bf16_t*)(p.ws + OFF_WT_IN1);
    const int G = gridDim.x, nfr = 832 / G, rem = 832 - nfr * G, nhalf = 2 * rem + 72;
    const int r0 = g_row(0), r1 = g_row(1), r2 = g_row(2), r3 = g_row(3);
#define IN1_ARGS p.ws, Ab + (size_t)r0 * 1024 + g_chunk(r0) * 8, Ab + (size_t)r1 * 1024 + g_chunk(r1) * 8, Ab + (size_t)r2 * 1024 + g_chunk(r2) * 8, Ab + (size_t)r3 * 1024 + g_chunk(r3) * 8, \
                Bb + (size_t)b_perm(r0) * 1024 + g_chunk(r0) * 8, Bb + (size_t)b_perm(r1) * 1024 + g_chunk(r1) * 8, Bb + (size_t)b_perm(r2) * 1024 + g_chunk(r2) * 8, Bb + (size_t)b_perm(r3) * 1024 + g_chunk(r3) * 8, \
                1024, smem_all, epi
    for (int trip = 0; trip < nfr; ++trip) {
        int nt2, mt2; inproj1_tile_of(trip * G + blockIdx.x, nt2, mt2);
        auto epi = [&](const float* Cs, int si, int sj, int tid) { inproj1_epi(p, Cs, 2 * nt2 + sj, (2 * mt2 + si) * 128, tid); };
        const bf16_t* Ab = H + (size_t)mt2 * 256 * 1024;
        const bf16_t* Bb = W + (size_t)nt2 * 256 * 1024;
        gemm256<-1>(IN1_ARGS);
    }
    for (int hq = blockIdx.x; hq < nhalf; hq += G) {
        int nt2, mt2, nh;
        if (hq < 2 * rem) { inproj1_tile_of(nfr * G + (hq >> 1), nt2, mt2); nh = hq & 1; } else { nt2 = 12; mt2 = hq - 2 * rem; nh = 0; }
        auto epi = [&](const float* Cs, int si, int, int tid) { inproj1_epi(p, Cs, 2 * nt2 + nh, (2 * mt2 + si) * 128, tid); };
        const bf16_t* Ab = H + (size_t)mt2 * 256 * 1024;
        const bf16_t* Bb = W + ((size_t)nt2 * 256 + nh * 128) * 1024;
        gemm256<0>(IN1_ARGS);
    }
#undef IN1_ARGS
}

DI void phase_qkconv(const Params& p) {
    const bf16_t* QK = (const bf16_t*)(p.ws + OFF_QKRAW);
    bf16_t* QC = (bf16_t*)(p.ws + OFF_H);
    {
        const int lane = threadIdx.x & 63, gw = blockIdx.x * 8 + (threadIdx.x >> 6);
        const float* GT = (const float*)(p.ws + OFF_GATES);
        float* SC = (float*)(p.ws + OFF_SCAN);
        for (int seg = gw; seg < 2304; seg += gridDim.x * 8) {
            const int step = seg % 18, dir = (seg / 18) & 1, hd = (seg / 36) & 7, b = seg / 288;
            int base, P0;
            if (step < 2) { base = 16384 + b * 256; P0 = (dir ? 1 - step : step) * 128; } else { base = b * 2048; P0 = (dir ? 17 - step : step - 2) * 128; }
            const int pa = dir ? P0 + 127 - lane : P0 + lane, pb = dir ? pa - 64 : pa + 64;
            const float* ga = GT + (size_t)(base + pa) * 32 + dir * 16 + hd; const float* gb = GT + (size_t)(base + pb) * 32 + dir * 16 + hd;
            const float i0 = ga[0], f0 = ga[8], i1 = gb[0], f1 = gb[8];
            float b0 = f0, b1 = f1;
#pragma unroll
            for (int off = 1; off < 64; off <<= 1) { float t0 = __shfl_up(b0, off), t1 = __shfl_up(b1, off); if (lane >= off) { b0 += t0; b1 += t1; } }
            b1 += __shfl(b0, 63);
            float p0 = i0 - b0, p1 = i1 - b1;
            const float c0 = p0, c1 = p1;
#pragma unroll
            for (int off = 1; off < 64; off <<= 1) { float t0 = __shfl_up(p0, off), t1 = __shfl_up(p1, off); if (lane >= off) { p0 = fmaxf(p0, t0); p1 = fmaxf(p1, t1); } }
            p1 = fmaxf(p1, __shfl(p0, 63));
            float* o = SC + (size_t)seg * 384;
            o[lane] = b0; o[64 + lane] = b1; o[128 + lane] = p0; o[192 + lane] = p1; o[256 + lane] = c0; o[320 + lane] = c1;
        }
    }
    for (int c = blockIdx.x * NTHREADS + threadIdx.x; c < 18432 * 128; c += gridDim.x * NTHREADS) {
        const int row = c >> 7, col = (c & 127) * 8;
        int T, t;
        if (row < 16384) { T = 2048; t = row & 2047; } else { T = 256; t = (row - 16384) & 255; }
        float acc[8];
        { const float4 b0 = *(const float4*)(p.ml_conv_b + col), b1 = *(const float4*)(p.ml_conv_b + col + 4);
          acc[0] = b0.x; acc[1] = b0.y; acc[2] = b0.z; acc[3] = b0.w; acc[4] = b1.x; acc[5] = b1.y; acc[6] = b1.z; acc[7] = b1.w; }
#pragma unroll
        for (int dj = 0; dj < 3; ++dj) {
            const int tt = t + dj - 1;
            const float on = (tt >= 0 && tt < T) ? 1.f : 0.f;
            const int rr = row + min(max(tt, 0), T - 1) - t;
            float f[8]; unpack8(*(const uint4*)(QK + (size_t)rr * 1024 + col), f);
            const float4 w0 = *(const float4*)(p.ml_conv_w + dj * 1024 + col), w1 = *(const float4*)(p.ml_conv_w + dj * 1024 + col + 4);
            acc[0] += w0.x * on * f[0]; acc[1] += w0.y * on * f[1]; acc[2] += w0.z * on * f[2]; acc[3] += w0.w * on * f[3];
            acc[4] += w1.x * on * f[4]; acc[5] += w1.y * on * f[5]; acc[6] += w1.z * on * f[6]; acc[7] += w1.w * on * f[7];
        }
        const float sc = col >= 512 ? 0.125f : 1.f;
#pragma unroll
        for (int i = 0; i < 8; ++i) acc[i] = siluf_(acc[i]) * sc;
        *(uint4*)(QC + (size_t)row * 1024 + col) = pack8(acc);
    }
}

DI void phase_mlstm(const Params& p, char* smem) {
    constexpr int LP = 72, TP = 136, L = 128;
    bf16_t* Qc = (bf16_t*)smem;
    bf16_t* Kc = Qc + L * LP;
    bf16_t* KcT = Kc + L * LP;
    bf16_t* VcT = KcT + 64 * TP;
    bf16_t* VwT = VcT + 64 * TP;
    bf16_t* Pm = VwT + 64 * TP;
    bf16_t* Cb = Pm + L * TP;
    float* fa = (float*)(Cb + 64 * LP);
    float* bcum = fa; float* ig = fa + 128; float* mtv = fa + 256; float* wint = fa + 384; float* denI = fa + 512; float* denX = fa + 640;
    float* wgt = fa + 768; float* nvec = fa + 896; float* scal = fa + 960; float* csv = fa + 1024; float* denP = fa + 1152;
    static_assert((2 * L * LP + 3 * 64 * TP + L * TP + 64 * LP) * 2 + 1408 * 4 <= SMEM_ALL, "mLSTM LDS");
    const int lane0 = threadIdx.x & 63, w = __builtin_amdgcn_readfirstlane(threadIdx.x >> 6);
    const bf16_t* QK = (const bf16_t*)(p.ws + OFF_H);
    const bf16_t* V1 = (const bf16_t*)(p.ws + OFF_V1);
    const float* GT = (const float*)(p.ws + OFF_GATES);
    for (int item = blockIdx.x; item < 256; item += gridDim.x) {
        const int vh = item & 1, dir = (item >> 1) & 1, hd = (item >> 2) & 7, b = item >> 5;
        bf16_t* Hout = (bf16_t*)(p.ws + (dir ? OFF_HB : OFF_HF));
        f32x16 accC = zero16();
        float m_prev = 0.f;
        for (int i = w * 64 + lane0; i < 64 * LP; i += 512) Cb[i] = 0;
        if (w == 0) nvec[lane0] = 0.f;
        int lane = lane0, tid = w * 64 + lane0, h = lane0 >> 5, r = lane0 & 31;
        int u = tid >> 2, part = tid & 3;
        uint4 rq0, rq1, rk0, rk1, rv0, rv1;
        float sc_b = 0.f, sc_p = 0.f, sc_c = 0.f, sc_bl = 0.f, sc_pl = 0.f;
#define ML_STEP_GEOM(st, base_, P0_) { if ((st) < 2) { base_ = 16384 + b * 256; P0_ = (dir ? 1 - (st) : (st)) * L; } else { base_ = b * 2048; P0_ = (dir ? 17 - (st) : (st) - 2) * L; } }
#define ML_PREFETCH(st) { int base_, P0_; ML_STEP_GEOM(st, base_, P0_) \
            const int pos_ = dir ? P0_ + L - 1 - u : P0_ + u; \
            { const bf16_t* rowp = QK + (size_t)(base_ + pos_) * 1024; \
              const int qcol = hd * 64 + part * 16, kcol = 512 + qcol; rq0 = *(const uint4*)(rowp + qcol); rq1 = *(const uint4*)(rowp + qcol + 8); rk0 = *(const uint4*)(rowp + kcol); rk1 = *(const uint4*)(rowp + kcol + 8); } \
            { const bf16_t* vp_ = V1 + (size_t)(base_ + pos_) * 1024 + hd * 128 + vh * 64 + part * 16; rv0 = *(const uint4*)vp_; rv1 = *(const uint4*)(vp_ + 8); } \
            if (w < 2) { const float* sp_ = (const float*)(p.ws + OFF_SCAN) + (size_t)((((b * 8 + hd) * 2 + dir) * 18) + (st)) * 384; \
                sc_b = sp_[tid]; sc_p = sp_[128 + tid]; sc_c = sp_[256 + tid]; sc_bl = sp_[127]; sc_pl = sp_[255]; } }
        ML_PREFETCH(0)
        __syncthreads();
#pragma unroll 1
        for (int step = 0; step < 18; ++step) {
            lane = lane0; asm volatile("" : "+v"(lane));
            tid = w * 64 + lane; h = lane >> 5; r = lane & 31; u = tid >> 2; part = tid & 3;
            int base, P0; ML_STEP_GEOM(step, base, P0)
            const bool full = step >= 2;
            if (w < 2) {
                const float mt = fmaxf(sc_b + m_prev, sc_b + sc_p);
                const float mnew = fmaxf(sc_bl + m_prev, sc_bl + sc_pl);
                bcum[tid] = sc_b; csv[tid] = sc_c; mtv[tid] = mt;
                wint[tid] = __expf(sc_b + m_prev - mt);
                wgt[tid] = __expf(sc_bl + sc_c - mnew);
                if (tid == 0) { scal[0] = mnew; scal[1] = __expf(sc_bl + m_prev - mnew); }
            }
            {
                *(uint4*)(Qc + u * LP + part * 16) = rq0; *(uint4*)(Qc + u * LP + part * 16 + 8) = rq1;
                *(uint4*)(Kc + u * LP + part * 16) = rk0; *(uint4*)(Kc + u * LP + part * 16 + 8) = rk1;
#define ML_T2(dstT, wv, ci) { dstT[(part * 16 + (ci)) * TP + u] = (bf16_t)((wv) & 0xffffu); dstT[(part * 16 + (ci) + 1) * TP + u] = (bf16_t)((wv) >> 16); }
                ML_T2(KcT, rk0.x, 0) ML_T2(KcT, rk0.y, 2) ML_T2(KcT, rk0.z, 4) ML_T2(KcT, rk0.w, 6) ML_T2(KcT, rk1.x, 8) ML_T2(KcT, rk1.y, 10) ML_T2(KcT, rk1.z, 12) ML_T2(KcT, rk1.w, 14)
                ML_T2(VcT, rv0.x, 0) ML_T2(VcT, rv0.y, 2) ML_T2(VcT, rv0.z, 4) ML_T2(VcT, rv0.w, 6) ML_T2(VcT, rv1.x, 8) ML_T2(VcT, rv1.y, 10) ML_T2(VcT, rv1.z, 12) ML_T2(VcT, rv1.w, 14)
#undef ML_T2
            }
            if (step + 1 < 18) ML_PREFETCH(step + 1)
            LDS_BARRIER();
            const float m_new = scal[0], decay = scal[1];
            {
                const int vv = tid >> 3, s0_ = (tid & 7) * 16;
#pragma unroll
                for (int q = 0; q < 2; ++q) {
                    float f[8]; unpack8(*(const uint4*)(VcT + vv * TP + s0_ + q * 8), f);
                    const float4 w0 = *(const float4*)(wgt + s0_ + q * 8), w1 = *(const float4*)(wgt + s0_ + q * 8 + 4);
                    f[0] *= w0.x; f[1] *= w0.y; f[2] *= w0.z; f[3] *= w0.w; f[4] *= w1.x; f[5] *= w1.y; f[6] *= w1.z; f[7] *= w1.w;
                    *(uint4*)(VwT + vv * TP + s0_ + q * 8) = pack8(f);
                }
            }
            if (full) {
                {
                    float sacc_ = 0.f;
#pragma unroll
                    for (int q = 0; q < 2; ++q) {
                        float f[8]; unpack8(*(const uint4*)(Qc + u * LP + part * 16 + q * 8), f);
                        const float4 n0 = *(const float4*)(nvec + part * 16 + q * 8), n1 = *(const float4*)(nvec + part * 16 + q * 8 + 4);
                        sacc_ += f[0] * n0.x + f[1] * n0.y + f[2] * n0.z + f[3] * n0.w + f[4] * n1.x + f[5] * n1.y + f[6] * n1.z + f[7] * n1.w;
                    }
                    sacc_ += __shfl_xor(sacc_, 1); sacc_ += __shfl_xor(sacc_, 2);
                    if (part == 0) denX[u] = sacc_;
                }
                const int ti = w >> 1, t = ti * 32 + r;
                const float bt = bcum[t] - mtv[t];
                float rs = 0.f;
#pragma unroll
                for (int q = 0; q < 2; ++q) {
                    const int si = 2 * (w & 1) + q;
                    if (si <= ti) {
                        f32x16 sacc = zero16();
#pragma unroll
                        for (int ks = 0; ks < 4; ++ks) {
                            bf16x8 a = *(const bf16x8*)(Kc + (si * 32 + r) * LP + ks * 16 + h * 8);
                            bf16x8 bb = *(const bf16x8*)(Qc + (ti * 32 + r) * LP + ks * 16 + h * 8);
                            sacc = MFMA(a, bb, sacc);
                        }
#pragma unroll
                        for (int g4 = 0; g4 < 4; ++g4) {
                            const int s0_ = si * 32 + 8 * g4 + 4 * h;
                            const float4 c4 = *(const float4*)(csv + s0_);
                            float p0 = s0_ + 0 <= t ? sacc[4 * g4 + 0] * __expf(bt + c4.x) : 0.f;
                            float p1 = s0_ + 1 <= t ? sacc[4 * g4 + 1] * __expf(bt + c4.y) : 0.f;
                            float p2 = s0_ + 2 <= t ? sacc[4 * g4 + 2] * __expf(bt + c4.z) : 0.f;
                            float p3 = s0_ + 3 <= t ? sacc[4 * g4 + 3] * __expf(bt + c4.w) : 0.f;
                            rs += (p0 + p1) + (p2 + p3);
                            uint2 pk; pk.x = pack2(p0, p1); pk.y = pack2(p2, p3);
                            *(uint2*)(Pm + t * TP + s0_) = pk;
                        }
                    } else {
#pragma unroll
                        for (int g4 = 0; g4 < 4; ++g4) *(uint2*)(Pm + t * TP + si * 32 + 8 * g4 + 4 * h) = make_uint2(0u, 0u);
                    }
                }
                rs += __shfl_xor(rs, 32);
                if (h == 0) denP[(w & 1) * 128 + t] = rs;
            }
            LDS_BARRIER();
            f32x16 hacc = zero16();
            const int ti = w >> 1, vi = w & 1;
            if (full) {
#pragma unroll
                for (int ks = 0; ks < 4; ++ks) {
                    bf16x8 a = *(const bf16x8*)(Cb + (vi * 32 + r) * LP + ks * 16 + h * 8);
                    bf16x8 bb = *(const bf16x8*)(Qc + (ti * 32 + r) * LP + ks * 16 + h * 8);
                    hacc = MFMA(a, bb, hacc);
                }
                const float wi = wint[ti * 32 + r];
#pragma unroll
                for (int g = 0; g < 16; ++g) hacc[g] *= wi;
#pragma unroll
                for (int ks = 0; ks < 8; ++ks) {
                    if (ks <= 2 * ti + 1) {
                        bf16x8 a = *(const bf16x8*)(VcT + (vi * 32 + r) * TP + ks * 16 + h * 8);
                        bf16x8 bb = *(const bf16x8*)(Pm + (ti * 32 + r) * TP + ks * 16 + h * 8);
                        hacc = MFMA(a, bb, hacc);
                    }
                }
            }
            LDS_BARRIER();
            if (full) {
                const int t = ti * 32 + r;
                const float den = wint[t] * denX[t] + denP[t] + denP[128 + t];
                const float inv = __builtin_amdgcn_rcpf(fmaxf(fabsf(den), __expf(-mtv[t])));
                bf16_t* hp = Pm + t * LP + vi * 32 + 4 * h;
#pragma unroll
                for (int g4 = 0; g4 < 4; ++g4) {
                    uint2 pk; pk.x = pack2(hacc[4 * g4] * inv, hacc[4 * g4 + 1] * inv); pk.y = pack2(hacc[4 * g4 + 2] * inv, hacc[4 * g4 + 3] * inv);
                    *(uint2*)(hp + 8 * g4) = pk;
                }
            }
            if (w < 4) {
                const int vi2 = w >> 1, di = w & 1;
#pragma unroll
                for (int g = 0; g < 16; ++g) accC[g] *= decay;
#pragma unroll
                for (int ks = 0; ks < 8; ++ks) {
                    bf16x8 a = *(const bf16x8*)(VwT + (vi2 * 32 + r) * TP + ks * 16 + h * 8);
                    bf16x8 bb = *(const bf16x8*)(KcT + (di * 32 + r) * TP + ks * 16 + h * 8);
                    accC = MFMA(a, bb, accC);
                }
#pragma unroll
                for (int g = 0; g < 16; ++g) Cb[(vi2 * 32 + crow(g, h)) * LP + di * 32 + r] = f2bf_sw(accC[g]);
            } else {
                const int t2 = tid - 256, d = t2 >> 2, pq = t2 & 3;
                float sacc_ = 0.f;
#pragma unroll
                for (int q = 0; q < 4; ++q) {
                    float f[8]; unpack8(*(const uint4*)(KcT + d * TP + pq * 32 + q * 8), f);
                    const float4 w0 = *(const float4*)(wgt + pq * 32 + q * 8), w1 = *(const float4*)(wgt + pq * 32 + q * 8 + 4);
                    sacc_ += f[0] * w0.x + f[1] * w0.y + f[2] * w0.z + f[3] * w0.w + f[4] * w1.x + f[5] * w1.y + f[6] * w1.z + f[7] * w1.w;
                }
                sacc_ += __shfl_xor(sacc_, 1); sacc_ += __shfl_xor(sacc_, 2);
                if (pq == 0) nvec[d] = decay * nvec[d] + sacc_;
            }
            m_prev = m_new;
            LDS_BARRIER();
            if (full) {
#pragma unroll
                for (int q = 0; q < 2; ++q) {
                    const int c = tid + 512 * q, t = c >> 3, ch = c & 7;
                    const int pos = dir ? P0 + L - 1 - t : P0 + t;
                    *(uint4*)(Hout + (size_t)(base + pos) * 1024 + hd * 128 + vh * 64 + ch * 8) = *(const uint4*)(Pm + t * LP + ch * 8);
                }
            }
        }
#undef ML_STEP_GEOM
#undef ML_PREFETCH
    }
}

DI void phase_mix(const Params& p) {
    const int lane = threadIdx.x & 63, w = threadIdx.x >> 6;
    const bf16_t* HF = (const bf16_t*)(p.ws + OFF_HF);
    const bf16_t* HB = (const bf16_t*)(p.ws + OFF_HB);
    const bf16_t* OG = (const bf16_t*)(p.ws + OFF_OG);
    bf16_t* H = (bf16_t*)(p.ws + OFF_H);
    for (int row = blockIdx.x * 8 + w; row < 16384; row += gridDim.x * 8) {
        const size_t o = (size_t)row * 1024 + lane * 16;
        float a[16], bq[16], og[16];
        unpack8(*(const uint4*)(HF + o), a); unpack8(*(const uint4*)(HF + o + 8), a + 8);
        unpack8(*(const uint4*)(HB + o), bq); unpack8(*(const uint4*)(HB + o + 8), bq + 8);
        unpack8(*(const uint4*)(OG + o), og); unpack8(*(const uint4*)(OG + o + 8), og + 8);
        float ss = 0.f;
#pragma unroll
        for (int i = 0; i < 16; ++i) { a[i] += bq[i]; ss += a[i] * a[i]; }
        ss += __shfl_xor(ss, 1); ss += __shfl_xor(ss, 2); ss += __shfl_xor(ss, 4);
        const float rstd = rsqrtf(ss * (1.f / 128.f) + EPSF);
        const float* g = p.ml_out_g + lane * 16;
#pragma unroll
        for (int i = 0; i < 16; ++i) a[i] = a[i] * rstd * g[i] * sigmoidf_(og[i]);
        *(uint4*)(H + o) = pack8(a); *(uint4*)(H + o + 8) = pack8(a + 8);
    }
}

#define XB_TMO      128
#define XB_XCNT(j)  (256  + 64 * (j))
#define XB_XSUB(j)  (1280 + 64 * (j))
#define XB_XGEN(j)  (2304 + 64 * (j))
#define XB_TOP      3328
#define XB_TOPGEN   3392
#define XCD_BAR_WORDS 3456
#define XB_SPIN_CAP (1u << 18)
#define LAS __attribute__((address_space(3)))

__device__ __forceinline__ unsigned xb_ld(unsigned* p)              { return __hip_atomic_load(p, __ATOMIC_RELAXED, __HIP_MEMORY_SCOPE_AGENT); }
__device__ __forceinline__ unsigned xb_add(unsigned* p, unsigned v) { return __hip_atomic_fetch_add(p, v, __ATOMIC_RELAXED, __HIP_MEMORY_SCOPE_AGENT); }
__device__ __forceinline__ unsigned xb_xcc_id() { return (unsigned)__builtin_amdgcn_s_getreg((3 << 11) | 20) & 0xFu; }
#define XB_SPIN(cond, bar) do { unsigned _sp = 0; while (cond) { __builtin_amdgcn_s_sleep(1); \
    if ((++_sp & 255u) == 0u) { if (xb_ld(&(bar)[XB_TMO])) break; if (_sp > XB_SPIN_CAP) { atomicAdd(&(bar)[XB_TMO], 1u); break; } } } } while (0)

struct XcdBarrier {
    unsigned* bar; unsigned x;
    volatile LAS unsigned* st;
};

__device__ __forceinline__ XcdBarrier xcd_barrier_post(unsigned* bar, volatile LAS unsigned* st) {
    XcdBarrier b; b.bar = bar; b.x = xb_xcc_id(); b.st = st;
    if (threadIdx.x == 0) (void)xb_add(&bar[XB_XCNT(b.x)], 1u);
    return b;
}
__device__ __forceinline__ void xcd_barrier_complete(unsigned* bar, unsigned x, unsigned& nloc, unsigned& nx) {
    const unsigned G = gridDim.x * gridDim.y * gridDim.z;
    unsigned sum, cnt, mine, sp = 0u;
    for (;;) {
        sum = 0u; cnt = 0u; mine = 0u;
#pragma unroll
        for (unsigned j = 0; j < 16; ++j) { const unsigned c = xb_ld(&bar[XB_XCNT(j)]); sum += c; cnt += (c > 0u) ? 1u : 0u; mine = (j == x) ? c : mine; }
        if (sum == G) break;
        __builtin_amdgcn_s_sleep(1);
        if ((++sp & 255u) == 0u) { if (xb_ld(&bar[XB_TMO])) break; if (sp > XB_SPIN_CAP) { atomicAdd(&bar[XB_TMO], 1u); break; } }
    }
    nloc = mine > 0u ? mine : 1u; nx = cnt > 0u ? cnt : 1u;
}

__device__ __forceinline__ void xcd_barrier(const XcdBarrier& b) {
    asm volatile("s_waitcnt vmcnt(0)" ::: "memory");
    __syncthreads();
    if (threadIdx.x == 0) {
        unsigned* bar = b.bar;
        __builtin_amdgcn_s_waitcnt(0);
        unsigned nloc = b.st[0], nx = b.st[1];
        if (nloc == 0u) { xcd_barrier_complete(bar, b.x, nloc, nx); b.st[0] = nloc; b.st[1] = nx; }
        const unsigned old = xb_add(&bar[XB_XSUB(b.x)], 1u);
        const unsigned gen = old / nloc;
        if (old + 1u == (gen + 1u) * nloc) {
            __builtin_amdgcn_fence(__ATOMIC_RELEASE, "agent");
            asm volatile("s_waitcnt vmcnt(0)" ::: "memory");
            const unsigned og = xb_add(&bar[XB_TOP], 1u);
            const unsigned tg = og / nx;
            if (og + 1u == (tg + 1u) * nx) xb_add(&bar[XB_TOPGEN], 1u);
            else XB_SPIN(xb_ld(&bar[XB_TOPGEN]) == tg, bar);
            __builtin_amdgcn_fence(__ATOMIC_ACQUIRE, "agent");
            xb_add(&bar[XB_XGEN(b.x)], 1u);
            asm volatile("s_waitcnt vmcnt(0)" ::: "memory");
        } else {
            XB_SPIN(xb_ld(&bar[XB_XGEN(b.x)]) == gen, bar);
            __builtin_amdgcn_fence(__ATOMIC_ACQUIRE, "agent");
            asm volatile("s_waitcnt vmcnt(0)" ::: "memory");
        }
    }
    __syncthreads();
}


__global__ void __launch_bounds__(NTHREADS, 2) __attribute__((amdgpu_waves_per_eu(2, 2))) fwd_megakernel(Params p) {
    __shared__ __attribute__((aligned(1024))) char smem[SMEM_ALL];
    cg::grid_group grid = cg::this_grid();
    __shared__ uint4 xb_words;
    if (threadIdx.x == 0) xb_words = make_uint4(0u, 0u, 0u, 0u);
    __syncthreads();
    XcdBarrier xb = xcd_barrier_post((unsigned*)(p.ws + OFF_BAR), (volatile LAS unsigned*)&xb_words);
    const float* MOD0 = (const float*)(p.ws + OFF_MOD);
    const float* MOD1 = MOD0 + 9 * 6144;
    float* XRC = (float*)(p.ws + OFF_XRC);
    const bf16_t* Hb = (const bf16_t*)(p.ws + OFF_H);

    phase0(p, smem);
    if (p.ws == nullptr) grid.sync();
    xcd_barrier(xb);
    phase_norm(p, p.x, p.ctx, p.norm1_g, MOD0, 0, 18432);
    xcd_barrier(xb);
    phase_inproj0(p, smem);
    xcd_barrier(xb);
    phase_mla_up(p, smem);
    xcd_barrier(xb);
    phase_attn(p, smem);
    xcd_barrier(xb);
    phase_proj_resid(p, Hb, 1024, (const bf16_t*)(p.ws + OFF_WT_OUT0), MOD0, 2, p.x, p.ctx, p.out, XRC, 64, true, WT_UP0_0, WT_UP0_N, smem);
    xcd_barrier(xb);
    phase_norm(p, p.out, XRC, p.norm2_g, MOD0, 3, 18432);
    xcd_barrier(xb);
    phase_ffn_up(p, (const bf16_t*)(p.ws + OFF_WT_UP0), p.ffn_conv_w, p.ffn_conv_b, 80, WT_DOWN0_0, WT_DOWN0_N, smem);
    xcd_barrier(xb);
    phase_proj_resid(p, (const bf16_t*)(p.ws + OFF_ACT), 2816, (const bf16_t*)(p.ws + OFF_WT_DOWN0), MOD0, 5, p.out, XRC, p.out, XRC, 64, true, WT_L1_0, WT_L1_N, smem);
    xcd_barrier(xb);
    phase_norm(p, p.out, XRC, p.norm1_g + 1024, MOD1, 0, 18432);
    xcd_barrier(xb);
    phase_inproj1(p, smem);
    xcd_barrier(xb);
    phase_qkconv(p);
    xcd_barrier(xb);
    phase_mlstm(p, smem);
    xcd_barrier(xb);
    phase_mix(p);
    xcd_barrier(xb);
    phase_proj_resid(p, Hb, 1024, (const bf16_t*)(p.ws + OFF_WT_OUT1), MOD1, 2, p.out, XRC, p.out, XRC, 64, false, 0, 0, smem);
    xcd_barrier(xb);
    phase_norm(p, p.out, XRC, p.norm2_g + 1024, MOD1, 3, 16384);
    xcd_barrier(xb);
    phase_ffn_up(p, (const bf16_t*)(p.ws + OFF_WT_UP1), p.ffn_conv_w + 3 * 2816, p.ffn_conv_b + 2816, 68, 0, 0, smem);
    xcd_barrier(xb);
    phase_proj_resid(p, (const bf16_t*)(p.ws + OFF_ACT), 2816, (const bf16_t*)(p.ws + OFF_WT_DOWN1), MOD1, 5, p.out, XRC, p.out, XRC, 64, false, 0, 0, smem);
}

extern "C" void kernel_launch(void* const* d_in, const int* in_sizes, int n_in, void* d_out, int out_size, void* d_ws, size_t ws_size,
                              hipStream_t stream) {
    static int grid_blocks = 0;
    if (!grid_blocks) {
        int dev = 0, cus = 0, per_cu = 0;
        hipGetDevice(&dev);
        hipDeviceGetAttribute(&cus, hipDeviceAttributeMultiprocessorCount, dev);
        hipOccupancyMaxActiveBlocksPerMultiprocessor(&per_cu, fwd_megakernel, NTHREADS, 0);
        if (per_cu < 1) per_cu = 1;
        if (per_cu > 1) per_cu = 1;
        grid_blocks = cus * per_cu;
        if (ws_size < WS_END) fprintf(stderr, "kernel_launch: workspace too small: %zu < %zu\n", ws_size, (size_t)WS_END);
    }
    Params p{};
    const float** pf = (const float**)&p;
    for (int i = 0; i < 28; ++i) pf[i] = (const float*)d_in[i];
    p.out = (float*)d_out;
    p.ws = (char*)d_ws;
    hipMemsetAsync((char*)d_ws + OFF_BAR, 0, 16384, stream);
    void* args[] = {&p};
    hipError_t e = hipLaunchCooperativeKernel((void*)fwd_megakernel, dim3(grid_blocks), dim3(NTHREADS), args, 0, stream);
    if (e != hipSuccess) fprintf(stderr, "cooperative launch failed: %s (grid %d)\n", hipGetErrorString(e), grid_blocks);
}
```

```cpp
#include <hip/hip_runtime.h>
#include <hip/hip_cooperative_groups.h>
#include <cstdio>
namespace cg = cooperative_groups;

typedef unsigned short bf16_t;
using bf16x8 = __attribute__((ext_vector_type(8))) short;
using f32x16 = __attribute__((ext_vector_type(16))) float;
using f32x4 = __attribute__((ext_vector_type(4))) float;
#define DI __device__ __forceinline__
#define MFMA(a, b, c) __builtin_amdgcn_mfma_f32_32x32x16_bf16((a), (b), (c), 0, 0, 0)
#define MFMA16(a, b, c) __builtin_amdgcn_mfma_f32_16x16x32_bf16((a), (b), (c), 0, 0, 0)
#define LDS_BARRIER() do { asm volatile("s_waitcnt lgkmcnt(0)" ::: "memory"); __builtin_amdgcn_s_barrier(); asm volatile("" ::: "memory"); } while (0)
#define TID ((int)(threadIdx.x & 255))
#define HBI ((int)(threadIdx.x >> 8))

constexpr float EPSF = 1e-6f;
constexpr float LOG2E = 1.4426950408889634f;
constexpr int NTHREADS = 512;
constexpr int HB_SMEM = 73728;
constexpr int SMEM_ALL = 2 * HB_SMEM;
constexpr int GP = 72;
constexpr int CP = 132;
constexpr int ROWSS_OFF = 67584;

constexpr size_t OFF_WT_UP1 = 0;
constexpr size_t OFF_WT_DOWN1 = OFF_WT_UP1 + 5632ull * 1024 * 2;
constexpr size_t OFF_WT_IN1 = OFF_WT_DOWN1 + 1024ull * 2816 * 2;
constexpr size_t OFF_WT_OUT1 = OFF_WT_IN1 + 3328ull * 1024 * 2;
constexpr size_t OFF_MOD = OFF_WT_OUT1 + 1024ull * 1024 * 2;
constexpr size_t OFF_TABG = OFF_MOD + 2ull * 9 * 6144 * 4;
constexpr size_t OFF_TABM = OFF_TABG + 64 * 16 * 2 * 4;
constexpr size_t OFF_ZROW = OFF_TABM + 64 * 8 * 2 * 4;
constexpr size_t OFF_W0 = OFF_ZROW + 8192;
constexpr size_t OFF_WT_IN0 = OFF_W0;
constexpr size_t OFF_WT_QB = OFF_WT_IN0 + 1536ull * 1024 * 2;
constexpr size_t OFF_WT_KVB = OFF_WT_QB + 1024ull * 384 * 2;
constexpr size_t OFF_WT_OUT0 = OFF_WT_KVB + 1024ull * 256 * 2;
constexpr size_t OFF_WT_UP0 = OFF_WT_OUT0 + 1024ull * 1024 * 2;
constexpr size_t OFF_WT_DOWN0 = OFF_WT_UP0 + 5632ull * 1024 * 2;
constexpr size_t OFF_XRC = OFF_WT_DOWN0 + 1024ull * 2816 * 2;
constexpr size_t OFF_R = OFF_XRC + 2048ull * 1024 * 4;
constexpr size_t OFF_QG = OFF_R;
constexpr size_t OFF_KG = OFF_QG + 18432ull * 512 * 2;
constexpr size_t OFF_VGT = OFF_KG + 18432ull * 128 * 2;
constexpr size_t OFF_CQ = OFF_VGT + 18432ull * 128 * 2;
constexpr size_t OFF_CKV = OFF_CQ + 18432ull * 384 * 2;
constexpr size_t OFF_KR = OFF_CKV + 18432ull * 256 * 2;
constexpr size_t OFF_QM = OFF_KR + 18432ull * 32 * 4;
constexpr size_t OFF_KM = OFF_QM + 18432ull * 768 * 2;
constexpr size_t OFF_VMT = OFF_KM + 18432ull * 768 * 2;
constexpr size_t END_L0 = OFF_VMT + 18432ull * 512 * 2;
constexpr size_t OFF_ACT = OFF_R;
constexpr size_t END_ACT = OFF_ACT + 18432ull * 2816 * 2;
constexpr size_t OFF_QKRAW = OFF_W0;
constexpr size_t OFF_V1 = OFF_QKRAW + 18432ull * 1024 * 2;
constexpr size_t OFF_OG = OFF_V1 + 18432ull * 1024 * 2;
constexpr size_t OFF_GATES = OFF_OG + 16384ull * 1024 * 2;
constexpr size_t OFF_HF = OFF_GATES + 18432ull * 32 * 4;
constexpr size_t OFF_HB = OFF_HF + 16384ull * 1024 * 2;
constexpr size_t END_L1 = OFF_HB + 16384ull * 1024 * 2;
constexpr size_t cmax(size_t a, size_t b) { return a > b ? a : b; }
constexpr size_t OFF_H = cmax(cmax(END_L0, END_ACT), END_L1);
constexpr size_t OFF_BAR = OFF_H + 18432ull * 1024 * 2;
constexpr size_t OFF_SCAN = OFF_BAR + 16384;
constexpr size_t WS_END = OFF_SCAN + 2304ull * 384 * 4;
static_assert(WS_END <= 268435456ull, "workspace too large");
static_assert(OFF_H % 256 == 0 && OFF_R % 256 == 0 && OFF_HF % 256 == 0, "align");

struct Params {
    const float *x, *c, *ctx, *c_ctx, *ada_w, *ada_b, *norm1_g, *norm2_g, *ffn_w_up, *ffn_conv_w, *ffn_conv_b, *ffn_w_down,
        *att_w_in, *mla_qa_g, *mla_w_qb, *mla_kva_g, *mla_w_kvb, *mla_q_g, *mla_k_g, *gqa_q_g, *gqa_k_g, *att_w_out,
        *ml_w_in, *ml_conv_w, *ml_conv_b, *ml_gate_b, *ml_out_g, *ml_w_out;
    float* out;
    char* ws;
};

DI unsigned short f2bf_sw(float x) { unsigned u = __float_as_uint(x); u += 0x7fffu + ((u >> 16) & 1u); return (unsigned short)(u >> 16); }
DI unsigned short f2bf(float x) { unsigned r; asm("v_cvt_pk_bf16_f32 %0, %1, %1" : "=v"(r) : "v"(x)); return (unsigned short)(r & 0xffffu); }
DI unsigned pack2(float a, float b) { unsigned r; asm("v_cvt_pk_bf16_f32 %0, %1, %2" : "=v"(r) : "v"(a), "v"(b)); return r; }
DI bf16x8 pack_frag(float a0, float a1, float a2, float a3, float a4, float a5, float a6, float a7) {
    using u32x4_ = __attribute__((ext_vector_type(4))) unsigned; u32x4_ p;
    asm volatile("v_cvt_pk_bf16_f32 %0, %4, %5\n\tv_cvt_pk_bf16_f32 %1, %6, %7\n\tv_cvt_pk_bf16_f32 %2, %8, %9\n\tv_cvt_pk_bf16_f32 %3, %10, %11\n\ts_nop 1"
                 : "=&v"(p[0]), "=&v"(p[1]), "=&v"(p[2]), "=&v"(p[3]) : "v"(a0), "v"(a1), "v"(a2), "v"(a3), "v"(a4), "v"(a5), "v"(a6), "v"(a7));
    return __builtin_bit_cast(bf16x8, p);
}
DI float bflo(unsigned v) { return __uint_as_float(v << 16); }
DI float bfhi(unsigned v) { return __uint_as_float(v & 0xffff0000u); }
DI float bf2f(unsigned short v) { return __uint_as_float(((unsigned)v) << 16); }
DI uint4 pack8(const float* v) { uint4 o; o.x = pack2(v[0], v[1]); o.y = pack2(v[2], v[3]); o.z = pack2(v[4], v[5]); o.w = pack2(v[6], v[7]); return o; }
DI void unpack8(uint4 u, float* v) { v[0] = bflo(u.x); v[1] = bfhi(u.x); v[2] = bflo(u.y); v[3] = bfhi(u.y); v[4] = bflo(u.z); v[5] = bfhi(u.z); v[6] = bflo(u.w); v[7] = bfhi(u.w); }
DI int crow(int reg, int h) { return (reg & 3) + 8 * (reg >> 2) + 4 * h; }
DI float sigmoidf_(float x) { return __builtin_amdgcn_rcpf(1.f + __expf(-x)); }
DI float siluf_(float x) { return x * __builtin_amdgcn_rcpf(1.f + __expf(-x)); }
DI float logsigmoidf_(float x) { return fminf(x, 0.f) - log1pf(__expf(-fabsf(x))); }
DI f32x16 zero16() { f32x16 z;
#pragma unroll
    for (int i = 0; i < 16; ++i) z[i] = 0.f; return z; }

DI void row_info(int m0, int& b, int& t0, bool& lat) {
    if (m0 < 16384) { b = m0 >> 11; t0 = m0 & 2047; lat = true; }
    else { int q = m0 - 16384; b = q >> 8; t0 = q & 255; lat = false; }
}

template <bool SS, bool HALO, class Epi>
DI void gemm_tile(const bf16_t* ap0, const bf16_t* ap1, const bf16_t* ap2, const bf16_t* ap3, unsigned mk0, unsigned mk1, unsigned mk2, unsigned mk3, const bf16_t* __restrict__ Bt, int ldb, int K, char* smem, Epi epi) {
    const int tid = TID, lane = tid & 63, w = tid >> 6, h = lane >> 5, r = lane & 31;
    const int wm = w >> 1, wn = w & 1;
    const int lr = tid >> 3, kc = tid & 7;
    ap0 += kc * 8; ap1 += kc * 8; ap2 += kc * 8; ap3 += kc * 8;
    const bf16_t* bp0 = Bt + (size_t)lr * ldb + kc * 8;
    const bf16_t* bp1 = bp0 + (size_t)32 * ldb; const bf16_t* bp2 = bp0 + (size_t)64 * ldb; const bf16_t* bp3 = bp0 + (size_t)96 * ldb;
    f32x16 acc00 = zero16(), acc01 = zero16(), acc10 = zero16(), acc11 = zero16();
    float ss0 = 0.f, ss1 = 0.f, ss2 = 0.f, ss3 = 0.f;
    uint4 ra0, ra1, ra2, ra3, rb0, rb1, rb2, rb3;
    const int nk = K >> 6;
#define GLOAD(k0) { ra0 = *(const uint4*)(ap0 + (k0)); ra1 = *(const uint4*)(ap1 + (k0)); ra2 = *(const uint4*)(ap2 + (k0)); ra3 = *(const uint4*)(ap3 + (k0)); \
                    rb0 = *(const uint4*)(bp0 + (k0)); rb1 = *(const uint4*)(bp1 + (k0)); rb2 = *(const uint4*)(bp2 + (k0)); rb3 = *(const uint4*)(bp3 + (k0)); }
#define SSQ(ssv, rv) { if (SS) { float f_[8]; unpack8(rv, f_); ssv += f_[0]*f_[0] + f_[1]*f_[1] + f_[2]*f_[2] + f_[3]*f_[3] + f_[4]*f_[4] + f_[5]*f_[5] + f_[6]*f_[6] + f_[7]*f_[7]; } }
#define MSK(rv, mk) { rv.x &= mk; rv.y &= mk; rv.z &= mk; rv.w &= mk; }
#define SWRITE(s_) { if (HALO) { MSK(ra0, mk0) MSK(ra1, mk1) MSK(ra2, mk2) MSK(ra3, mk3) } bf16_t* As_ = (bf16_t*)(smem + (s_) * 36864) + lr * GP + kc * 8; bf16_t* Bs_ = As_ + 128 * GP; \
                     *(uint4*)(As_) = ra0; *(uint4*)(As_ + 32 * GP) = ra1; *(uint4*)(As_ + 64 * GP) = ra2; *(uint4*)(As_ + 96 * GP) = ra3; \
                     *(uint4*)(Bs_) = rb0; *(uint4*)(Bs_ + 32 * GP) = rb1; *(uint4*)(Bs_ + 64 * GP) = rb2; *(uint4*)(Bs_ + 96 * GP) = rb3; \
                     SSQ(ss0, ra0) SSQ(ss1, ra1) SSQ(ss2, ra2) SSQ(ss3, ra3) }
    GLOAD(0) SWRITE(0) __syncthreads();
#pragma unroll 1
    for (int kt = 0; kt < nk; ++kt) {
        if (kt + 1 < nk) GLOAD((kt + 1) * 64)
        {
            const bf16_t* As = (const bf16_t*)(smem + (kt & 1) * 36864) + (wm * 64 + r) * GP + h * 8;
            const bf16_t* Bs = (const bf16_t*)(smem + (kt & 1) * 36864) + 128 * GP + (wn * 64 + r) * GP + h * 8;
#pragma unroll
            for (int ks = 0; ks < 4; ++ks) {
                const bf16x8 a0 = *(const bf16x8*)(As + ks * 16), a1 = *(const bf16x8*)(As + 32 * GP + ks * 16);
                const bf16x8 b0 = *(const bf16x8*)(Bs + ks * 16), b1 = *(const bf16x8*)(Bs + 32 * GP + ks * 16);
                acc00 = MFMA(a0, b0, acc00); acc01 = MFMA(a0, b1, acc01); acc10 = MFMA(a1, b0, acc10); acc11 = MFMA(a1, b1, acc11);
            }
        }
        if (kt + 1 < nk) SWRITE((kt + 1) & 1)
        __syncthreads();
    }
#undef GLOAD
#undef SWRITE
#undef SSQ
#undef MSK
    float* Cs = (float*)smem;
    {
        float* cb = Cs + (wm * 64 + 4 * h) * CP + wn * 64 + r;
#pragma unroll
        for (int g = 0; g < 16; ++g) {
            const int ro = (g & 3) + 8 * (g >> 2);
            cb[ro * CP] = acc00[g]; cb[ro * CP + 32] = acc01[g]; cb[(ro + 32) * CP] = acc10[g]; cb[(ro + 32) * CP + 32] = acc11[g];
        }
    }
    if (SS) {
        float* rowss = (float*)(smem + ROWSS_OFF);
        ss0 += __shfl_xor(ss0, 1); ss0 += __shfl_xor(ss0, 2); ss0 += __shfl_xor(ss0, 4);
        ss1 += __shfl_xor(ss1, 1); ss1 += __shfl_xor(ss1, 2); ss1 += __shfl_xor(ss1, 4);
        ss2 += __shfl_xor(ss2, 1); ss2 += __shfl_xor(ss2, 2); ss2 += __shfl_xor(ss2, 4);
        ss3 += __shfl_xor(ss3, 1); ss3 += __shfl_xor(ss3, 2); ss3 += __shfl_xor(ss3, 4);
        if (kc == 0) { rowss[lr] = ss0; rowss[lr + 32] = ss1; rowss[lr + 64] = ss2; rowss[lr + 96] = ss3; }
    }
    __syncthreads();
    epi((const float*)smem, (const float*)(smem + ROWSS_OFF));
    __syncthreads();
}


DI int g_row(int i) { return ((i * 8 + (int)(threadIdx.x >> 6)) * 8) + (int)((threadIdx.x & 63) >> 3); }
DI int b_perm(int row) { return ((row >> 5) & 1) * 128 + (row >> 6) * 32 + (row & 31); }
DI int g_chunk(int row) { return (int)(threadIdx.x & 7) ^ ((row >> 1) & 7); }
#define GLDS(g_, l_) __builtin_amdgcn_global_load_lds((const unsigned*)(g_), (unsigned*)(l_), 16, 0, 0)
template <int NH = -1, class Epi>
DI void gemm256(const char* wsb, const bf16_t* a0p, const bf16_t* a1p, const bf16_t* a2p, const bf16_t* a3p,
                const bf16_t* b0p, const bf16_t* b1p, const bf16_t* b2p, const bf16_t* b3p, int K, char* smem_all, Epi epi) {
    const unsigned a0 = (unsigned)((const char*)a0p - wsb), a1 = (unsigned)((const char*)a1p - wsb), a2 = (unsigned)((const char*)a2p - wsb), a3 = (unsigned)((const char*)a3p - wsb);
    const unsigned b0 = (unsigned)((const char*)b0p - wsb), b1 = (unsigned)((const char*)b1p - wsb), b2 = (unsigned)((const char*)b2p - wsb), b3 = (unsigned)((const char*)b3p - wsb);
    const int lane = threadIdx.x & 63, wid = __builtin_amdgcn_readfirstlane(threadIdx.x >> 6), wr = wid >> 2, wc = wid & 3, fr = lane & 15, fq = lane >> 4;
    f32x4 acc[8][4];
#pragma unroll
    for (int m = 0; m < 8; ++m)
#pragma unroll
        for (int n = 0; n < 4; ++n) acc[m][n] = (f32x4){0.f, 0.f, 0.f, 0.f};
#define STAGE256(buf, k0) { char* sa_ = smem_all + (buf) * 65536 + wid * 1024; char* sb_ = sa_ + 32768; const char* wk_ = wsb + (size_t)(k0) * 2; \
        GLDS(wk_ + a0, sa_); GLDS(wk_ + a1, sa_ + 8192); GLDS(wk_ + a2, sa_ + 16384); GLDS(wk_ + a3, sa_ + 24576); \
        if (NH < 0 || (wid >> 2) == NH) { GLDS(wk_ + b0, sb_); GLDS(wk_ + b1, sb_ + 8192); GLDS(wk_ + b2, sb_ + 16384); GLDS(wk_ + b3, sb_ + 24576); } }
    const int sw = (fr >> 1) & 7;
    const unsigned offA = (wr * 128 + fr) * 128, offB = 32768 + (wc * 64 + fr) * 128;
    const unsigned co0 = ((0 + fq) ^ sw) << 4, co1 = ((4 + fq) ^ sw) << 4;
    const unsigned lds0 = (unsigned)(size_t)smem_all;
    const int nt = K >> 6;
    STAGE256(0, 0)
    asm volatile("s_waitcnt vmcnt(0)" ::: "memory");
    __syncthreads();
#pragma unroll 1
    for (int t = 0; t < nt; ++t) {
        const int cur = t & 1;
        if (t + 1 < nt) STAGE256(cur ^ 1, (t + 1) * 64)
        const unsigned lb = lds0 + cur * 65536;
        const unsigned aA0 = lb + offA + co0, aA1 = lb + offA + co1, aB0 = lb + offB + co0, aB1 = lb + offB + co1;
        bf16x8 Bq0[4], Bq1[4], Aq0[2], Aq1[2];
#define DSR(dst, addr, off) asm volatile("ds_read_b128 %0, %1 offset:%2" : "=v"(dst) : "v"(addr), "n"(off) : "memory")
#define LDA2(dst, addr, mo) { DSR(dst[0], addr, (mo) * 2048); DSR(dst[1], addr, ((mo) + 1) * 2048); }
#define LDB4(dst, addr) { DSR(dst[0], addr, 0); DSR(dst[1], addr, 2048); DSR(dst[2], addr, 4096); DSR(dst[3], addr, 6144); }
#define WAIT_A(n, X) asm volatile("s_waitcnt lgkmcnt(" #n ")" : "+v"(X[0]), "+v"(X[1]) :: "memory")
#define WAIT_AB(n, X, Y) asm volatile("s_waitcnt lgkmcnt(" #n ")" : "+v"(X[0]), "+v"(X[1]), "+v"(Y[0]), "+v"(Y[1]), "+v"(Y[2]), "+v"(Y[3]) :: "memory")
#define MM8(Aq, Bq, mo) { _Pragma("unroll") for (int m = 0; m < 2; ++m) _Pragma("unroll") for (int n = 0; n < 4; ++n) if (NH < 0 || (n >> 1) == NH) acc[(mo) + m][n] = MFMA16(Bq[n], Aq[m], acc[(mo) + m][n]); }
        LDB4(Bq0, aB0) LDA2(Aq0, aA0, 0) LDA2(Aq1, aA0, 2)
        WAIT_AB(2, Aq0, Bq0);
        MM8(Aq0, Bq0, 0)
        LDA2(Aq0, aA0, 4)
        WAIT_A(2, Aq1);
        MM8(Aq1, Bq0, 2)
        LDA2(Aq1, aA0, 6) LDB4(Bq1, aB1)
        WAIT_A(6, Aq0);
        MM8(Aq0, Bq0, 4)
        LDA2(Aq0, aA1, 0)
        WAIT_A(6, Aq1);
        MM8(Aq1, Bq0, 6)
        LDA2(Aq1, aA1, 2)
        WAIT_AB(2, Aq0, Bq1);
        MM8(Aq0, Bq1, 0)
        LDA2(Aq0, aA1, 4)
        WAIT_A(2, Aq1);
        MM8(Aq1, Bq1, 2)
        LDA2(Aq1, aA1, 6)
        WAIT_A(2, Aq0);
        MM8(Aq0, Bq1, 4)
        WAIT_A(0, Aq1);
        MM8(Aq1, Bq1, 6)
#undef DSR
#undef LDA2
#undef LDB4
#undef WAIT_A
#undef WAIT_AB
#undef MM8
        asm volatile("s_waitcnt vmcnt(0)" ::: "memory");
        __syncthreads();
    }
#undef STAGE256
    int t_ = threadIdx.x;
    asm volatile("" : "+v"(t_));
    const int lane_ = t_ & 63, wid_ = t_ >> 6, wr_ = wid_ >> 2, wc_ = wid_ & 3, fr_ = lane_ & 15, fq_ = lane_ >> 4, hb_ = t_ >> 8;
#pragma unroll
    for (int p = 0; p < 2; ++p) {
        if (NH >= 0 && p != NH) continue;
        {
            float* Cs = (float*)(smem_all + wr_ * HB_SMEM) + fr_ * CP + wc_ * 32 + 4 * fq_;
#pragma unroll
            for (int m = 0; m < 8; ++m)
#pragma unroll
                for (int n = 0; n < 2; ++n) *(f32x4*)(Cs + (m * 16) * CP + n * 16) = acc[m][2 * p + n];
        }
        __syncthreads();
        epi((const float*)(smem_all + hb_ * HB_SMEM), hb_, p, t_ & 255);
        __syncthreads();
    }
}

DI void epi_store_bf16(const float* Cs, bf16_t* dst, int ld, int tid) {
#pragma unroll 2
    for (int j = 0; j < 8; ++j) {
        int c = tid + 256 * j, row = c >> 4, cc = c & 15;
        const float4* cp = (const float4*)(Cs + row * CP + cc * 8);
        float4 f0 = cp[0], f1 = cp[1];
        float v[8] = {f0.x, f0.y, f0.z, f0.w, f1.x, f1.y, f1.z, f1.w};
        *(uint4*)(dst + (size_t)row * ld + cc * 8) = pack8(v);
    }
}
DI void epi_resid(const float* Cs, const float* src, float* dst, const float* gate, int tid) {
#pragma unroll 4
    for (int j = 0; j < 16; ++j) {
        int c = tid + 256 * j, row = c >> 5, c4 = c & 31;
        float4 cv = *(const float4*)(Cs + row * CP + c4 * 4);
        float4 sv = *(const float4*)(src + (size_t)row * 1024 + c4 * 4);
        float4 gv = *(const float4*)(gate + c4 * 4);
        float4 o; o.x = sv.x + gv.x * cv.x; o.y = sv.y + gv.y * cv.y; o.z = sv.z + gv.z * cv.z; o.w = sv.w + gv.w * cv.w;
        *(float4*)(dst + (size_t)row * 1024 + c4 * 4) = o;
    }
}

DI int wsrc_col(int mode, int tn, int c) {
    if (mode == 0) return tn * 128 + c;
    if (mode == 1) {
        const int np = tn * 128;
        if (np < 512) return 672 + np + c;
        if (np < 640) return 1184 + np - 512 + c;
        if (np < 768) return 1312 + np - 640 + c;
        if (np < 1152) return np - 768 + c;
        if (np < 1408) return 384 + np - 1152 + c;
        return c < 32 ? 640 + c : -1;
    }
    if (mode == 2) return c < 96 ? tn * 96 + c : -1;
    return c < 64 ? 64 * tn + c : 2816 + 64 * tn + c - 64;
}
DI void wtile(const float* __restrict__ src, int Nsrc, const float* __restrict__ g, bf16_t* __restrict__ dst, int K, int k0, int tn, int mode, char* smem) {
    bf16_t* T = (bf16_t*)smem;
    const int tid = TID, lane = tid & 63, w = tid >> 6, rsub = lane >> 5, c4 = (lane & 31) * 4;
    int sc = wsrc_col(mode, tn, c4);
    if (sc >= Nsrc) sc = -1;
#pragma unroll 8
    for (int i = 0; i < 16; ++i) {
        const int rr = w * 32 + 2 * i + rsub;
        float4 v = make_float4(0.f, 0.f, 0.f, 0.f);
        if (sc >= 0) { v = *(const float4*)(src + (size_t)(k0 + rr) * Nsrc + sc); if (g) { const float gg = g[k0 + rr]; v.x *= gg; v.y *= gg; v.z *= gg; v.w *= gg; } }
        T[(c4 + 0) * 130 + rr] = f2bf(v.x);
        T[(c4 + 1) * 130 + rr] = f2bf(v.y);
        T[(c4 + 2) * 130 + rr] = f2bf(v.z);
        T[(c4 + 3) * 130 + rr] = f2bf(v.w);
    }
    __syncthreads();
#pragma unroll
    for (int j = 0; j < 8; ++j) {
        const int c = tid + 256 * j, n = c >> 4, kc = c & 15;
        const unsigned* s32 = (const unsigned*)(T + n * 130 + kc * 8);
        uint4 o; o.x = s32[0]; o.y = s32[1]; o.z = s32[2]; o.w = s32[3];
        *(uint4*)(dst + (size_t)(tn * 128 + n) * K + k0 + kc * 8) = o;
    }
    __syncthreads();
}

DI void mod_item(const Params& p, int item, char* smem) {
    const int tid = TID, lane = tid & 63, w = tid >> 6, hl = lane >> 5, cl = lane & 31;
    const int l = item / 192, n0 = (item % 192) * 32;
    float* sl = (float*)smem;
    for (int i = tid; i < 9216; i += 256) {
        int rr = i >> 10, k = i & 1023;
        float cv = rr < 8 ? p.c[rr * 1024 + k] : p.c_ctx[k];
        sl[k * 12 + rr] = cv / (1.f + expf(-cv));
    }
    __syncthreads();
    float acc[9];
#pragma unroll
    for (int q = 0; q < 9; ++q) acc[q] = 0.f;
    const float* wp = p.ada_w + (size_t)l * 1024 * 6144 + n0 + cl;
#pragma unroll 16
    for (int kk = 0; kk < 128; ++kk) {
        const int k = w * 256 + 2 * kk + hl;
        const float wv = wp[(size_t)k * 6144];
        const float4 s0 = *(const float4*)(sl + k * 12), s1 = *(const float4*)(sl + k * 12 + 4);
        const float s8 = sl[k * 12 + 8];
        acc[0] += s0.x * wv; acc[1] += s0.y * wv; acc[2] += s0.z * wv; acc[3] += s0.w * wv;
        acc[4] += s1.x * wv; acc[5] += s1.y * wv; acc[6] += s1.z * wv; acc[7] += s1.w * wv; acc[8] += s8 * wv;
    }
    float* red = (float*)(smem + 49152);
#pragma unroll
    for (int q = 0; q < 9; ++q) red[((w * 2 + hl) * 9 + q) * 32 + cl] = acc[q];
    __syncthreads();
    float* MOD = (float*)(p.ws + OFF_MOD);
    for (int i = tid; i < 288; i += 256) {
        int q = i >> 5, ln = i & 31;
        float sacc = 0.f;
#pragma unroll
        for (int u = 0; u < 8; ++u) sacc += red[(u * 9 + q) * 32 + ln];
        sacc += p.ada_b[l * 6144 + n0 + ln];
        MOD[(size_t)(l * 9 + q) * 6144 + n0 + ln] = sacc;
    }
    __syncthreads();
}

DI void sincos_d(double x, float& s, float& c) {
    const double TWO_PI = 6.283185307179586476925;
    double t = x / TWO_PI;
    t -= rint(t);
    double y = t * TWO_PI, y2 = y * y;
    double sv = y, cv = 1.0, ts = y, tc = 1.0;
#pragma unroll 1
    for (int k = 1; k <= 14; ++k) {
        tc *= -y2 / (double)((2 * k - 1) * (2 * k));
        ts *= -y2 / (double)((2 * k) * (2 * k + 1));
        cv += tc; sv += ts;
    }
    s = (float)sv; c = (float)cv;
}

DI void rope_tables(const Params& p) {
    float* TG = (float*)(p.ws + OFF_TABG);
    float* TM = (float*)(p.ws + OFF_TABM);
    for (int i = TID; i < 1024; i += 256) {
        int v = i >> 4, f = i & 15;
        float inv = exp2f(-(float)f / 16.f * 13.287712379549449f);
        float ang = (float)v * inv, s, c;
        sincos_d((double)ang, s, c);
        TG[i] = c; TG[1024 + i] = s;
    }
    for (int i = TID; i < 512; i += 256) {
        int v = i >> 3, f = i & 7;
        float inv = exp2f(-(float)f / 8.f * 13.287712379549449f);
        float ang = (float)v * inv, s, c;
        sincos_d((double)ang, s, c);
        TM[i] = c; TM[512 + i] = s;
    }
}

constexpr int NW = 10;
constexpr int N_WT0 = 8 * 12 + 3 * 8 + 2 * 8 + 8 * 8 + 8 * 44 + 22 * 8;
constexpr int N_WT1 = 8 * 44 + 22 * 8 + 8 * 26 + 8 * 8;
constexpr int N_MOD = 384;
constexpr int N_P0 = N_MOD + 96;
static_assert(N_P0 % 2 == 0 && N_MOD % 2 == 0 && N_WT1 % 2 == 0, "items are dealt to half-block pairs");

DI void wtile_item(const Params& p, int t, char* smem) {
    int wi = 0;
    int cnt[NW] = {8 * 12, 3 * 8, 2 * 8, 8 * 8, 8 * 44, 22 * 8, 8 * 44, 22 * 8, 8 * 26, 8 * 8};
#pragma unroll
    for (int i = 0; i < NW - 1; ++i) { if (wi == i && t >= cnt[i]) { t -= cnt[i]; wi = i + 1; } }
    const float* src; const float* g = nullptr; bf16_t* dst; int K, Nsrc, ntn, mode;
    switch (wi) {
        case 0: src = p.att_w_in; dst = (bf16_t*)(p.ws + OFF_WT_IN0); K = 1024; Nsrc = 1440; ntn = 12; mode = 1; break;
        case 1: src = p.mla_w_qb; g = p.mla_qa_g; dst = (bf16_t*)(p.ws + OFF_WT_QB); K = 384; Nsrc = 768; ntn = 8; mode = 2; break;
        case 2: src = p.mla_w_kvb; g = p.mla_kva_g; dst = (bf16_t*)(p.ws + OFF_WT_KVB); K = 256; Nsrc = 1024; ntn = 8; mode = 0; break;
        case 3: src = p.att_w_out; dst = (bf16_t*)(p.ws + OFF_WT_OUT0); K = 1024; Nsrc = 1024; ntn = 8; mode = 0; break;
        case 4: src = p.ffn_w_up; dst = (bf16_t*)(p.ws + OFF_WT_UP0); K = 1024; Nsrc = 5632; ntn = 44; mode = 3; break;
        case 5: src = p.ffn_w_down; dst = (bf16_t*)(p.ws + OFF_WT_DOWN0); K = 2816; Nsrc = 1024; ntn = 8; mode = 0; break;
        case 6: src = p.ffn_w_up + 1024ull * 5632; dst = (bf16_t*)(p.ws + OFF_WT_UP1); K = 1024; Nsrc = 5632; ntn = 44; mode = 3; break;
        case 7: src = p.ffn_w_down + 2816ull * 1024; dst = (bf16_t*)(p.ws + OFF_WT_DOWN1); K = 2816; Nsrc = 1024; ntn = 8; mode = 0; break;
        case 8: src = p.ml_w_in; dst = (bf16_t*)(p.ws + OFF_WT_IN1); K = 1024; Nsrc = 3104; ntn = 26; mode = 0; break;
        default: src = p.ml_w_out; dst = (bf16_t*)(p.ws + OFF_WT_OUT1); K = 1024; Nsrc = 1024; ntn = 8; mode = 0; break;
    }
    const int tn = t % ntn, tk = t / ntn;
    wtile(src, Nsrc, g, dst, K, tk * 128, tn, mode, smem);
}

DI void phase0(const Params& p, char* smem_all) {
    char* smem = smem_all + HBI * HB_SMEM;
    if (blockIdx.x == gridDim.x - 1) {
        if (HBI == 0) rope_tables(p);
        else { for (int i = TID; i < 512; i += 256) ((uint4*)(p.ws + OFF_ZROW))[i] = make_uint4(0, 0, 0, 0); }
    }
    for (int it0 = blockIdx.x * 2; it0 < N_P0; it0 += gridDim.x * 2) {
        const int item = it0 + HBI;
        if (item < N_MOD) mod_item(p, item, smem);
        else wtile_item(p, item - N_MOD, smem);
    }
}
DI void convert_weights(const Params& p, char* smem_all, int t0, int cnt, int first) {
    char* smem = smem_all + HBI * HB_SMEM;
    const int G = gridDim.x;
    if (first >= G) first = 0;
    if ((int)blockIdx.x < first) return;
    for (int it0 = ((int)blockIdx.x - first) * 2; it0 < cnt; it0 += (G - first) * 2) wtile_item(p, t0 + it0 + HBI, smem);
}
constexpr int WT_IN0_0 = 0, WT_IN0_N = 96, WT_MLA_0 = 96, WT_MLA_N = 40, WT_OUT0_0 = 136, WT_OUT0_N = 64, WT_UP0_0 = 200, WT_UP0_N = 352, WT_DOWN0_0 = 552, WT_DOWN0_N = 176, WT_L1_0 = 728, WT_L1_N = 800;
static_assert(WT_L1_0 == N_WT0 && WT_L1_N == N_WT1, "tile ranges");

DI void norm_row_ptrs(int row, const float* srcLat, const float* srcCtx, const float* mod, int shift_idx, const float*& src, const float*& sh) {
    int mb;
    if (row < 16384) { src = srcLat + (size_t)row * 1024; mb = row >> 11; }
    else { src = srcCtx + (size_t)(row - 16384) * 1024; mb = 8; }
    sh = mod + (size_t)mb * 6144 + shift_idx * 1024;
}
DI void norm_row_finish(const float4 (&v)[4], float ss, const float* g, const float* sh, bf16_t* dst, int lane) {
#pragma unroll
    for (int o = 32; o >= 1; o >>= 1) ss += __shfl_xor(ss, o);
    const float rstd = rsqrtf(ss * (1.f / 1024.f) + EPSF);
    const float* sc = sh + 1024;
#pragma unroll
    for (int j = 0; j < 4; ++j) {
        const int c = j * 256 + lane * 4;
        const float4 gv = *(const float4*)(g + c), shv = *(const float4*)(sh + c), scv = *(const float4*)(sc + c);
        const float o0 = v[j].x * rstd * gv.x * (1.f + scv.x) + shv.x;
        const float o1 = v[j].y * rstd * gv.y * (1.f + scv.y) + shv.y;
        const float o2 = v[j].z * rstd * gv.z * (1.f + scv.z) + shv.z;
        const float o3 = v[j].w * rstd * gv.w * (1.f + scv.w) + shv.w;
        uint2 o; o.x = pack2(o0, o1); o.y = pack2(o2, o3);
        *(uint2*)(dst + c) = o;
    }
}
DI void phase_norm(const Params& p, const float* srcLat, const float* srcCtx, const float* g, const float* mod, int shift_idx, int nrows) {
    const int lane = threadIdx.x & 63, w = threadIdx.x >> 6;
    bf16_t* H = (bf16_t*)(p.ws + OFF_H);
    for (int row = (blockIdx.x * 8 + w) * 2; row < nrows; row += gridDim.x * 16) {
        const float *srcA, *shA, *srcB, *shB;
        norm_row_ptrs(row, srcLat, srcCtx, mod, shift_idx, srcA, shA);
        norm_row_ptrs(row + 1, srcLat, srcCtx, mod, shift_idx, srcB, shB);
        float4 va[4], vb[4];
        float sa = 0.f, sb = 0.f;
#pragma unroll
        for (int j = 0; j < 4; ++j) { va[j] = *(const float4*)(srcA + j * 256 + lane * 4); vb[j] = *(const float4*)(srcB + j * 256 + lane * 4); }
#pragma unroll
        for (int j = 0; j < 4; ++j) { sa += va[j].x * va[j].x + va[j].y * va[j].y + va[j].z * va[j].z + va[j].w * va[j].w; sb += vb[j].x * vb[j].x + vb[j].y * vb[j].y + vb[j].z * vb[j].z + vb[j].w * vb[j].w; }
        norm_row_finish(va, sa, g, shA, H + (size_t)row * 1024, lane);
        norm_row_finish(vb, sb, g, shB, H + (size_t)(row + 1) * 1024, lane);
    }
}

template <int Q>
DI void rope_apply(float* v, const float* tab, int rw, int cl) {
#pragma unroll
    for (int f = 0; f < Q; ++f) {
        float cr = tab[rw * Q + f], sr = tab[64 * Q + rw * Q + f], cc = tab[cl * Q + f], sc = tab[64 * Q + cl * Q + f];
        float a1 = v[f], a2 = v[Q + f], b1 = v[2 * Q + f], b2 = v[3 * Q + f];
        v[f] = a1 * cr - a2 * sr; v[Q + f] = a2 * cr + a1 * sr;
        v[2 * Q + f] = b1 * cc - b2 * sc; v[3 * Q + f] = b2 * cc + b1 * sc;
    }
}

DI void phase_inproj0(const Params& p, char* smem_all) {
    const bf16_t* H = (const bf16_t*)(p.ws + OFF_H);
    const bf16_t* W = (const bf16_t*)(p.ws + OFF_WT_IN0);
    const float* TG = (const float*)(p.ws + OFF_TABG);
    for (int id = blockIdx.x; id < 72 * 6; id += gridDim.x) {
        const int nt2 = id / 72, mt2 = id % 72;
        auto epi = [&](const float* Cs, int si, int sj, int tid) {
            const int nt = 2 * nt2 + sj, m0 = (2 * mt2 + si) * 128;
            int b, t0; bool lat; row_info(m0, b, t0, lat);
            const int s0 = lat ? 256 + t0 : t0;
            if (nt < 5) {
                const int row = tid & 127, half = tid >> 7;
                const float4* cp = (const float4*)(Cs + row * CP + half * 64);
                float ss = 0.f;
#pragma unroll
                for (int i = 0; i < 16; ++i) { float4 f = cp[i]; ss += f.x * f.x + f.y * f.y + f.z * f.z + f.w * f.w; }
                const float rstd = rsqrtf(ss * (1.f / 64.f) + EPSF);
                const float* g = nt < 4 ? p.gqa_q_g : p.gqa_k_g;
                const float osc = nt < 4 ? 0.125f * LOG2E : 1.f;
                bf16_t* dst;
                if (nt < 4) dst = (bf16_t*)(p.ws + OFF_QG) + ((size_t)(b * 2304 + s0 + row) * 8 + nt * 2 + half) * 64;
                else dst = (bf16_t*)(p.ws + OFF_KG) + ((size_t)(b * 2304 + s0 + row) * 2 + half) * 64;
                const int t = t0 + row;
#pragma unroll 1
                for (int hh = 0; hh < 2; ++hh) {
                    float v[32];
#pragma unroll
                    for (int i = 0; i < 8; ++i) { float4 f = cp[hh * 8 + i]; const float4 gv = *(const float4*)(g + hh * 32 + 4 * i);
                        v[4 * i] = f.x * rstd * gv.x; v[4 * i + 1] = f.y * rstd * gv.y; v[4 * i + 2] = f.z * rstd * gv.z; v[4 * i + 3] = f.w * rstd * gv.w; }
                    if (lat) {
                        const int pos = hh ? (t & 63) : (t >> 6);
#pragma unroll
                        for (int f = 0; f < 16; ++f) {
                            const float c_ = TG[pos * 16 + f], s_ = TG[1024 + pos * 16 + f];
                            const float x1 = v[f], x2 = v[16 + f];
                            v[f] = x1 * c_ - x2 * s_; v[16 + f] = x2 * c_ + x1 * s_;
                        }
                    }
#pragma unroll
                    for (int i = 0; i < 32; ++i) v[i] *= osc;
#pragma unroll
                    for (int i = 0; i < 4; ++i) *(uint4*)(dst + hh * 32 + i * 8) = pack8(v + i * 8);
                }
            } else if (nt == 5) {
                const int dall = tid & 127, ch0 = (tid >> 7) * 8;
                bf16_t* dst = (bf16_t*)(p.ws + OFF_VGT) + ((size_t)(b * 2 + (dall >> 6)) * 64 + (dall & 63)) * 2304 + s0;
#pragma unroll 2
                for (int ch = 0; ch < 8; ++ch) {
                    float v[8];
#pragma unroll
                    for (int i = 0; i < 8; ++i) v[i] = Cs[((ch0 + ch) * 8 + i) * CP + dall];
                    *(uint4*)(dst + (ch0 + ch) * 8) = pack8(v);
                }
            } else if (nt < 9) {
                epi_store_bf16(Cs, (bf16_t*)(p.ws + OFF_CQ) + (size_t)m0 * 384 + (nt - 6) * 128, 384, tid);
            } else if (nt < 11) {
                epi_store_bf16(Cs, (bf16_t*)(p.ws + OFF_CKV) + (size_t)m0 * 256 + (nt - 9) * 128, 256, tid);
            } else {
                const int row = tid >> 1, half = tid & 1;
                float* dst = (float*)(p.ws + OFF_KR) + (size_t)(m0 + row) * 32 + half * 16;
                const float4* cp = (const float4*)(Cs + row * CP + half * 16);
#pragma unroll
                for (int i = 0; i < 4; ++i) ((float4*)dst)[i] = cp[i];
            }
        };
        const int r0 = g_row(0), r1 = g_row(1), r2 = g_row(2), r3 = g_row(3);
        const bf16_t* Ab = H + (size_t)mt2 * 256 * 1024;
        const bf16_t* Bb = W + (size_t)nt2 * 256 * 1024;
        gemm256(p.ws, Ab + (size_t)r0 * 1024 + g_chunk(r0) * 8, Ab + (size_t)r1 * 1024 + g_chunk(r1) * 8, Ab + (size_t)r2 * 1024 + g_chunk(r2) * 8, Ab + (size_t)r3 * 1024 + g_chunk(r3) * 8,
                Bb + (size_t)b_perm(r0) * 1024 + g_chunk(r0) * 8, Bb + (size_t)b_perm(r1) * 1024 + g_chunk(r1) * 8, Bb + (size_t)b_perm(r2) * 1024 + g_chunk(r2) * 8, Bb + (size_t)b_perm(r3) * 1024 + g_chunk(r3) * 8,
                1024, smem_all, epi);
    }
    convert_weights(p, smem_all, WT_MLA_0, WT_MLA_N, (72 * 6) % (int)gridDim.x);
}

DI void phase_mla_up(const Params& p, char* smem_all) {
    char* smem = smem_all + HBI * HB_SMEM;
    const float* TM = (const float*)(p.ws + OFF_TABM);
    for (int id0 = blockIdx.x * 2; id0 < 144 * 16; id0 += gridDim.x * 2) {
        const int id = id0 + HBI;
        const int nt = (id / 144) & 7, isKV = (id / 144) >> 3, mt = id % 144, m0 = mt * 128;
        int b, t0; bool lat; row_info(m0, b, t0, lat);
        const int s0 = lat ? 256 + t0 : t0;
        if (!isKV) {
            const bf16_t* A = (const bf16_t*)(p.ws + OFF_CQ);
#undef AROW
#define AROW(o_) (A + (size_t)(m0 + (TID >> 3) + (o_)) * 384)
            auto epi = [&](const float* Cs, const float* rowss) {
                const int tid = TID, row = tid >> 1, part = tid & 1;
                const float r1 = rsqrtf(rowss[row] * (1.f / 384.f) + EPSF);
                float v[48];
                const float4* cp = (const float4*)(Cs + row * CP + part * 48);
                float ss = 0.f;
#pragma unroll
                for (int i = 0; i < 12; ++i) { float4 f = cp[i]; v[4 * i] = f.x * r1; v[4 * i + 1] = f.y * r1; v[4 * i + 2] = f.z * r1; v[4 * i + 3] = f.w * r1; }
#pragma unroll
                for (int i = 0; i < 48; ++i) ss += v[i] * v[i];
                ss += __shfl_xor(ss, 1);
                const float r2 = rsqrtf(ss * (1.f / 96.f) + EPSF);
                const float* g = p.mla_q_g + part * 48;
#pragma unroll
                for (int i = 0; i < 48; ++i) v[i] = v[i] * r2 * g[i];
                if (lat && part == 1) { int t = t0 + row; rope_apply<8>(v + 16, TM, t >> 6, t & 63); }
                const float sc = 0.10206207261596575f * LOG2E;
#pragma unroll
                for (int i = 0; i < 48; ++i) v[i] *= sc;
                bf16_t* dst = (bf16_t*)(p.ws + OFF_QM) + ((size_t)(b * 2304 + s0 + row) * 8 + nt) * 96 + part * 48;
#pragma unroll
                for (int i = 0; i < 6; ++i) *(uint4*)(dst + i * 8) = pack8(v + i * 8);
            };
            gemm_tile<true, false>(AROW(0), AROW(32), AROW(64), AROW(96), 0u, 0u, 0u, 0u, (const bf16_t*)(p.ws + OFF_WT_QB) + (size_t)nt * 128 * 384, 384, 384, smem, epi);
        } else {
            const bf16_t* A = (const bf16_t*)(p.ws + OFF_CKV);
#undef AROW
#define AROW(o_) (A + (size_t)(m0 + (TID >> 3) + (o_)) * 256)
            auto epi = [&](const float* Cs, const float* rowss) {
                const int tid = TID;
                {
                    const int row = tid >> 1, part = tid & 1;
                    const float r1 = rsqrtf(rowss[row] * (1.f / 256.f) + EPSF);
                    float v[48];
                    if (part == 0) {
                        const float4* cp = (const float4*)(Cs + row * CP);
#pragma unroll
                        for (int i = 0; i < 12; ++i) { float4 f = cp[i]; v[4 * i] = f.x * r1; v[4 * i + 1] = f.y * r1; v[4 * i + 2] = f.z * r1; v[4 * i + 3] = f.w * r1; }
                    } else {
                        const float4* cp = (const float4*)(Cs + row * CP + 48);
#pragma unroll
                        for (int i = 0; i < 4; ++i) { float4 f = cp[i]; v[4 * i] = f.x * r1; v[4 * i + 1] = f.y * r1; v[4 * i + 2] = f.z * r1; v[4 * i + 3] = f.w * r1; }
                        const float4* kp = (const float4*)((const float*)(p.ws + OFF_KR) + (size_t)(m0 + row) * 32);
#pragma unroll
                        for (int i = 0; i < 8; ++i) { float4 f = kp[i]; v[16 + 4 * i] = f.x; v[16 + 4 * i + 1] = f.y; v[16 + 4 * i + 2] = f.z; v[16 + 4 * i + 3] = f.w; }
                    }
                    float ss = 0.f;
#pragma unroll
                    for (int i = 0; i < 48; ++i) ss += v[i] * v[i];
                    ss += __shfl_xor(ss, 1);
                    const float r2 = rsqrtf(ss * (1.f / 96.f) + EPSF);
                    const float* g = p.mla_k_g + part * 48;
#pragma unroll
                    for (int i = 0; i < 48; ++i) v[i] = v[i] * r2 * g[i];
                    if (lat && part == 1) { int t = t0 + row; rope_apply<8>(v + 16, TM, t >> 6, t & 63); }
                    bf16_t* dst = (bf16_t*)(p.ws + OFF_KM) + ((size_t)(b * 2304 + s0 + row) * 8 + nt) * 96 + part * 48;
#pragma unroll
                    for (int i = 0; i < 6; ++i) *(uint4*)(dst + i * 8) = pack8(v + i * 8);
                }
                {
                    const int d = tid & 63, cg4 = (tid >> 6) * 4;
                    bf16_t* dst = (bf16_t*)(p.ws + OFF_VMT) + ((size_t)(b * 8 + nt) * 64 + d) * 2304 + s0;
#pragma unroll 1
                    for (int ch = 0; ch < 4; ++ch) {
                        float v[8];
#pragma unroll
                        for (int i = 0; i < 8; ++i) { int rr = (cg4 + ch) * 8 + i; v[i] = Cs[rr * CP + 64 + d] * rsqrtf(rowss[rr] * (1.f / 256.f) + EPSF); }
                        *(uint4*)(dst + (cg4 + ch) * 8) = pack8(v);
                    }
                }
            };
            gemm_tile<true, false>(AROW(0), AROW(32), AROW(64), AROW(96), 0u, 0u, 0u, 0u, (const bf16_t*)(p.ws + OFF_WT_KVB) + (size_t)nt * 128 * 256, 256, 256, smem, epi);
        }
    }
}

template <int DK>
DI void attn_body(const bf16_t* __restrict__ Q, int qstride, const bf16_t* __restrict__ Kp, int kstride, const bf16_t* __restrict__ VT,
                  int nkeys, bf16_t* __restrict__ Odst, char* smem, char* smem_os) {
    constexpr int KP = DK + 8, VP = 72, NST = DK / 16, KCH = DK / 8;
    constexpr int NKL = (64 * KCH) / 256;
    constexpr int STAGE = 64 * KP * 2 + 64 * VP * 2;
    const int tid = TID, lane = tid & 63, w = tid >> 6, h = lane >> 5, r = lane & 31;
    bf16x8 qf[NST];
    {
        const bf16_t* qrow = Q + (size_t)(w * 32 + r) * qstride;
#pragma unroll
        for (int st = 0; st < NST; ++st) qf[st] = *(const bf16x8*)(qrow + st * 16 + h * 8);
    }
    f32x16 o[2]; o[0] = zero16(); o[1] = zero16();
    float m = 0.f, l = 0.f;
    uint4 ak0, ak1 = make_uint4(0, 0, 0, 0), av0, bk0, bk1 = make_uint4(0, 0, 0, 0), bv0;
    const int t5 = threadIdx.x;
    const int kr0 = t5 / KCH, kc0 = t5 % KCH, kr1 = (t5 + 512) / KCH, kc1 = (t5 + 512) % KCH;
    const bool k2 = t5 + 512 < 64 * KCH;
    const int vd0 = t5 >> 3, vc0 = t5 & 7;
#define AGLOAD(P_, key0) { P_##k0 = *(const uint4*)(Kp + (size_t)((key0) + kr0) * kstride + kc0 * 8); if (k2) P_##k1 = *(const uint4*)(Kp + (size_t)((key0) + kr1) * kstride + kc1 * 8); \
                       P_##v0 = *(const uint4*)(VT + (size_t)vd0 * 2304 + (key0) + vc0 * 8); }
#define ASWRITE(P_, s_) { bf16_t* Ks_ = (bf16_t*)(smem + (s_) * STAGE); bf16_t* Vs_ = Ks_ + 64 * KP; \
                      *(uint4*)(Ks_ + kr0 * KP + kc0 * 8) = P_##k0; if (k2) *(uint4*)(Ks_ + kr1 * KP + kc1 * 8) = P_##k1; \
                      *(uint4*)(Vs_ + vd0 * VP + vc0 * 8) = P_##v0; }
    const int nkt = nkeys >> 6;
    AGLOAD(a, 0) ASWRITE(a, 0) AGLOAD(a, 64) AGLOAD(b, 128) __syncthreads();
#pragma unroll 1
    for (int kt = 0; kt < nkt; kt += 2) {
        {
            const bf16_t* Ks = (const bf16_t*)(smem);
            const bf16_t* Vs = Ks + 64 * KP;
            f32x16 s[2];
#pragma unroll
            for (int i = 0; i < 16; ++i) { s[0][i] = -m; s[1][i] = -m; }
#pragma unroll
            for (int st = 0; st < NST; ++st)
#pragma unroll
                for (int kk = 0; kk < 2; ++kk) {
                    bf16x8 a = *(const bf16x8*)(Ks + (kk * 32 + r) * KP + st * 16 + h * 8);
                    s[kk] = MFMA(a, qf[st], s[kk]);
                }
            float mx = s[0][0];
#pragma unroll
            for (int i = 0; i < 16; ++i) { mx = fmaxf(mx, s[0][i]); mx = fmaxf(mx, s[1][i]); }
            mx = fmaxf(mx, __shfl_xor(mx, 32));
            if (__any(mx > 8.f)) {
                const float d = fmaxf(mx, 0.f);
                const float alpha = __builtin_amdgcn_exp2f(-d);
                l *= alpha;
#pragma unroll
                for (int i = 0; i < 16; ++i) { o[0][i] *= alpha; o[1][i] *= alpha; s[0][i] -= d; s[1][i] -= d; }
                m += d;
            }
            float ps = 0.f;
#pragma unroll
            for (int kk = 0; kk < 2; ++kk)
#pragma unroll
                for (int i = 0; i < 16; ++i) { float pv = __builtin_amdgcn_exp2f(s[kk][i]); s[kk][i] = pv; ps += pv; }
            l += ps;
#pragma unroll
            for (int kk = 0; kk < 2; ++kk)
#pragma unroll
                for (int s2 = 0; s2 < 2; ++s2) {
                    const bf16x8 pb = pack_frag(s[kk][8 * s2 + 0], s[kk][8 * s2 + 1], s[kk][8 * s2 + 2], s[kk][8 * s2 + 3], s[kk][8 * s2 + 4], s[kk][8 * s2 + 5], s[kk][8 * s2 + 6], s[kk][8 * s2 + 7]);
#pragma unroll
                    for (int dt = 0; dt < 2; ++dt) {
                        const bf16_t* vp = Vs + (dt * 32 + r) * VP + kk * 32 + 16 * s2 + 4 * h;
                        uint2 lo = *(const uint2*)vp, hi = *(const uint2*)(vp + 8);
                        uint4 vu; vu.x = lo.x; vu.y = lo.y; vu.z = hi.x; vu.w = hi.y;
                        o[dt] = MFMA(__builtin_bit_cast(bf16x8, vu), pb, o[dt]);
                    }
                }
        }
        ASWRITE(a, 1)
        if (kt + 3 < nkt) AGLOAD(a, (kt + 3) * 64)
        LDS_BARRIER();
        {
            const bf16_t* Ks = (const bf16_t*)(smem + STAGE);
            const bf16_t* Vs = Ks + 64 * KP;
            f32x16 s[2];
#pragma unroll
            for (int i = 0; i < 16; ++i) { s[0][i] = -m; s[1][i] = -m; }
#pragma unroll
            for (int st = 0; st < NST; ++st)
#pragma unroll
                for (int kk = 0; kk < 2; ++kk) {
                    bf16x8 a = *(const bf16x8*)(Ks + (kk * 32 + r) * KP + st * 16 + h * 8);
                    s[kk] = MFMA(a, qf[st], s[kk]);
                }
            float mx = s[0][0];
#pragma unroll
            for (int i = 0; i < 16; ++i) { mx = fmaxf(mx, s[0][i]); mx = fmaxf(mx, s[1][i]); }
            mx = fmaxf(mx, __shfl_xor(mx, 32));
            if (__any(mx > 8.f)) {
                const float d = fmaxf(mx, 0.f);
                const float alpha = __builtin_amdgcn_exp2f(-d);
                l *= alpha;
#pragma unroll
                for (int i = 0; i < 16; ++i) { o[0][i] *= alpha; o[1][i] *= alpha; s[0][i] -= d; s[1][i] -= d; }
                m += d;
            }
            float ps = 0.f;
#pragma unroll
            for (int kk = 0; kk < 2; ++kk)
#pragma unroll
                for (int i = 0; i < 16; ++i) { float pv = __builtin_amdgcn_exp2f(s[kk][i]); s[kk][i] = pv; ps += pv; }
            l += ps;
#pragma unroll
            for (int kk = 0; kk < 2; ++kk)
#pragma unroll
                for (int s2 = 0; s2 < 2; ++s2) {
                    const bf16x8 pb = pack_frag(s[kk][8 * s2 + 0], s[kk][8 * s2 + 1], s[kk][8 * s2 + 2], s[kk][8 * s2 + 3], s[kk][8 * s2 + 4], s[kk][8 * s2 + 5], s[kk][8 * s2 + 6], s[kk][8 * s2 + 7]);
#pragma unroll
                    for (int dt = 0; dt < 2; ++dt) {
                        const bf16_t* vp = Vs + (dt * 32 + r) * VP + kk * 32 + 16 * s2 + 4 * h;
                        uint2 lo = *(const uint2*)vp, hi = *(const uint2*)(vp + 8);
                        uint4 vu; vu.x = lo.x; vu.y = lo.y; vu.z = hi.x; vu.w = hi.y;
                        o[dt] = MFMA(__builtin_bit_cast(bf16x8, vu), pb, o[dt]);
                    }
                }
        }
        if (kt + 2 < nkt) ASWRITE(b, 0)
        if (kt + 4 < nkt) AGLOAD(b, (kt + 4) * 64)
        LDS_BARRIER();
    }
#undef AGLOAD
#undef ASWRITE
    l += __shfl_xor(l, 32);
    const float inv = 1.f / l;
    bf16_t* Os = (bf16_t*)smem_os + (size_t)w * 32 * 72;
#pragma unroll
    for (int dt = 0; dt < 2; ++dt)
#pragma unroll
        for (int g = 0; g < 4; ++g) {
            uint2 u; u.x = pack2(o[dt][4 * g] * inv, o[dt][4 * g + 1] * inv); u.y = pack2(o[dt][4 * g + 2] * inv, o[dt][4 * g + 3] * inv);
            *(uint2*)(Os + r * 72 + dt * 32 + 8 * g + 4 * h) = u;
        }
    __syncthreads();
#pragma unroll
    for (int j = 0; j < 4; ++j) {
        int c = lane + 64 * j, row = c >> 3, cc = c & 7;
        uint4 u = *(const uint4*)(Os + row * 72 + cc * 8);
        *(uint4*)(Odst + (size_t)(w * 32 + row) * 1024 + cc * 8) = u;
    }
    __syncthreads();
}

DI void phase_attn(const Params& p, char* smem_all) {
    char* smem = smem_all;
    char* smem_os = smem_all + 65536 + HBI * 20480;
    bf16_t* O = (bf16_t*)(p.ws + OFF_H);
    for (int it0 = blockIdx.x * 2; it0 < 2304; it0 += gridDim.x * 2) {
        const int item = it0 + HBI;
        int b, kind, hq, qb, nkeys, sq0, orow;
        if (item < 2048) { qb = item & 15; hq = (item >> 4) & 7; kind = (item >> 7) & 1; b = item >> 8; sq0 = 256 + qb * 128; nkeys = 2304; orow = b * 2048 + qb * 128; }
        else { int it = item - 2048; qb = it & 1; hq = (it >> 1) & 7; kind = (it >> 4) & 1; b = it >> 5; sq0 = qb * 128; nkeys = 256; orow = 16384 + b * 256 + qb * 128; }
        bf16_t* od = O + (size_t)orow * 1024 + kind * 512 + hq * 64;
        if (kind == 0) {
            const bf16_t* Q = (const bf16_t*)(p.ws + OFF_QM) + ((size_t)(b * 2304 + sq0) * 8 + hq) * 96;
            const bf16_t* K = (const bf16_t*)(p.ws + OFF_KM) + ((size_t)(b * 2304) * 8 + hq) * 96;
            const bf16_t* VT = (const bf16_t*)(p.ws + OFF_VMT) + (size_t)(b * 8 + hq) * 64 * 2304;
            attn_body<96>(Q, 768, K, 768, VT, nkeys, od, smem, smem_os);
        } else {
            const int kvh = hq >> 2;
            const bf16_t* Q = (const bf16_t*)(p.ws + OFF_QG) + ((size_t)(b * 2304 + sq0) * 8 + hq) * 64;
            const bf16_t* K = (const bf16_t*)(p.ws + OFF_KG) + ((size_t)(b * 2304) * 2 + kvh) * 64;
            const bf16_t* VT = (const bf16_t*)(p.ws + OFF_VGT) + (size_t)(b * 2 + kvh) * 64 * 2304;
            attn_body<64>(Q, 512, K, 128, VT, nkeys, od, smem, smem_os);
        }
    }
    convert_weights(p, smem_all, WT_OUT0_0, WT_OUT0_N, 1152 % (int)gridDim.x);
}

DI void phase_proj_resid(const Params& p, const bf16_t* A, int K, const bf16_t* W, const float* mod, int gate_idx,
                         const float* srcLat, const float* srcCtx, float* dstLat, float* dstCtx, int mtiles2, bool ctx_small, int conv_t0, int conv_cnt, char* smem_all) {
    for (int id = blockIdx.x; id < mtiles2 * 4; id += gridDim.x) {
        const int nt2 = id / mtiles2, mt2 = id % mtiles2;
        auto epi = [&](const float* Cs, int si, int sj, int tid) {
            const int nt = 2 * nt2 + sj, m0 = (2 * mt2 + si) * 128;
            const float* src; float* dst; int mb;
            if (m0 < 16384) { src = srcLat + (size_t)m0 * 1024; dst = dstLat + (size_t)m0 * 1024; mb = m0 >> 11; }
            else { src = srcCtx + (size_t)(m0 - 16384) * 1024; dst = dstCtx + (size_t)(m0 - 16384) * 1024; mb = 8; }
            epi_resid(Cs, src + nt * 128, dst + nt * 128, mod + (size_t)mb * 6144 + gate_idx * 1024 + nt * 128, tid);
        };
        const int r0 = g_row(0), r1 = g_row(1), r2 = g_row(2), r3 = g_row(3);
        const bf16_t* Ab = A + (size_t)mt2 * 256 * K;
        const bf16_t* Bb = W + (size_t)nt2 * 256 * K;
        gemm256(p.ws, Ab + (size_t)r0 * K + g_chunk(r0) * 8, Ab + (size_t)r1 * K + g_chunk(r1) * 8, Ab + (size_t)r2 * K + g_chunk(r2) * 8, Ab + (size_t)r3 * K + g_chunk(r3) * 8,
                Bb + (size_t)b_perm(r0) * K + g_chunk(r0) * 8, Bb + (size_t)b_perm(r1) * K + g_chunk(r1) * 8, Bb + (size_t)b_perm(r2) * K + g_chunk(r2) * 8, Bb + (size_t)b_perm(r3) * K + g_chunk(r3) * 8,
                K, smem_all, epi);
    }
    if (ctx_small) {
        for (int hq = blockIdx.x; hq < 64; hq += gridDim.x) {
            const int mt2 = 64 + (hq >> 3), nt = hq & 7;
            auto epi = [&](const float* Cs, int si, int, int tid) {
                const int m0 = (2 * mt2 + si) * 128 - 16384;
                epi_resid(Cs, srcCtx + (size_t)m0 * 1024 + nt * 128, dstCtx + (size_t)m0 * 1024 + nt * 128, mod + (size_t)8 * 6144 + gate_idx * 1024 + nt * 128, tid);
            };
            const int r0 = g_row(0), r1 = g_row(1), r2 = g_row(2), r3 = g_row(3);
            const bf16_t* Ab = A + (size_t)mt2 * 256 * K;
            const bf16_t* Bb = W + (size_t)nt * 128 * K;
            gemm256<0>(p.ws, Ab + (size_t)r0 * K + g_chunk(r0) * 8, Ab + (size_t)r1 * K + g_chunk(r1) * 8, Ab + (size_t)r2 * K + g_chunk(r2) * 8, Ab + (size_t)r3 * K + g_chunk(r3) * 8,
                       Bb + (size_t)b_perm(r0) * K + g_chunk(r0) * 8, Bb + (size_t)b_perm(r1) * K + g_chunk(r1) * 8, Bb + (size_t)b_perm(r2) * K + g_chunk(r2) * 8, Bb + (size_t)b_perm(r3) * K + g_chunk(r3) * 8,
                       K, smem_all, epi);
        }
    }
    if (conv_cnt) convert_weights(p, smem_all, conv_t0, conv_cnt, 64);
}

DI float4 conv4(float4 w0, float4 w1, float4 w2, float4 bb, float4 gm, float4 g0, float4 gp, float4 v) {
    float4 o;
    o.x = siluf_(w0.x * gm.x + w1.x * g0.x + w2.x * gp.x + bb.x) * v.x;
    o.y = siluf_(w0.y * gm.y + w1.y * g0.y + w2.y * gp.y + bb.y) * v.y;
    o.z = siluf_(w0.z * gm.z + w1.z * g0.z + w2.z * gp.z + bb.z) * v.z;
    o.w = siluf_(w0.w * gm.w + w1.w * g0.w + w2.w * gp.w + bb.w) * v.w;
    return o;
}
DI void halo_info(int mt, int& base, int& T, int& tstart) {
    int ti;
    if (mt < 136) { base = (mt / 17) * 2048; T = 2048; ti = mt % 17; }
    else { int q = mt - 136; base = 16384 + (q / 3) * 256; T = 256; ti = q % 3; }
    tstart = 126 * ti - 1;
}
DI const bf16_t* halo_ptr(const bf16_t* H, const bf16_t* Z, int mt2, int row) {
    int base, T, tstart; halo_info(2 * mt2 + (row >> 7), base, T, tstart);
    const int t = tstart + (row & 127);
    return (t >= 0 && t < T) ? H + (size_t)(base + t) * 1024 + g_chunk(row) * 8 : Z;
}
DI void phase_ffn_up(const Params& p, const bf16_t* W, const float* convw, const float* convb, int mtiles2, int conv_t0, int conv_cnt, char* smem_all) {
    const bf16_t* H = (const bf16_t*)(p.ws + OFF_H);
    const bf16_t* Z = (const bf16_t*)(p.ws + OFF_ZROW);
    bf16_t* ACT = (bf16_t*)(p.ws + OFF_ACT);
    for (int id = blockIdx.x; id < mtiles2 * 22; id += gridDim.x) {
        const int nt2 = id / mtiles2, mt2 = id % mtiles2;
        auto epi = [&](const float* Cs, int si, int sj, int tid) {
            const int nt = 2 * nt2 + sj;
            int base, T, tstart; halo_info(2 * mt2 + si, base, T, tstart);
            const int cc = tid & 7;
            const int cg0 = nt * 64 + cc * 8;
            const float4 w0a = *(const float4*)(convw + cg0), w0b = *(const float4*)(convw + cg0 + 4);
            const float4 w1a = *(const float4*)(convw + 2816 + cg0), w1b = *(const float4*)(convw + 2816 + cg0 + 4);
            const float4 w2a = *(const float4*)(convw + 5632 + cg0), w2b = *(const float4*)(convw + 5632 + cg0 + 4);
            const float4 bba = *(const float4*)(convb + cg0), bbb = *(const float4*)(convb + cg0 + 4);
#pragma unroll
            for (int j = 0; j < 4; ++j) {
                const int rr = (tid >> 3) + 32 * j, t = tstart + rr;
                if (rr >= 1 && rr <= 126 && t < T) {
                    const float4* a = (const float4*)(Cs + (rr - 1) * CP + cc * 8);
                    const float4* bq = (const float4*)(Cs + rr * CP + cc * 8);
                    const float4* c = (const float4*)(Cs + (rr + 1) * CP + cc * 8);
                    const float4* d = (const float4*)(Cs + rr * CP + 64 + cc * 8);
                    const float4 oa = conv4(w0a, w1a, w2a, bba, a[0], bq[0], c[0], d[0]);
                    const float4 ob = conv4(w0b, w1b, w2b, bbb, a[1], bq[1], c[1], d[1]);
                    uint4 u; u.x = pack2(oa.x, oa.y); u.y = pack2(oa.z, oa.w); u.z = pack2(ob.x, ob.y); u.w = pack2(ob.z, ob.w);
                    *(uint4*)(ACT + (size_t)(base + t) * 2816 + cg0) = u;
                }
            }
        };
        const int r0 = g_row(0), r1 = g_row(1), r2 = g_row(2), r3 = g_row(3);
        const bf16_t* Bb = W + (size_t)nt2 * 256 * 1024;
        gemm256(p.ws, halo_ptr(H, Z, mt2, r0), halo_ptr(H, Z, mt2, r1), halo_ptr(H, Z, mt2, r2), halo_ptr(H, Z, mt2, r3),
                Bb + (size_t)b_perm(r0) * 1024 + g_chunk(r0) * 8, Bb + (size_t)b_perm(r1) * 1024 + g_chunk(r1) * 8, Bb + (size_t)b_perm(r2) * 1024 + g_chunk(r2) * 8, Bb + (size_t)b_perm(r3) * 1024 + g_chunk(r3) * 8,
                1024, smem_all, epi);
    }
    if (conv_cnt) convert_weights(p, smem_all, conv_t0, conv_cnt, (mtiles2 * 22) % (int)gridDim.x);
}

DI void inproj1_epi(const Params& p, const float* Cs, int nt, int m0, int tid) {
    if (nt < 8) epi_store_bf16(Cs, (bf16_t*)(p.ws + OFF_QKRAW) + (size_t)m0 * 1024 + nt * 128, 1024, tid);
    else if (nt < 16) epi_store_bf16(Cs, (bf16_t*)(p.ws + OFF_V1) + (size_t)m0 * 1024 + (nt - 8) * 128, 1024, tid);
    else if (nt < 24) epi_store_bf16(Cs, (bf16_t*)(p.ws + OFF_OG) + (size_t)m0 * 1024 + (nt - 16) * 128, 1024, tid);
    else if (nt == 24) {
        const int row = tid >> 1, half = tid & 1;
        float* dst = (float*)(p.ws + OFF_GATES) + (size_t)(m0 + row) * 32 + half * 16;
#pragma unroll 4
        for (int i = 0; i < 16; ++i) {
            int c = half * 16 + i;
            float v = Cs[row * CP + c] + p.ml_gate_b[c];
            if (c & 8) v = logsigmoidf_(v);
            dst[i] = v;
        }
    }
}
DI void inproj1_tile_of(int f, int& nt2, int& mt2) { if (f < 576) { nt2 = f / 72; mt2 = f % 72; } else { const int g = f - 576; nt2 = 8 + g / 64; mt2 = g % 64; } }
DI void phase_inproj1(const Params& p, char* smem_all) {
    const bf16_t* H = (const bf16_t*)(p.ws + OFF_H);
    const bf16_t* W = (const bf16_t*)(p.ws + OFF_WT_IN1);
    const int G = gridDim.x, nfr = 832 / G, rem = 832 - nfr * G, nhalf = 2 * rem + 72;
    const int r0 = g_row(0), r1 = g_row(1), r2 = g_row(2), r3 = g_row(3);
#define IN1_ARGS p.ws, Ab + (size_t)r0 * 1024 + g_chunk(r0) * 8, Ab + (size_t)r1 * 1024 + g_chunk(r1) * 8, Ab + (size_t)r2 * 1024 + g_chunk(r2) * 8, Ab + (size_t)r3 * 1024 + g_chunk(r3) * 8, \
                Bb + (size_t)b_perm(r0) * 1024 + g_chunk(r0) * 8, Bb + (size_t)b_perm(r1) * 1024 + g_chunk(r1) * 8, Bb + (size_t)b_perm(r2) * 1024 + g_chunk(r2) * 8, Bb + (size_t)b_perm(r3) * 1024 + g_chunk(r3) * 8, \
                1024, smem_all, epi
    for (int trip = 0; trip < nfr; ++trip) {
        int nt2, mt2; inproj1_tile_of(trip * G + blockIdx.x, nt2, mt2);
        auto epi = [&](const float* Cs, int si, int sj, int tid) { inproj1_epi(p, Cs, 2 * nt2 + sj, (2 * mt2 + si) * 128, tid); };
        const bf16_t* Ab = H + (size_t)mt2 * 256 * 1024;
        const bf16_t* Bb = W + (size_t)nt2 * 256 * 1024;
        gemm256<-1>(IN1_ARGS);
    }
    for (int hq = blockIdx.x; hq < nhalf; hq += G) {
        int nt2, mt2, nh;
        if (hq < 2 * rem) { inproj1_tile_of(nfr * G + (hq >> 1), nt2, mt2); nh = hq & 1; } else { nt2 = 12; mt2 = hq - 2 * rem; nh = 0; }
        auto epi = [&](const float* Cs, int si, int, int tid) { inproj1_epi(p, Cs, 2 * nt2 + nh, (2 * mt2 + si) * 128, tid); };
        const bf16_t* Ab = H + (size_t)mt2 * 256 * 1024;
        const bf16_t* Bb = W + ((size_t)nt2 * 256 + nh * 128) * 1024;
        gemm256<0>(IN1_ARGS);
    }
#undef IN1_ARGS
}

DI void phase_qkconv(const Params& p) {
    const bf16_t* QK = (const bf16_t*)(p.ws + OFF_QKRAW);
    bf16_t* QC = (bf16_t*)(p.ws + OFF_H);
    {
        const int lane = threadIdx.x & 63, gw = blockIdx.x * 8 + (threadIdx.x >> 6);
        const float* GT = (const float*)(p.ws + OFF_GATES);
        float* SC = (float*)(p.ws + OFF_SCAN);
        for (int seg = gw; seg < 2304; seg += gridDim.x * 8) {
            const int step = seg % 18, dir = (seg / 18) & 1, hd = (seg / 36) & 7, b = seg / 288;
            int base, P0;
            if (step < 2) { base = 16384 + b * 256; P0 = (dir ? 1 - step : step) * 128; } else { base = b * 2048; P0 = (dir ? 17 - step : step - 2) * 128; }
            const int pa = dir ? P0 + 127 - lane : P0 + lane, pb = dir ? pa - 64 : pa + 64;
            const float* ga = GT + (size_t)(base + pa) * 32 + dir * 16 + hd; const float* gb = GT + (size_t)(base + pb) * 32 + dir * 16 + hd;
            const float i0 = ga[0], f0 = ga[8], i1 = gb[0], f1 = gb[8];
            float b0 = f0, b1 = f1;
#pragma unroll
            for (int off = 1; off < 64; off <<= 1) { float t0 = __shfl_up(b0, off), t1 = __shfl_up(b1, off); if (lane >= off) { b0 += t0; b1 += t1; } }
            b1 += __shfl(b0, 63);
            float p0 = i0 - b0, p1 = i1 - b1;
            const float c0 = p0, c1 = p1;
#pragma unroll
            for (int off = 1; off < 64; off <<= 1) { float t0 = __shfl_up(p0, off), t1 = __shfl_up(p1, off); if (lane >= off) { p0 = fmaxf(p0, t0); p1 = fmaxf(p1, t1); } }
            p1 = fmaxf(p1, __shfl(p0, 63));
            float* o = SC + (size_t)seg * 384;
            o[lane] = b0; o[64 + lane] = b1; o[128 + lane] = p0; o[192 + lane] = p1; o[256 + lane] = c0; o[320 + lane] = c1;
        }
    }
    for (int c = blockIdx.x * NTHREADS + threadIdx.x; c < 18432 * 128; c += gridDim.x * NTHREADS) {
        const int row = c >> 7, col = (c & 127) * 8;
        int T, t;
        if (row < 16384) { T = 2048; t = row & 2047; } else { T = 256; t = (row - 16384) & 255; }
        float acc[8];
        { const float4 b0 = *(const float4*)(p.ml_conv_b + col), b1 = *(const float4*)(p.ml_conv_b + col + 4);
          acc[0] = b0.x; acc[1] = b0.y; acc[2] = b0.z; acc[3] = b0.w; acc[4] = b1.x; acc[5] = b1.y; acc[6] = b1.z; acc[7] = b1.w; }
#pragma unroll
        for (int dj = 0; dj < 3; ++dj) {
            const int tt = t + dj - 1;
            const float on = (tt >= 0 && tt < T) ? 1.f : 0.f;
            const int rr = row + min(max(tt, 0), T - 1) - t;
            float f[8]; unpack8(*(const uint4*)(QK + (size_t)rr * 1024 + col), f);
            const float4 w0 = *(const float4*)(p.ml_conv_w + dj * 1024 + col), w1 = *(const float4*)(p.ml_conv_w + dj * 1024 + col + 4);
            acc[0] += w0.x * on * f[0]; acc[1] += w0.y * on * f[1]; acc[2] += w0.z * on * f[2]; acc[3] += w0.w * on * f[3];
            acc[4] += w1.x * on * f[4]; acc[5] += w1.y * on * f[5]; acc[6] += w1.z * on * f[6]; acc[7] += w1.w * on * f[7];
        }
        const float sc = col >= 512 ? 0.125f : 1.f;
#pragma unroll
        for (int i = 0; i < 8; ++i) acc[i] = siluf_(acc[i]) * sc;
        *(uint4*)(QC + (size_t)row * 1024 + col) = pack8(acc);
    }
}

DI void phase_mlstm(const Params& p, char* smem) {
    constexpr int LP = 72, TP = 136, L = 128;
    bf16_t* Qc = (bf16_t*)smem;
    bf16_t* Kc = Qc + L * LP;
    bf16_t* KcT = Kc + L * LP;
    bf16_t* VcT = KcT + 64 * TP;
    bf16_t* VwT = VcT + 64 * TP;
    bf16_t* Pm = VwT + 64 * TP;
    bf16_t* Cb = Pm + L * TP;
    float* fa = (float*)(Cb + 64 * LP);
    float* bcum = fa; float* ig = fa + 128; float* mtv = fa + 256; float* wint = fa + 384; float* denI = fa + 512; float* denX = fa + 640;
    float* wgt = fa + 768; float* nvec = fa + 896; float* scal = fa + 960; float* csv = fa + 1024; float* denP = fa + 1152;
    static_assert((2 * L * LP + 3 * 64 * TP + L * TP + 64 * LP) * 2 + 1408 * 4 <= SMEM_ALL, "mLSTM LDS");
    const int lane0 = threadIdx.x & 63, w = __builtin_amdgcn_readfirstlane(threadIdx.x >> 6);
    const bf16_t* QK = (const bf16_t*)(p.ws + OFF_H);
    const bf16_t* V1 = (const bf16_t*)(p.ws + OFF_V1);
    const float* GT = (const float*)(p.ws + OFF_GATES);
    for (int item = blockIdx.x; item < 256; item += gridDim.x) {
        const int vh = item & 1, dir = (item >> 1) & 1, hd = (item >> 2) & 7, b = item >> 5;
        bf16_t* Hout = (bf16_t*)(p.ws + (dir ? OFF_HB : OFF_HF));
        f32x16 accC = zero16();
        float m_prev = 0.f;
        for (int i = w * 64 + lane0; i < 64 * LP; i += 512) Cb[i] = 0;
        if (w == 0) nvec[lane0] = 0.f;
        int lane = lane0, tid = w * 64 + lane0, h = lane0 >> 5, r = lane0 & 31;
        int u = tid >> 2, part = tid & 3;
        uint4 rq0, rq1, rk0, rk1, rv0, rv1;
        float sc_b = 0.f, sc_p = 0.f, sc_c = 0.f, sc_bl = 0.f, sc_pl = 0.f;
#define ML_STEP_GEOM(st, base_, P0_) { if ((st) < 2) { base_ = 16384 + b * 256; P0_ = (dir ? 1 - (st) : (st)) * L; } else { base_ = b * 2048; P0_ = (dir ? 17 - (st) : (st) - 2) * L; } }
#define ML_PREFETCH(st) { int base_, P0_; ML_STEP_GEOM(st, base_, P0_) \
            const int pos_ = dir ? P0_ + L - 1 - u : P0_ + u; \
            { const bf16_t* rowp = QK + (size_t)(base_ + pos_) * 1024; \
              const int qcol = hd * 64 + part * 16, kcol = 512 + qcol; rq0 = *(const uint4*)(rowp + qcol); rq1 = *(const uint4*)(rowp + qcol + 8); rk0 = *(const uint4*)(rowp + kcol); rk1 = *(const uint4*)(rowp + kcol + 8); } \
            { const bf16_t* vp_ = V1 + (size_t)(base_ + pos_) * 1024 + hd * 128 + vh * 64 + part * 16; rv0 = *(const uint4*)vp_; rv1 = *(const uint4*)(vp_ + 8); } \
            if (w < 2) { const float* sp_ = (const float*)(p.ws + OFF_SCAN) + (size_t)((((b * 8 + hd) * 2 + dir) * 18) + (st)) * 384; \
                sc_b = sp_[tid]; sc_p = sp_[128 + tid]; sc_c = sp_[256 + tid]; sc_bl = sp_[127]; sc_pl = sp_[255]; } }
        ML_PREFETCH(0)
        __syncthreads();
#pragma unroll 1
        for (int step = 0; step < 18; ++step) {
            lane = lane0; asm volatile("" : "+v"(lane));
            tid = w * 64 + lane; h = lane >> 5; r = lane & 31; u = tid >> 2; part = tid & 3;
            int base, P0; ML_STEP_GEOM(step, base, P0)
            const bool full = step >= 2;
            if (w < 2) {
                const float mt = fmaxf(sc_b + m_prev, sc_b + sc_p);
                const float mnew = fmaxf(sc_bl + m_prev, sc_bl + sc_pl);
                bcum[tid] = sc_b; csv[tid] = sc_c; mtv[tid] = mt;
                wint[tid] = __expf(sc_b + m_prev - mt);
                wgt[tid] = __expf(sc_bl + sc_c - mnew);
                if (tid == 0) { scal[0] = mnew; scal[1] = __expf(sc_bl + m_prev - mnew); }
            }
            {
                *(uint4*)(Qc + u * LP + part * 16) = rq0; *(uint4*)(Qc + u * LP + part * 16 + 8) = rq1;
                *(uint4*)(Kc + u * LP + part * 16) = rk0; *(uint4*)(Kc + u * LP + part * 16 + 8) = rk1;
#define ML_T2(dstT, wv, ci) { dstT[(part * 16 + (ci)) * TP + u] = (bf16_t)((wv) & 0xffffu); dstT[(part * 16 + (ci) + 1) * TP + u] = (bf16_t)((wv) >> 16); }
                ML_T2(KcT, rk0.x, 0) ML_T2(KcT, rk0.y, 2) ML_T2(KcT, rk0.z, 4) ML_T2(KcT, rk0.w, 6) ML_T2(KcT, rk1.x, 8) ML_T2(KcT, rk1.y, 10) ML_T2(KcT, rk1.z, 12) ML_T2(KcT, rk1.w, 14)
                ML_T2(VcT, rv0.x, 0) ML_T2(VcT, rv0.y, 2) ML_T2(VcT, rv0.z, 4) ML_T2(VcT, rv0.w, 6) ML_T2(VcT, rv1.x, 8) ML_T2(VcT, rv1.y, 10) ML_T2(VcT, rv1.z, 12) ML_T2(VcT, rv1.w, 14)
#undef ML_T2
            }
            if (step + 1 < 18) ML_PREFETCH(step + 1)
            LDS_BARRIER();
            const float m_new = scal[0], decay = scal[1];
            {
                const int vv = tid >> 3, s0_ = (tid & 7) * 16;
#pragma unroll
                for (int q = 0; q < 2; ++q) {
                    float f[8]; unpack8(*(const uint4*)(VcT + vv * TP + s0_ + q * 8), f);
                    const float4 w0 = *(const float4*)(wgt + s0_ + q * 8), w1 = *(const float4*)(wgt + s0_ + q * 8 + 4);
                    f[0] *= w0.x; f[1] *= w0.y; f[2] *= w0.z; f[3] *= w0.w; f[4] *= w1.x; f[5] *= w1.y; f[6] *= w1.z; f[7] *= w1.w;
                    *(uint4*)(VwT + vv * TP + s0_ + q * 8) = pack8(f);
                }
            }
            if (full) {
                {
                    float sacc_ = 0.f;
#pragma unroll
                    for (int q = 0; q < 2; ++q) {
                        float f[8]; unpack8(*(const uint4*)(Qc + u * LP + part * 16 + q * 8), f);
                        const float4 n0 = *(const float4*)(nvec + part * 16 + q * 8), n1 = *(const float4*)(nvec + part * 16 + q * 8 + 4);
                        sacc_ += f[0] * n0.x + f[1] * n0.y + f[2] * n0.z + f[3] * n0.w + f[4] * n1.x + f[5] * n1.y + f[6] * n1.z + f[7] * n1.w;
                    }
                    sacc_ += __shfl_xor(sacc_, 1); sacc_ += __shfl_xor(sacc_, 2);
                    if (part == 0) denX[u] = sacc_;
                }
                const int ti = w >> 1, t = ti * 32 + r;
                const float bt = bcum[t] - mtv[t];
                float rs = 0.f;
#pragma unroll
                for (int q = 0; q < 2; ++q) {
                    const int si = 2 * (w & 1) + q;
                    if (si <= ti) {
                        f32x16 sacc = zero16();
#pragma unroll
                        for (int ks = 0; ks < 4; ++ks) {
                            bf16x8 a = *(const bf16x8*)(Kc + (si * 32 + r) * LP + ks * 16 + h * 8);
                            bf16x8 bb = *(const bf16x8*)(Qc + (ti * 32 + r) * LP + ks * 16 + h * 8);
                            sacc = MFMA(a, bb, sacc);
                        }
#pragma unroll
                        for (int g4 = 0; g4 < 4; ++g4) {
                            const int s0_ = si * 32 + 8 * g4 + 4 * h;
                            const float4 c4 = *(const float4*)(csv + s0_);
                            float p0 = s0_ + 0 <= t ? sacc[4 * g4 + 0] * __expf(bt + c4.x) : 0.f;
                            float p1 = s0_ + 1 <= t ? sacc[4 * g4 + 1] * __expf(bt + c4.y) : 0.f;
                            float p2 = s0_ + 2 <= t ? sacc[4 * g4 + 2] * __expf(bt + c4.z) : 0.f;
                            float p3 = s0_ + 3 <= t ? sacc[4 * g4 + 3] * __expf(bt + c4.w) : 0.f;
                            rs += (p0 + p1) + (p2 + p3);
                            uint2 pk; pk.x = pack2(p0, p1); pk.y = pack2(p2, p3);
                            *(uint2*)(Pm + t * TP + s0_) = pk;
                        }
                    } else {
#pragma unroll
                        for (int g4 = 0; g4 < 4; ++g4) *(uint2*)(Pm + t * TP + si * 32 + 8 * g4 + 4 * h) = make_uint2(0u, 0u);
                    }
                }
                rs += __shfl_xor(rs, 32);
                if (h == 0) denP[(w & 1) * 128 + t] = rs;
            }
            LDS_BARRIER();
            f32x16 hacc = zero16();
            const int ti = w >> 1, vi = w & 1;
            if (full) {
#pragma unroll
                for (int ks = 0; ks < 4; ++ks) {
                    bf16x8 a = *(const bf16x8*)(Cb + (vi * 32 + r) * LP + ks * 16 + h * 8);
                    bf16x8 bb = *(const bf16x8*)(Qc + (ti * 32 + r) * LP + ks * 16 + h * 8);
                    hacc = MFMA(a, bb, hacc);
                }
                const float wi = wint[ti * 32 + r];
#pragma unroll
                for (int g = 0; g < 16; ++g) hacc[g] *= wi;
#pragma unroll
                for (int ks = 0; ks < 8; ++ks) {
                    if (ks <= 2 * ti + 1) {
                        bf16x8 a = *(const bf16x8*)(VcT + (vi * 32 + r) * TP + ks * 16 + h * 8);
                        bf16x8 bb = *(const bf16x8*)(Pm + (ti * 32 + r) * TP + ks * 16 + h * 8);
                        hacc = MFMA(a, bb, hacc);
                    }
                }
            }
            LDS_BARRIER();
            if (full) {
                const int t = ti * 32 + r;
                const float den = wint[t] * denX[t] + denP[t] + denP[128 + t];
                const float inv = __builtin_amdgcn_rcpf(fmaxf(fabsf(den), __expf(-mtv[t])));
                bf16_t* hp = Pm + t * LP + vi * 32 + 4 * h;
#pragma unroll
                for (int g4 = 0; g4 < 4; ++g4) {
                    uint2 pk; pk.x = pack2(hacc[4 * g4] * inv, hacc[4 * g4 + 1] * inv); pk.y = pack2(hacc[4 * g4 + 2] * inv, hacc[4 * g4 + 3] * inv);
                    *(uint2*)(hp + 8 * g4) = pk;
                }
            }
            if (w < 4) {
                const int vi2 = w >> 1, di = w & 1;
#pragma unroll
                for (int g = 0; g < 16; ++g) accC[g] *= decay;
#pragma unroll
                for (int ks = 0; ks < 8; ++ks) {
                    bf16x8 a = *(const bf16x8*)(VwT + (vi2 * 32 + r) * TP + ks * 16 + h * 8);
                    bf16x8 bb = *(const bf16x8*)(KcT + (di * 32 + r) * TP + ks * 16 + h * 8);
                    accC = MFMA(a, bb, accC);
                }
#pragma unroll
                for (int g = 0; g < 16; ++g) Cb[(vi2 * 32 + crow(g, h)) * LP + di * 32 + r] = f2bf_sw(accC[g]);
            } else {
                const int t2 = tid - 256, d = t2 >> 2, pq = t2 & 3;
                float sacc_ = 0.f;
#pragma unroll
                for (int q = 0; q < 4; ++q) {
                    float f[8]; unpack8(*(const uint4*)(KcT + d * TP + pq * 32 + q * 8), f);
                    const float4 w0 = *(const float4*)(wgt + pq * 32 + q * 8), w1 = *(const float4*)(wgt + pq * 32 + q * 8 + 4);
                    sacc_ += f[0] * w0.x + f[1] * w0.y + f[2] * w0.z + f[3] * w0.w + f[4] * w1.x + f[5] * w1.y + f[6] * w1.z + f[7] * w1.w;
                }
                sacc_ += __shfl_xor(sacc_, 1); sacc_ += __shfl_xor(sacc_, 2);
                if (pq == 0) nvec[d] = decay * nvec[d] + sacc_;
            }
            m_prev = m_new;
            LDS_BARRIER();
            if (full) {
#pragma unroll
                for (int q = 0; q < 2; ++q) {
                    const int c = tid + 512 * q, t = c >> 3, ch = c & 7;
                    const int pos = dir ? P0 + L - 1 - t : P0 + t;
                    *(uint4*)(Hout + (size_t)(base + pos) * 1024 + hd * 128 + vh * 64 + ch * 8) = *(const uint4*)(Pm + t * LP + ch * 8);
                }
            }
        }
#undef ML_STEP_GEOM
#undef ML_PREFETCH
    }
}

DI void phase_mix(const Params& p) {
    const int lane = threadIdx.x & 63, w = threadIdx.x >> 6;
    const bf16_t* HF = (const bf16_t*)(p.ws + OFF_HF);
    const bf16_t* HB = (const bf16_t*)(p.ws + OFF_HB);
    const bf16_t* OG = (const bf16_t*)(p.ws + OFF_OG);
    bf16_t* H = (bf16_t*)(p.ws + OFF_H);
    for (int row = blockIdx.x * 8 + w; row < 16384; row += gridDim.x * 8) {
        const size_t o = (size_t)row * 1024 + lane * 16;
        float a[16], bq[16], og[16];
        unpack8(*(const uint4*)(HF + o), a); unpack8(*(const uint4*)(HF + o + 8), a + 8);
        unpack8(*(const uint4*)(HB + o), bq); unpack8(*(const uint4*)(HB + o + 8), bq + 8);
        unpack8(*(const uint4*)(OG + o), og); unpack8(*(const uint4*)(OG + o + 8), og + 8);
        float ss = 0.f;
#pragma unroll
        for (int i = 0; i < 16; ++i) { a[i] += bq[i]; ss += a[i] * a[i]; }
        ss += __shfl_xor(ss, 1); ss += __shfl_xor(ss, 2); ss += __shfl_xor(ss, 4);
        const float rstd = rsqrtf(ss * (1.f / 128.f) + EPSF);
        const float* g = p.ml_out_g + lane * 16;
#pragma unroll
        for (int i = 0; i < 16; ++i) a[i] = a[i] * rstd * g[i] * sigmoidf_(og[i]);
        *(uint4*)(H + o) = pack8(a); *(uint4*)(H + o + 8) = pack8(a + 8);
    }
}

#define XB_TMO      128
#define XB_XCNT(j)  (256  + 64 * (j))
#define XB_XSUB(j)  (1280 + 64 * (j))
#define XB_XGEN(j)  (2304 + 64 * (j))
#define XB_TOP      3328
#define XB_TOPGEN   3392
#define XCD_BAR_WORDS 3456
#define XB_SPIN_CAP (1u << 18)
#define LAS __attribute__((address_space(3)))

__device__ __forceinline__ unsigned xb_ld(unsigned* p)              { return __hip_atomic_load(p, __ATOMIC_RELAXED, __HIP_MEMORY_SCOPE_AGENT); }
__device__ __forceinline__ unsigned xb_add(unsigned* p, unsigned v) { return __hip_atomic_fetch_add(p, v, __ATOMIC_RELAXED, __HIP_MEMORY_SCOPE_AGENT); }
__device__ __forceinline__ unsigned xb_xcc_id() { return (unsigned)__builtin_amdgcn_s_getreg((3 << 11) | 20) & 0xFu; }
#define XB_SPIN(cond, bar) do { unsigned _sp = 0; while (cond) { __builtin_amdgcn_s_sleep(1); \
    if ((++_sp & 255u) == 0u) { if (xb_ld(&(bar)[XB_TMO])) break; if (_sp > XB_SPIN_CAP) { atomicAdd(&(bar)[XB_TMO], 1u); break; } } } } while (0)

struct XcdBarrier {
    unsigned* bar; unsigned x;
    volatile LAS unsigned* st;
};

__device__ __forceinline__ XcdBarrier xcd_barrier_post(unsigned* bar, volatile LAS unsigned* st) {
    XcdBarrier b; b.bar = bar; b.x = xb_xcc_id(); b.st = st;
    if (threadIdx.x == 0) (void)xb_add(&bar[XB_XCNT(b.x)], 1u);
    return b;
}
__device__ __forceinline__ void xcd_barrier_complete(unsigned* bar, unsigned x, unsigned& nloc, unsigned& nx) {
    const unsigned G = gridDim.x * gridDim.y * gridDim.z;
    unsigned sum, cnt, mine, sp = 0u;
    for (;;) {
        sum = 0u; cnt = 0u; mine = 0u;
#pragma unroll
        for (unsigned j = 0; j < 16; ++j) { const unsigned c = xb_ld(&bar[XB_XCNT(j)]); sum += c; cnt += (c > 0u) ? 1u : 0u; mine = (j == x) ? c : mine; }
        if (sum == G) break;
        __builtin_amdgcn_s_sleep(1);
        if ((++sp & 255u) == 0u) { if (xb_ld(&bar[XB_TMO])) break; if (sp > XB_SPIN_CAP) { atomicAdd(&bar[XB_TMO], 1u); break; } }
    }
    nloc = mine > 0u ? mine : 1u; nx = cnt > 0u ? cnt : 1u;
}

__device__ __forceinline__ void xcd_barrier(const XcdBarrier& b) {
    asm volatile("s_waitcnt vmcnt(0)" ::: "memory");
    __syncthreads();
    if (threadIdx.x == 0) {
        unsigned* bar = b.bar;
        __builtin_amdgcn_s_waitcnt(0);
        unsigned nloc = b.st[0], nx = b.st[1];
        if (nloc == 0u) { xcd_barrier_complete(bar, b.x, nloc, nx); b.st[0] = nloc; b.st[1] = nx; }
        const unsigned old = xb_add(&bar[XB_XSUB(b.x)], 1u);
        const unsigned gen = old / nloc;
        if (old + 1u == (gen + 1u) * nloc) {
            __builtin_amdgcn_fence(__ATOMIC_RELEASE, "agent");
            asm volatile("s_waitcnt vmcnt(0)" ::: "memory");
            const unsigned og = xb_add(&bar[XB_TOP], 1u);
            const unsigned tg = og / nx;
            if (og + 1u == (tg + 1u) * nx) xb_add(&bar[XB_TOPGEN], 1u);
            else XB_SPIN(xb_ld(&bar[XB_TOPGEN]) == tg, bar);
            __builtin_amdgcn_fence(__ATOMIC_ACQUIRE, "agent");
            xb_add(&bar[XB_XGEN(b.x)], 1u);
            asm volatile("s_waitcnt vmcnt(0)" ::: "memory");
        } else {
            XB_SPIN(xb_ld(&bar[XB_XGEN(b.x)]) == gen, bar);
            __builtin_amdgcn_fence(__ATOMIC_ACQUIRE, "agent");
            asm volatile("s_waitcnt vmcnt(0)" ::: "memory");
        }
    }
    __syncthreads();
}


__global__ void __launch_bounds__(NTHREADS, 2) __attribute__((amdgpu_waves_per_eu(2, 2))) fwd_megakernel(Params p) {
    __shared__ __attribute__((aligned(1024))) char smem[SMEM_ALL];
    cg::grid_group grid = cg::this_grid();
    __shared__ uint4 xb_words;
    if (threadIdx.x == 0) xb_words = make_uint4(0u, 0u, 0u, 0u);
    __syncthreads();
    XcdBarrier xb = xcd_barrier_post((unsigned*)(p.ws + OFF_BAR), (volatile LAS unsigned*)&xb_words);
    const float* MOD0 = (const float*)(p.ws + OFF_MOD);
    const float* MOD1 = MOD0 + 9 * 6144;
    float* XRC = (float*)(p.ws + OFF_XRC);
    const bf16_t* Hb = (const bf16_t*)(p.ws + OFF_H);

    phase0(p, smem);
    if (p.ws == nullptr) grid.sync();
    xcd_barrier(xb);
    phase_norm(p, p.x, p.ctx, p.norm1_g, MOD0, 0, 18432);
    xcd_barrier(xb);
    phase_inproj0(p, smem);
    xcd_barrier(xb);
    phase_mla_up(p, smem);
    xcd_barrier(xb);
    phase_attn(p, smem);
    xcd_barrier(xb);
    phase_proj_resid(p, Hb, 1024, (const bf16_t*)(p.ws + OFF_WT_OUT0), MOD0, 2, p.x, p.ctx, p.out, XRC, 64, true, WT_UP0_0, WT_UP0_N, smem);
    xcd_barrier(xb);
    phase_norm(p, p.out, XRC, p.norm2_g, MOD0, 3, 18432);
    xcd_barrier(xb);
    phase_ffn_up(p, (const bf16_t*)(p.ws + OFF_WT_UP0), p.ffn_conv_w, p.ffn_conv_b, 80, WT_DOWN0_0, WT_DOWN0_N, smem);
    xcd_barrier(xb);
    phase_proj_resid(p, (const bf16_t*)(p.ws + OFF_ACT), 2816, (const bf16_t*)(p.ws + OFF_WT_DOWN0), MOD0, 5, p.out, XRC, p.out, XRC, 64, true, WT_L1_0, WT_L1_N, smem);
    xcd_barrier(xb);
    phase_norm(p, p.out, XRC, p.norm1_g + 1024, MOD1, 0, 18432);
    xcd_barrier(xb);
    phase_inproj1(p, smem);
    xcd_barrier(xb);
    phase_qkconv(p);
    xcd_barrier(xb);
    phase_mlstm(p, smem);
    xcd_barrier(xb);
    phase_mix(p);
    xcd_barrier(xb);
    phase_proj_resid(p, Hb, 1024, (const bf16_t*)(p.ws + OFF_WT_OUT1), MOD1, 2, p.out, XRC, p.out, XRC, 64, false, 0, 0, smem);
    xcd_barrier(xb);
    phase_norm(p, p.out, XRC, p.norm2_g + 1024, MOD1, 3, 16384);
    xcd_barrier(xb);
    phase_ffn_up(p, (const bf16_t*)(p.ws + OFF_WT_UP1), p.ffn_conv_w + 3 * 2816, p.ffn_conv_b + 2816, 68, 0, 0, smem);
    xcd_barrier(xb);
    phase_proj_resid(p, (const bf16_t*)(p.ws + OFF_ACT), 2816, (const bf16_t*)(p.ws + OFF_WT_DOWN1), MOD1, 5, p.out, XRC, p.out, XRC, 64, false, 0, 0, smem);
}

extern "C" void kernel_launch(void* const* d_in, const int* in_sizes, int n_in, void* d_out, int out_size, void* d_ws, size_t ws_size,
                              hipStream_t stream) {
    static int grid_blocks = 0;
    if (!grid_blocks) {
        int dev = 0, cus = 0, per_cu = 0;
        hipGetDevice(&dev);
        hipDeviceGetAttribute(&cus, hipDeviceAttributeMultiprocessorCount, dev);
        hipOccupancyMaxActiveBlocksPerMultiprocessor(&per_cu, fwd_megakernel, NTHREADS, 0);
        if (per_cu < 1) per_cu = 1;
        if (per_cu > 1) per_cu = 1;
        grid_blocks = cus * per_cu;
        if (ws_size < WS_END) fprintf(stderr, "kernel_launch: workspace too small: %zu < %zu\n", ws_size, (size_t)WS_END);
    }
    Params p{};
    const float** pf = (const float**)&p;
    for (int i = 0; i < 28; ++i) pf[i] = (const float*)d_in[i];
    p.out = (float*)d_out;
    p.ws = (char*)d_ws;
    hipMemsetAsync((char*)d_ws + OFF_BAR, 0, 16384, stream);
    void* args[] = {&p};
    hipError_t e = hipLaunchCooperativeKernel((void*)fwd_megakernel, dim3(grid_blocks), dim3(NTHREADS), args, 0, stream);
    if (e != hipSuccess) fprintf(stderr, "cooperative launch failed: %s (grid %d)\n", hipGetErrorString(e), grid_blocks);
}
```

```cpp
#include <hip/hip_runtime.h>
#include <hip/hip_cooperative_groups.h>
#include <cstdio>
namespace cg = cooperative_groups;

typedef unsigned short bf16_t;
using bf16x8 = __attribute__((ext_vector_type(8))) short;
using f32x16 = __attribute__((ext_vector_type(16))) float;
using f32x4 = __attribute__((ext_vector_type(4))) float;
#define DI __device__ __forceinline__
#define MFMA(a, b, c) __builtin_amdgcn_mfma_f32_32x32x16_bf16((a), (b), (c), 0, 0, 0)
#define MFMA16(a, b, c) __builtin_amdgcn_mfma_f32_16x16x32_bf16((a), (b), (c), 0, 0, 0)
#define LDS_BARRIER() do { asm volatile("s_waitcnt lgkmcnt(0)" ::: "memory"); __builtin_amdgcn_s_barrier(); asm volatile("" ::: "memory"); } while (0)
#define TID ((int)(threadIdx.x & 255))
#define HBI ((int)(threadIdx.x >> 8))

constexpr float EPSF = 1e-6f;
constexpr float LOG2E = 1.4426950408889634f;
constexpr int NTHREADS = 512;
constexpr int HB_SMEM = 73728;
constexpr int SMEM_ALL = 2 * HB_SMEM;
constexpr int GP = 72;
constexpr int CP = 132;
constexpr int ROWSS_OFF = 67584;

constexpr size_t OFF_WT_UP1 = 0;
constexpr size_t OFF_WT_DOWN1 = OFF_WT_UP1 + 5632ull * 1024 * 2;
constexpr size_t OFF_WT_IN1 = OFF_WT_DOWN1 + 1024ull * 2816 * 2;
constexpr size_t OFF_WT_OUT1 = OFF_WT_IN1 + 3328ull * 1024 * 2;
constexpr size_t OFF_MOD = OFF_WT_OUT1 + 1024ull * 1024 * 2;
constexpr size_t OFF_TABG = OFF_MOD + 2ull * 9 * 6144 * 4;
constexpr size_t OFF_TABM = OFF_TABG + 64 * 16 * 2 * 4;
constexpr size_t OFF_ZROW = OFF_TABM + 64 * 8 * 2 * 4;
constexpr size_t OFF_W0 = OFF_ZROW + 8192;
constexpr size_t OFF_WT_IN0 = OFF_W0;
constexpr size_t OFF_WT_QB = OFF_WT_IN0 + 1536ull * 1024 * 2;
constexpr size_t OFF_WT_KVB = OFF_WT_QB + 1024ull * 384 * 2;
constexpr size_t OFF_WT_OUT0 = OFF_WT_KVB + 1024ull * 256 * 2;
constexpr size_t OFF_WT_UP0 = OFF_WT_OUT0 + 1024ull * 1024 * 2;
constexpr size_t OFF_WT_DOWN0 = OFF_WT_UP0 + 5632ull * 1024 * 2;
constexpr size_t OFF_XRC = OFF_WT_DOWN0 + 1024ull * 2816 * 2;
constexpr size_t OFF_R = OFF_XRC + 2048ull * 1024 * 4;
constexpr size_t OFF_QG = OFF_R;
constexpr size_t OFF_KG = OFF_QG + 18432ull * 512 * 2;
constexpr size_t OFF_VGT = OFF_KG + 18432ull * 128 * 2;
constexpr size_t OFF_CQ = OFF_VGT + 18432ull * 128 * 2;
constexpr size_t OFF_CKV = OFF_CQ + 18432ull * 384 * 2;
constexpr size_t OFF_KR = OFF_CKV + 18432ull * 256 * 2;
constexpr size_t OFF_QM = OFF_KR + 18432ull * 32 * 4;
constexpr size_t OFF_KM = OFF_QM + 18432ull * 768 * 2;
constexpr size_t OFF_VMT = OFF_KM + 18432ull * 768 * 2;
constexpr size_t END_L0 = OFF_VMT + 18432ull * 512 * 2;
constexpr size_t OFF_ACT = OFF_R;
constexpr size_t END_ACT = OFF_ACT + 18432ull * 2816 * 2;
constexpr size_t OFF_QKRAW = OFF_W0;
constexpr size_t OFF_V1 = OFF_QKRAW + 18432ull * 1024 * 2;
constexpr size_t OFF_OG = OFF_V1 + 18432ull * 1024 * 2;
constexpr size_t OFF_GATES = OFF_OG + 16384ull * 1024 * 2;
constexpr size_t OFF_HF = OFF_GATES + 18432ull * 32 * 4;
constexpr size_t OFF_HB = OFF_HF + 16384ull * 1024 * 2;
constexpr size_t END_L1 = OFF_HB + 16384ull * 1024 * 2;
constexpr size_t cmax(size_t a, size_t b) { return a > b ? a : b; }
constexpr size_t OFF_H = cmax(cmax(END_L0, END_ACT), END_L1);
constexpr size_t OFF_BAR = OFF_H + 18432ull * 1024 * 2;
constexpr size_t OFF_SCAN = OFF_BAR + 16384;
constexpr size_t WS_END = OFF_SCAN + 2304ull * 384 * 4;
static_assert(WS_END <= 268435456ull, "workspace too large");
static_assert(OFF_H % 256 == 0 && OFF_R % 256 == 0 && OFF_HF % 256 == 0, "align");

struct Params {
    const float *x, *c, *ctx, *c_ctx, *ada_w, *ada_b, *norm1_g, *norm2_g, *ffn_w_up, *ffn_conv_w, *ffn_conv_b, *ffn_w_down,
        *att_w_in, *mla_qa_g, *mla_w_qb, *mla_kva_g, *mla_w_kvb, *mla_q_g, *mla_k_g, *gqa_q_g, *gqa_k_g, *att_w_out,
        *ml_w_in, *ml_conv_w, *ml_conv_b, *ml_gate_b, *ml_out_g, *ml_w_out;
    float* out;
    char* ws;
};

DI unsigned short f2bf_sw(float x) { unsigned u = __float_as_uint(x); u += 0x7fffu + ((u >> 16) & 1u); return (unsigned short)(u >> 16); }
DI unsigned short f2bf(float x) { unsigned r; asm("v_cvt_pk_bf16_f32 %0, %1, %1" : "=v"(r) : "v"(x)); return (unsigned short)(r & 0xffffu); }
DI unsigned pack2(float a, float b) { unsigned r; asm("v_cvt_pk_bf16_f32 %0, %1, %2" : "=v"(r) : "v"(a), "v"(b)); return r; }
DI bf16x8 pack_frag(float a0, float a1, float a2, float a3, float a4, float a5, float a6, float a7) {
    using u32x4_ = __attribute__((ext_vector_type(4))) unsigned; u32x4_ p;
    asm volatile("v_cvt_pk_bf16_f32 %0, %4, %5\n\tv_cvt_pk_bf16_f32 %1, %6, %7\n\tv_cvt_pk_bf16_f32 %2, %8, %9\n\tv_cvt_pk_bf16_f32 %3, %10, %11\n\ts_nop 1"
                 : "=&v"(p[0]), "=&v"(p[1]), "=&v"(p[2]), "=&v"(p[3]) : "v"(a0), "v"(a1), "v"(a2), "v"(a3), "v"(a4), "v"(a5), "v"(a6), "v"(a7));
    return __builtin_bit_cast(bf16x8, p);
}
DI float bflo(unsigned v) { return __uint_as_float(v << 16); }
DI float bfhi(unsigned v) { return __uint_as_float(v & 0xffff0000u); }
DI float bf2f(unsigned short v) { return __uint_as_float(((unsigned)v) << 16); }
DI uint4 pack8(const float* v) { uint4 o; o.x = pack2(v[0], v[1]); o.y = pack2(v[2], v[3]); o.z = pack2(v[4], v[5]); o.w = pack2(v[6], v[7]); return o; }
DI void unpack8(uint4 u, float* v) { v[0] = bflo(u.x); v[1] = bfhi(u.x); v[2] = bflo(u.y); v[3] = bfhi(u.y); v[4] = bflo(u.z); v[5] = bfhi(u.z); v[6] = bflo(u.w); v[7] = bfhi(u.w); }
DI int crow(int reg, int h) { return (reg & 3) + 8 * (reg >> 2) + 4 * h; }
DI float sigmoidf_(float x) { return __builtin_amdgcn_rcpf(1.f + __expf(-x)); }
DI float siluf_(float x) { return x * __builtin_amdgcn_rcpf(1.f + __expf(-x)); }
DI float logsigmoidf_(float x) { return fminf(x, 0.f) - log1pf(__expf(-fabsf(x))); }
DI f32x16 zero16() { f32x16 z;
#pragma unroll
    for (int i = 0; i < 16; ++i) z[i] = 0.f; return z; }

DI void row_info(int m0, int& b, int& t0, bool& lat) {
    if (m0 < 16384) { b = m0 >> 11; t0 = m0 & 2047; lat = true; }
    else { int q = m0 - 16384; b = q >> 8; t0 = q & 255; lat = false; }
}

template <bool SS, bool HALO, class Epi>
DI void gemm_tile(const bf16_t* ap0, const bf16_t* ap1, const bf16_t* ap2, const bf16_t* ap3, unsigned mk0, unsigned mk1, unsigned mk2, unsigned mk3, const bf16_t* __restrict__ Bt, int ldb, int K, char* smem, Epi epi) {
    const int tid = TID, lane = tid & 63, w = tid >> 6, h = lane >> 5, r = lane & 31;
    const int wm = w >> 1, wn = w & 1;
    const int lr = tid >> 3, kc = tid & 7;
    ap0 += kc * 8; ap1 += kc * 8; ap2 += kc * 8; ap3 += kc * 8;
    const bf16_t* bp0 = Bt + (size_t)lr * ldb + kc * 8;
    const bf16_t* bp1 = bp0 + (size_t)32 * ldb; const bf16_t* bp2 = bp0 + (size_t)64 * ldb; const bf16_t* bp3 = bp0 + (size_t)96 * ldb;
    f32x16 acc00 = zero16(), acc01 = zero16(), acc10 = zero16(), acc11 = zero16();
    float ss0 = 0.f, ss1 = 0.f, ss2 = 0.f, ss3 = 0.f;
    uint4 ra0, ra1, ra2, ra3, rb0, rb1, rb2, rb3;
    const int nk = K >> 6;
#define GLOAD(k0) { ra0 = *(const uint4*)(ap0 + (k0)); ra1 = *(const uint4*)(ap1 + (k0)); ra2 = *(const uint4*)(ap2 + (k0)); ra3 = *(const uint4*)(ap3 + (k0)); \
                    rb0 = *(const uint4*)(bp0 + (k0)); rb1 = *(const uint4*)(bp1 + (k0)); rb2 = *(const uint4*)(bp2 + (k0)); rb3 = *(const uint4*)(bp3 + (k0)); }
#define SSQ(ssv, rv) { if (SS) { float f_[8]; unpack8(rv, f_); ssv += f_[0]*f_[0] + f_[1]*f_[1] + f_[2]*f_[2] + f_[3]*f_[3] + f_[4]*f_[4] + f_[5]*f_[5] + f_[6]*f_[6] + f_[7]*f_[7]; } }
#define MSK(rv, mk) { rv.x &= mk; rv.y &= mk; rv.z &= mk; rv.w &= mk; }
#define SWRITE(s_) { if (HALO) { MSK(ra0, mk0) MSK(ra1, mk1) MSK(ra2, mk2) MSK(ra3, mk3) } bf16_t* As_ = (bf16_t*)(smem + (s_) * 36864) + lr * GP + kc * 8; bf16_t* Bs_ = As_ + 128 * GP; \
                     *(uint4*)(As_) = ra0; *(uint4*)(As_ + 32 * GP) = ra1; *(uint4*)(As_ + 64 * GP) = ra2; *(uint4*)(As_ + 96 * GP) = ra3; \
                     *(uint4*)(Bs_) = rb0; *(uint4*)(Bs_ + 32 * GP) = rb1; *(uint4*)(Bs_ + 64 * GP) = rb2; *(uint4*)(Bs_ + 96 * GP) = rb3; \
                     SSQ(ss0, ra0) SSQ(ss1, ra1) SSQ(ss2, ra2) SSQ(ss3, ra3) }
    GLOAD(0) SWRITE(0) __syncthreads();
#pragma unroll 1
    for (int kt = 0; kt < nk; ++kt) {
        if (kt + 1 < nk) GLOAD((kt + 1) * 64)
        {
            const bf16_t* As = (const bf16_t*)(smem + (kt & 1) * 36864) + (wm * 64 + r) * GP + h * 8;
            const bf16_t* Bs = (const bf16_t*)(smem + (kt & 1) * 36864) + 128 * GP + (wn * 64 + r) * GP + h * 8;
#pragma unroll
            for (int ks = 0; ks < 4; ++ks) {
                const bf16x8 a0 = *(const bf16x8*)(As + ks * 16), a1 = *(const bf16x8*)(As + 32 * GP + ks * 16);
                const bf16x8 b0 = *(const bf16x8*)(Bs + ks * 16), b1 = *(const bf16x8*)(Bs + 32 * GP + ks * 16);
                acc00 = MFMA(a0, b0, acc00); acc01 = MFMA(a0, b1, acc01); acc10 = MFMA(a1, b0, acc10); acc11 = MFMA(a1, b1, acc11);
            }
        }
        if (kt + 1 < nk) SWRITE((kt + 1) & 1)
        __syncthreads();
    }
#undef GLOAD
#undef SWRITE
#undef SSQ
#undef MSK
    float* Cs = (float*)smem;
    {
        float* cb = Cs + (wm * 64 + 4 * h) * CP + wn * 64 + r;
#pragma unroll
        for (int g = 0; g < 16; ++g) {
            const int ro = (g & 3) + 8 * (g >> 2);
            cb[ro * CP] = acc00[g]; cb[ro * CP + 32] = acc01[g]; cb[(ro + 32) * CP] = acc10[g]; cb[(ro + 32) * CP + 32] = acc11[g];
        }
    }
    if (SS) {
        float* rowss = (float*)(smem + ROWSS_OFF);
        ss0 += __shfl_xor(ss0, 1); ss0 += __shfl_xor(ss0, 2); ss0 += __shfl_xor(ss0, 4);
        ss1 += __shfl_xor(ss1, 1); ss1 += __shfl_xor(ss1, 2); ss1 += __shfl_xor(ss1, 4);
        ss2 += __shfl_xor(ss2, 1); ss2 += __shfl_xor(ss2, 2); ss2 += __shfl_xor(ss2, 4);
        ss3 += __shfl_xor(ss3, 1); ss3 += __shfl_xor(ss3, 2); ss3 += __shfl_xor(ss3, 4);
        if (kc == 0) { rowss[lr] = ss0; rowss[lr + 32] = ss1; rowss[lr + 64] = ss2; rowss[lr + 96] = ss3; }
    }
    __syncthreads();
    epi((const float*)smem, (const float*)(smem + ROWSS_OFF));
    __syncthreads();
}


DI int g_row(int i) { return ((i * 8 + (int)(threadIdx.x >> 6)) * 8) + (int)((threadIdx.x & 63) >> 3); }
DI int b_perm(int row) { return ((row >> 5) & 1) * 128 + (row >> 6) * 32 + (row & 31); }
DI int g_chunk(int row) { return (int)(threadIdx.x & 7) ^ ((row >> 1) & 7); }
#define GLDS(g_, l_) __builtin_amdgcn_global_load_lds((const unsigned*)(g_), (unsigned*)(l_), 16, 0, 0)
template <int NH = -1, class Epi>
DI void gemm256(const char* wsb, const bf16_t* a0p, const bf16_t* a1p, const bf16_t* a2p, const bf16_t* a3p,
                const bf16_t* b0p, const bf16_t* b1p, const bf16_t* b2p, const bf16_t* b3p, int K, char* smem_all, Epi epi) {
    const unsigned a0 = (unsigned)((const char*)a0p - wsb), a1 = (unsigned)((const char*)a1p - wsb), a2 = (unsigned)((const char*)a2p - wsb), a3 = (unsigned)((const char*)a3p - wsb);
    const unsigned b0 = (unsigned)((const char*)b0p - wsb), b1 = (unsigned)((const char*)b1p - wsb), b2 = (unsigned)((const char*)b2p - wsb), b3 = (unsigned)((const char*)b3p - wsb);
    const int lane = threadIdx.x & 63, wid = __builtin_amdgcn_readfirstlane(threadIdx.x >> 6), wr = wid >> 2, wc = wid & 3, fr = lane & 15, fq = lane >> 4;
    f32x4 acc[8][4];
#pragma unroll
    for (int m = 0; m < 8; ++m)
#pragma unroll
        for (int n = 0; n < 4; ++n) acc[m][n] = (f32x4){0.f, 0.f, 0.f, 0.f};
#define STAGE256(buf, k0) { char* sa_ = smem_all + (buf) * 65536 + wid * 1024; char* sb_ = sa_ + 32768; const char* wk_ = wsb + (size_t)(k0) * 2; \
        GLDS(wk_ + a0, sa_); GLDS(wk_ + a1, sa_ + 8192); GLDS(wk_ + a2, sa_ + 16384); GLDS(wk_ + a3, sa_ + 24576); \
        if (NH < 0 || (wid >> 2) == NH) { GLDS(wk_ + b0, sb_); GLDS(wk_ + b1, sb_ + 8192); GLDS(wk_ + b2, sb_ + 16384); GLDS(wk_ + b3, sb_ + 24576); } }
    const int sw = (fr >> 1) & 7;
    const unsigned offA = (wr * 128 + fr) * 128, offB = 32768 + (wc * 64 + fr) * 128;
    const unsigned co0 = ((0 + fq) ^ sw) << 4, co1 = ((4 + fq) ^ sw) << 4;
    const unsigned lds0 = (unsigned)(size_t)smem_all;
    const int nt = K >> 6;
    STAGE256(0, 0)
    asm volatile("s_waitcnt vmcnt(0)" ::: "memory");
    __syncthreads();
#pragma unroll 1
    for (int t = 0; t < nt; ++t) {
        const int cur = t & 1;
        if (t + 1 < nt) STAGE256(cur ^ 1, (t + 1) * 64)
        const unsigned lb = lds0 + cur * 65536;
        const unsigned aA0 = lb + offA + co0, aA1 = lb + offA + co1, aB0 = lb + offB + co0, aB1 = lb + offB + co1;
        bf16x8 Bq0[4], Bq1[4], Aq0[2], Aq1[2];
#define DSR(dst, addr, off) asm volatile("ds_read_b128 %0, %1 offset:%2" : "=v"(dst) : "v"(addr), "n"(off) : "memory")
#define LDA2(dst, addr, mo) { DSR(dst[0], addr, (mo) * 2048); DSR(dst[1], addr, ((mo) + 1) * 2048); }
#define LDB4(dst, addr) { DSR(dst[0], addr, 0); DSR(dst[1], addr, 2048); DSR(dst[2], addr, 4096); DSR(dst[3], addr, 6144); }
#define WAIT_A(n, X) asm volatile("s_waitcnt lgkmcnt(" #n ")" : "+v"(X[0]), "+v"(X[1]) :: "memory")
#define WAIT_AB(n, X, Y) asm volatile("s_waitcnt lgkmcnt(" #n ")" : "+v"(X[0]), "+v"(X[1]), "+v"(Y[0]), "+v"(Y[1]), "+v"(Y[2]), "+v"(Y[3]) :: "memory")
#define MM8(Aq, Bq, mo) { _Pragma("unroll") for (int m = 0; m < 2; ++m) _Pragma("unroll") for (int n = 0; n < 4; ++n) if (NH < 0 || (n >> 1) == NH) acc[(mo) + m][n] = MFMA16(Bq[n], Aq[m], acc[(mo) + m][n]); }
        LDB4(Bq0, aB0) LDA2(Aq0, aA0, 0) LDA2(Aq1, aA0, 2)
        WAIT_AB(2, Aq0, Bq0);
        MM8(Aq0, Bq0, 0)
        LDA2(Aq0, aA0, 4)
        WAIT_A(2, Aq1);
        MM8(Aq1, Bq0, 2)
        LDA2(Aq1, aA0, 6) LDB4(Bq1, aB1)
        WAIT_A(6, Aq0);
        MM8(Aq0, Bq0, 4)
        LDA2(Aq0, aA1, 0)
        WAIT_A(6, Aq1);
        MM8(Aq1, Bq0, 6)
        LDA2(Aq1, aA1, 2)
        WAIT_AB(2, Aq0, Bq1);
        MM8(Aq0, Bq1, 0)
        LDA2(Aq0, aA1, 4)
        WAIT_A(2, Aq1);
        MM8(Aq1, Bq1, 2)
        LDA2(Aq1, aA1, 6)
        WAIT_A(2, Aq0);
        MM8(Aq0, Bq1, 4)
        WAIT_A(0, Aq1);
        MM8(Aq1, Bq1, 6)
#undef DSR
#undef LDA2
#undef LDB4
#undef WAIT_A
#undef WAIT_AB
#undef MM8
        asm volatile("s_waitcnt vmcnt(0)" ::: "memory");
        __syncthreads();
    }
#undef STAGE256
    int t_ = threadIdx.x;
    asm volatile("" : "+v"(t_));
    const int lane_ = t_ & 63, wid_ = t_ >> 6, wr_ = wid_ >> 2, wc_ = wid_ & 3, fr_ = lane_ & 15, fq_ = lane_ >> 4, hb_ = t_ >> 8;
#pragma unroll
    for (int p = 0; p < 2; ++p) {
        if (NH >= 0 && p != NH) continue;
        {
            float* Cs = (float*)(smem_all + wr_ * HB_SMEM) + fr_ * CP + wc_ * 32 + 4 * fq_;
#pragma unroll
            for (int m = 0; m < 8; ++m)
#pragma unroll
                for (int n = 0; n < 2; ++n) *(f32x4*)(Cs + (m * 16) * CP + n * 16) = acc[m][2 * p + n];
        }
        __syncthreads();
        epi((const float*)(smem_all + hb_ * HB_SMEM), hb_, p, t_ & 255);
        __syncthreads();
    }
}

DI void epi_store_bf16(const float* Cs, bf16_t* dst, int ld, int tid) {
#pragma unroll 2
    for (int j = 0; j < 8; ++j) {
        int c = tid + 256 * j, row = c >> 4, cc = c & 15;
        const float4* cp = (const float4*)(Cs + row * CP + cc * 8);
        float4 f0 = cp[0], f1 = cp[1];
        float v[8] = {f0.x, f0.y, f0.z, f0.w, f1.x, f1.y, f1.z, f1.w};
        *(uint4*)(dst + (size_t)row * ld + cc * 8) = pack8(v);
    }
}
DI void epi_resid(const float* Cs, const float* src, float* dst, const float* gate, int tid) {
#pragma unroll 4
    for (int j = 0; j < 16; ++j) {
        int c = tid + 256 * j, row = c >> 5, c4 = c & 31;
        float4 cv = *(const float4*)(Cs + row * CP + c4 * 4);
        float4 sv = *(const float4*)(src + (size_t)row * 1024 + c4 * 4);
        float4 gv = *(const float4*)(gate + c4 * 4);
        float4 o; o.x = sv.x + gv.x * cv.x; o.y = sv.y + gv.y * cv.y; o.z = sv.z + gv.z * cv.z; o.w = sv.w + gv.w * cv.w;
        *(float4*)(dst + (size_t)row * 1024 + c4 * 4) = o;
    }
}

DI int wsrc_col(int mode, int tn, int c) {
    if (mode == 0) return tn * 128 + c;
    if (mode == 1) {
        const int np = tn * 128;
        if (np < 512) return 672 + np + c;
        if (np < 640) return 1184 + np - 512 + c;
        if (np < 768) return 1312 + np - 640 + c;
        if (np < 1152) return np - 768 + c;
        if (np < 1408) return 384 + np - 1152 + c;
        return c < 32 ? 640 + c : -1;
    }
    if (mode == 2) return c < 96 ? tn * 96 + c : -1;
    return c < 64 ? 64 * tn + c : 2816 + 64 * tn + c - 64;
}
DI void wtile(const float* __restrict__ src, int Nsrc, const float* __restrict__ g, bf16_t* __restrict__ dst, int K, int k0, int tn, int mode, char* smem) {
    bf16_t* T = (bf16_t*)smem;
    const int tid = TID, lane = tid & 63, w = tid >> 6, rsub = lane >> 5, c4 = (lane & 31) * 4;
    int sc = wsrc_col(mode, tn, c4);
    if (sc >= Nsrc) sc = -1;
#pragma unroll 8
    for (int i = 0; i < 16; ++i) {
        const int rr = w * 32 + 2 * i + rsub;
        float4 v = make_float4(0.f, 0.f, 0.f, 0.f);
        if (sc >= 0) { v = *(const float4*)(src + (size_t)(k0 + rr) * Nsrc + sc); if (g) { const float gg = g[k0 + rr]; v.x *= gg; v.y *= gg; v.z *= gg; v.w *= gg; } }
        T[(c4 + 0) * 130 + rr] = f2bf(v.x);
        T[(c4 + 1) * 130 + rr] = f2bf(v.y);
        T[(c4 + 2) * 130 + rr] = f2bf(v.z);
        T[(c4 + 3) * 130 + rr] = f2bf(v.w);
    }
    __syncthreads();
#pragma unroll
    for (int j = 0; j < 8; ++j) {
        const int c = tid + 256 * j, n = c >> 4, kc = c & 15;
        const unsigned* s32 = (const unsigned*)(T + n * 130 + kc * 8);
        uint4 o; o.x = s32[0]; o.y = s32[1]; o.z = s32[2]; o.w = s32[3];
        *(uint4*)(dst + (size_t)(tn * 128 + n) * K + k0 + kc * 8) = o;
    }
    __syncthreads();
}

DI void mod_item(const Params& p, int item, char* smem) {
    const int tid = TID, lane = tid & 63, w = tid >> 6, hl = lane >> 5, cl = lane & 31;
    const int l = item / 192, n0 = (item % 192) * 32;
    float* sl = (float*)smem;
    for (int i = tid; i < 9216; i += 256) {
        int rr = i >> 10, k = i & 1023;
        float cv = rr < 8 ? p.c[rr * 1024 + k] : p.c_ctx[k];
        sl[k * 12 + rr] = cv / (1.f + expf(-cv));
    }
    __syncthreads();
    float acc[9];
#pragma unroll
    for (int q = 0; q < 9; ++q) acc[q] = 0.f;
    const float* wp = p.ada_w + (size_t)l * 1024 * 6144 + n0 + cl;
#pragma unroll 16
    for (int kk = 0; kk < 128; ++kk) {
        const int k = w * 256 + 2 * kk + hl;
        const float wv = wp[(size_t)k * 6144];
        const float4 s0 = *(const float4*)(sl + k * 12), s1 = *(const float4*)(sl + k * 12 + 4);
        const float s8 = sl[k * 12 + 8];
        acc[0] += s0.x * wv; acc[1] += s0.y * wv; acc[2] += s0.z * wv; acc[3] += s0.w * wv;
        acc[4] += s1.x * wv; acc[5] += s1.y * wv; acc[6] += s1.z * wv; acc[7] += s1.w * wv; acc[8] += s8 * wv;
    }
    float* red = (float*)(smem + 49152);
#pragma unroll
    for (int q = 0; q < 9; ++q) red[((w * 2 + hl) * 9 + q) * 32 + cl] = acc[q];
    __syncthreads();
    float* MOD = (float*)(p.ws + OFF_MOD);
    for (int i = tid; i < 288; i += 256) {
        int q = i >> 5, ln = i & 31;
        float sacc = 0.f;
#pragma unroll
        for (int u = 0; u < 8; ++u) sacc += red[(u * 9 + q) * 32 + ln];
        sacc += p.ada_b[l * 6144 + n0 + ln];
        MOD[(size_t)(l * 9 + q) * 6144 + n0 + ln] = sacc;
    }
    __syncthreads();
}

DI void mod_item8(const Params& p, int item, char* smem_all) {
    const int tid = threadIdx.x, lane = tid & 63, w = tid >> 6, hl = lane >> 5, cl = lane & 31;
    const int l = item / 96, n0 = (item % 96) * 64;
    float* sl = (float*)smem_all;
    for (int i = tid; i < 9216; i += 512) {
        int rr = i >> 10, k = i & 1023;
        float cv = rr < 8 ? p.c[rr * 1024 + k] : p.c_ctx[k];
        sl[k * 12 + rr] = cv / (1.f + expf(-cv));
    }
    __syncthreads();
    float a0[9], a1[9];
#pragma unroll
    for (int q = 0; q < 9; ++q) { a0[q] = 0.f; a1[q] = 0.f; }
    const float* wp = p.ada_w + (size_t)l * 1024 * 6144 + n0 + cl * 2;
#pragma unroll 16
    for (int kk = 0; kk < 64; ++kk) {
        const int k = w * 128 + 2 * kk + hl;
        const float2 wv = *(const float2*)(wp + (size_t)k * 6144);
        const float4 s0 = *(const float4*)(sl + k * 12), s1 = *(const float4*)(sl + k * 12 + 4);
        const float s8 = sl[k * 12 + 8];
        a0[0] += s0.x * wv.x; a0[1] += s0.y * wv.x; a0[2] += s0.z * wv.x; a0[3] += s0.w * wv.x; a0[4] += s1.x * wv.x; a0[5] += s1.y * wv.x; a0[6] += s1.z * wv.x; a0[7] += s1.w * wv.x; a0[8] += s8 * wv.x;
        a1[0] += s0.x * wv.y; a1[1] += s0.y * wv.y; a1[2] += s0.z * wv.y; a1[3] += s0.w * wv.y; a1[4] += s1.x * wv.y; a1[5] += s1.y * wv.y; a1[6] += s1.z * wv.y; a1[7] += s1.w * wv.y; a1[8] += s8 * wv.y;
    }
    float* red = (float*)(smem_all + 49152);
#pragma unroll
    for (int q = 0; q < 9; ++q) { red[((w * 2 + hl) * 9 + q) * 64 + cl * 2] = a0[q]; red[((w * 2 + hl) * 9 + q) * 64 + cl * 2 + 1] = a1[q]; }
    __syncthreads();
    float* MOD = (float*)(p.ws + OFF_MOD);
    for (int i = tid; i < 576; i += 512) {
        int q = i >> 6, ln = i & 63;
        float sacc = 0.f;
#pragma unroll
        for (int u = 0; u < 16; ++u) sacc += red[(u * 9 + q) * 64 + ln];
        sacc += p.ada_b[l * 6144 + n0 + ln];
        MOD[(size_t)(l * 9 + q) * 6144 + n0 + ln] = sacc;
    }
    __syncthreads();
}

DI void sincos_d(double x, float& s, float& c) {
    const double TWO_PI = 6.283185307179586476925;
    double t = x / TWO_PI;
    t -= rint(t);
    double y = t * TWO_PI, y2 = y * y;
    double sv = y, cv = 1.0, ts = y, tc = 1.0;
#pragma unroll 1
    for (int k = 1; k <= 14; ++k) {
        tc *= -y2 / (double)((2 * k - 1) * (2 * k));
        ts *= -y2 / (double)((2 * k) * (2 * k + 1));
        cv += tc; sv += ts;
    }
    s = (float)sv; c = (float)cv;
}

DI void rope_tables(const Params& p) {
    float* TG = (float*)(p.ws + OFF_TABG);
    float* TM = (float*)(p.ws + OFF_TABM);
    for (int i = TID; i < 1024; i += 256) {
        int v = i >> 4, f = i & 15;
        float inv = exp2f(-(float)f / 16.f * 13.287712379549449f);
        float ang = (float)v * inv, s, c;
        sincos_d((double)ang, s, c);
        TG[i] = c; TG[1024 + i] = s;
    }
    for (int i = TID; i < 512; i += 256) {
        int v = i >> 3, f = i & 7;
        float inv = exp2f(-(float)f / 8.f * 13.287712379549449f);
        float ang = (float)v * inv, s, c;
        sincos_d((double)ang, s, c);
        TM[i] = c; TM[512 + i] = s;
    }
}

constexpr int NW = 10;
constexpr int N_WT0 = 8 * 12 + 3 * 8 + 2 * 8 + 8 * 8 + 8 * 44 + 22 * 8;
constexpr int N_WT1 = 8 * 44 + 22 * 8 + 8 * 26 + 8 * 8;
constexpr int N_MOD = 384;
constexpr int N_P0 = N_MOD + 96;
static_assert(N_P0 % 2 == 0 && N_MOD % 2 == 0 && N_WT1 % 2 == 0, "items are dealt to half-block pairs");

DI void wtile_item(const Params& p, int t, char* smem) {
    int wi = 0;
    int cnt[NW] = {8 * 12, 3 * 8, 2 * 8, 8 * 8, 8 * 44, 22 * 8, 8 * 44, 22 * 8, 8 * 26, 8 * 8};
#pragma unroll
    for (int i = 0; i < NW - 1; ++i) { if (wi == i && t >= cnt[i]) { t -= cnt[i]; wi = i + 1; } }
    const float* src; const float* g = nullptr; bf16_t* dst; int K, Nsrc, ntn, mode;
    switch (wi) {
        case 0: src = p.att_w_in; dst = (bf16_t*)(p.ws + OFF_WT_IN0); K = 1024; Nsrc = 1440; ntn = 12; mode = 1; break;
        case 1: src = p.mla_w_qb; g = p.mla_qa_g; dst = (bf16_t*)(p.ws + OFF_WT_QB); K = 384; Nsrc = 768; ntn = 8; mode = 2; break;
        case 2: src = p.mla_w_kvb; g = p.mla_kva_g; dst = (bf16_t*)(p.ws + OFF_WT_KVB); K = 256; Nsrc = 1024; ntn = 8; mode = 0; break;
        case 3: src = p.att_w_out; dst = (bf16_t*)(p.ws + OFF_WT_OUT0); K = 1024; Nsrc = 1024; ntn = 8; mode = 0; break;
        case 4: src = p.ffn_w_up; dst = (bf16_t*)(p.ws + OFF_WT_UP0); K = 1024; Nsrc = 5632; ntn = 44; mode = 3; break;
        case 5: src = p.ffn_w_down; dst = (bf16_t*)(p.ws + OFF_WT_DOWN0); K = 2816; Nsrc = 1024; ntn = 8; mode = 0; break;
        case 6: src = p.ffn_w_up + 1024ull * 5632; dst = (bf16_t*)(p.ws + OFF_WT_UP1); K = 1024; Nsrc = 5632; ntn = 44; mode = 3; break;
        case 7: src = p.ffn_w_down + 2816ull * 1024; dst = (bf16_t*)(p.ws + OFF_WT_DOWN1); K = 2816; Nsrc = 1024; ntn = 8; mode = 0; break;
        case 8: src = p.ml_w_in; dst = (bf16_t*)(p.ws + OFF_WT_IN1); K = 1024; Nsrc = 3104; ntn = 26; mode = 0; break;
        default: src = p.ml_w_out; dst = (bf16_t*)(p.ws + OFF_WT_OUT1); K = 1024; Nsrc = 1024; ntn = 8; mode = 0; break;
    }
    const int tn = t % ntn, tk = t / ntn;
    wtile(src, Nsrc, g, dst, K, tk * 128, tn, mode, smem);
}

DI void phase0(const Params& p, char* smem_all) {
    char* smem = smem_all + HBI * HB_SMEM;
    if (blockIdx.x == gridDim.x - 1) {
        if (HBI == 0) rope_tables(p);
        else { for (int i = TID; i < 512; i += 256) ((uint4*)(p.ws + OFF_ZROW))[i] = make_uint4(0, 0, 0, 0); }
    }
    for (int u = blockIdx.x; u < 192 + 48; u += gridDim.x) {
        if (u < 192) mod_item8(p, u, smem_all);
        else wtile_item(p, (u - 192) * 2 + HBI, smem);
    }
}
DI void convert_weights(const Params& p, char* smem_all, int t0, int cnt, int first) {
    char* smem = smem_all + HBI * HB_SMEM;
    const int G = gridDim.x;
    if (first >= G) first = 0;
    if ((int)blockIdx.x < first) return;
    for (int it0 = ((int)blockIdx.x - first) * 2; it0 < cnt; it0 += (G - first) * 2) wtile_item(p, t0 + it0 + HBI, smem);
}
constexpr int WT_IN0_0 = 0, WT_IN0_N = 96, WT_MLA_0 = 96, WT_MLA_N = 40, WT_OUT0_0 = 136, WT_OUT0_N = 64, WT_UP0_0 = 200, WT_UP0_N = 352, WT_DOWN0_0 = 552, WT_DOWN0_N = 176, WT_L1_0 = 728, WT_L1_N = 800;
static_assert(WT_L1_0 == N_WT0 && WT_L1_N == N_WT1, "tile ranges");

DI void norm_row_ptrs(int row, const float* srcLat, const float* srcCtx, const float* mod, int shift_idx, const float*& src, const float*& sh) {
    int mb;
    if (row < 16384) { src = srcLat + (size_t)row * 1024; mb = row >> 11; }
    else { src = srcCtx + (size_t)(row - 16384) * 1024; mb = 8; }
    sh = mod + (size_t)mb * 6144 + shift_idx * 1024;
}
DI void norm_row_finish(const float4 (&v)[4], float ss, const float* g, const float* sh, bf16_t* dst, int lane) {
#pragma unroll
    for (int o = 32; o >= 1; o >>= 1) ss += __shfl_xor(ss, o);
    const float rstd = rsqrtf(ss * (1.f / 1024.f) + EPSF);
    const float* sc = sh + 1024;
#pragma unroll
    for (int j = 0; j < 4; ++j) {
        const int c = j * 256 + lane * 4;
        const float4 gv = *(const float4*)(g + c), shv = *(const float4*)(sh + c), scv = *(const float4*)(sc + c);
        const float o0 = v[j].x * rstd * gv.x * (1.f + scv.x) + shv.x;
        const float o1 = v[j].y * rstd * gv.y * (1.f + scv.y) + shv.y;
        const float o2 = v[j].z * rstd * gv.z * (1.f + scv.z) + shv.z;
        const float o3 = v[j].w * rstd * gv.w * (1.f + scv.w) + shv.w;
        uint2 o; o.x = pack2(o0, o1); o.y = pack2(o2, o3);
        *(uint2*)(dst + c) = o;
    }
}
DI void phase_norm(const Params& p, const float* srcLat, const float* srcCtx, const float* g, const float* mod, int shift_idx, int nrows) {
    const int lane = threadIdx.x & 63, w = threadIdx.x >> 6;
    bf16_t* H = (bf16_t*)(p.ws + OFF_H);
    for (int row = (blockIdx.x * 8 + w) * 2; row < nrows; row += gridDim.x * 16) {
        const float *srcA, *shA, *srcB, *shB;
        norm_row_ptrs(row, srcLat, srcCtx, mod, shift_idx, srcA, shA);
        norm_row_ptrs(row + 1, srcLat, srcCtx, mod, shift_idx, srcB, shB);
        float4 va[4], vb[4];
        float sa = 0.f, sb = 0.f;
#pragma unroll
        for (int j = 0; j < 4; ++j) { va[j] = *(const float4*)(srcA + j * 256 + lane * 4); vb[j] = *(const float4*)(srcB + j * 256 + lane * 4); }
#pragma unroll
        for (int j = 0; j < 4; ++j) { sa += va[j].x * va[j].x + va[j].y * va[j].y + va[j].z * va[j].z + va[j].w * va[j].w; sb += vb[j].x * vb[j].x + vb[j].y * vb[j].y + vb[j].z * vb[j].z + vb[j].w * vb[j].w; }
        norm_row_finish(va, sa, g, shA, H + (size_t)row * 1024, lane);
        norm_row_finish(vb, sb, g, shB, H + (size_t)(row + 1) * 1024, lane);
    }
}

template <int Q>
DI void rope_apply(float* v, const float* tab, int rw, int cl) {
#pragma unroll
    for (int f = 0; f < Q; ++f) {
        float cr = tab[rw * Q + f], sr = tab[64 * Q + rw * Q + f], cc = tab[cl * Q + f], sc = tab[64 * Q + cl * Q + f];
        float a1 = v[f], a2 = v[Q + f], b1 = v[2 * Q + f], b2 = v[3 * Q + f];
        v[f] = a1 * cr - a2 * sr; v[Q + f] = a2 * cr + a1 * sr;
        v[2 * Q + f] = b1 * cc - b2 * sc; v[3 * Q + f] = b2 * cc + b1 * sc;
    }
}

DI void phase_inproj0(const Params& p, char* smem_all) {
    const bf16_t* H = (const bf16_t*)(p.ws + OFF_H);
    const bf16_t* W = (const bf16_t*)(p.ws + OFF_WT_IN0);
    const float* TG = (const float*)(p.ws + OFF_TABG);
    for (int id = blockIdx.x; id < 72 * 6; id += gridDim.x) {
        const int nt2 = id / 72, mt2 = id % 72;
        auto epi = [&](const float* Cs, int si, int sj, int tid) {
            const int nt = 2 * nt2 + sj, m0 = (2 * mt2 + si) * 128;
            int b, t0; bool lat; row_info(m0, b, t0, lat);
            const int s0 = lat ? 256 + t0 : t0;
            if (nt < 5) {
                const int row = tid & 127, half = tid >> 7;
                const float4* cp = (const float4*)(Cs + row * CP + half * 64);
                float ss = 0.f;
#pragma unroll
                for (int i = 0; i < 16; ++i) { float4 f = cp[i]; ss += f.x * f.x + f.y * f.y + f.z * f.z + f.w * f.w; }
                const float rstd = rsqrtf(ss * (1.f / 64.f) + EPSF);
                const float* g = nt < 4 ? p.gqa_q_g : p.gqa_k_g;
                const float osc = nt < 4 ? 0.125f * LOG2E : 1.f;
                bf16_t* dst;
                if (nt < 4) dst = (bf16_t*)(p.ws + OFF_QG) + ((size_t)(b * 2304 + s0 + row) * 8 + nt * 2 + half) * 64;
                else dst = (bf16_t*)(p.ws + OFF_KG) + ((size_t)(b * 2304 + s0 + row) * 2 + half) * 64;
                const int t = t0 + row;
#pragma unroll 1
                for (int hh = 0; hh < 2; ++hh) {
                    float v[32];
#pragma unroll
                    for (int i = 0; i < 8; ++i) { float4 f = cp[hh * 8 + i]; const float4 gv = *(const float4*)(g + hh * 32 + 4 * i);
                        v[4 * i] = f.x * rstd * gv.x; v[4 * i + 1] = f.y * rstd * gv.y; v[4 * i + 2] = f.z * rstd * gv.z; v[4 * i + 3] = f.w * rstd * gv.w; }
                    if (lat) {
                        const int pos = hh ? (t & 63) : (t >> 6);
#pragma unroll
                        for (int f = 0; f < 16; ++f) {
                            const float c_ = TG[pos * 16 + f], s_ = TG[1024 + pos * 16 + f];
                            const float x1 = v[f], x2 = v[16 + f];
                            v[f] = x1 * c_ - x2 * s_; v[16 + f] = x2 * c_ + x1 * s_;
                        }
                    }
#pragma unroll
                    for (int i = 0; i < 32; ++i) v[i] *= osc;
#pragma unroll
                    for (int i = 0; i < 4; ++i) *(uint4*)(dst + hh * 32 + i * 8) = pack8(v + i * 8);
                }
            } else if (nt == 5) {
                const int dall = tid & 127, ch0 = (tid >> 7) * 8;
                bf16_t* dst = (bf16_t*)(p.ws + OFF_VGT) + ((size_t)(b * 2 + (dall >> 6)) * 64 + (dall & 63)) * 2304 + s0;
#pragma unroll 2
                for (int ch = 0; ch < 8; ++ch) {
                    float v[8];
#pragma unroll
                    for (int i = 0; i < 8; ++i) v[i] = Cs[((ch0 + ch) * 8 + i) * CP + dall];
                    *(uint4*)(dst + (ch0 + ch) * 8) = pack8(v);
                }
            } else if (nt < 9) {
                epi_store_bf16(Cs, (bf16_t*)(p.ws + OFF_CQ) + (size_t)m0 * 384 + (nt - 6) * 128, 384, tid);
            } else if (nt < 11) {
                epi_store_bf16(Cs, (bf16_t*)(p.ws + OFF_CKV) + (size_t)m0 * 256 + (nt - 9) * 128, 256, tid);
            } else {
                const int row = tid >> 1, half = tid & 1;
                float* dst = (float*)(p.ws + OFF_KR) + (size_t)(m0 + row) * 32 + half * 16;
                const float4* cp = (const float4*)(Cs + row * CP + half * 16);
#pragma unroll
                for (int i = 0; i < 4; ++i) ((float4*)dst)[i] = cp[i];
            }
        };
        const int r0 = g_row(0), r1 = g_row(1), r2 = g_row(2), r3 = g_row(3);
        const bf16_t* Ab = H + (size_t)mt2 * 256 * 1024;
        const bf16_t* Bb = W + (size_t)nt2 * 256 * 1024;
        gemm256(p.ws, Ab + (size_t)r0 * 1024 + g_chunk(r0) * 8, Ab + (size_t)r1 * 1024 + g_chunk(r1) * 8, Ab + (size_t)r2 * 1024 + g_chunk(r2) * 8, Ab + (size_t)r3 * 1024 + g_chunk(r3) * 8,
                Bb + (size_t)b_perm(r0) * 1024 + g_chunk(r0) * 8, Bb + (size_t)b_perm(r1) * 1024 + g_chunk(r1) * 8, Bb + (size_t)b_perm(r2) * 1024 + g_chunk(r2) * 8, Bb + (size_t)b_perm(r3) * 1024 + g_chunk(r3) * 8,
                1024, smem_all, epi);
    }
    convert_weights(p, smem_all, WT_MLA_0, WT_MLA_N, (72 * 6) % (int)gridDim.x);
}

DI void phase_mla_up(const Params& p, char* smem_all) {
    char* smem = smem_all + HBI * HB_SMEM;
    const float* TM = (const float*)(p.ws + OFF_TABM);
    for (int id0 = blockIdx.x * 2; id0 < 144 * 16; id0 += gridDim.x * 2) {
        const int id = id0 + HBI;
        const int nt = (id / 144) & 7, isKV = (id / 144) >> 3, mt = id % 144, m0 = mt * 128;
        int b, t0; bool lat; row_info(m0, b, t0, lat);
        const int s0 = lat ? 256 + t0 : t0;
        if (!isKV) {
            const bf16_t* A = (const bf16_t*)(p.ws + OFF_CQ);
#undef AROW
#define AROW(o_) (A + (size_t)(m0 + (TID >> 3) + (o_)) * 384)
            auto epi = [&](const float* Cs, const float* rowss) {
                const int tid = TID, row = tid >> 1, part = tid & 1;
                const float r1 = rsqrtf(rowss[row] * (1.f / 384.f) + EPSF);
                float v[48];
                const float4* cp = (const float4*)(Cs + row * CP + part * 48);
                float ss = 0.f;
#pragma unroll
                for (int i = 0; i < 12; ++i) { float4 f = cp[i]; v[4 * i] = f.x * r1; v[4 * i + 1] = f.y * r1; v[4 * i + 2] = f.z * r1; v[4 * i + 3] = f.w * r1; }
#pragma unroll
                for (int i = 0; i < 48; ++i) ss += v[i] * v[i];
                ss += __shfl_xor(ss, 1);
                const float r2 = rsqrtf(ss * (1.f / 96.f) + EPSF);
                const float* g = p.mla_q_g + part * 48;
#pragma unroll
                for (int i = 0; i < 48; ++i) v[i] = v[i] * r2 * g[i];
                if (lat && part == 1) { int t = t0 + row; rope_apply<8>(v + 16, TM, t >> 6, t & 63); }
                const float sc = 0.10206207261596575f * LOG2E;
#pragma unroll
                for (int i = 0; i < 48; ++i) v[i] *= sc;
                bf16_t* dst = (bf16_t*)(p.ws + OFF_QM) + ((size_t)(b * 2304 + s0 + row) * 8 + nt) * 96 + part * 48;
#pragma unroll
                for (int i = 0; i < 6; ++i) *(uint4*)(dst + i * 8) = pack8(v + i * 8);
            };
            gemm_tile<true, false>(AROW(0), AROW(32), AROW(64), AROW(96), 0u, 0u, 0u, 0u, (const bf16_t*)(p.ws + OFF_WT_QB) + (size_t)nt * 128 * 384, 384, 384, smem, epi);
        } else {
            const bf16_t* A = (const bf16_t*)(p.ws + OFF_CKV);
#undef AROW
#define AROW(o_) (A + (size_t)(m0 + (TID >> 3) + (o_)) * 256)
            auto epi = [&](const float* Cs, const float* rowss) {
                const int tid = TID;
                {
                    const int row = tid >> 1, part = tid & 1;
                    const float r1 = rsqrtf(rowss[row] * (1.f / 256.f) + EPSF);
                    float v[48];
                    if (part == 0) {
                        const float4* cp = (const float4*)(Cs + row * CP);
#pragma unroll
                        for (int i = 0; i < 12; ++i) { float4 f = cp[i]; v[4 * i] = f.x * r1; v[4 * i + 1] = f.y * r1; v[4 * i + 2] = f.z * r1; v[4 * i + 3] = f.w * r1; }
                    } else {
                        const float4* cp = (const float4*)(Cs + row * CP + 48);
#pragma unroll
                        for (int i = 0; i < 4; ++i) { float4 f = cp[i]; v[4 * i] = f.x * r1; v[4 * i + 1] = f.y * r1; v[4 * i + 2] = f.z * r1; v[4 * i + 3] = f.w * r1; }
                        const float4* kp = (const float4*)((const float*)(p.ws + OFF_KR) + (size_t)(m0 + row) * 32);
#pragma unroll
                        for (int i = 0; i < 8; ++i) { float4 f = kp[i]; v[16 + 4 * i] = f.x; v[16 + 4 * i + 1] = f.y; v[16 + 4 * i + 2] = f.z; v[16 + 4 * i + 3] = f.w; }
                    }
                    float ss = 0.f;
#pragma unroll
                    for (int i = 0; i < 48; ++i) ss += v[i] * v[i];
                    ss += __shfl_xor(ss, 1);
                    const float r2 = rsqrtf(ss * (1.f / 96.f) + EPSF);
                    const float* g = p.mla_k_g + part * 48;
#pragma unroll
                    for (int i = 0; i < 48; ++i) v[i] = v[i] * r2 * g[i];
                    if (lat && part == 1) { int t = t0 + row; rope_apply<8>(v + 16, TM, t >> 6, t & 63); }
                    bf16_t* dst = (bf16_t*)(p.ws + OFF_KM) + ((size_t)(b * 2304 + s0 + row) * 8 + nt) * 96 + part * 48;
#pragma unroll
                    for (int i = 0; i < 6; ++i) *(uint4*)(dst + i * 8) = pack8(v + i * 8);
                }
                {
                    const int d = tid & 63, cg4 = (tid >> 6) * 4;
                    bf16_t* dst = (bf16_t*)(p.ws + OFF_VMT) + ((size_t)(b * 8 + nt) * 64 + d) * 2304 + s0;
#pragma unroll 1
                    for (int ch = 0; ch < 4; ++ch) {
                        float v[8];
#pragma unroll
                        for (int i = 0; i < 8; ++i) { int rr = (cg4 + ch) * 8 + i; v[i] = Cs[rr * CP + 64 + d] * rsqrtf(rowss[rr] * (1.f / 256.f) + EPSF); }
                        *(uint4*)(dst + (cg4 + ch) * 8) = pack8(v);
                    }
                }
            };
            gemm_tile<true, false>(AROW(0), AROW(32), AROW(64), AROW(96), 0u, 0u, 0u, 0u, (const bf16_t*)(p.ws + OFF_WT_KVB) + (size_t)nt * 128 * 256, 256, 256, smem, epi);
        }
    }
}

template <int DK>
DI void attn_body(const bf16_t* __restrict__ Q, int qstride, const bf16_t* __restrict__ Kp, int kstride, const bf16_t* __restrict__ VT,
                  int nkeys, bf16_t* __restrict__ Odst, char* smem, char* smem_os) {
    constexpr int KP = DK + 8, VP = 72, NST = DK / 16, KCH = DK / 8;
    constexpr int NKL = (64 * KCH) / 256;
    constexpr int STAGE = 64 * KP * 2 + 64 * VP * 2;
    const int tid = TID, lane = tid & 63, w = tid >> 6, h = lane >> 5, r = lane & 31;
    bf16x8 qf[NST];
    {
        const bf16_t* qrow = Q + (size_t)(w * 32 + r) * qstride;
#pragma unroll
        for (int st = 0; st < NST; ++st) qf[st] = *(const bf16x8*)(qrow + st * 16 + h * 8);
    }
    f32x16 o[2]; o[0] = zero16(); o[1] = zero16();
    float m = 0.f, l = 0.f;
    uint4 ak0, ak1 = make_uint4(0, 0, 0, 0), av0, bk0, bk1 = make_uint4(0, 0, 0, 0), bv0;
    const int t5 = threadIdx.x;
    const int kr0 = t5 / KCH, kc0 = t5 % KCH, kr1 = (t5 + 512) / KCH, kc1 = (t5 + 512) % KCH;
    const bool k2 = t5 + 512 < 64 * KCH;
    const int vd0 = t5 >> 3, vc0 = t5 & 7;
#define AGLOAD(P_, key0) { P_##k0 = *(const uint4*)(Kp + (size_t)((key0) + kr0) * kstride + kc0 * 8); if (k2) P_##k1 = *(const uint4*)(Kp + (size_t)((key0) + kr1) * kstride + kc1 * 8); \
                       P_##v0 = *(const uint4*)(VT + (size_t)vd0 * 2304 + (key0) + vc0 * 8); }
#define ASWRITE(P_, s_) { bf16_t* Ks_ = (bf16_t*)(smem + (s_) * STAGE); bf16_t* Vs_ = Ks_ + 64 * KP; \
                      *(uint4*)(Ks_ + kr0 * KP + kc0 * 8) = P_##k0; if (k2) *(uint4*)(Ks_ + kr1 * KP + kc1 * 8) = P_##k1; \
                      *(uint4*)(Vs_ + vd0 * VP + vc0 * 8) = P_##v0; }
    const int nkt = nkeys >> 6;
    AGLOAD(a, 0) ASWRITE(a, 0) AGLOAD(a, 64) AGLOAD(b, 128) __syncthreads();
#pragma unroll 1
    for (int kt = 0; kt < nkt; kt += 2) {
        {
            const bf16_t* Ks = (const bf16_t*)(smem);
            const bf16_t* Vs = Ks + 64 * KP;
            f32x16 s[2];
#pragma unroll
            for (int i = 0; i < 16; ++i) { s[0][i] = -m; s[1][i] = -m; }
#pragma unroll
            for (int st = 0; st < NST; ++st)
#pragma unroll
                for (int kk = 0; kk < 2; ++kk) {
                    bf16x8 a = *(const bf16x8*)(Ks + (kk * 32 + r) * KP + st * 16 + h * 8);
                    s[kk] = MFMA(a, qf[st], s[kk]);
                }
            float mx = s[0][0];
#pragma unroll
            for (int i = 0; i < 16; ++i) { mx = fmaxf(mx, s[0][i]); mx = fmaxf(mx, s[1][i]); }
            mx = fmaxf(mx, __shfl_xor(mx, 32));
            if (__any(mx > 8.f)) {
                const float d = fmaxf(mx, 0.f);
                const float alpha = __builtin_amdgcn_exp2f(-d);
                l *= alpha;
#pragma unroll
                for (int i = 0; i < 16; ++i) { o[0][i] *= alpha; o[1][i] *= alpha; s[0][i] -= d; s[1][i] -= d; }
                m += d;
            }
            float ps = 0.f;
#pragma unroll
            for (int kk = 0; kk < 2; ++kk)
#pragma unroll
                for (int i = 0; i < 16; ++i) { float pv = __builtin_amdgcn_exp2f(s[kk][i]); s[kk][i] = pv; ps += pv; }
            l += ps;
#pragma unroll
            for (int kk = 0; kk < 2; ++kk)
#pragma unroll
                for (int s2 = 0; s2 < 2; ++s2) {
                    const bf16x8 pb = pack_frag(s[kk][8 * s2 + 0], s[kk][8 * s2 + 1], s[kk][8 * s2 + 2], s[kk][8 * s2 + 3], s[kk][8 * s2 + 4], s[kk][8 * s2 + 5], s[kk][8 * s2 + 6], s[kk][8 * s2 + 7]);
#pragma unroll
                    for (int dt = 0; dt < 2; ++dt) {
                        const bf16_t* vp = Vs + (dt * 32 + r) * VP + kk * 32 + 16 * s2 + 4 * h;
                        uint2 lo = *(const uint2*)vp, hi = *(const uint2*)(vp + 8);
                        uint4 vu; vu.x = lo.x; vu.y = lo.y; vu.z = hi.x; vu.w = hi.y;
                        o[dt] = MFMA(__builtin_bit_cast(bf16x8, vu), pb, o[dt]);
                    }
                }
        }
        ASWRITE(a, 1)
        if (kt + 3 < nkt) AGLOAD(a, (kt + 3) * 64)
        LDS_BARRIER();
        {
            const bf16_t* Ks = (const bf16_t*)(smem + STAGE);
            const bf16_t* Vs = Ks + 64 * KP;
            f32x16 s[2];
#pragma unroll
            for (int i = 0; i < 16; ++i) { s[0][i] = -m; s[1][i] = -m; }
#pragma unroll
            for (int st = 0; st < NST; ++st)
#pragma unroll
                for (int kk = 0; kk < 2; ++kk) {
                    bf16x8 a = *(const bf16x8*)(Ks + (kk * 32 + r) * KP + st * 16 + h * 8);
                    s[kk] = MFMA(a, qf[st], s[kk]);
                }
            float mx = s[0][0];
#pragma unroll
            for (int i = 0; i < 16; ++i) { mx = fmaxf(mx, s[0][i]); mx = fmaxf(mx, s[1][i]); }
            mx = fmaxf(mx, __shfl_xor(mx, 32));
            if (__any(mx > 8.f)) {
                const float d = fmaxf(mx, 0.f);
                const float alpha = __builtin_amdgcn_exp2f(-d);
                l *= alpha;
#pragma unroll
                for (int i = 0; i < 16; ++i) { o[0][i] *= alpha; o[1][i] *= alpha; s[0][i] -= d; s[1][i] -= d; }
                m += d;
            }
            float ps = 0.f;
#pragma unroll
            for (int kk = 0; kk < 2; ++kk)
#pragma unroll
                for (int i = 0; i < 16; ++i) { float pv = __builtin_amdgcn_exp2f(s[kk][i]); s[kk][i] = pv; ps += pv; }
            l += ps;
#pragma unroll
            for (int kk = 0; kk < 2; ++kk)
#pragma unroll
                for (int s2 = 0; s2 < 2; ++s2) {
                    const bf16x8 pb = pack_frag(s[kk][8 * s2 + 0], s[kk][8 * s2 + 1], s[kk][8 * s2 + 2], s[kk][8 * s2 + 3], s[kk][8 * s2 + 4], s[kk][8 * s2 + 5], s[kk][8 * s2 + 6], s[kk][8 * s2 + 7]);
#pragma unroll
                    for (int dt = 0; dt < 2; ++dt) {
                        const bf16_t* vp = Vs + (dt * 32 + r) * VP + kk * 32 + 16 * s2 + 4 * h;
                        uint2 lo = *(const uint2*)vp, hi = *(const uint2*)(vp + 8);
                        uint4 vu; vu.x = lo.x; vu.y = lo.y; vu.z = hi.x; vu.w = hi.y;
                        o[dt] = MFMA(__builtin_bit_cast(bf16x8, vu), pb, o[dt]);
                    }
                }
        }
        if (kt + 2 < nkt) ASWRITE(b, 0)
        if (kt + 4 < nkt) AGLOAD(b, (kt + 4) * 64)
        LDS_BARRIER();
    }
#undef AGLOAD
#undef ASWRITE
    l += __shfl_xor(l, 32);
    const float inv = 1.f / l;
    bf16_t* Os = (bf16_t*)smem_os + (size_t)w * 32 * 72;
#pragma unroll
    for (int dt = 0; dt < 2; ++dt)
#pragma unroll
        for (int g = 0; g < 4; ++g) {
            uint2 u; u.x = pack2(o[dt][4 * g] * inv, o[dt][4 * g + 1] * inv); u.y = pack2(o[dt][4 * g + 2] * inv, o[dt][4 * g + 3] * inv);
            *(uint2*)(Os + r * 72 + dt * 32 + 8 * g + 4 * h) = u;
        }
    __syncthreads();
#pragma unroll
    for (int j = 0; j < 4; ++j) {
        int c = lane + 64 * j, row = c >> 3, cc = c & 7;
        uint4 u = *(const uint4*)(Os + row * 72 + cc * 8);
        *(uint4*)(Odst + (size_t)(w * 32 + row) * 1024 + cc * 8) = u;
    }
    __syncthreads();
}

DI void phase_attn(const Params& p, char* smem_all) {
    char* smem = smem_all;
    char* smem_os = smem_all + 65536 + HBI * 20480;
    bf16_t* O = (bf16_t*)(p.ws + OFF_H);
    for (int it0 = blockIdx.x * 2; it0 < 2304; it0 += gridDim.x * 2) {
        const int item = it0 + HBI;
        int b, kind, hq, qb, nkeys, sq0, orow;
        if (item < 2048) { qb = item & 15; hq = (item >> 4) & 7; kind = (item >> 7) & 1; b = item >> 8; sq0 = 256 + qb * 128; nkeys = 2304; orow = b * 2048 + qb * 128; }
        else { int it = item - 2048; qb = it & 1; hq = (it >> 1) & 7; kind = (it >> 4) & 1; b = it >> 5; sq0 = qb * 128; nkeys = 256; orow = 16384 + b * 256 + qb * 128; }
        bf16_t* od = O + (size_t)orow * 1024 + kind * 512 + hq * 64;
        if (kind == 0) {
            const bf16_t* Q = (const bf16_t*)(p.ws + OFF_QM) + ((size_t)(b * 2304 + sq0) * 8 + hq) * 96;
            const bf16_t* K = (const bf16_t*)(p.ws + OFF_KM) + ((size_t)(b * 2304) * 8 + hq) * 96;
            const bf16_t* VT = (const bf16_t*)(p.ws + OFF_VMT) + (size_t)(b * 8 + hq) * 64 * 2304;
            attn_body<96>(Q, 768, K, 768, VT, nkeys, od, smem, smem_os);
        } else {
            const int kvh = hq >> 2;
            const bf16_t* Q = (const bf16_t*)(p.ws + OFF_QG) + ((size_t)(b * 2304 + sq0) * 8 + hq) * 64;
            const bf16_t* K = (const bf16_t*)(p.ws + OFF_KG) + ((size_t)(b * 2304) * 2 + kvh) * 64;
            const bf16_t* VT = (const bf16_t*)(p.ws + OFF_VGT) + (size_t)(b * 2 + kvh) * 64 * 2304;
            attn_body<64>(Q, 512, K, 128, VT, nkeys, od, smem, smem_os);
        }
    }
    convert_weights(p, smem_all, WT_OUT0_0, WT_OUT0_N, 1152 % (int)gridDim.x);
}

DI void phase_proj_resid(const Params& p, const bf16_t* A, int K, const bf16_t* W, const float* mod, int gate_idx,
                         const float* srcLat, const float* srcCtx, float* dstLat, float* dstCtx, int mtiles2, bool ctx_small, int conv_t0, int conv_cnt, char* smem_all) {
    for (int id = blockIdx.x; id < mtiles2 * 4; id += gridDim.x) {
        const int nt2 = id / mtiles2, mt2 = id % mtiles2;
        auto epi = [&](const float* Cs, int si, int sj, int tid) {
            const int nt = 2 * nt2 + sj, m0 = (2 * mt2 + si) * 128;
            const float* src; float* dst; int mb;
            if (m0 < 16384) { src = srcLat + (size_t)m0 * 1024; dst = dstLat + (size_t)m0 * 1024; mb = m0 >> 11; }
            else { src = srcCtx + (size_t)(m0 - 16384) * 1024; dst = dstCtx + (size_t)(m0 - 16384) * 1024; mb = 8; }
            epi_resid(Cs, src + nt * 128, dst + nt * 128, mod + (size_t)mb * 6144 + gate_idx * 1024 + nt * 128, tid);
        };
        const int r0 = g_row(0), r1 = g_row(1), r2 = g_row(2), r3 = g_row(3);
        const bf16_t* Ab = A + (size_t)mt2 * 256 * K;
        const bf16_t* Bb = W + (size_t)nt2 * 256 * K;
        gemm256(p.ws, Ab + (size_t)r0 * K + g_chunk(r0) * 8, Ab + (size_t)r1 * K + g_chunk(r1) * 8, Ab + (size_t)r2 * K + g_chunk(r2) * 8, Ab + (size_t)r3 * K + g_chunk(r3) * 8,
                Bb + (size_t)b_perm(r0) * K + g_chunk(r0) * 8, Bb + (size_t)b_perm(r1) * K + g_chunk(r1) * 8, Bb + (size_t)b_perm(r2) * K + g_chunk(r2) * 8, Bb + (size_t)b_perm(r3) * K + g_chunk(r3) * 8,
                K, smem_all, epi);
    }
    if (ctx_small) {
        for (int hq = blockIdx.x; hq < 64; hq += gridDim.x) {
            const int mt2 = 64 + (hq >> 3), nt = hq & 7;
            auto epi = [&](const float* Cs, int si, int, int tid) {
                const int m0 = (2 * mt2 + si) * 128 - 16384;
                epi_resid(Cs, srcCtx + (size_t)m0 * 1024 + nt * 128, dstCtx + (size_t)m0 * 1024 + nt * 128, mod + (size_t)8 * 6144 + gate_idx * 1024 + nt * 128, tid);
            };
            const int r0 = g_row(0), r1 = g_row(1), r2 = g_row(2), r3 = g_row(3);
            const bf16_t* Ab = A + (size_t)mt2 * 256 * K;
            const bf16_t* Bb = W + (size_t)nt * 128 * K;
            gemm256<0>(p.ws, Ab + (size_t)r0 * K + g_chunk(r0) * 8, Ab + (size_t)r1 * K + g_chunk(r1) * 8, Ab + (size_t)r2 * K + g_chunk(r2) * 8, Ab + (size_t)r3 * K + g_chunk(r3) * 8,
                       Bb + (size_t)b_perm(r0) * K + g_chunk(r0) * 8, Bb + (size_t)b_perm(r1) * K + g_chunk(r1) * 8, Bb + (size_t)b_perm(r2) * K + g_chunk(r2) * 8, Bb + (size_t)b_perm(r3) * K + g_chunk(r3) * 8,
                       K, smem_all, epi);
        }
    }
    if (conv_cnt) convert_weights(p, smem_all, conv_t0, conv_cnt, 64);
}

DI float4 conv4(float4 w0, float4 w1, float4 w2, float4 bb, float4 gm, float4 g0, float4 gp, float4 v) {
    float4 o;
    o.x = siluf_(w0.x * gm.x + w1.x * g0.x + w2.x * gp.x + bb.x) * v.x;
    o.y = siluf_(w0.y * gm.y + w1.y * g0.y + w2.y * gp.y + bb.y) * v.y;
    o.z = siluf_(w0.z * gm.z + w1.z * g0.z + w2.z * gp.z + bb.z) * v.z;
    o.w = siluf_(w0.w * gm.w + w1.w * g0.w + w2.w * gp.w + bb.w) * v.w;
    return o;
}
DI void halo_info(int mt, int& base, int& T, int& tstart) {
    int ti;
    if (mt < 136) { base = (mt / 17) * 2048; T = 2048; ti = mt % 17; }
    else { int q = mt - 136; base = 16384 + (q / 3) * 256; T = 256; ti = q % 3; }
    tstart = 126 * ti - 1;
}
DI const bf16_t* halo_ptr(const bf16_t* H, const bf16_t* Z, int mt2, int row) {
    int base, T, tstart; halo_info(2 * mt2 + (row >> 7), base, T, tstart);
    const int t = tstart + (row & 127);
    return (t >= 0 && t < T) ? H + (size_t)(base + t) * 1024 + g_chunk(row) * 8 : Z;
}
DI void phase_ffn_up(const Params& p, const bf16_t* W, const float* convw, const float* convb, int mtiles2, int conv_t0, int conv_cnt, char* smem_all) {
    const bf16_t* H = (const bf16_t*)(p.ws + OFF_H);
    const bf16_t* Z = (const bf16_t*)(p.ws + OFF_ZROW);
    bf16_t* ACT = (bf16_t*)(p.ws + OFF_ACT);
    for (int id = blockIdx.x; id < mtiles2 * 22; id += gridDim.x) {
        const int nt2 = id / mtiles2, mt2 = id % mtiles2;
        auto epi = [&](const float* Cs, int si, int sj, int tid) {
            const int nt = 2 * nt2 + sj;
            int base, T, tstart; halo_info(2 * mt2 + si, base, T, tstart);
            const int cc = tid & 7;
            const int cg0 = nt * 64 + cc * 8;
            const float4 w0a = *(const float4*)(convw + cg0), w0b = *(const float4*)(convw + cg0 + 4);
            const float4 w1a = *(const float4*)(convw + 2816 + cg0), w1b = *(const float4*)(convw + 2816 + cg0 + 4);
            const float4 w2a = *(const float4*)(convw + 5632 + cg0), w2b = *(const float4*)(convw + 5632 + cg0 + 4);
            const float4 bba = *(const float4*)(convb + cg0), bbb = *(const float4*)(convb + cg0 + 4);
#pragma unroll
            for (int j = 0; j < 4; ++j) {
                const int rr = (tid >> 3) + 32 * j, t = tstart + rr;
                if (rr >= 1 && rr <= 126 && t < T) {
                    const float4* a = (const float4*)(Cs + (rr - 1) * CP + cc * 8);
                    const float4* bq = (const float4*)(Cs + rr * CP + cc * 8);
                    const float4* c = (const float4*)(Cs + (rr + 1) * CP + cc * 8);
                    const float4* d = (const float4*)(Cs + rr * CP + 64 + cc * 8);
                    const float4 oa = conv4(w0a, w1a, w2a, bba, a[0], bq[0], c[0], d[0]);
                    const float4 ob = conv4(w0b, w1b, w2b, bbb, a[1], bq[1], c[1], d[1]);
                    uint4 u; u.x = pack2(oa.x, oa.y); u.y = pack2(oa.z, oa.w); u.z = pack2(ob.x, ob.y); u.w = pack2(ob.z, ob.w);
                    *(uint4*)(ACT + (size_t)(base + t) * 2816 + cg0) = u;
                }
            }
        };
        const int r0 = g_row(0), r1 = g_row(1), r2 = g_row(2), r3 = g_row(3);
        const bf16_t* Bb = W + (size_t)nt2 * 256 * 1024;
        gemm256(p.ws, halo_ptr(H, Z, mt2, r0), halo_ptr(H, Z, mt2, r1), halo_ptr(H, Z, mt2, r2), halo_ptr(H, Z, mt2, r3),
                Bb + (size_t)b_perm(r0) * 1024 + g_chunk(r0) * 8, Bb + (size_t)b_perm(r1) * 1024 + g_chunk(r1) * 8, Bb + (size_t)b_perm(r2) * 1024 + g_chunk(r2) * 8, Bb + (size_t)b_perm(r3) * 1024 + g_chunk(r3) * 8,
                1024, smem_all, epi);
    }
    if (conv_cnt) convert_weights(p, smem_all, conv_t0, conv_cnt, (mtiles2 * 22) % (int)gridDim.x);
}

DI void inproj1_epi(const Params& p, const float* Cs, int nt, int m0, int tid) {
    if (nt < 8) epi_store_bf16(Cs, (bf16_t*)(p.ws + OFF_QKRAW) + (size_t)m0 * 1024 + nt * 128, 1024, tid);
    else if (nt < 16) epi_store_bf16(Cs, (bf16_t*)(p.ws + OFF_V1) + (size_t)m0 * 1024 + (nt - 8) * 128, 1024, tid);
    else if (nt < 24) epi_store_bf16(Cs, (bf16_t*)(p.ws + OFF_OG) + (size_t)m0 * 1024 + (nt - 16) * 128, 1024, tid);
    else if (nt == 24) {
        const int row = tid >> 1, half = tid & 1;
        float* dst = (float*)(p.ws + OFF_GATES) + (size_t)(m0 + row) * 32 + half * 16;
#pragma unroll 4
        for (int i = 0; i < 16; ++i) {
            int c = half * 16 + i;
            float v = Cs[row * CP + c] + p.ml_gate_b[c];
            if (c & 8) v = logsigmoidf_(v);
            dst[i] = v;
        }
    }
}
DI void inproj1_tile_of(int f, int& nt2, int& mt2) { if (f < 576) { nt2 = f / 72; mt2 = f % 72; } else { const int g = f - 576; nt2 = 8 + g / 64; mt2 = g % 64; } }
DI void phase_inproj1(const Params& p, char* smem_all) {
    const bf16_t* H = (const bf16_t*)(p.ws + OFF_H);
    const bf16_t* W = (const bf16_t*)(p.ws + OFF_WT_IN1);
    const int G = gridDim.x, nfr = 832 / G, rem = 832 - nfr * G, nhalf = 2 * rem + 72;
    const int r0 = g_row(0), r1 = g_row(1), r2 = g_row(2), r3 = g_row(3);
#define IN1_ARGS p.ws, Ab + (size_t)r0 * 1024 + g_chunk(r0) * 8, Ab + (size_t)r1 * 1024 + g_chunk(r1) * 8, Ab + (size_t)r2 * 1024 + g_chunk(r2) * 8, Ab + (size_t)r3 * 1024 + g_chunk(r3) * 8, \
                Bb + (size_t)b_perm(r0) * 1024 + g_chunk(r0) * 8, Bb + (size_t)b_perm(r1) * 1024 + g_chunk(r1) * 8, Bb + (size_t)b_perm(r2) * 1024 + g_chunk(r2) * 8, Bb + (size_t)b_perm(r3) * 1024 + g_chunk(r3) * 8, \
                1024, smem_all, epi
    for (int trip = 0; trip < nfr; ++trip) {
        int nt2, mt2; inproj1_tile_of(trip * G + blockIdx.x, nt2, mt2);
        auto epi = [&](const float* Cs, int si, int sj, int tid) { inproj1_epi(p, Cs, 2 * nt2 + sj, (2 * mt2 + si) * 128, tid); };
        const bf16_t* Ab = H + (size_t)mt2 * 256 * 1024;
        const bf16_t* Bb = W + (size_t)nt2 * 256 * 1024;
        gemm256<-1>(IN1_ARGS);
    }
    for (int hq = blockIdx.x; hq < nhalf; hq += G) {
        int nt2, mt2, nh;
        if (hq < 2 * rem) { inproj1_tile_of(nfr * G + (hq >> 1), nt2, mt2); nh = hq & 1; } else { nt2 = 12; mt2 = hq - 2 * rem; nh = 0; }
        auto epi = [&](const float* Cs, int si, int, int tid) { inproj1_epi(p, Cs, 2 * nt2 + nh, (2 * mt2 + si) * 128, tid); };
        const bf16_t* Ab = H + (size_t)mt2 * 256 * 1024;
        const bf16_t* Bb = W + ((size_t)nt2 * 256 + nh * 128) * 1024;
        gemm256<0>(IN1_ARGS);
    }
#undef IN1_ARGS
}

DI void phase_qkconv(const Params& p) {
    const bf16_t* QK = (const bf16_t*)(p.ws + OFF_QKRAW);
    bf16_t* QC = (bf16_t*)(p.ws + OFF_H);
    {
        const int lane = threadIdx.x & 63, gw = blockIdx.x * 8 + (threadIdx.x >> 6);
        const float* GT = (const float*)(p.ws + OFF_GATES);
        float* SC = (float*)(p.ws + OFF_SCAN);
        for (int seg = gw; seg < 2304; seg += gridDim.x * 8) {
            const int step = seg % 18, dir = (seg / 18) & 1, hd = (seg / 36) & 7, b = seg / 288;
            int base, P0;
            if (step < 2) { base = 16384 + b * 256; P0 = (dir ? 1 - step : step) * 128; } else { base = b * 2048; P0 = (dir ? 17 - step : step - 2) * 128; }
            const int pa = dir ? P0 + 127 - lane : P0 + lane, pb = dir ? pa - 64 : pa + 64;
            const float* ga = GT + (size_t)(base + pa) * 32 + dir * 16 + hd; const float* gb = GT + (size_t)(base + pb) * 32 + dir * 16 + hd;
            const float i0 = ga[0], f0 = ga[8], i1 = gb[0], f1 = gb[8];
            float b0 = f0, b1 = f1;
#pragma unroll
            for (int off = 1; off < 64; off <<= 1) { float t0 = __shfl_up(b0, off), t1 = __shfl_up(b1, off); if (lane >= off) { b0 += t0; b1 += t1; } }
            b1 += __shfl(b0, 63);
            float p0 = i0 - b0, p1 = i1 - b1;
            const float c0 = p0, c1 = p1;
#pragma unroll
            for (int off = 1; off < 64; off <<= 1) { float t0 = __shfl_up(p0, off), t1 = __shfl_up(p1, off); if (lane >= off) { p0 = fmaxf(p0, t0); p1 = fmaxf(p1, t1); } }
            p1 = fmaxf(p1, __shfl(p0, 63));
            float* o = SC + (size_t)seg * 384;
            o[lane] = b0; o[64 + lane] = b1; o[128 + lane] = p0; o[192 + lane] = p1; o[256 + lane] = c0; o[320 + lane] = c1;
        }
    }
    for (int c = blockIdx.x * NTHREADS + threadIdx.x; c < 18432 * 128; c += gridDim.x * NTHREADS) {
        const int row = c >> 7, col = (c & 127) * 8;
        int T, t;
        if (row < 16384) { T = 2048; t = row & 2047; } else { T = 256; t = (row - 16384) & 255; }
        float acc[8];
        { const float4 b0 = *(const float4*)(p.ml_conv_b + col), b1 = *(const float4*)(p.ml_conv_b + col + 4);
          acc[0] = b0.x; acc[1] = b0.y; acc[2] = b0.z; acc[3] = b0.w; acc[4] = b1.x; acc[5] = b1.y; acc[6] = b1.z; acc[7] = b1.w; }
#pragma unroll
        for (int dj = 0; dj < 3; ++dj) {
            const int tt = t + dj - 1;
            const float on = (tt >= 0 && tt < T) ? 1.f : 0.f;
            const int rr = row + min(max(tt, 0), T - 1) - t;
            float f[8]; unpack8(*(const uint4*)(QK + (size_t)rr * 1024 + col), f);
            const float4 w0 = *(const float4*)(p.ml_conv_w + dj * 1024 + col), w1 = *(const float4*)(p.ml_conv_w + dj * 1024 + col + 4);
            acc[0] += w0.x * on * f[0]; acc[1] += w0.y * on * f[1]; acc[2] += w0.z * on * f[2]; acc[3] += w0.w * on * f[3];
            acc[4] += w1.x * on * f[4]; acc[5] += w1.y * on * f[5]; acc[6] += w1.z * on * f[6]; acc[7] += w1.w * on * f[7];
        }
        const float sc = col >= 512 ? 0.125f : 1.f;
#pragma unroll
        for (int i = 0; i < 8; ++i) acc[i] = siluf_(acc[i]) * sc;
        *(uint4*)(QC + (size_t)row * 1024 + col) = pack8(acc);
    }
}

DI void phase_mlstm(const Params& p, char* smem) {
    constexpr int LP = 72, TP = 136, L = 128;
    bf16_t* Qc = (bf16_t*)smem;
    bf16_t* Kc = Qc + L * LP;
    bf16_t* KcT = Kc + L * LP;
    bf16_t* VcT = KcT + 64 * TP;
    bf16_t* VwT = VcT + 64 * TP;
    bf16_t* Pm = VwT + 64 * TP;
    bf16_t* Cb = Pm + L * TP;
    float* fa = (float*)(Cb + 64 * LP);
    float* bcum = fa; float* ig = fa + 128; float* mtv = fa + 256; float* wint = fa + 384; float* denI = fa + 512; float* denX = fa + 640;
    float* wgt = fa + 768; float* nvec = fa + 896; float* scal = fa + 960; float* csv = fa + 1024; float* denP = fa + 1152;
    static_assert((2 * L * LP + 3 * 64 * TP + L * TP + 64 * LP) * 2 + 1408 * 4 <= SMEM_ALL, "mLSTM LDS");
    const int lane0 = threadIdx.x & 63, w = __builtin_amdgcn_readfirstlane(threadIdx.x >> 6);
    const bf16_t* QK = (const bf16_t*)(p.ws + OFF_H);
    const bf16_t* V1 = (const bf16_t*)(p.ws + OFF_V1);
    const float* GT = (const float*)(p.ws + OFF_GATES);
    for (int item = blockIdx.x; item < 256; item += gridDim.x) {
        const int vh = item & 1, dir = (item >> 1) & 1, hd = (item >> 2) & 7, b = item >> 5;
        bf16_t* Hout = (bf16_t*)(p.ws + (dir ? OFF_HB : OFF_HF));
        f32x16 accC = zero16();
        float m_prev = 0.f;
        for (int i = w * 64 + lane0; i < 64 * LP; i += 512) Cb[i] = 0;
        if (w == 0) nvec[lane0] = 0.f;
        int lane = lane0, tid = w * 64 + lane0, h = lane0 >> 5, r = lane0 & 31;
        int u = tid >> 2, part = tid & 3;
        uint4 rq0, rq1, rk0, rk1, rv0, rv1;
        float sc_b = 0.f, sc_p = 0.f, sc_c = 0.f, sc_bl = 0.f, sc_pl = 0.f;
#define ML_STEP_GEOM(st, base_, P0_) { if ((st) < 2) { base_ = 16384 + b * 256; P0_ = (dir ? 1 - (st) : (st)) * L; } else { base_ = b * 2048; P0_ = (dir ? 17 - (st) : (st) - 2) * L; } }
#define ML_PREFETCH(st) { int base_, P0_; ML_STEP_GEOM(st, base_, P0_) \
            const int pos_ = dir ? P0_ + L - 1 - u : P0_ + u; \
            { const bf16_t* rowp = QK + (size_t)(base_ + pos_) * 1024; \
              const int qcol = hd * 64 + part * 16, kcol = 512 + qcol; rq0 = *(const uint4*)(rowp + qcol); rq1 = *(const uint4*)(rowp + qcol + 8); rk0 = *(const uint4*)(rowp + kcol); rk1 = *(const uint4*)(rowp + kcol + 8); } \
            { const bf16_t* vp_ = V1 + (size_t)(base_ + pos_) * 1024 + hd * 128 + vh * 64 + part * 16; rv0 = *(const uint4*)vp_; rv1 = *(const uint4*)(vp_ + 8); } \
            if (w < 2) { const float* sp_ = (const float*)(p.ws + OFF_SCAN) + (size_t)((((b * 8 + hd) * 2 + dir) * 18) + (st)) * 384; \
                sc_b = sp_[tid]; sc_p = sp_[128 + tid]; sc_c = sp_[256 + tid]; sc_bl = sp_[127]; sc_pl = sp_[255]; } }
        ML_PREFETCH(0)
        __syncthreads();
#pragma unroll 1
        for (int step = 0; step < 18; ++step) {
            lane = lane0; asm volatile("" : "+v"(lane));
            tid = w * 64 + lane; h = lane >> 5; r = lane & 31; u = tid >> 2; part = tid & 3;
            int base, P0; ML_STEP_GEOM(step, base, P0)
            const bool full = step >= 2;
            if (w < 2) {
                const float mt = fmaxf(sc_b + m_prev, sc_b + sc_p);
                const float mnew = fmaxf(sc_bl + m_prev, sc_bl + sc_pl);
                bcum[tid] = sc_b; csv[tid] = sc_c; mtv[tid] = mt;
                wint[tid] = __expf(sc_b + m_prev - mt);
                wgt[tid] = __expf(sc_bl + sc_c - mnew);
                if (tid == 0) { scal[0] = mnew; scal[1] = __expf(sc_bl + m_prev - mnew); }
            }
            {
                *(uint4*)(Qc + u * LP + part * 16) = rq0; *(uint4*)(Qc + u * LP + part * 16 + 8) = rq1;
                *(uint4*)(Kc + u * LP + part * 16) = rk0; *(uint4*)(Kc + u * LP + part * 16 + 8) = rk1;
#define ML_T2(dstT, wv, ci) { dstT[(part * 16 + (ci)) * TP + u] = (bf16_t)((wv) & 0xffffu); dstT[(part * 16 + (ci) + 1) * TP + u] = (bf16_t)((wv) >> 16); }
                ML_T2(KcT, rk0.x, 0) ML_T2(KcT, rk0.y, 2) ML_T2(KcT, rk0.z, 4) ML_T2(KcT, rk0.w, 6) ML_T2(KcT, rk1.x, 8) ML_T2(KcT, rk1.y, 10) ML_T2(KcT, rk1.z, 12) ML_T2(KcT, rk1.w, 14)
                ML_T2(VcT, rv0.x, 0) ML_T2(VcT, rv0.y, 2) ML_T2(VcT, rv0.z, 4) ML_T2(VcT, rv0.w, 6) ML_T2(VcT, rv1.x, 8) ML_T2(VcT, rv1.y, 10) ML_T2(VcT, rv1.z, 12) ML_T2(VcT, rv1.w, 14)
#undef ML_T2
            }
            if (step + 1 < 18) ML_PREFETCH(step + 1)
            LDS_BARRIER();
            const float m_new = scal[0], decay = scal[1];
            {
                const int vv = tid >> 3, s0_ = (tid & 7) * 16;
#pragma unroll
                for (int q = 0; q < 2; ++q) {
                    float f[8]; unpack8(*(const uint4*)(VcT + vv * TP + s0_ + q * 8), f);
                    const float4 w0 = *(const float4*)(wgt + s0_ + q * 8), w1 = *(const float4*)(wgt + s0_ + q * 8 + 4);
                    f[0] *= w0.x; f[1] *= w0.y; f[2] *= w0.z; f[3] *= w0.w; f[4] *= w1.x; f[5] *= w1.y; f[6] *= w1.z; f[7] *= w1.w;
                    *(uint4*)(VwT + vv * TP + s0_ + q * 8) = pack8(f);
                }
            }
            if (full) {
                {
                    float sacc_ = 0.f;
#pragma unroll
                    for (int q = 0; q < 2; ++q) {
                        float f[8]; unpack8(*(const uint4*)(Qc + u * LP + part * 16 + q * 8), f);
                        const float4 n0 = *(const float4*)(nvec + part * 16 + q * 8), n1 = *(const float4*)(nvec + part * 16 + q * 8 + 4);
                        sacc_ += f[0] * n0.x + f[1] * n0.y + f[2] * n0.z + f[3] * n0.w + f[4] * n1.x + f[5] * n1.y + f[6] * n1.z + f[7] * n1.w;
                    }
                    sacc_ += __shfl_xor(sacc_, 1); sacc_ += __shfl_xor(sacc_, 2);
                    if (part == 0) denX[u] = sacc_;
                }
                const int ti = w >> 1, t = ti * 32 + r;
                const float bt = bcum[t] - mtv[t];
                float rs = 0.f;
#pragma unroll
                for (int q = 0; q < 2; ++q) {
                    const int si = 2 * (w & 1) + q;
                    if (si <= ti) {
                        f32x16 sacc = zero16();
#pragma unroll
                        for (int ks = 0; ks < 4; ++ks) {
                            bf16x8 a = *(const bf16x8*)(Kc + (si * 32 + r) * LP + ks * 16 + h * 8);
                            bf16x8 bb = *(const bf16x8*)(Qc + (ti * 32 + r) * LP + ks * 16 + h * 8);
                            sacc = MFMA(a, bb, sacc);
                        }
#pragma unroll
                        for (int g4 = 0; g4 < 4; ++g4) {
                            const int s0_ = si * 32 + 8 * g4 + 4 * h;
                            const float4 c4 = *(const float4*)(csv + s0_);
                            float p0 = s0_ + 0 <= t ? sacc[4 * g4 + 0] * __expf(bt + c4.x) : 0.f;
                            float p1 = s0_ + 1 <= t ? sacc[4 * g4 + 1] * __expf(bt + c4.y) : 0.f;
                            float p2 = s0_ + 2 <= t ? sacc[4 * g4 + 2] * __expf(bt + c4.z) : 0.f;
                            float p3 = s0_ + 3 <= t ? sacc[4 * g4 + 3] * __expf(bt + c4.w) : 0.f;
                            rs += (p0 + p1) + (p2 + p3);
                            uint2 pk; pk.x = pack2(p0, p1); pk.y = pack2(p2, p3);
                            *(uint2*)(Pm + t * TP + s0_) = pk;
                        }
                    } else {
#pragma unroll
                        for (int g4 = 0; g4 < 4; ++g4) *(uint2*)(Pm + t * TP + si * 32 + 8 * g4 + 4 * h) = make_uint2(0u, 0u);
                    }
                }
                rs += __shfl_xor(rs, 32);
                if (h == 0) denP[(w & 1) * 128 + t] = rs;
            }
            LDS_BARRIER();
            f32x16 hacc = zero16();
            const int ti = w >> 1, vi = w & 1;
            if (full) {
#pragma unroll
                for (int ks = 0; ks < 4; ++ks) {
                    bf16x8 a = *(const bf16x8*)(Cb + (vi * 32 + r) * LP + ks * 16 + h * 8);
                    bf16x8 bb = *(const bf16x8*)(Qc + (ti * 32 + r) * LP + ks * 16 + h * 8);
                    hacc = MFMA(a, bb, hacc);
                }
                const float wi = wint[ti * 32 + r];
#pragma unroll
                for (int g = 0; g < 16; ++g) hacc[g] *= wi;
#pragma unroll
                for (int ks = 0; ks < 8; ++ks) {
                    if (ks <= 2 * ti + 1) {
                        bf16x8 a = *(const bf16x8*)(VcT + (vi * 32 + r) * TP + ks * 16 + h * 8);
                        bf16x8 bb = *(const bf16x8*)(Pm + (ti * 32 + r) * TP + ks * 16 + h * 8);
                        hacc = MFMA(a, bb, hacc);
                    }
                }
            }
            LDS_BARRIER();
            if (full) {
                const int t = ti * 32 + r;
                const float den = wint[t] * denX[t] + denP[t] + denP[128 + t];
                const float inv = __builtin_amdgcn_rcpf(fmaxf(fabsf(den), __expf(-mtv[t])));
                bf16_t* hp = Pm + t * LP + vi * 32 + 4 * h;
#pragma unroll
                for (int g4 = 0; g4 < 4; ++g4) {
                    uint2 pk; pk.x = pack2(hacc[4 * g4] * inv, hacc[4 * g4 + 1] * inv); pk.y = pack2(hacc[4 * g4 + 2] * inv, hacc[4 * g4 + 3] * inv);
                    *(uint2*)(hp + 8 * g4) = pk;
                }
            }
            if (w < 4) {
                const int vi2 = w >> 1, di = w & 1;
#pragma unroll
                for (int g = 0; g < 16; ++g) accC[g] *= decay;
#pragma unroll
                for (int ks = 0; ks < 8; ++ks) {
                    bf16x8 a = *(const bf16x8*)(VwT + (vi2 * 32 + r) * TP + ks * 16 + h * 8);
                    bf16x8 bb = *(const bf16x8*)(KcT + (di * 32 + r) * TP + ks * 16 + h * 8);
                    accC = MFMA(a, bb, accC);
                }
#pragma unroll
                for (int g = 0; g < 16; ++g) Cb[(vi2 * 32 + crow(g, h)) * LP + di * 32 + r] = f2bf_sw(accC[g]);
            } else {
                const int t2 = tid - 256, d = t2 >> 2, pq = t2 & 3;
                float sacc_ = 0.f;
#pragma unroll
                for (int q = 0; q < 4; ++q) {
                    float f[8]; unpack8(*(const uint4*)(KcT + d * TP + pq * 32 + q * 8), f);
                    const float4 w0 = *(const float4*)(wgt + pq * 32 + q * 8), w1 = *(const float4*)(wgt + pq * 32 + q * 8 + 4);
                    sacc_ += f[0] * w0.x + f[1] * w0.y + f[2] * w0.z + f[3] * w0.w + f[4] * w1.x + f[5] * w1.y + f[6] * w1.z + f[7] * w1.w;
                }
                sacc_ += __shfl_xor(sacc_, 1); sacc_ += __shfl_xor(sacc_, 2);
                if (pq == 0) nvec[d] = decay * nvec[d] + sacc_;
            }
            m_prev = m_new;
            LDS_BARRIER();
            if (full) {
#pragma unroll
                for (int q = 0; q < 2; ++q) {
                    const int c = tid + 512 * q, t = c >> 3, ch = c & 7;
                    const int pos = dir ? P0 + L - 1 - t : P0 + t;
                    *(uint4*)(Hout + (size_t)(base + pos) * 1024 + hd * 128 + vh * 64 + ch * 8) = *(const uint4*)(Pm + t * LP + ch * 8);
                }
            }
        }
#undef ML_STEP_GEOM
#undef ML_PREFETCH
    }
}

DI void phase_mix(const Params& p) {
    const int lane = threadIdx.x & 63, w = threadIdx.x >> 6;
    const bf16_t* HF = (const bf16_t*)(p.ws + OFF_HF);
    const bf16_t* HB = (const bf16_t*)(p.ws + OFF_HB);
    const bf16_t* OG = (const bf16_t*)(p.ws + OFF_OG);
    bf16_t* H = (bf16_t*)(p.ws + OFF_H);
    for (int row = blockIdx.x * 8 + w; row < 16384; row += gridDim.x * 8) {
        const size_t o = (size_t)row * 1024 + lane * 16;
        float a[16], bq[16], og[16];
        unpack8(*(const uint4*)(HF + o), a); unpack8(*(const uint4*)(HF + o + 8), a + 8);
        unpack8(*(const uint4*)(HB + o), bq); unpack8(*(const uint4*)(HB + o + 8), bq + 8);
        unpack8(*(const uint4*)(OG + o), og); unpack8(*(const uint4*)(OG + o + 8), og + 8);
        float ss = 0.f;
#pragma unroll
        for (int i = 0; i < 16; ++i) { a[i] += bq[i]; ss += a[i] * a[i]; }
        ss += __shfl_xor(ss, 1); ss += __shfl_xor(ss, 2); ss += __shfl_xor(ss, 4);
        const float rstd = rsqrtf(ss * (1.f / 128.f) + EPSF);
        const float* g = p.ml_out_g + lane * 16;
#pragma unroll
        for (int i = 0; i < 16; ++i) a[i] = a[i] * rstd * g[i] * sigmoidf_(og[i]);
        *(uint4*)(H + o) = pack8(a); *(uint4*)(H + o + 8) = pack8(a + 8);
    }
}

#define XB_TMO      128
#define XB_XCNT(j)  (256  + 64 * (j))
#define XB_XSUB(j)  (1280 + 64 * (j))
#define XB_XGEN(j)  (2304 + 64 * (j))
#define XB_TOP      3328
#define XB_TOPGEN   3392
#define XCD_BAR_WORDS 3456
#define XB_SPIN_CAP (1u << 18)
#define LAS __attribute__((address_space(3)))

__device__ __forceinline__ unsigned xb_ld(unsigned* p)              { return __hip_atomic_load(p, __ATOMIC_RELAXED, __HIP_MEMORY_SCOPE_AGENT); }
__device__ __forceinline__ unsigned xb_add(unsigned* p, unsigned v) { return __hip_atomic_fetch_add(p, v, __ATOMIC_RELAXED, __HIP_MEMORY_SCOPE_AGENT); }
__device__ __forceinline__ unsigned xb_xcc_id() { return (unsigned)__builtin_amdgcn_s_getreg((3 << 11) | 20) & 0xFu; }
#define XB_SPIN(cond, bar) do { unsigned _sp = 0; while (cond) { __builtin_amdgcn_s_sleep(1); \
    if ((++_sp & 255u) == 0u) { if (xb_ld(&(bar)[XB_TMO])) break; if (_sp > XB_SPIN_CAP) { atomicAdd(&(bar)[XB_TMO], 1u); break; } } } } while (0)

struct XcdBarrier {
    unsigned* bar; unsigned x;
    volatile LAS unsigned* st;
};

__device__ __forceinline__ XcdBarrier xcd_barrier_post(unsigned* bar, volatile LAS unsigned* st) {
    XcdBarrier b; b.bar = bar; b.x = xb_xcc_id(); b.st = st;
    if (threadIdx.x == 0) (void)xb_add(&bar[XB_XCNT(b.x)], 1u);
    return b;
}
__device__ __forceinline__ void xcd_barrier_complete(unsigned* bar, unsigned x, unsigned& nloc, unsigned& nx) {
    const unsigned G = gridDim.x * gridDim.y * gridDim.z;
    unsigned sum, cnt, mine, sp = 0u;
    for (;;) {
        sum = 0u; cnt = 0u; mine = 0u;
#pragma unroll
        for (unsigned j = 0; j < 16; ++j) { const unsigned c = xb_ld(&bar[XB_XCNT(j)]); sum += c; cnt += (c > 0u) ? 1u : 0u; mine = (j == x) ? c : mine; }
        if (sum == G) break;
        __builtin_amdgcn_s_sleep(1);
        if ((++sp & 255u) == 0u) { if (xb_ld(&bar[XB_TMO])) break; if (sp > XB_SPIN_CAP) { atomicAdd(&bar[XB_TMO], 1u); break; } }
    }
    nloc = mine > 0u ? mine : 1u; nx = cnt > 0u ? cnt : 1u;
}

__device__ __forceinline__ void xcd_barrier(const XcdBarrier& b) {
    asm volatile("s_waitcnt vmcnt(0)" ::: "memory");
    __syncthreads();
    if (threadIdx.x == 0) {
        unsigned* bar = b.bar;
        __builtin_amdgcn_s_waitcnt(0);
        unsigned nloc = b.st[0], nx = b.st[1];
        if (nloc == 0u) { xcd_barrier_complete(bar, b.x, nloc, nx); b.st[0] = nloc; b.st[1] = nx; }
        const unsigned old = xb_add(&bar[XB_XSUB(b.x)], 1u);
        const unsigned gen = old / nloc;
        if (old + 1u == (gen + 1u) * nloc) {
            __builtin_amdgcn_fence(__ATOMIC_RELEASE, "agent");
            asm volatile("s_waitcnt vmcnt(0)" ::: "memory");
            const unsigned og = xb_add(&bar[XB_TOP], 1u);
            const unsigned tg = og / nx;
            if (og + 1u == (tg + 1u) * nx) xb_add(&bar[XB_TOPGEN], 1u);
            else XB_SPIN(xb_ld(&bar[XB_TOPGEN]) == tg, bar);
            __builtin_amdgcn_fence(__ATOMIC_ACQUIRE, "agent");
            xb_add(&bar[XB_XGEN(b.x)], 1u);
            asm volatile("s_waitcnt vmcnt(0)" ::: "memory");
        } else {
            XB_SPIN(xb_ld(&bar[XB_XGEN(b.x)]) == gen, bar);
            __builtin_amdgcn_fence(__ATOMIC_ACQUIRE, "agent");
            asm volatile("s_waitcnt vmcnt(0)" ::: "memory");
        }
    }
    __syncthreads();
}


__global__ void __launch_bounds__(NTHREADS, 2) __attribute__((amdgpu_waves_per_eu(2, 2))) fwd_megakernel(Params p) {
    __shared__ __attribute__((aligned(1024))) char smem[SMEM_ALL];
    cg::grid_group grid = cg::this_grid();
    __shared__ uint4 xb_words;
    if (threadIdx.x == 0) xb_words = make_uint4(0u, 0u, 0u, 0u);
    __syncthreads();
    XcdBarrier xb = xcd_barrier_post((unsigned*)(p.ws + OFF_BAR), (volatile LAS unsigned*)&xb_words);
    const float* MOD0 = (const float*)(p.ws + OFF_MOD);
    const float* MOD1 = MOD0 + 9 * 6144;
    float* XRC = (float*)(p.ws + OFF_XRC);
    const bf16_t* Hb = (const bf16_t*)(p.ws + OFF_H);

    phase0(p, smem);
    if (p.ws == nullptr) grid.sync();
    xcd_barrier(xb);
    phase_norm(p, p.x, p.ctx, p.norm1_g, MOD0, 0, 18432);
    xcd_barrier(xb);
    phase_inproj0(p, smem);
    xcd_barrier(xb);
    phase_mla_up(p, smem);
    xcd_barrier(xb);
    phase_attn(p, smem);
    xcd_barrier(xb);
    phase_proj_resid(p, Hb, 1024, (const bf16_t*)(p.ws + OFF_WT_OUT0), MOD0, 2, p.x, p.ctx, p.out, XRC, 64, true, WT_UP0_0, WT_UP0_N, smem);
    xcd_barrier(xb);
    phase_norm(p, p.out, XRC, p.norm2_g, MOD0, 3, 18432);
    xcd_barrier(xb);
    phase_ffn_up(p, (const bf16_t*)(p.ws + OFF_WT_UP0), p.ffn_conv_w, p.ffn_conv_b, 80, WT_DOWN0_0, WT_DOWN0_N, smem);
    xcd_barrier(xb);
    phase_proj_resid(p, (const bf16_t*)(p.ws + OFF_ACT), 2816, (const bf16_t*)(p.ws + OFF_WT_DOWN0), MOD0, 5, p.out, XRC, p.out, XRC, 64, true, WT_L1_0, WT_L1_N, smem);
    xcd_barrier(xb);
    phase_norm(p, p.out, XRC, p.norm1_g + 1024, MOD1, 0, 18432);
    xcd_barrier(xb);
    phase_inproj1(p, smem);
    xcd_barrier(xb);
    phase_qkconv(p);
    xcd_barrier(xb);
    phase_mlstm(p, smem);
    xcd_barrier(xb);
    phase_mix(p);
    xcd_barrier(xb);
    phase_proj_resid(p, Hb, 1024, (const bf16_t*)(p.ws + OFF_WT_OUT1), MOD1, 2, p.out, XRC, p.out, XRC, 64, false, 0, 0, smem);
    xcd_barrier(xb);
    phase_norm(p, p.out, XRC, p.norm2_g + 1024, MOD1, 3, 16384);
    xcd_barrier(xb);
    phase_ffn_up(p, (const bf16_t*)(p.ws + OFF_WT_UP1), p.ffn_conv_w + 3 * 2816, p.ffn_conv_b + 2816, 68, 0, 0, smem);
    xcd_barrier(xb);
    phase_proj_resid(p, (const bf16_t*)(p.ws + OFF_ACT), 2816, (const bf16_t*)(p.ws + OFF_WT_DOWN1), MOD1, 5, p.out, XRC, p.out, XRC, 64, false, 0, 0, smem);
}

extern "C" void kernel_launch(void* const* d_in, const int* in_sizes, int n_in, void* d_out, int out_size, void* d_ws, size_t ws_size,
                              hipStream_t stream) {
    static int grid_blocks = 0;
    if (!grid_blocks) {
        int dev = 0, cus = 0, per_cu = 0;
        hipGetDevice(&dev);
        hipDeviceGetAttribute(&cus, hipDeviceAttributeMultiprocessorCount, dev);
        hipOccupancyMaxActiveBlocksPerMultiprocessor(&per_cu, fwd_megakernel, NTHREADS, 0);
        if (per_cu < 1) per_cu = 1;
        if (per_cu > 1) per_cu = 1;
        grid_blocks = cus * per_cu;
        if (ws_size < WS_END) fprintf(stderr, "kernel_launch: workspace too small: %zu < %zu\n", ws_size, (size_t)WS_END);
    }
    Params p{};
    const float** pf = (const float**)&p;
    for (int i = 0; i < 28; ++i) pf[i] = (const float*)d_in[i];
    p.out = (float*)d_out;
    p.ws = (char*)d_ws;
    hipMemsetAsync((char*)d_ws + OFF_BAR, 0, 16384, stream);
    void* args[] = {&p};
    hipError_t e = hipLaunchCooperativeKernel((void*)fwd_megakernel, dim3(grid_blocks), dim3(NTHREADS), args, 0, stream);
    if (e != hipSuccess) fprintf(stderr, "cooperative launch failed: %s (grid %d)\n", hipGetErrorString(e), grid_blocks);
}
```
